# Optimizing an MI355X kernel written in HIP

```python
import jax, jax.numpy as jnp
from jax import lax
import numpy as np

D_MODEL = 1024
BATCH = 8
SEQ = 4096
DEPTH = 4

HEAD_DIM = 64
N_HEADS_TOTAL = D_MODEL // HEAD_DIM
A_Q_HEADS = N_HEADS_TOTAL // 4
A_KV_HEADS = max(1, A_Q_HEADS // 2)
B_HEADS = (N_HEADS_TOTAL - A_Q_HEADS) // 2
C_HEADS = N_HEADS_TOTAL - A_Q_HEADS - B_HEADS
A_Q_W = A_Q_HEADS * HEAD_DIM
A_KV_W = A_KV_HEADS * HEAD_DIM
B_W = B_HEADS * HEAD_DIM
C_W = C_HEADS * HEAD_DIM
MIX_W = A_Q_W + B_W + C_W
IN_COLS = A_Q_W + 2 * A_KV_W + 3 * B_W + 3 * C_W

GRID_W = 64
AXIAL_THETA = 10000.0
NA_ROWS_MAX = 8
NA_COLS = 16
C_BRANCHES = ((128, 1), (512, 4), (2048, 16))
ROPE_THETA = 500000.0
ROPE_DIMS = HEAD_DIM // 4
Q_BLOCK = 128
N_EXPERTS = 16
EC_CAPACITY = 2
D_FF_EXPERT = 1024
D_PLE = 256
EPS = 1e-6
NEG_INF = -1e30

kernel_name = "hybrid_parallel_heads_ec_moe_encoder"


def rmsnorm(x, g):
    xf = x.astype(jnp.float32)
    y = xf * lax.rsqrt(jnp.mean(xf * xf, axis=-1, keepdims=True) + EPS)
    return (y * g.astype(jnp.float32)).astype(x.dtype)


def rope_angles(pos_f, n, theta):
    inv = theta ** (-jnp.arange(0, n, 2, dtype=jnp.float32) / n)
    return pos_f[:, None] * inv[None, :]


def apply_rope(x, ang):
    half = x.shape[-1] // 2
    xf = x.astype(jnp.float32)
    c = jnp.cos(ang)[None, :, None, :]
    s = jnp.sin(ang)[None, :, None, :]
    x1, x2 = xf[..., :half], xf[..., half:]
    return jnp.concatenate([x1 * c - x2 * s, x1 * s + x2 * c], axis=-1).astype(x.dtype)


def axial_rope(x, ang_row, ang_col):
    half = x.shape[-1] // 2
    return jnp.concatenate([apply_rope(x[..., :half], ang_row),
                            apply_rope(x[..., half:], ang_col)], axis=-1)


def partial_rope(x, ang):
    return jnp.concatenate([apply_rope(x[..., :ROPE_DIMS], ang), x[..., ROPE_DIMS:]], axis=-1)


def axial_gqa(q, k, v):
    bsz, seq, hq, dh = q.shape
    hkv = k.shape[2]
    grp = hq // hkv
    nblk = seq // Q_BLOCK
    scale = dh ** -0.5
    qb = q.reshape(bsz, nblk, Q_BLOCK, hkv, grp, dh).transpose(1, 0, 3, 4, 2, 5)

    def block(qblk):
        s = jnp.einsum("bkgqd,bskd->bkgqs", qblk, k).astype(jnp.float32) * scale
        pr = jax.nn.softmax(s, axis=-1).astype(v.dtype)
        return jnp.einsum("bkgqs,bskd->bkgqd", pr, v)

    o = lax.map(block, qb)
    return o.transpose(1, 0, 4, 2, 3, 5).reshape(bsz, seq, hq * dh)


def neighbourhood_attn(q, k, v, rpb):
    bsz, seq, nh, dh = q.shape
    rows = seq // GRID_W
    wr = min(NA_ROWS_MAX, rows)
    scale = dh ** -0.5
    qg = q.reshape(bsz, rows, GRID_W, nh, dh).transpose(1, 0, 3, 2, 4)
    kg = k.reshape(bsz, rows, GRID_W, nh, dh).transpose(0, 3, 1, 2, 4)
    vg = v.reshape(bsz, rows, GRID_W, nh, dh).transpose(0, 3, 1, 2, 4)
    cols = jnp.arange(GRID_W)
    cstart = jnp.clip(cols - NA_COLS // 2, 0, GRID_W - NA_COLS)
    colidx = cstart[:, None] + jnp.arange(NA_COLS)[None, :]
    coloff = colidx - cols[:, None] + (NA_COLS - 1)

    def row_block(args):
        r, qrow = args
        rs = jnp.clip(r - wr // 2, 0, rows - wr)
        krows = lax.dynamic_slice_in_dim(kg, rs, wr, axis=2)
        vrows = lax.dynamic_slice_in_dim(vg, rs, wr, axis=2)
        kwin = krows[:, :, :, colidx, :]
        vwin = vrows[:, :, :, colidx, :]
        rowoff = rs + jnp.arange(wr) - r + (NA_ROWS_MAX - 1)
        bias = rpb[:, rowoff[:, None, None], coloff[None, :, :]]
        s = jnp.einsum("bhcd,bhrcjd->bhcrj", qrow, kwin).astype(jnp.float32) * scale
        s = s + bias.transpose(0, 2, 1, 3)[None].astype(jnp.float32)
        pr = jax.nn.softmax(s.reshape(s.shape[:3] + (wr * NA_COLS,)), axis=-1)
        pr = pr.reshape(s.shape).astype(v.dtype)
        return jnp.einsum("bhcrj,bhrcjd->bhcd", pr, vwin)

    o = lax.map(row_block, (jnp.arange(rows), qg))
    return o.transpose(1, 0, 3, 2, 4).reshape(bsz, seq, nh * dh)


def banded_attn(q, k, v, half):
    n, nh, length, dh = q.shape
    scale = dh ** -0.5
    nblk = -(-length // Q_BLOCK)
    lpad = nblk * Q_BLOCK
    span = Q_BLOCK + 2 * half
    qp = jnp.pad(q, ((0, 0), (0, 0), (0, lpad - length), (0, 0)))
    kp = jnp.pad(k, ((0, 0), (0, 0), (half, lpad - length + half), (0, 0)))
    vp = jnp.pad(v, ((0, 0), (0, 0), (half, lpad - length + half), (0, 0)))
    kidx = jnp.arange(nblk)[:, None] * Q_BLOCK + jnp.arange(span)[None, :]
    kb = kp[:, :, kidx]
    vb = vp[:, :, kidx]
    qpos = jnp.arange(nblk)[:, None] * Q_BLOCK + jnp.arange(Q_BLOCK)[None, :]
    kpos = kidx - half
    mask = ((jnp.abs(qpos[:, :, None] - kpos[:, None, :]) <= half)
            & ((kpos >= 0) & (kpos < length))[:, None, :])
    qr = qp.reshape(n, nh, nblk, Q_BLOCK, dh)
    s = jnp.einsum("nhbqd,nhbkd->nhbqk", qr, kb).astype(jnp.float32) * scale
    s = jnp.where(mask[None, None], s, NEG_INF)
    m = jnp.max(s, axis=-1, keepdims=True)
    e = jnp.exp(s - m)
    l = jnp.sum(e, axis=-1, keepdims=True)
    o = jnp.einsum("nhbqk,nhbkd->nhbqd", (e / l).astype(v.dtype), vb)
    lse = (m + jnp.log(l))[..., 0]
    o = o.reshape(n, nh, lpad, dh)[:, :, :length]
    lse = lse.reshape(n, nh, lpad)[:, :, :length]
    return o, lse


def dilated_mixture(q, k, v):
    bsz, seq, nh, dh = q.shape
    outs, lses = [], []
    for window, dil in C_BRANCHES:
        half = window // 2 // dil
        length = seq // dil

        def to_classes(t):
            return t.reshape(bsz, length, dil, nh, dh).transpose(0, 2, 3, 1, 4).reshape(bsz * dil, nh, length, dh)

        o, lse = banded_attn(to_classes(q), to_classes(k), to_classes(v), half)
        outs.append(o.reshape(bsz, dil, nh, length, dh).transpose(0, 3, 1, 2, 4).reshape(bsz, seq, nh, dh))
        lses.append(lse.reshape(bsz, dil, nh, length).transpose(0, 3, 1, 2).reshape(bsz, seq, nh))
    w = jax.nn.softmax(jnp.stack(lses, axis=0), axis=0)
    o = jnp.sum(w[..., None] * jnp.stack(outs, axis=0).astype(jnp.float32), axis=0)
    return o.astype(q.dtype).reshape(bsz, seq, nh * dh)


def expert_choice_ffn(h, w_router, w_gate, w_up, w_down):
    bsz, seq, d = h.shape
    cap = max(1, EC_CAPACITY * seq // N_EXPERTS)
    logits = jnp.einsum("bsd,de->bse", h, w_router).astype(jnp.float32)
    aff = jax.nn.softmax(logits, axis=-1)
    gates, idx = lax.top_k(aff.transpose(0, 2, 1), cap)
    xg = jax.vmap(lambda hb, ib: hb[ib])(h, idx)
    hid = jax.nn.silu(jnp.einsum("becd,edf->becf", xg, w_gate)) * jnp.einsum("becd,edf->becf", xg, w_up)
    y = jnp.einsum("becf,efd->becd", hid, w_down) * gates[..., None].astype(h.dtype)
    return jax.vmap(lambda yb, ib: jax.ops.segment_sum(yb.reshape(-1, d), ib.reshape(-1), num_segments=seq))(y, idx)


def split_heads(t, n):
    return t.reshape(t.shape[0], t.shape[1], n, HEAD_DIM)


def setup_inputs(seed: int = 0) -> dict:
    key = jax.random.key(seed)
    ks = jax.random.split(key, 20)
    f32 = jnp.float32
    nrm = lambda k, shape, sc: jax.random.normal(k, shape, f32) * sc
    gain = lambda k, shape: 1.0 + 0.05 * jax.random.normal(k, shape, f32)
    return {
        "x": nrm(ks[0], (BATCH, SEQ, D_MODEL), 1.0),
        "p": nrm(ks[1], (DEPTH, BATCH, SEQ, D_PLE), 1.0),
        "g_mix": gain(ks[2], (DEPTH, D_MODEL)),
        "w_in": nrm(ks[3], (DEPTH, D_MODEL, IN_COLS), D_MODEL ** -0.5),
        "qk_gain": gain(ks[4], (DEPTH, 3, 2, HEAD_DIM)),
        "na_bias": nrm(ks[5], (DEPTH, B_HEADS, 2 * NA_ROWS_MAX - 1, 2 * NA_COLS - 1), 0.1),
        "g_out": gain(ks[6], (DEPTH, MIX_W)),
        "w_out": nrm(ks[7], (DEPTH, MIX_W, D_MODEL), MIX_W ** -0.5),
        "g_ffn": gain(ks[8], (DEPTH, D_MODEL)),
        "w_router": nrm(ks[9], (DEPTH, D_MODEL, N_EXPERTS), D_MODEL ** -0.5),
        "w_gate": nrm(ks[10], (DEPTH, N_EXPERTS, D_MODEL, D_FF_EXPERT), D_MODEL ** -0.5),
        "w_up": nrm(ks[11], (DEPTH, N_EXPERTS, D_MODEL, D_FF_EXPERT), D_MODEL ** -0.5),
        "w_down": nrm(ks[12], (DEPTH, N_EXPERTS, D_FF_EXPERT, D_MODEL), D_FF_EXPERT ** -0.5),
        "g_ple": gain(ks[13], (DEPTH, D_MODEL)),
        "w_ple_gate": nrm(ks[14], (DEPTH, D_MODEL, D_MODEL), D_MODEL ** -0.5),
        "w_ple_proj": nrm(ks[15], (DEPTH, D_PLE, D_MODEL), D_PLE ** -0.5),
    }


def reference(x, p, g_mix, w_in, qk_gain, na_bias, g_out, w_out, g_ffn, w_router,
              w_gate, w_up, w_down, g_ple, w_ple_gate, w_ple_proj):
    bsz, seq, _ = x.shape
    pos = jnp.arange(seq)
    ang_row = rope_angles((pos // GRID_W).astype(jnp.float32), HEAD_DIM // 2, AXIAL_THETA)
    ang_col = rope_angles((pos % GRID_W).astype(jnp.float32), HEAD_DIM // 2, AXIAL_THETA)
    ang_1d = rope_angles(pos.astype(jnp.float32), ROPE_DIMS, ROPE_THETA)
    sizes = [A_Q_W, A_KV_W, A_KV_W, B_W, B_W, B_W, C_W, C_W, C_W]
    cuts = np.cumsum(sizes)[:-1].tolist()
    out_cuts = [A_Q_W, A_Q_W + B_W]
    h = x
    for i in range(DEPTH):
        a = rmsnorm(h, g_mix[i])
        proj = jnp.einsum("bsd,dc->bsc", a, w_in[i])
        qa, ka, va, qb, kb, vb, qc, kc, vc = jnp.split(proj, cuts, axis=-1)
        qg = qk_gain[i]
        qa = axial_rope(rmsnorm(split_heads(qa, A_Q_HEADS), qg[0, 0]), ang_row, ang_col)
        ka = axial_rope(rmsnorm(split_heads(ka, A_KV_HEADS), qg[0, 1]), ang_row, ang_col)
        oa = axial_gqa(qa, ka, split_heads(va, A_KV_HEADS))
        ob = neighbourhood_attn(rmsnorm(split_heads(qb, B_HEADS), qg[1, 0]),
                                rmsnorm(split_heads(kb, B_HEADS), qg[1, 1]),
                                split_heads(vb, B_HEADS), na_bias[i])
        qc = partial_rope(rmsnorm(split_heads(qc, C_HEADS), qg[2, 0]), ang_1d)
        kc = partial_rope(rmsnorm(split_heads(kc, C_HEADS), qg[2, 1]), ang_1d)
        oc = dilated_mixture(qc, kc, split_heads(vc, C_HEADS))
        ga, gb, gc = jnp.split(g_out[i], out_cuts)
        mixed = jnp.concatenate([rmsnorm(oa, ga), rmsnorm(ob, gb), rmsnorm(oc, gc)], axis=-1)
        h = h + jnp.einsum("bsc,cd->bsd", mixed, w_out[i])
        h = h + expert_choice_ffn(rmsnorm(h, g_ffn[i]), w_router[i], w_gate[i], w_up[i], w_down[i])
        gate = jax.nn.sigmoid(jnp.einsum("bsd,de->bse", rmsnorm(h, g_ple[i]), w_ple_gate[i]).astype(jnp.float32))
        h = h + (gate * jnp.einsum("bsk,kd->bsd", p[i], w_ple_proj[i]).astype(jnp.float32)).astype(h.dtype)
    return h
```

```cpp
#include <hip/hip_runtime.h>
#include <cstdio>
#include <cstdint>
#include <cmath>
namespace pg8 {
#define PG8_LAS __attribute__((address_space(3)))
typedef unsigned short bf16_t;
typedef short bf16x8 __attribute__((ext_vector_type(8)));
typedef float f32x4 __attribute__((ext_vector_type(4)));
typedef unsigned u32x4 __attribute__((ext_vector_type(4)));
constexpr int BM = 256, BK = 64, HALF = 128, HTB = HALF * BK * 2  , STAGE_BYTES = 8 * HTB, NXCD = 8, WGM = 8;

__host__ __device__ __forceinline__ int lds_byte(int r, int c) { const int st = (r >> 4) * 2 + (c >> 5), rr = r & 15, cc = c & 31, ob = rr * 64 + cc * 2; return st * 1024 + (ob ^ (((ob >> 9) & 1) << 5)); }
__host__ __device__ __forceinline__ void stage_rc(int b, int& R, int& C) { const int st = b / 1024, sb = b % 1024, swz = sb ^ (((sb >> 9) & 1) << 5); R = (st >> 1) * 16 + swz / 64; C = (st & 1) * 32 + (swz % 64) / 2; }
__host__ __device__ __forceinline__ int perm32(int rho) { const int n = rho >> 4, i = rho & 15; return 8 * (i >> 2) + 4 * n + (i & 3); }

struct Unit { int pm, pn; };
struct Gemm { const bf16_t* A; const bf16_t* Bt; int M, N, K; };

struct StaticOrder {
    int nM, nN, nwg, G, c;
    __host__ __device__ void init(int M, int N, int G_, int c_) { nM = M / BM; nN = N / BM; nwg = nM * nN; G = G_; c = c_; }
    __host__ __device__ bool next(int i, Unit& u) const {
        const long L = (long)i * G + c; if (L >= nwg) return false;
        int wgid = (int)L; { const int q = nwg / NXCD, r = nwg % NXCD, xcd = wgid % NXCD, off = wgid / NXCD; wgid = (xcd < r ? xcd * (q + 1) : r * (q + 1) + (xcd - r) * q) + off; }
        const int nig = WGM * nN, gid = wgid / nig, fm = gid * WGM, gsz = (nM - fm) < WGM ? (nM - fm) : WGM;
        u.pm = fm + ((wgid % nig) % gsz); u.pn = (wgid % nig) / gsz; return true;
    }
    __device__ __forceinline__ void a_ready(const Unit&) const {}
    __device__ __forceinline__ void done(const Unit&) const {}
};

__device__ __forceinline__ unsigned cvt_pk_bf16(float lo, float hi) { unsigned r; asm volatile("v_cvt_pk_bf16_f32 %0, %1, %2" : "=v"(r) : "v"(lo), "v"(hi)); return r; }
typedef float f32x2 __attribute__((ext_vector_type(2)));
__device__ __forceinline__ f32x2 gelu_pk(f32x2 v) {
    const f32x2 av = __builtin_elementwise_abs(v), d = av * 0.2316418882f + 1.0f;
    f32x2 t; t.x = __builtin_amdgcn_rcpf(d.x); t.y = __builtin_amdgcn_rcpf(d.y);
    f32x2 q = t * 0.5307027145f + (-0.7265760135f); q = q * t + 0.7107068705f; q = q * t + (-0.142248368f); q = q * t + 0.127414796f; q = q * t;
    const f32x2 s = (v * v) * (-0.72134752044f);
    f32x2 e; e.x = __builtin_amdgcn_exp2f(s.x); e.y = __builtin_amdgcn_exp2f(s.y);
    const f32x2 m = v * (q * e), r = v - m;
    f32x2 o; o.x = v.x < 0.f ? m.x : r.x; o.y = v.y < 0.f ? m.y : r.y; return o;
}

template <int ACT  > struct EpiBf16 {
    static constexpr bool PERM = true, AFTER_DRAIN = false; static_assert(ACT == 0 || ACT == 1, "EpiBf16: ACT is 0 (none) or 1 (gelu_pk)");
    bf16_t* O; int ldc; const float* bias; int split_cols; size_t split_stride; float scale0;
    __device__ __forceinline__ void operator()(const f32x4 (&acc)[2][2][4][2], const Unit& u, int wr, int wc, int fr, int fq) const {
        const int row0 = u.pm * BM + wr * 64 + fr; int colt = u.pn * BM; bf16_t* base = O;
        float sc = 1.f; if (split_cols) { const int t = colt / split_cols; base += (size_t)t * split_stride; colt -= t * split_cols; if (t == 0) sc = scale0; }
        const int col0 = colt + wc * 32 + 8 * fq, bcol0 = u.pn * BM + wc * 32 + 8 * fq;
        f32x4 bv[2][2];
#pragma unroll
        for (int bj = 0; bj < 2; ++bj)
#pragma unroll
            for (int n = 0; n < 2; ++n) bv[bj][n] = bias ? *(const f32x4*)(bias + bcol0 + bj * HALF + 4 * n) : (f32x4){0.f, 0.f, 0.f, 0.f};
#pragma unroll
        for (int ai = 0; ai < 2; ++ai)
#pragma unroll
            for (int m = 0; m < 4; ++m) { bf16_t* rowp = base + (size_t)(row0 + ai * HALF + m * 16) * ldc + col0;
#pragma unroll
                for (int bj = 0; bj < 2; ++bj) { f32x4 v0 = acc[ai][bj][m][0] + bv[bj][0], v1 = acc[ai][bj][m][1] + bv[bj][1];
                    if (ACT == 1) { f32x2 a = gelu_pk((f32x2){v0[0], v0[1]}), b = gelu_pk((f32x2){v0[2], v0[3]}), c = gelu_pk((f32x2){v1[0], v1[1]}), d = gelu_pk((f32x2){v1[2], v1[3]});
                        v0 = (f32x4){a.x, a.y, b.x, b.y}; v1 = (f32x4){c.x, c.y, d.x, d.y}; }
                    v0 = v0 * sc; v1 = v1 * sc; u32x4 w; w.x = cvt_pk_bf16(v0[0], v0[1]); w.y = cvt_pk_bf16(v0[2], v0[3]); w.z = cvt_pk_bf16(v1[0], v1[1]); w.w = cvt_pk_bf16(v1[2], v1[3]);
                    *(u32x4*)(rowp + bj * HALF) = w; } }
    }
};

struct PanelStats {
    unsigned* xbuf;
    unsigned* cnt;
    unsigned* tmo;
    int ntn; float eps;
    unsigned code;
    __device__ __forceinline__ bool run(const f32x4 (&v)[2][2][4][2], const Unit& u, int wr, int wc, int fr, int fq, PG8_LAS unsigned char* lds, int wid, int lane) const {
        typedef float f32x2v __attribute__((ext_vector_type(2)));
        PG8_LAS f32x2v* P = (PG8_LAS f32x2v*)lds;
        PG8_LAS f32x2v* S = (PG8_LAS f32x2v*)(lds + 8192);
        PG8_LAS unsigned* flag = (PG8_LAS unsigned*)(lds + 8192 + 2048);
#pragma unroll
        for (int ai = 0; ai < 2; ++ai)
#pragma unroll
            for (int m = 0; m < 4; ++m) {
                float s = 0.f;
#pragma unroll
                for (int bj = 0; bj < 2; ++bj)
#pragma unroll
                    for (int n = 0; n < 2; ++n) { const f32x4 x = v[ai][bj][m][n]; s += (x[0] + x[1]) + (x[2] + x[3]); }
                s += __shfl_xor(s, 16); s += __shfl_xor(s, 32);
                const float mw = s * (1.0f / 64.0f); float q = 0.f;
#pragma unroll
                for (int bj = 0; bj < 2; ++bj)
#pragma unroll
                    for (int n = 0; n < 2; ++n) { const f32x4 d = v[ai][bj][m][n] - mw; q += (d[0] * d[0] + d[1] * d[1]) + (d[2] * d[2] + d[3] * d[3]); }
                q += __shfl_xor(q, 16); q += __shfl_xor(q, 32);
                if (fq == 0) P[(ai * HALF + wr * 64 + m * 16 + fr) * 4 + wc] = (f32x2v){mw, q};
            }
        asm volatile("s_waitcnt lgkmcnt(0)" ::: "memory"); __builtin_amdgcn_s_barrier(); asm volatile("" ::: "memory");
#if defined(BROKEN_EXCHANGE_NO_WAIT)
#warning BROKEN CONTROL BUILD: the row-statistics exchange does not wait; results are wrong by design
        if (blockIdx.x >= 64) { const long long t0_ = clock64(); while (clock64() - t0_ < 60000) __builtin_amdgcn_s_sleep(8); }
#endif
        const int row = wid * 32 + (lane & 31);
        if (lane < 32) {
            const f32x2v a = P[row * 4 + 0], b = P[row * 4 + 1], c = P[row * 4 + 2], d = P[row * 4 + 3];
            const float mt = (a.x + b.x + c.x + d.x) * 0.25f;
            const float da = a.x - mt, db = b.x - mt, dc = c.x - mt, dd = d.x - mt;
            const float m2 = (a.y + b.y) + (c.y + d.y) + 64.0f * ((da * da + db * db) + (dc * dc + dd * dd));
            unsigned long long* slot = (unsigned long long*)xbuf + ((size_t)(u.pm * BM + row) * 4 + u.pn);
            __hip_atomic_store(slot, ((unsigned long long)__float_as_uint(m2) << 32) | __float_as_uint(mt), __ATOMIC_RELAXED, __HIP_MEMORY_SCOPE_AGENT);
        }
        asm volatile("s_waitcnt vmcnt(0)" ::: "memory");
        if (lane == 0) __hip_atomic_fetch_add(cnt + 64 * u.pm, 1u, __ATOMIC_RELAXED, __HIP_MEMORY_SCOPE_AGENT);
        if (wid == 0) {
            bool dead = false; const unsigned long long t0 = __builtin_amdgcn_s_memrealtime(); const unsigned want = 8u * (unsigned)ntn;
            for (;;) {
#if defined(BROKEN_EXCHANGE_NO_WAIT)
                break;
#endif
                if ((unsigned)__builtin_amdgcn_readfirstlane(__hip_atomic_load(cnt + 64 * u.pm, __ATOMIC_RELAXED, __HIP_MEMORY_SCOPE_AGENT)) >= want) break;
                if (__builtin_amdgcn_s_memrealtime() - t0 > 2000000ull) {
                    if (lane == 0) { unsigned expect = 0u; __hip_atomic_compare_exchange_strong(tmo + 1, &expect, code | (unsigned)(u.pm & 0xff), __ATOMIC_RELAXED, __ATOMIC_RELAXED, __HIP_MEMORY_SCOPE_AGENT);
                                     __hip_atomic_store(tmo, 1u, __ATOMIC_RELAXED, __HIP_MEMORY_SCOPE_AGENT); }
                    dead = true; break; }
                __builtin_amdgcn_s_sleep(2);
            }
            __builtin_amdgcn_fence(__ATOMIC_ACQUIRE, "agent");
            if (lane == 0) flag[0] = dead ? 1u : 0u;
        }
        asm volatile("s_waitcnt vmcnt(0) lgkmcnt(0)" ::: "memory"); __builtin_amdgcn_s_barrier(); asm volatile("" ::: "memory");
        const bool bad = flag[0] != 0u;
        if (lane < 32) {
            const unsigned long long* slot = (const unsigned long long*)xbuf + (size_t)(u.pm * BM + row) * 4; float mt[4], m2[4]; float ms = 0.f;
#pragma unroll
            for (int t = 0; t < 4; ++t) { if (t < ntn) { const unsigned long long w = __hip_atomic_load(slot + t, __ATOMIC_RELAXED, __HIP_MEMORY_SCOPE_AGENT); mt[t] = __uint_as_float((unsigned)w); m2[t] = __uint_as_float((unsigned)(w >> 32)); } else { mt[t] = 0.f; m2[t] = 0.f; } ms += mt[t]; }
            const float mean = ms / (float)ntn; float q = 0.f;
#pragma unroll
            for (int t = 0; t < 4; ++t) if (t < ntn) { const float dm = mt[t] - mean; q += m2[t] + 256.0f * dm * dm; }
            S[row] = (f32x2v){mean, 1.0f / sqrtf(q / (256.0f * (float)ntn) + eps)};
        }
        asm volatile("s_waitcnt lgkmcnt(0)" ::: "memory"); __builtin_amdgcn_s_barrier(); asm volatile("" ::: "memory");
        return bad;
    }
};
struct EpiLnRes {
    static constexpr bool PERM = false, AFTER_DRAIN = true;
    const float* base; float* out; int ldc; const float* bias; PanelStats st; unsigned poison;
    __device__ __forceinline__ void fused(f32x4 (&acc)[2][2][4][2], const Unit& u, int wr, int wc, int fr, int fq, PG8_LAS unsigned char* lds, int wid, int lane) const {
        typedef float f32x2v __attribute__((ext_vector_type(2)));
        const PG8_LAS f32x2v* S = (const PG8_LAS f32x2v*)(lds + 8192);
        const int col0 = u.pn * BM + wc * 32 + 4 * fq;
#pragma unroll
        for (int bj = 0; bj < 2; ++bj)
#pragma unroll
            for (int n = 0; n < 2; ++n) { const f32x4 bv = bias ? *(const f32x4*)(bias + col0 + bj * HALF + n * 16) : (f32x4){0.f, 0.f, 0.f, 0.f};
#pragma unroll
                for (int ai = 0; ai < 2; ++ai)
#pragma unroll
                    for (int m = 0; m < 4; ++m) acc[ai][bj][m][n] += bv; }
        f32x4 pre[4][2][2];
#pragma unroll
        for (int m = 0; m < 4; ++m) { const size_t off = (size_t)(u.pm * BM + wr * 64 + m * 16 + fr) * ldc + col0;
#pragma unroll
            for (int bj = 0; bj < 2; ++bj)
#pragma unroll
                for (int n = 0; n < 2; ++n) pre[m][bj][n] = *(const f32x4*)(base + off + bj * HALF + n * 16); }
        const bool bad = st.run(acc, u, wr, wc, fr, fq, lds, wid, lane) || poison != 0u;
        const float qnan = __builtin_nanf("");
#pragma unroll
        for (int ai = 0; ai < 2; ++ai)
#pragma unroll
            for (int m = 0; m < 4; ++m) { const int r = ai * HALF + wr * 64 + m * 16 + fr; const f32x2v sr = S[r]; const size_t off = (size_t)(u.pm * BM + r) * ldc + col0;
#pragma unroll
                for (int bj = 0; bj < 2; ++bj)
#pragma unroll
                    for (int n = 0; n < 2; ++n) { const f32x4 bs = ai == 0 ? pre[m][bj][n] : *(const f32x4*)(base + off + bj * HALF + n * 16); f32x4 o = bs + (acc[ai][bj][m][n] - sr.x) * sr.y;
                        if (bad) o = (f32x4){qnan, qnan, qnan, qnan}; *(f32x4*)(out + off + bj * HALF + n * 16) = o; }
                if (m & 1) asm volatile("" ::: "memory"); }
    }
};
struct EpiLnResLn {
    static constexpr bool PERM = false, AFTER_DRAIN = true;
    const float* base; float* out; bf16_t* xn; int ldc; const float* bias; PanelStats st1, st2; unsigned poison;
    __device__ __forceinline__ void fused(f32x4 (&acc)[2][2][4][2], const Unit& u, int wr, int wc, int fr, int fq, PG8_LAS unsigned char* lds, int wid, int lane) const {
        typedef float f32x2v __attribute__((ext_vector_type(2))); typedef unsigned u32x2v __attribute__((ext_vector_type(2)));
        const PG8_LAS f32x2v* S = (const PG8_LAS f32x2v*)(lds + 8192);
        const int col0 = u.pn * BM + wc * 32 + 4 * fq;
#pragma unroll
        for (int bj = 0; bj < 2; ++bj)
#pragma unroll
            for (int n = 0; n < 2; ++n) { const f32x4 bv = bias ? *(const f32x4*)(bias + col0 + bj * HALF + n * 16) : (f32x4){0.f, 0.f, 0.f, 0.f};
#pragma unroll
                for (int ai = 0; ai < 2; ++ai)
#pragma unroll
                    for (int m = 0; m < 4; ++m) acc[ai][bj][m][n] += bv; }
        bool bad = st1.run(acc, u, wr, wc, fr, fq, lds, wid, lane) || poison != 0u;
        const float qnan = __builtin_nanf("");
#pragma unroll
        for (int ai = 0; ai < 2; ++ai)
#pragma unroll
            for (int m = 0; m < 4; ++m) { const int r = ai * HALF + wr * 64 + m * 16 + fr; const f32x2v sr = S[r]; const size_t off = (size_t)(u.pm * BM + r) * ldc + col0;
#pragma unroll
                for (int bj = 0; bj < 2; ++bj)
#pragma unroll
                    for (int n = 0; n < 2; ++n) { const f32x4 bs = *(const f32x4*)(base + off + bj * HALF + n * 16); acc[ai][bj][m][n] = bs + (acc[ai][bj][m][n] - sr.x) * sr.y; }
                asm volatile("" : "+v"(acc[ai][0][m][0]), "+v"(acc[ai][0][m][1]), "+v"(acc[ai][1][m][0]), "+v"(acc[ai][1][m][1]));
                if (m & 1) asm volatile("" ::: "memory"); }
        const bool bad1 = bad;
        bad = st2.run(acc, u, wr, wc, fr, fq, lds, wid, lane) || bad;
#pragma unroll
        for (int ai = 0; ai < 2; ++ai)
#pragma unroll
            for (int m = 0; m < 4; ++m) { const int r = ai * HALF + wr * 64 + m * 16 + fr; const f32x2v sr = S[r]; const size_t off = (size_t)(u.pm * BM + r) * ldc + col0;
#pragma unroll
                for (int bj = 0; bj < 2; ++bj)
#pragma unroll
                    for (int n = 0; n < 2; ++n) { const f32x4 x1 = acc[ai][bj][m][n]; *(f32x4*)(out + off + bj * HALF + n * 16) = bad1 ? (f32x4){qnan, qnan, qnan, qnan} : x1;
                        const f32x4 o = (x1 - sr.x) * sr.y; u32x2v w; w.x = cvt_pk_bf16(o[0], o[1]); w.y = cvt_pk_bf16(o[2], o[3]);
                        if (bad) { w.x = 0x7fc07fc0u; w.y = 0x7fc07fc0u; } *(u32x2v*)(xn + off + bj * HALF + n * 16) = w; }
                asm volatile("" ::: "memory"); }
    }
};

template <class Epi, class Sched, bool ALIGN_EPI = false, bool SP2 = false>
__device__ __forceinline__ void gemm_phase(PG8_LAS unsigned char* lds, const Gemm g, const Sched& S, const Epi& E, const int tid_in) {
    int tid_l = tid_in; asm volatile("" : "+v"(tid_l));
    const int tid = tid_l, wid = __builtin_amdgcn_readfirstlane(tid >> 6), lane = tid & 63, wr = wid >> 2, wc = wid & 3, fr = lane & 15, fq = lane >> 4;
    const bf16_t* gA_l = g.A; const bf16_t* gB_l = g.Bt; asm volatile("" : "+s"(gA_l), "+s"(gB_l));
    const int K = g.K, nt = K / BK;
    unsigned voffA[2], voffB[2];
#pragma unroll
    for (int i = 0; i < 2; ++i) { int R, C; stage_rc(tid * 16 + i * 8192, R, C); const int Rb = Epi::PERM ? ((R & ~31) + perm32(R & 31)) : R;
        voffA[i] = (unsigned)(R * K + C) * 2u; voffB[i] = (unsigned)(Rb * K + C) * 2u; }
    const size_t kstep = (size_t)(BK * 2);
    const size_t hstep = (size_t)HALF * K * 2;
    const size_t tstep = 2 * hstep;
    const unsigned ldsw = (unsigned)wid * 1024u;
    const int aoff = lds_byte(wr * 64 + fr, fq * 8), boff = lds_byte(wc * 32 + fr, fq * 8);
#define PG8_SA(b, h) (((b) * 2 + (h)) * HTB)
#define PG8_SB(b, h) ((4 + (b) * 2 + (h)) * HTB)
#define PG8_STAGE(bufoff, gbase, voff) do { _Pragma("unroll") for (int _i = 0; _i < 2; ++_i) \
        __builtin_amdgcn_global_load_lds((const unsigned*)((const char*)(gbase) + (voff)[_i]), (PG8_LAS unsigned*)(lds + (bufoff) + ldsw + _i * 8192), 16, 0, 0); } while (0)
#define PG8_LDA(dst, b, h) do { _Pragma("unroll") for (int m = 0; m < 4; ++m) _Pragma("unroll") for (int k = 0; k < 2; ++k) dst[m][k] = *(const PG8_LAS bf16x8*)(lds + PG8_SA(b, h) + aoff + m * 2048 + k * 1024); } while (0)
#define PG8_LDB(dst, b, h) do { _Pragma("unroll") for (int n = 0; n < 2; ++n) _Pragma("unroll") for (int k = 0; k < 2; ++k) dst[n][k] = *(const PG8_LAS bf16x8*)(lds + PG8_SB(b, h) + boff + n * 2048 + k * 1024); } while (0)
#define PG8_MMA(ai, bj, At, Bt) do { __builtin_amdgcn_s_setprio(1); _Pragma("unroll") for (int m = 0; m < 4; ++m) _Pragma("unroll") for (int n = 0; n < 2; ++n) _Pragma("unroll") for (int k = 0; k < 2; ++k) \
        acc[ai][bj][m][n] = __builtin_amdgcn_mfma_f32_16x16x32_bf16(Bt[n][k], At[m][k], acc[ai][bj][m][n], 0, 0, 0); __builtin_amdgcn_s_setprio(0); } while (0)
#define PG8_WAIT_V(n) asm volatile("s_waitcnt vmcnt(" #n ")" ::: "memory")
#define PG8_WAIT_L(n) asm volatile("s_waitcnt lgkmcnt(" #n ")" ::: "memory")
#define PG8_BAR __builtin_amdgcn_s_barrier()
#define PG8_SCHED __builtin_amdgcn_sched_barrier(0)
    Unit cur, nxt; int ui = 0;
    if (!S.next(0, cur)) return;
    f32x4 acc[2][2][4][2];
#pragma unroll
    for (int a = 0; a < 2; ++a)
#pragma unroll
        for (int b = 0; b < 2; ++b)
#pragma unroll
            for (int m = 0; m < 4; ++m)
#pragma unroll
                for (int n = 0; n < 2; ++n) acc[a][b][m][n] = (f32x4){0.f, 0.f, 0.f, 0.f};
    bf16x8 At[4][2], B0[2][2], B1[2][2];
    const char* cA = (const char*)gA_l + (size_t)cur.pm * tstep; const char* cB = (const char*)gB_l + (size_t)cur.pn * tstep;
    S.a_ready(cur);
    if constexpr (SP2) {
        PG8_STAGE(PG8_SB(0, 0), cB, voffB); PG8_STAGE(PG8_SB(0, 1), cB + hstep, voffB); PG8_STAGE(PG8_SA(0, 0), cA, voffA); PG8_STAGE(PG8_SA(0, 1), cA + hstep, voffA);
        if (wr == 1) PG8_BAR;
        PG8_WAIT_V(2); PG8_BAR;
        PG8_STAGE(PG8_SB(1, 0), cB + kstep, voffB); PG8_STAGE(PG8_SA(1, 0), cA + kstep, voffA); PG8_STAGE(PG8_SB(1, 1), cB + hstep + kstep, voffB);
        PG8_WAIT_V(6); PG8_BAR;
    } else {
        PG8_STAGE(PG8_SB(0, 0), cB, voffB); PG8_STAGE(PG8_SA(0, 0), cA, voffA); PG8_STAGE(PG8_SB(0, 1), cB + hstep, voffB); PG8_STAGE(PG8_SA(0, 1), cA + hstep, voffA);
        if (wr == 1) PG8_BAR;
        PG8_WAIT_V(4); PG8_BAR;
        PG8_STAGE(PG8_SB(1, 0), cB + kstep, voffB); PG8_STAGE(PG8_SA(1, 0), cA + kstep, voffA); PG8_STAGE(PG8_SB(1, 1), cB + hstep + kstep, voffB);
        PG8_WAIT_V(6); PG8_BAR;
    }
    for (;;) {
        const bool has_next = S.next(ui + 1, nxt);
        const char* nA = has_next ? (const char*)gA_l + (size_t)nxt.pm * tstep : cA; const char* nB = has_next ? (const char*)gB_l + (size_t)nxt.pn * tstep : cB;
        for (int t = 0; t < nt; t += 2) {
            const bool last = (t == nt - 2);
            const char* a1 = cA + (size_t)(t + 1) * kstep;
            const char* a2 = last ? nA : cA + (size_t)(t + 2) * kstep; const char* b2 = last ? nB : cB + (size_t)(t + 2) * kstep;
            const char* a3 = a2 + kstep; const char* b3 = b2 + kstep;
            if (last && has_next) S.a_ready(nxt);
            if constexpr (SP2) {
            PG8_LDB(B0, 0, 0); PG8_LDB(B1, 0, 1); PG8_SCHED; PG8_LDA(At, 0, 0); PG8_STAGE(PG8_SA(1, 1), a1 + hstep, voffA);
            PG8_WAIT_V(8); PG8_WAIT_L(0); PG8_BAR; PG8_MMA(0, 0, At, B0); PG8_MMA(0, 1, At, B1); PG8_BAR; PG8_SCHED;
            PG8_LDA(At, 0, 1); PG8_STAGE(PG8_SB(0, 0), b2, voffB); PG8_STAGE(PG8_SB(0, 1), b2 + hstep, voffB); PG8_STAGE(PG8_SA(0, 0), a2, voffA);
            PG8_WAIT_V(8); PG8_WAIT_L(0); PG8_BAR; PG8_MMA(1, 0, At, B0); PG8_MMA(1, 1, At, B1); PG8_BAR; PG8_SCHED;
            PG8_LDB(B0, 1, 0); PG8_LDB(B1, 1, 1); PG8_SCHED; PG8_LDA(At, 1, 0); PG8_STAGE(PG8_SA(0, 1), a2 + hstep, voffA);
            PG8_WAIT_V(8); PG8_WAIT_L(0); PG8_BAR; PG8_MMA(0, 0, At, B0); PG8_MMA(0, 1, At, B1); PG8_BAR; PG8_SCHED;
            PG8_LDA(At, 1, 1); PG8_STAGE(PG8_SB(1, 0), b3, voffB); PG8_STAGE(PG8_SB(1, 1), b3 + hstep, voffB); PG8_STAGE(PG8_SA(1, 0), a3, voffA);
            PG8_WAIT_V(8); PG8_WAIT_L(0); PG8_BAR; PG8_MMA(1, 0, At, B0); PG8_MMA(1, 1, At, B1); PG8_BAR; PG8_SCHED;
            } else {
            PG8_LDB(B0, 0, 0); PG8_SCHED; PG8_LDA(At, 0, 0); PG8_STAGE(PG8_SA(1, 1), a1 + hstep, voffA);
            PG8_WAIT_L(8); PG8_BAR; PG8_WAIT_L(0); PG8_MMA(0, 0, At, B0); PG8_BAR; PG8_SCHED;
            PG8_LDB(B1, 0, 1); PG8_STAGE(PG8_SB(0, 0), b2, voffB);
            PG8_BAR; PG8_WAIT_L(0); PG8_MMA(0, 1, At, B1); PG8_BAR;
            PG8_LDA(At, 0, 1); PG8_STAGE(PG8_SA(0, 0), a2, voffA);
            PG8_BAR; PG8_WAIT_L(0); PG8_MMA(1, 0, At, B0); PG8_BAR; PG8_SCHED;
            PG8_STAGE(PG8_SB(0, 1), b2 + hstep, voffB);
            PG8_WAIT_V(6); PG8_BAR; PG8_MMA(1, 1, At, B1); PG8_BAR;
            PG8_LDB(B0, 1, 0); PG8_SCHED; PG8_LDA(At, 1, 0); PG8_STAGE(PG8_SA(0, 1), a2 + hstep, voffA);
            PG8_WAIT_L(8); PG8_BAR; PG8_WAIT_L(0); PG8_MMA(0, 0, At, B0); PG8_BAR; PG8_SCHED;
            PG8_LDB(B1, 1, 1); PG8_STAGE(PG8_SB(1, 0), b3, voffB);
            PG8_BAR; PG8_WAIT_L(0); PG8_MMA(0, 1, At, B1); PG8_BAR;
            PG8_LDA(At, 1, 1); PG8_STAGE(PG8_SA(1, 0), a3, voffA);
            PG8_BAR; PG8_WAIT_L(0); PG8_MMA(1, 0, At, B0); PG8_BAR; PG8_SCHED;
            PG8_STAGE(PG8_SB(1, 1), b3 + hstep, voffB);
            PG8_WAIT_V(6); PG8_BAR; PG8_MMA(1, 1, At, B1); PG8_BAR;
            }
        }
        if constexpr (ALIGN_EPI) { if (wr == 0) PG8_BAR; }
        if constexpr (!Epi::AFTER_DRAIN) { E(acc, cur, wr, wc, fr, fq); S.done(cur); }
        if (!has_next) break;
#pragma unroll
        for (int a = 0; a < 2; ++a)
#pragma unroll
            for (int b = 0; b < 2; ++b)
#pragma unroll
                for (int m = 0; m < 4; ++m)
#pragma unroll
                    for (int n = 0; n < 2; ++n) acc[a][b][m][n] = (f32x4){0.f, 0.f, 0.f, 0.f};
        cur = nxt; cA = nA; cB = nB; ++ui;
        if constexpr (ALIGN_EPI) { if (wr == 1) PG8_BAR; }
    }
    PG8_WAIT_V(0);
    if constexpr (!ALIGN_EPI) { if (wr == 0) PG8_BAR; }
    PG8_BAR;
    if constexpr (Epi::AFTER_DRAIN) { E.fused(acc, cur, wr, wc, fr, fq, lds, wid, lane); S.done(cur); }
#undef PG8_SA
#undef PG8_SB
#undef PG8_STAGE
#undef PG8_LDA
#undef PG8_LDB
#undef PG8_MMA
#undef PG8_WAIT_V
#undef PG8_WAIT_L
#undef PG8_BAR
#undef PG8_SCHED
}
}
#define GAS __attribute__((address_space(1)))
#define LAS __attribute__((address_space(3)))
typedef unsigned short bf16;
typedef unsigned v4u __attribute__((ext_vector_type(4)));
typedef float f32x4 __attribute__((ext_vector_type(4)));
typedef short bf16x8 __attribute__((ext_vector_type(8)));
typedef GAS unsigned gu32;
typedef GAS unsigned long long gu64;
#define RLX_AGENT __ATOMIC_RELAXED, __HIP_MEMORY_SCOPE_AGENT
#define LDS_WAIT() asm volatile("s_waitcnt lgkmcnt(0)" ::: "memory")
#define VM_WAIT() asm volatile("s_waitcnt vmcnt(0)" ::: "memory")
__device__ __forceinline__ unsigned long long rt() { return __builtin_amdgcn_s_memrealtime(); }
__device__ __forceinline__ unsigned f2bf(float f) { unsigned u = __builtin_bit_cast(unsigned, f); return (u + 0x7fffu + ((u >> 16) & 1u)) >> 16; }
__device__ __forceinline__ unsigned pk2(float lo, float hi) { return f2bf(lo) | (f2bf(hi) << 16); }

#define XB_TMO      128
#define XB_XCNT(j)  (256  + 64 * (j))
#define XB_XSUB(j)  (1280 + 64 * (j))
#define XB_XGEN(j)  (2304 + 64 * (j))
#define XB_TOP      3328
#define XB_TOPGEN   3392
#define XCD_BAR_WORDS 3456
#define XB_SPIN_CAP (1u << 18)

__device__ __forceinline__ unsigned xb_ld(unsigned* p)              { return __hip_atomic_load(p, __ATOMIC_RELAXED, __HIP_MEMORY_SCOPE_AGENT); }
__device__ __forceinline__ unsigned xb_add(unsigned* p, unsigned v) { return __hip_atomic_fetch_add(p, v, __ATOMIC_RELAXED, __HIP_MEMORY_SCOPE_AGENT); }
__device__ __forceinline__ unsigned xb_xcc_id() { return (unsigned)__builtin_amdgcn_s_getreg((3 << 11) | 20) & 0xFu; }
#define XB_SPIN(cond, bar) do { unsigned _sp = 0; while (cond) { __builtin_amdgcn_s_sleep(1); \
    if ((++_sp & 255u) == 0u) { if (xb_ld(&(bar)[XB_TMO])) break; if (_sp > XB_SPIN_CAP) { atomicAdd(&(bar)[XB_TMO], 1u); break; } } } } while (0)

struct XcdBarrier {
    unsigned* bar; unsigned x;
    volatile LAS unsigned* st;
};

__device__ __forceinline__ XcdBarrier xcd_barrier_post(unsigned* bar, volatile LAS unsigned* st) {
    XcdBarrier b; b.bar = bar; b.x = xb_xcc_id(); b.st = st;
    if (threadIdx.x == 0) (void)xb_add(&bar[XB_XCNT(b.x)], 1u);
    return b;
}
__device__ __forceinline__ void xcd_barrier_complete(unsigned* bar, unsigned x, unsigned& nloc, unsigned& nx) {
    const unsigned G = gridDim.x * gridDim.y * gridDim.z;
    unsigned sum, cnt, mine, sp = 0u;
    for (;;) {
        sum = 0u; cnt = 0u; mine = 0u;
#pragma unroll
        for (unsigned j = 0; j < 16; ++j) { const unsigned c = xb_ld(&bar[XB_XCNT(j)]); sum += c; cnt += (c > 0u) ? 1u : 0u; mine = (j == x) ? c : mine; }
        if (sum == G) break;
        __builtin_amdgcn_s_sleep(1);
        if ((++sp & 255u) == 0u) { if (xb_ld(&bar[XB_TMO])) break; if (sp > XB_SPIN_CAP) { atomicAdd(&bar[XB_TMO], 1u); break; } }
    }
    nloc = mine > 0u ? mine : 1u; nx = cnt > 0u ? cnt : 1u;
}

__device__ __forceinline__ void xcd_barrier(const XcdBarrier& b) {
    asm volatile("s_waitcnt vmcnt(0)" ::: "memory");
    __syncthreads();
    if (threadIdx.x == 0) {
        unsigned* bar = b.bar;
        __builtin_amdgcn_s_waitcnt(0);
        unsigned nloc = b.st[0], nx = b.st[1];
        if (nloc == 0u) { xcd_barrier_complete(bar, b.x, nloc, nx); b.st[0] = nloc; b.st[1] = nx; }
        const unsigned old = xb_add(&bar[XB_XSUB(b.x)], 1u);
        const unsigned gen = old / nloc;
        if (old + 1u == (gen + 1u) * nloc) {
            __builtin_amdgcn_fence(__ATOMIC_RELEASE, "agent");
            asm volatile("s_waitcnt vmcnt(0)" ::: "memory");
            const unsigned og = xb_add(&bar[XB_TOP], 1u);
            const unsigned tg = og / nx;
            if (og + 1u == (tg + 1u) * nx) xb_add(&bar[XB_TOPGEN], 1u);
            else XB_SPIN(xb_ld(&bar[XB_TOPGEN]) == tg, bar);
            __builtin_amdgcn_fence(__ATOMIC_ACQUIRE, "agent");
            xb_add(&bar[XB_XGEN(b.x)], 1u);
            asm volatile("s_waitcnt vmcnt(0)" ::: "memory");
        } else {
            XB_SPIN(xb_ld(&bar[XB_XGEN(b.x)]) == gen, bar);
            __builtin_amdgcn_fence(__ATOMIC_ACQUIRE, "agent");
            asm volatile("s_waitcnt vmcnt(0)" ::: "memory");
        }
    }
    __syncthreads();
}

constexpr int NB = 8, SEQ = 4096, DM = 1024, DEPTH = 4, MTOK = NB * SEQ;
constexpr int NQKV = 2816, NE = 16, CAP = 512, DFF = 1024, DPLE = 256, MR = NE * NB * CAP;
constexpr int NWAVES = 8, NTHR = NWAVES * 64;
constexpr float RMS_EPS = 1e-6f;
constexpr int C_QA = 0, C_KA = 256, C_VA = 384, C_QB = 512, C_KB = 896, C_VB = 1280, C_QC = 1664, C_KC = 2048, C_VC = 2432;
constexpr int NPH_LAYER = 12, NPHASES = 1 + DEPTH * NPH_LAYER;

constexpr size_t MiB = 1u << 20;
constexpr size_t WS_CTL = 0, CTL_ZERO_BYTES = 1 * MiB;
constexpr size_t WS_TAB = 1 * MiB;
constexpr size_t WS_AFF = 2 * MiB;
constexpr size_t WS_IDX = 4 * MiB;
constexpr size_t WS_GATE = 5 * MiB;
constexpr size_t WS_SEL = 6 * MiB;
constexpr size_t WS_WIN = 16 * MiB;
constexpr size_t WS_WOUT = 22 * MiB;
constexpr size_t WS_WPG = 24 * MiB;
constexpr size_t WS_WPP = 26 * MiB;
constexpr size_t WS_WGU = 28 * MiB;
constexpr size_t WS_WD = 92 * MiB;
constexpr size_t WS_PBF = 124 * MiB;
constexpr size_t WS_AN = 140 * MiB;
constexpr size_t WS_QKV = 204 * MiB;
constexpr size_t WS_AO = 380 * MiB;
constexpr size_t WS_XG = 444 * MiB;
constexpr size_t WS_HID = 572 * MiB;
constexpr size_t WS_PP = 700 * MiB;
constexpr size_t WS_MIX = 764 * MiB;
constexpr size_t WS_Y = 828 * MiB;
constexpr size_t WS_END = 956 * MiB;
constexpr int CW_BAR = 4096;

constexpr int RING_OFF = 0, RING_BYTES = 131072;
constexpr int LDSCTL_OFF = RING_BYTES, MISC_OFF = LDSCTL_OFF + 320;
constexpr int LDS_BYTES = 147456;

struct float2_t { float x, y; };

__device__ __forceinline__ int dpp_i(int v, const int ctrl_unused) { return v; }
#define DPP_ADD_I(v, ctrl) ((v) + __builtin_amdgcn_update_dpp(0, (v), (ctrl), 0xf, 0xf, true))
__device__ __forceinline__ int xor16_add_i(int v) { auto r = __builtin_amdgcn_permlane16_swap((unsigned)v, (unsigned)v, false, false); return (int)(r[0] + r[1]); }
__device__ __forceinline__ int xor32_add_i(int v) { auto r = __builtin_amdgcn_permlane32_swap((unsigned)v, (unsigned)v, false, false); return (int)(r[0] + r[1]); }
__device__ __forceinline__ float xor16_add(float v) { auto r = __builtin_amdgcn_permlane16_swap(__float_as_uint(v), __float_as_uint(v), false, false); return __uint_as_float(r[0]) + __uint_as_float(r[1]); }
__device__ __forceinline__ float xor32_add(float v) { auto r = __builtin_amdgcn_permlane32_swap(__float_as_uint(v), __float_as_uint(v), false, false); return __uint_as_float(r[0]) + __uint_as_float(r[1]); }
__device__ __forceinline__ float dpp_f(float v, int) { return v; }
#define DPP_ADD_F(v, ctrl) ((v) + __int_as_float(__builtin_amdgcn_update_dpp(0, __float_as_int(v), (ctrl), 0xf, 0xf, true)))
__device__ __forceinline__ float wave_sum(float v) {
    v = DPP_ADD_F(v, 0xB1); v = DPP_ADD_F(v, 0x4E); v = DPP_ADD_F(v, 0x141); v = DPP_ADD_F(v, 0x140);
    v = xor16_add(v); v = xor32_add(v);
    return v;
}
__device__ __forceinline__ int wave_sum_i(int v) {
    v = DPP_ADD_I(v, 0xB1); v = DPP_ADD_I(v, 0x4E); v = DPP_ADD_I(v, 0x141); v = DPP_ADD_I(v, 0x140);
    v = xor16_add_i(v); v = xor32_add_i(v);
    return v;
}
__device__ __forceinline__ int lane_id() { int l; asm volatile("v_mbcnt_lo_u32_b32 %0, -1, 0\n\tv_mbcnt_hi_u32_b32 %0, -1, %0" : "=v"(l)); return l; }
__device__ __forceinline__ float bflo(unsigned u) { return __uint_as_float(u << 16); }
__device__ __forceinline__ float bfhi(unsigned u) { return __uint_as_float(u & 0xffff0000u); }

__device__ __forceinline__ void sincos_acc(float ang, float& c, float& s) {
    const double a = (double)ang;
    const double q = __builtin_rint(a * 0.63661977236758134308);
    const double t = a - q * 1.57079632679489661923;
    const int qi = (int)q;
    const double t2 = t * t;
    const double sn = t * (1.0 + t2 * (-1.0 / 6.0 + t2 * (1.0 / 120.0 + t2 * (-1.0 / 5040.0 + t2 * (1.0 / 362880.0 + t2 * (-1.0 / 39916800.0))))));
    const double cs = 1.0 + t2 * (-0.5 + t2 * (1.0 / 24.0 + t2 * (-1.0 / 720.0 + t2 * (1.0 / 40320.0 + t2 * (-1.0 / 3628800.0 + t2 * (1.0 / 479001600.0))))));
    const int k = qi & 3;
    const double cc = (k == 0) ? cs : (k == 1) ? -sn : (k == 2) ? -cs : sn;
    const double ss = (k == 0) ? sn : (k == 1) ? cs : (k == 2) ? -sn : -cs;
    c = (float)cc; s = (float)ss;
}

__device__ __forceinline__ void norm_row_bf16(const float* xrow, const float* gain, bf16* orow, int lane) {
    const f32x4* xr = (const f32x4*)xrow + lane;
    const f32x4* gr = (const f32x4*)gain + lane;
    f32x4 v[4]; float s = 0.f;
#pragma unroll
    for (int j = 0; j < 4; ++j) { v[j] = xr[64 * j]; s += (v[j].x * v[j].x + v[j].y * v[j].y) + (v[j].z * v[j].z + v[j].w * v[j].w); }
    const float rstd = 1.0f / sqrtf(wave_sum(s) * (1.0f / DM) + RMS_EPS);
    unsigned long long* o8 = (unsigned long long*)orow + lane;
#pragma unroll
    for (int j = 0; j < 4; ++j) { const f32x4 g = gr[64 * j];
        o8[64 * j] = (unsigned long long)pk2(v[j].x * rstd * g.x, v[j].y * rstd * g.y) | ((unsigned long long)pk2(v[j].z * rstd * g.z, v[j].w * rstd * g.w) << 32); }
}

__device__ __forceinline__ void tr_item(const float* W, int ldw, int k0, int n0, bf16* WT, int ldt, int drow0, LAS float* scr, int lane) {
#pragma unroll 8
    for (int i = 0; i < 32; ++i) { const int kk = 2 * i + (lane >> 5); scr[kk * 33 + (lane & 31)] = W[(size_t)(k0 + kk) * ldw + n0 + (lane & 31)]; }
    LDS_WAIT(); asm volatile("" ::: "memory");
    const int c = lane & 7;
#pragma unroll
    for (int j = 0; j < 4; ++j) { const int n = (lane >> 3) + 8 * j; const LAS float* s = scr + (8 * c) * 33 + n;
        v4u o; o.x = pk2(s[0 * 33], s[1 * 33]); o.y = pk2(s[2 * 33], s[3 * 33]); o.z = pk2(s[4 * 33], s[5 * 33]); o.w = pk2(s[6 * 33], s[7 * 33]);
        *(v4u*)(WT + (size_t)(drow0 + n) * ldt + k0 + 8 * c) = o; }
    LDS_WAIT(); asm volatile("" ::: "memory");
}

struct Args { const float* in[16]; float* out; unsigned char* ws; float inv_ax[16]; float inv_1d[8]; int ph_lo, ph_hi; };

__device__ __forceinline__ void convert_layer(const __attribute__((address_space(4))) struct Args* ka, int l, LAS unsigned char* lds, int gw, int NGW, int wave, int lane, int gtid, int NGT) {
    LAS float* scr = (LAS float*)(lds + RING_OFF + wave * 16384);
    bf16* Win_t = (bf16*)(ka->ws + WS_WIN); bf16* Wout_t = (bf16*)(ka->ws + WS_WOUT); bf16* Wpg_t = (bf16*)(ka->ws + WS_WPG); bf16* Wpp_t = (bf16*)(ka->ws + WS_WPP);
    bf16* Wgu_t = (bf16*)(ka->ws + WS_WGU); bf16* Wd_t = (bf16*)(ka->ws + WS_WD);
    constexpr int I_IN = 16 * 88, I_SQ = 16 * 32, I_PP = 4 * 32, I_EXP = 16 * 512;
    constexpr int NITEMS = I_IN + 2 * I_SQ + I_PP + 3 * I_EXP;
    for (int it = gw; it < NITEMS; it += NGW) {
        int r = it;
        if (r < I_IN) { const int kb = r / 88, nb = r % 88, n0 = 32 * nb, tile = n0 >> 8, lw = n0 & 255, wc = lw >> 6, bj = (lw >> 5) & 1;
            tr_item(ka->in[3] + (size_t)l * DM * NQKV, NQKV, 64 * kb, n0, Win_t, DM, tile * 256 + 128 * bj + 32 * wc, scr, lane); continue; } r -= I_IN;
        if (r < I_SQ) { const int kb = r >> 5, nb = r & 31; tr_item(ka->in[7] + (size_t)l * DM * DM, DM, 64 * kb, 32 * nb, Wout_t, DM, 32 * nb, scr, lane); continue; } r -= I_SQ;
        if (r < I_SQ) { const int kb = r >> 5, nb = r & 31; tr_item(ka->in[14] + (size_t)l * DM * DM, DM, 64 * kb, 32 * nb, Wpg_t, DM, 32 * nb, scr, lane); continue; } r -= I_SQ;
        if (r < I_PP) { const int kb = r >> 5, nb = r & 31; tr_item(ka->in[15] + (size_t)l * DPLE * DM, DM, 64 * kb, 32 * nb, Wpp_t, DPLE, 32 * nb, scr, lane); continue; } r -= I_PP;
        if (r < I_EXP) { const int e = r >> 9, rr = r & 511, kb = rr >> 5, nb = rr & 31, n0 = 32 * nb;
            tr_item(ka->in[10] + (size_t)(l * NE + e) * DM * DFF, DFF, 64 * kb, n0, Wgu_t, DM, e * 2048 + (n0 >> 7) * 256 + (n0 & 127), scr, lane); continue; } r -= I_EXP;
        if (r < I_EXP) { const int e = r >> 9, rr = r & 511, kb = rr >> 5, nb = rr & 31, n0 = 32 * nb;
            tr_item(ka->in[11] + (size_t)(l * NE + e) * DM * DFF, DFF, 64 * kb, n0, Wgu_t, DM, e * 2048 + (n0 >> 7) * 256 + 128 + (n0 & 127), scr, lane); continue; } r -= I_EXP;
        { const int e = r >> 9, rr = r & 511, kb = rr >> 5, nb = rr & 31, n0 = 32 * nb;
            tr_item(ka->in[12] + (size_t)(l * NE + e) * DFF * DM, DM, 64 * kb, n0, Wd_t, DFF, e * 1024 + n0, scr, lane); }
    }
    const f32x4* ps = (const f32x4*)(ka->in[1] + (size_t)l * MTOK * DPLE);
    v4u* pd = (v4u*)(ka->ws + WS_PBF);
    for (int i = gtid; i < MTOK * DPLE / 8; i += NGT) { const f32x4 a = ps[2 * i], b = ps[2 * i + 1];
        v4u o; o.x = pk2(a.x, a.y); o.y = pk2(a.z, a.w); o.z = pk2(b.x, b.y); o.w = pk2(b.z, b.w); pd[i] = o; }
}

struct GroupedOrder {
    pg8::StaticOrder so; int nN;
    __device__ __forceinline__ void init(int N, int G, int c) { so.init(MR, N, G, c); nN = N / 256; }
    __device__ __forceinline__ bool next(int i, pg8::Unit& u) const { if (!so.next(i, u)) return false; u.pn = (u.pm >> 4) * nN + u.pn; return true; }
    __device__ __forceinline__ void a_ready(const pg8::Unit&) const {}
    __device__ __forceinline__ void done(const pg8::Unit&) const {}
};

typedef unsigned u32x2 __attribute__((ext_vector_type(2)));

struct EpiQKV {
    static constexpr bool PERM = false, AFTER_DRAIN = false;
    bf16* qkv; const float* qg; const float2_t* cs_ax; const float2_t* cs_1d;
    __device__ __forceinline__ void operator()(const f32x4 (&acc)[2][2][4][2], const pg8::Unit& u, int wr, int wc, int fr, int fq) const {
        { const int l_ = lane_id(); fr = l_ & 15; fq = l_ >> 4; } asm volatile("" : "+s"(wr), "+s"(wc));
        const int hs = u.pn * 4 + wc;
        int kind, gi;
        if (hs < 4) { kind = 2; gi = 0; } else if (hs < 6) { kind = 2; gi = 1; } else if (hs < 8) { kind = 0; gi = 0; }
        else if (hs < 14) { kind = 1; gi = 2; } else if (hs < 20) { kind = 1; gi = 3; } else if (hs < 26) { kind = 0; gi = 0; }
        else if (hs < 32) { kind = 3; gi = 4; } else if (hs < 38) { kind = 3; gi = 5; } else { kind = 0; gi = 0; }
        f32x4 gv[2][2];
#pragma unroll
        for (int bj = 0; bj < 2; ++bj)
#pragma unroll
            for (int n = 0; n < 2; ++n) gv[bj][n] = *(const f32x4*)(qg + gi * 64 + 32 * bj + 16 * n + 4 * fq);
        const int colbase = u.pn * 256 + wc * 64 + 4 * fq;
#pragma unroll
        for (int ai = 0; ai < 2; ++ai)
#pragma unroll
            for (int m = 0; m < 4; ++m) {
                const int row = u.pm * 256 + ai * 128 + wr * 64 + m * 16 + fr;
                f32x4 v[2][2];
#pragma unroll
                for (int bj = 0; bj < 2; ++bj)
#pragma unroll
                    for (int n = 0; n < 2; ++n) v[bj][n] = acc[ai][bj][m][n];
                if (kind != 0) {
                    float ss = 0.f;
#pragma unroll
                    for (int bj = 0; bj < 2; ++bj)
#pragma unroll
                        for (int n = 0; n < 2; ++n) ss += (v[bj][n].x * v[bj][n].x + v[bj][n].y * v[bj][n].y) + (v[bj][n].z * v[bj][n].z + v[bj][n].w * v[bj][n].w);
                    ss = xor16_add(ss); ss = xor32_add(ss);
                    const float rstd = 1.0f / sqrtf(ss * (1.0f / 64.0f) + RMS_EPS);
#pragma unroll
                    for (int bj = 0; bj < 2; ++bj)
#pragma unroll
                        for (int n = 0; n < 2; ++n) v[bj][n] = v[bj][n] * rstd * gv[bj][n];
                    const int s = row & (SEQ - 1);
                    if (kind == 2) {
#pragma unroll
                        for (int bj = 0; bj < 2; ++bj) {
                            const int pos = bj ? (s & 63) : (s >> 6);
                            const float2_t* cs = cs_ax + pos * 16 + 4 * fq;
#pragma unroll
                            for (int e = 0; e < 4; ++e) { const float c = cs[e].x, sn = cs[e].y; const float x1 = v[bj][0][e], x2 = v[bj][1][e];
                                v[bj][0][e] = x1 * c - x2 * sn; v[bj][1][e] = x1 * sn + x2 * c; }
                        }
                    } else if (kind == 3) {
                        const float2_t* cs = cs_1d + s * 8 + 4 * (fq & 1);
#pragma unroll
                        for (int e = 0; e < 4; ++e) { const float c = cs[e].x, sn = cs[e].y; const float own = v[0][0][e]; auto sw = __builtin_amdgcn_permlane32_swap(__float_as_uint(own), __float_as_uint(own), false, false); const float oth = __uint_as_float(fq < 2 ? sw[1] : sw[0]);
                            v[0][0][e] = (fq < 2) ? (own * c - oth * sn) : (oth * sn + own * c); }
                    }
                }
                bf16* rp = qkv + (size_t)row * NQKV + colbase;
#pragma unroll
                for (int bj = 0; bj < 2; ++bj)
#pragma unroll
                    for (int n = 0; n < 2; ++n) { u32x2 w; w.x = pk2(v[bj][n].x, v[bj][n].y); w.y = pk2(v[bj][n].z, v[bj][n].w); *(u32x2*)(rp + 32 * bj + 16 * n) = w; }
                asm volatile("" ::: "memory");
            }
    }
};

struct EpiResid {
    static constexpr bool PERM = false, AFTER_DRAIN = false;
    const float* base; float* out;
    __device__ __forceinline__ void operator()(const f32x4 (&acc)[2][2][4][2], const pg8::Unit& u, int wr, int wc, int fr, int fq) const {
        { const int l_ = lane_id(); fr = l_ & 15; fq = l_ >> 4; } asm volatile("" : "+s"(wr), "+s"(wc));
        const int col0 = u.pn * 256 + wc * 32 + 4 * fq;
#pragma unroll
        for (int ai = 0; ai < 2; ++ai)
#pragma unroll
            for (int m = 0; m < 4; ++m) { const size_t off = (size_t)(u.pm * 256 + ai * 128 + wr * 64 + m * 16 + fr) * DM + col0;
#pragma unroll
                for (int bj = 0; bj < 2; ++bj)
#pragma unroll
                    for (int n = 0; n < 2; ++n) { const f32x4 b = *(const f32x4*)(base + off + bj * 128 + n * 16); *(f32x4*)(out + off + bj * 128 + n * 16) = b + acc[ai][bj][m][n]; } }
    }
};

struct EpiStoreBf16 {
    static constexpr bool PERM = false, AFTER_DRAIN = false;
    bf16* O;
    __device__ __forceinline__ void operator()(const f32x4 (&acc)[2][2][4][2], const pg8::Unit& u, int wr, int wc, int fr, int fq) const {
        { const int l_ = lane_id(); fr = l_ & 15; fq = l_ >> 4; } asm volatile("" : "+s"(wr), "+s"(wc));
        const int col0 = (u.pn & 3) * 256 + wc * 32 + 4 * fq;
#pragma unroll
        for (int ai = 0; ai < 2; ++ai)
#pragma unroll
            for (int m = 0; m < 4; ++m) { bf16* rp = O + (size_t)(u.pm * 256 + ai * 128 + wr * 64 + m * 16 + fr) * DM + col0;
#pragma unroll
                for (int bj = 0; bj < 2; ++bj)
#pragma unroll
                    for (int n = 0; n < 2; ++n) { const f32x4 a = acc[ai][bj][m][n]; u32x2 w; w.x = pk2(a.x, a.y); w.y = pk2(a.z, a.w); *(u32x2*)(rp + bj * 128 + n * 16) = w; } }
    }
};

struct EpiSwiGLU {
    static constexpr bool PERM = false, AFTER_DRAIN = false;
    bf16* H;
    __device__ __forceinline__ void operator()(const f32x4 (&acc)[2][2][4][2], const pg8::Unit& u, int wr, int wc, int fr, int fq) const {
        { const int l_ = lane_id(); fr = l_ & 15; fq = l_ >> 4; } asm volatile("" : "+s"(wr), "+s"(wc));
        const int col0 = (u.pn & 7) * 128 + wc * 32 + 4 * fq;
#pragma unroll
        for (int ai = 0; ai < 2; ++ai)
#pragma unroll
            for (int m = 0; m < 4; ++m) { bf16* rp = H + (size_t)(u.pm * 256 + ai * 128 + wr * 64 + m * 16 + fr) * DFF + col0;
#pragma unroll
                for (int n = 0; n < 2; ++n) { const f32x4 g = acc[ai][0][m][n], up = acc[ai][1][m][n]; f32x4 h;
#pragma unroll
                    for (int e = 0; e < 4; ++e) h[e] = g[e] / (1.0f + __expf(-g[e])) * up[e];
                    u32x2 w; w.x = pk2(h.x, h.y); w.y = pk2(h.z, h.w); *(u32x2*)(rp + n * 16) = w; } }
    }
};

struct EpiPLE {
    static constexpr bool PERM = false, AFTER_DRAIN = false;
    float* h; const bf16* pp;
    __device__ __forceinline__ void operator()(const f32x4 (&acc)[2][2][4][2], const pg8::Unit& u, int wr, int wc, int fr, int fq) const {
        { const int l_ = lane_id(); fr = l_ & 15; fq = l_ >> 4; } asm volatile("" : "+s"(wr), "+s"(wc));
        const int col0 = u.pn * 256 + wc * 32 + 4 * fq;
#pragma unroll
        for (int ai = 0; ai < 2; ++ai)
#pragma unroll
            for (int m = 0; m < 4; ++m) { const size_t off = (size_t)(u.pm * 256 + ai * 128 + wr * 64 + m * 16 + fr) * DM + col0;
#pragma unroll
                for (int bj = 0; bj < 2; ++bj)
#pragma unroll
                    for (int n = 0; n < 2; ++n) { const size_t o2 = off + bj * 128 + n * 16; const f32x4 a = acc[ai][bj][m][n]; const u32x2 pw = *(const u32x2*)(pp + o2);
                        f32x4 hv = *(const f32x4*)(h + o2);
                        hv.x += bflo(pw.x) / (1.0f + __expf(-a.x)); hv.y += bfhi(pw.x) / (1.0f + __expf(-a.y));
                        hv.z += bflo(pw.y) / (1.0f + __expf(-a.z)); hv.w += bfhi(pw.y) / (1.0f + __expf(-a.w));
                        *(f32x4*)(h + o2) = hv; } }
    }
};

__device__ __forceinline__ void load_row64(const bf16* p, float (&q)[64], float sc) {
    const v4u* p4 = (const v4u*)p;
#pragma unroll
    for (int c = 0; c < 8; ++c) { const v4u u = p4[c];
        q[8 * c + 0] = bflo(u.x) * sc; q[8 * c + 1] = bfhi(u.x) * sc; q[8 * c + 2] = bflo(u.y) * sc; q[8 * c + 3] = bfhi(u.y) * sc;
        q[8 * c + 4] = bflo(u.z) * sc; q[8 * c + 5] = bfhi(u.z) * sc; q[8 * c + 6] = bflo(u.w) * sc; q[8 * c + 7] = bfhi(u.w) * sc; }
}
__device__ __forceinline__ float dot64(const float (&q)[64], const bf16* kp) {
    const v4u* p4 = (const v4u*)kp; float s0 = 0.f, s1 = 0.f;
#pragma unroll
    for (int c = 0; c < 8; ++c) { const v4u u = p4[c];
        s0 = fmaf(q[8 * c + 0], bflo(u.x), s0); s1 = fmaf(q[8 * c + 1], bfhi(u.x), s1); s0 = fmaf(q[8 * c + 2], bflo(u.y), s0); s1 = fmaf(q[8 * c + 3], bfhi(u.y), s1);
        s0 = fmaf(q[8 * c + 4], bflo(u.z), s0); s1 = fmaf(q[8 * c + 5], bfhi(u.z), s1); s0 = fmaf(q[8 * c + 6], bflo(u.w), s0); s1 = fmaf(q[8 * c + 7], bfhi(u.w), s1); }
    return s0 + s1;
}
__device__ __forceinline__ void online_update(float s, bool valid, const bf16* vp, float (&o)[64], float& m, float& l) {
    const float sm = valid ? s : -1e30f;
    if (__any(sm > m)) { const float mn = fmaxf(m, sm); const float corr = __expf(m - mn); l *= corr;
#pragma unroll
        for (int d = 0; d < 64; ++d) o[d] *= corr;
        m = mn; }
    const float p = valid ? __expf(s - m) : 0.f;
    l += p;
    const v4u* p4 = (const v4u*)vp;
#pragma unroll
    for (int c = 0; c < 8; ++c) { const v4u u = p4[c];
        o[8 * c + 0] = fmaf(p, bflo(u.x), o[8 * c + 0]); o[8 * c + 1] = fmaf(p, bfhi(u.x), o[8 * c + 1]); o[8 * c + 2] = fmaf(p, bflo(u.y), o[8 * c + 2]); o[8 * c + 3] = fmaf(p, bfhi(u.y), o[8 * c + 3]);
        o[8 * c + 4] = fmaf(p, bflo(u.z), o[8 * c + 4]); o[8 * c + 5] = fmaf(p, bfhi(u.z), o[8 * c + 5]); o[8 * c + 6] = fmaf(p, bflo(u.w), o[8 * c + 6]); o[8 * c + 7] = fmaf(p, bfhi(u.w), o[8 * c + 7]); }
}
__device__ __forceinline__ void store_row64(bf16* p, const float (&o)[64], float sc) {
    v4u* p4 = (v4u*)p;
#pragma unroll
    for (int c = 0; c < 8; ++c) { v4u w; w.x = pk2(o[8 * c + 0] * sc, o[8 * c + 1] * sc); w.y = pk2(o[8 * c + 2] * sc, o[8 * c + 3] * sc);
        w.z = pk2(o[8 * c + 4] * sc, o[8 * c + 5] * sc); w.w = pk2(o[8 * c + 6] * sc, o[8 * c + 7] * sc); p4[c] = w; }
}
__device__ __forceinline__ void attnA_naive(const bf16* qkv, bf16* ao, int item, int lane) {
    const int chunk = item & 63, hq = (item >> 6) & 3, b = item >> 8, kvh = hq >> 1, t = chunk * 64 + lane;
    float q[64], o[64];
    load_row64(qkv + (size_t)(b * SEQ + t) * NQKV + C_QA + hq * 64, q, 0.125f);
#pragma unroll
    for (int d = 0; d < 64; ++d) o[d] = 0.f;
    float m = -1e30f, l = 0.f;
    const bf16* kb = qkv + (size_t)b * SEQ * NQKV + C_KA + kvh * 64;
    const bf16* vb = qkv + (size_t)b * SEQ * NQKV + C_VA + kvh * 64;
    for (int j = 0; j < SEQ; ++j) { const float s = dot64(q, kb + (size_t)j * NQKV); online_update(s, true, vb + (size_t)j * NQKV, o, m, l); }
    store_row64(ao + (size_t)(b * SEQ + t) * DM + hq * 64, o, 1.0f / l);
}
__device__ __forceinline__ void attnB_naive(const bf16* qkv, const float* nab, bf16* ao, int item, int lane) {
    const int r = item & 63, bh = item >> 6, h = bh % 6, b = bh / 6, c = lane;
    const int rs = min(max(r - 4, 0), 56), cs = min(max(c - 8, 0), 48);
    float q[64], o[64];
    load_row64(qkv + (size_t)(b * SEQ + r * 64 + c) * NQKV + C_QB + h * 64, q, 0.125f);
#pragma unroll
    for (int d = 0; d < 64; ++d) o[d] = 0.f;
    float m = -1e30f, l = 0.f;
    for (int i = 0; i < 8; ++i)
        for (int jj = 0; jj < 16; ++jj) {
            const size_t krow = (size_t)(b * SEQ + (rs + i) * 64 + cs + jj) * NQKV;
            const float bias = nab[(h * 15 + (rs + i - r + 7)) * 31 + (cs + jj - c + 15)];
            const float s = dot64(q, qkv + krow + C_KB + h * 64) + bias;
            online_update(s, true, qkv + krow + C_VB + h * 64, o, m, l);
        }
    store_row64(ao + (size_t)(b * SEQ + r * 64 + c) * DM + 256 + h * 64, o, 1.0f / l);
}
__device__ __forceinline__ void attnC_naive(const bf16* qkv, bf16* ao, int item, int lane) {
    const int chunk = item & 63, bh = item >> 6, h = bh % 6, b = bh / 6, t = chunk * 64 + lane;
    float q[64], o[64];
    load_row64(qkv + (size_t)(b * SEQ + t) * NQKV + C_QC + h * 64, q, 0.125f);
#pragma unroll
    for (int d = 0; d < 64; ++d) o[d] = 0.f;
    float m = -1e30f, l = 0.f;
    for (int br = 0; br < 3; ++br) { const int dil = 1 << (2 * br);
        for (int j = -64; j <= 64; ++j) { const int pos = t + dil * j; const bool valid = (unsigned)pos < (unsigned)SEQ; const int pc = valid ? pos : t;
            const size_t krow = (size_t)(b * SEQ + pc) * NQKV;
            const float s = dot64(q, qkv + krow + C_KC + h * 64);
            online_update(s, valid, qkv + krow + C_VC + h * 64, o, m, l); } }
    store_row64(ao + (size_t)(b * SEQ + t) * DM + 640 + h * 64, o, 1.0f / l);
}

__device__ __forceinline__ void groupnorm_row(const bf16* arow, const float* gout, bf16* orow, int lane) {
    const v4u* a4 = (const v4u*)arow + 2 * lane; const v4u u0 = a4[0], u1 = a4[1];
    float v[16];
    v[0] = bflo(u0.x); v[1] = bfhi(u0.x); v[2] = bflo(u0.y); v[3] = bfhi(u0.y); v[4] = bflo(u0.z); v[5] = bfhi(u0.z); v[6] = bflo(u0.w); v[7] = bfhi(u0.w);
    v[8] = bflo(u1.x); v[9] = bfhi(u1.x); v[10] = bflo(u1.y); v[11] = bfhi(u1.y); v[12] = bflo(u1.z); v[13] = bfhi(u1.z); v[14] = bflo(u1.w); v[15] = bfhi(u1.w);
    float ss = 0.f;
#pragma unroll
    for (int i = 0; i < 16; ++i) ss += v[i] * v[i];
    const int grp = lane < 16 ? 0 : (lane < 40 ? 1 : 2);
    const float sa = wave_sum(grp == 0 ? ss : 0.f), sb = wave_sum(grp == 1 ? ss : 0.f), sc = wave_sum(grp == 2 ? ss : 0.f);
    const float rstd = (grp == 0) ? 1.0f / sqrtf(sa * (1.0f / 256.0f) + RMS_EPS) : (grp == 1) ? 1.0f / sqrtf(sb * (1.0f / 384.0f) + RMS_EPS) : 1.0f / sqrtf(sc * (1.0f / 384.0f) + RMS_EPS);
    const f32x4* g4 = (const f32x4*)gout + 4 * lane;
    v4u o0, o1; { const f32x4 g0 = g4[0], g1 = g4[1], g2 = g4[2], g3 = g4[3];
        o0.x = pk2(v[0] * rstd * g0.x, v[1] * rstd * g0.y); o0.y = pk2(v[2] * rstd * g0.z, v[3] * rstd * g0.w); o0.z = pk2(v[4] * rstd * g1.x, v[5] * rstd * g1.y); o0.w = pk2(v[6] * rstd * g1.z, v[7] * rstd * g1.w);
        o1.x = pk2(v[8] * rstd * g2.x, v[9] * rstd * g2.y); o1.y = pk2(v[10] * rstd * g2.z, v[11] * rstd * g2.w); o1.z = pk2(v[12] * rstd * g3.x, v[13] * rstd * g3.y); o1.w = pk2(v[14] * rstd * g3.z, v[15] * rstd * g3.w); }
    v4u* o4 = (v4u*)orow + 2 * lane; o4[0] = o0; o4[1] = o1;
}

__device__ __forceinline__ void router_phase(const float* h, const float* gffn, const float* wr, bf16* an, float* aff, LAS unsigned char* lds, int tid, int lane, int gw, int NGW) {
    LAS float* wrT = (LAS float*)(lds + RING_OFF);
    for (int i = tid; i < DM * NE; i += NTHR) { const int col = i >> 4, e = i & 15; wrT[e * DM + col] = wr[i]; }
    __syncthreads();
    for (int mrow = gw; mrow < MTOK; mrow += NGW) {
        const f32x4* xr = (const f32x4*)(h + (size_t)mrow * DM) + lane;
        const f32x4* gr = (const f32x4*)gffn + lane;
        f32x4 v[4]; float s = 0.f;
#pragma unroll
        for (int j = 0; j < 4; ++j) { v[j] = xr[64 * j]; s += (v[j].x * v[j].x + v[j].y * v[j].y) + (v[j].z * v[j].z + v[j].w * v[j].w); }
        const float rstd = 1.0f / sqrtf(wave_sum(s) * (1.0f / DM) + RMS_EPS);
#pragma unroll
        for (int j = 0; j < 4; ++j) { const f32x4 g = gr[64 * j]; v[j].x = v[j].x * rstd * g.x; v[j].y = v[j].y * rstd * g.y; v[j].z = v[j].z * rstd * g.z; v[j].w = v[j].w * rstd * g.w; }
        unsigned long long* o8 = (unsigned long long*)(an + (size_t)mrow * DM) + lane;
#pragma unroll
        for (int j = 0; j < 4; ++j) o8[64 * j] = (unsigned long long)pk2(v[j].x, v[j].y) | ((unsigned long long)pk2(v[j].z, v[j].w) << 32);
        float lg[16];
#pragma unroll
        for (int e = 0; e < 16; ++e) { float a = 0.f;
#pragma unroll
            for (int j = 0; j < 4; ++j) { const f32x4 w = *(const LAS f32x4*)(wrT + e * DM + 4 * lane + 256 * j); a += (v[j].x * w.x + v[j].y * w.y) + (v[j].z * w.z + v[j].w * w.w); }
            lg[e] = wave_sum(a); asm volatile("" ::: "memory"); }
        float mx = lg[0];
#pragma unroll
        for (int e = 1; e < 16; ++e) mx = fmaxf(mx, lg[e]);
        float sum = 0.f;
#pragma unroll
        for (int e = 0; e < 16; ++e) { lg[e] = expf(lg[e] - mx); sum += lg[e]; }
        float mine = 0.f;
#pragma unroll
        for (int e = 0; e < 16; ++e) mine = (lane == e) ? lg[e] : mine;
        if (lane < 16) { const int b = mrow >> 12, sidx = mrow & (SEQ - 1); aff[(size_t)(b * NE + lane) * SEQ + sidx] = mine / sum; }
    }
    __syncthreads();
}

__device__ __forceinline__ void topk_item(const float* aff, int* idx, float* gval, int* sel, int b, int e, LAS unsigned char* lds, int tid, int lane, int wave) {
    LAS int* sc = (LAS int*)(lds + RING_OFF);
    const f32x4* a4 = (const f32x4*)(aff + (size_t)(b * NE + e) * SEQ) + 2 * tid;
    const f32x4 x0 = a4[0], x1 = a4[1];
    unsigned v[8] = {__float_as_uint(x0.x), __float_as_uint(x0.y), __float_as_uint(x0.z), __float_as_uint(x0.w), __float_as_uint(x1.x), __float_as_uint(x1.y), __float_as_uint(x1.z), __float_as_uint(x1.w)};
    unsigned T = 0u;
    for (int bit = 30; bit >= 0; --bit) {
        const unsigned cand = T | (1u << bit);
        int c = 0;
#pragma unroll
        for (int i = 0; i < 8; ++i) c += (v[i] >= cand) ? 1 : 0;
        c = wave_sum_i(c);
        const int par = (bit & 1) * 8;
        if (lane == 0) sc[par + wave] = c;
        __syncthreads();
        int tot = 0;
#pragma unroll
        for (int w = 0; w < 8; ++w) tot += sc[par + w];
        if (tot >= CAP) T = cand;
    }
    int cg = 0, ce = 0;
#pragma unroll
    for (int i = 0; i < 8; ++i) { cg += (v[i] > T) ? 1 : 0; ce += (v[i] == T) ? 1 : 0; }
    int sg = cg, se = ce;
#pragma unroll
    for (int o = 1; o < 64; o <<= 1) { const int src = ((lane - o) & 63) << 2; const int tg = __builtin_amdgcn_ds_bpermute(src, sg), te = __builtin_amdgcn_ds_bpermute(src, se); if (lane >= o) { sg += tg; se += te; } }
    if (lane == 63) { sc[32 + wave] = sg; sc[48 + wave] = se; }
    __syncthreads();
    int baseg = 0, basee = 0, totg = 0;
#pragma unroll
    for (int w = 0; w < 8; ++w) { const int g = sc[32 + w], q = sc[48 + w]; if (w < wave) { baseg += g; basee += q; } totg += g; }
    int pg = baseg + sg - cg, pe = basee + se - ce;
    const int need = CAP - totg;
    const int R0 = (e * NB + b) * CAP;
#pragma unroll
    for (int i = 0; i < 8; ++i) { const int s = tid * 8 + i; int slot = -1;
        if (v[i] > T) { slot = pg; ++pg; }
        else if (v[i] == T) { if (pe < need) slot = totg + pe; ++pe; }
        sel[(size_t)(b * SEQ + s) * NE + e] = slot;
        if (slot >= 0) { idx[R0 + slot] = s; gval[R0 + slot] = __uint_as_float(v[i]); } }
    __syncthreads();
}

#ifndef ONLY_PHASE
#define ONLY_PHASE -1
#endif
#define PHEN(k) (ONLY_PHASE < 0 || ONLY_PHASE == (k))
#define KAS __attribute__((address_space(4)))
#define PHV int ll = lane_id(); int gwl = gw, wvl = wave; asm volatile("" : "+s"(gwl), "+s"(wvl)); int tl = wvl * 64 + ll; (void)tl; (void)ll; (void)gwl; (void)wvl; \
    const KAS Args* ka = (const KAS Args*)__builtin_amdgcn_kernarg_segment_ptr(); asm volatile("" : "+s"(ka)); unsigned char* const ws = ka->ws; float* const hout = ka->out; (void)ws; (void)hout


#define cs_ax ((float2_t*)(ws + WS_TAB))
#define cs_1d ((float2_t*)(ws + WS_TAB + 65536))
#define aff ((float*)(ws + WS_AFF))
#define idx ((int*)(ws + WS_IDX))
#define gval ((float*)(ws + WS_GATE))
#define sel ((int*)(ws + WS_SEL))
#define Win_t ((bf16*)(ws + WS_WIN))
#define Wout_t ((bf16*)(ws + WS_WOUT))
#define Wpg_t ((bf16*)(ws + WS_WPG))
#define Wpp_t ((bf16*)(ws + WS_WPP))
#define Wgu_t ((bf16*)(ws + WS_WGU))
#define Wd_t ((bf16*)(ws + WS_WD))
#define pbf ((bf16*)(ws + WS_PBF))
#define an ((bf16*)(ws + WS_AN))
#define qkv ((bf16*)(ws + WS_QKV))
#define ao ((bf16*)(ws + WS_AO))
#define xg ((bf16*)(ws + WS_XG))
#define hid ((bf16*)(ws + WS_HID))
#define pp ((bf16*)(ws + WS_PP))
#define mix ((bf16*)(ws + WS_MIX))
#define yb ((bf16*)(ws + WS_Y))
#define IN_X (ka->in[0])
#define IN_P (ka->in[1])
#define IN_GMIX (ka->in[2])
#define IN_WIN (ka->in[3])
#define IN_QKG (ka->in[4])
#define IN_NAB (ka->in[5])
#define IN_GOUT (ka->in[6])
#define IN_WOUT (ka->in[7])
#define IN_GFFN (ka->in[8])
#define IN_WR (ka->in[9])
#define IN_WG (ka->in[10])
#define IN_WU (ka->in[11])
#define IN_WD (ka->in[12])
#define IN_GPLE (ka->in[13])
#define IN_WPG (ka->in[14])
#define IN_WPP (ka->in[15])
__global__ void __launch_bounds__(NTHR, 2) mk_fwd(Args args) {
    extern __shared__ __attribute__((aligned(16))) unsigned char lds_raw[];
    LAS unsigned char* lds = (LAS unsigned char*)lds_raw;
    volatile LAS unsigned* MISC = (volatile LAS unsigned*)(lds + MISC_OFF);
    const int wave = __builtin_amdgcn_readfirstlane((int)threadIdx.x >> 6);
    const int G = gridDim.x, bid = blockIdx.x;
    const int gw = bid * NWAVES + wave, NGW = G * NWAVES, NGT = G * NTHR;
    gu32* ctl = (gu32*)(args.ws + WS_CTL);

    for (int u = wave * 64 + lane_id(); u < (LDS_BYTES - LDSCTL_OFF) / 4; u += NTHR) ((LAS unsigned*)(lds + LDSCTL_OFF))[u] = 0u;
    __syncthreads();
    const int lo = args.ph_lo, hi = args.ph_hi;
    const bool use_bar = (hi - lo) > 1;
    XcdBarrier bar; bar.bar = (unsigned*)(ctl + CW_BAR); bar.x = 0; bar.st = nullptr;
    if (use_bar) bar = xcd_barrier_post((unsigned*)(ctl + CW_BAR), MISC + 8);
#define IN(k) (lo <= (k) && (k) < hi)
#define SEAM(k) do { if (IN(k) && IN((k) + 1)) xcd_barrier(bar); } while (0)

    if (PHEN(100) && IN(0)) { PHV;
        const int gtid0 = bid * NTHR + tl;
        for (int i = gtid0; i < 64 * 16 + SEQ * 8; i += NGT) {
            float c, s;
            if (i < 1024) { const int pos = i >> 4, j = i & 15; sincos_acc((float)pos * ka->inv_ax[j], c, s); cs_ax[i].x = c; cs_ax[i].y = s; }
            else { const int k = i - 1024, pos = k >> 3, j = k & 7; sincos_acc((float)pos * ka->inv_1d[j], c, s); cs_1d[k].x = c; cs_1d[k].y = s; }
        }
        for (int m = gwl; m < MTOK; m += NGW) norm_row_bf16(IN_X + (size_t)m * DM, IN_GMIX, an + (size_t)m * DM, ll);
        convert_layer(ka, 0, lds, gwl, NGW, wvl, ll, gtid0, NGT);
    }
    SEAM(0);

    for (int l = 0; l < DEPTH; ++l) {
        const int pb = 1 + l * NPH_LAYER;
        if (PHEN(0) && IN(pb + 0)) { PHV;
            pg8::Gemm g{an, Win_t, MTOK, NQKV, DM}; pg8::StaticOrder S; S.init(MTOK, NQKV, G, bid);
            EpiQKV E{qkv, IN_QKG + (size_t)l * 3 * 2 * 64, cs_ax, cs_1d};
            pg8::gemm_phase<EpiQKV, pg8::StaticOrder, true, true>(lds + RING_OFF, g, S, E, tl);
        }
        SEAM(pb + 0);
        if (PHEN(1) && IN(pb + 1)) { PHV;
#ifndef NO_ATTA
            for (int it = gwl; it < NB * 4 * 64; it += NGW) attnA_naive(qkv, ao, it, ll);
#endif
#ifndef NO_ATTB
            for (int it = gwl; it < NB * 6 * 64; it += NGW) attnB_naive(qkv, IN_NAB + (size_t)l * 6 * 15 * 31, ao, it, ll);
#endif
#ifndef NO_ATTC
            for (int it = gwl; it < NB * 6 * 64; it += NGW) attnC_naive(qkv, ao, it, ll);
#endif
        }
        SEAM(pb + 1);
        if (PHEN(2) && IN(pb + 2)) { PHV;
            for (int m = gwl; m < MTOK; m += NGW) groupnorm_row(ao + (size_t)m * DM, IN_GOUT + (size_t)l * DM, mix + (size_t)m * DM, ll);
        }
        SEAM(pb + 2);
        if (PHEN(3) && IN(pb + 3)) { PHV;
            pg8::Gemm g{mix, Wout_t, MTOK, DM, DM}; pg8::StaticOrder S; S.init(MTOK, DM, G, bid);
            EpiResid E{(l == 0) ? IN_X : (const float*)hout, hout};
            pg8::gemm_phase<EpiResid, pg8::StaticOrder, true, true>(lds + RING_OFF, g, S, E, tl);
        }
        SEAM(pb + 3);
        if (PHEN(4) && IN(pb + 4)) { PHV; router_phase(hout, IN_GFFN + (size_t)l * DM, IN_WR + (size_t)l * DM * NE, an, aff, lds, tl, ll, gwl, NGW); }
        SEAM(pb + 4);
        if (PHEN(5) && IN(pb + 5)) { PHV;
            const int halfG = G >> 1;
            if (bid < halfG) { const int l2 = lane_id(); for (int it = bid; it < NB * NE; it += halfG) topk_item(aff, idx, gval, sel, it >> 4, it & 15, lds, wvl * 64 + l2, l2, wvl); }
            else {
                pg8::Gemm g{pbf, Wpp_t, MTOK, DM, DPLE}; pg8::StaticOrder S; S.init(MTOK, DM, G - halfG, bid - halfG);
                EpiStoreBf16 E{pp};
                pg8::gemm_phase<EpiStoreBf16, pg8::StaticOrder, true, true>(lds + RING_OFF, g, S, E, tl);
            }
        }
        SEAM(pb + 5);
        if (PHEN(6) && IN(pb + 6)) { PHV;
            for (int R = gwl; R < MR; R += NGW) { const int b = (R >> 9) & 7; const int tok = b * SEQ + idx[R];
                const v4u* src = (const v4u*)(an + (size_t)tok * DM) + ll; v4u* dst = (v4u*)(xg + (size_t)R * DM) + ll;
                const v4u a = src[0], c = src[64]; dst[0] = a; dst[64] = c; }
        }
        SEAM(pb + 6);
        if (PHEN(7) && IN(pb + 7)) { PHV;
            pg8::Gemm g{xg, Wgu_t, MR, 2048, DM}; GroupedOrder S; S.init(2048, G, bid);
            EpiSwiGLU E{hid};
            pg8::gemm_phase<EpiSwiGLU, GroupedOrder, true, true>(lds + RING_OFF, g, S, E, tl);
        }
        SEAM(pb + 7);
        if (PHEN(8) && IN(pb + 8)) { PHV;
            pg8::Gemm g{hid, Wd_t, MR, DM, DFF}; GroupedOrder S; S.init(DM, G, bid);
            EpiStoreBf16 E{yb};
            pg8::gemm_phase<EpiStoreBf16, GroupedOrder, true, true>(lds + RING_OFF, g, S, E, tl);
        }
        SEAM(pb + 8);
        if (PHEN(9) && IN(pb + 9)) { PHV;
            for (int m = gwl; m < MTOK; m += NGW) {
                const int b = m >> 12;
                f32x4* hr = (f32x4*)(hout + (size_t)m * DM) + ll;
                f32x4 v[4];
#pragma unroll
                for (int j = 0; j < 4; ++j) v[j] = hr[64 * j];
                const int* sl = sel + (size_t)m * NE;
                for (int e = 0; e < NE; ++e) { const int slot = sl[e];
                    if (slot >= 0) { const int R = (e * NB + b) * CAP + slot; const float gt = gval[R];
                        const unsigned long long* y8 = (const unsigned long long*)(yb + (size_t)R * DM) + ll;
#pragma unroll
                        for (int j = 0; j < 4; ++j) { const unsigned long long w = y8[64 * j]; const unsigned w0 = (unsigned)w, w1 = (unsigned)(w >> 32);
                            v[j].x += gt * bflo(w0); v[j].y += gt * bfhi(w0); v[j].z += gt * bflo(w1); v[j].w += gt * bfhi(w1); } } }
                float s = 0.f;
#pragma unroll
                for (int j = 0; j < 4; ++j) { hr[64 * j] = v[j]; s += (v[j].x * v[j].x + v[j].y * v[j].y) + (v[j].z * v[j].z + v[j].w * v[j].w); }
                const float rstd = 1.0f / sqrtf(wave_sum(s) * (1.0f / DM) + RMS_EPS);
                const f32x4* gr = (const f32x4*)(IN_GPLE + (size_t)l * DM) + ll;
                unsigned long long* o8 = (unsigned long long*)(an + (size_t)m * DM) + ll;
#pragma unroll
                for (int j = 0; j < 4; ++j) { const f32x4 g = gr[64 * j];
                    o8[64 * j] = (unsigned long long)pk2(v[j].x * rstd * g.x, v[j].y * rstd * g.y) | ((unsigned long long)pk2(v[j].z * rstd * g.z, v[j].w * rstd * g.w) << 32); }
            }
        }
        SEAM(pb + 9);
        if (PHEN(10) && IN(pb + 10)) { PHV;
            pg8::Gemm g{an, Wpg_t, MTOK, DM, DM}; pg8::StaticOrder S; S.init(MTOK, DM, G, bid);
            EpiPLE E{hout, pp};
            pg8::gemm_phase<EpiPLE, pg8::StaticOrder, true, true>(lds + RING_OFF, g, S, E, tl);
        }
        SEAM(pb + 10);
        if (PHEN(11) && IN(pb + 11) && l + 1 < DEPTH) { PHV;
            for (int m = gwl; m < MTOK; m += NGW) norm_row_bf16(hout + (size_t)m * DM, IN_GMIX + (size_t)(l + 1) * DM, an + (size_t)m * DM, ll);
            convert_layer(ka, l + 1, lds, gwl, NGW, wvl, ll, (bid * NTHR + tl), NGT);
        }
        SEAM(pb + 11);
    }
#undef IN
#undef SEAM
}

#ifndef MK_ONE_LAUNCH
#define MK_ONE_LAUNCH 0
#endif
extern "C" void kernel_launch(void* const* d_in, const int* in_sizes, int n_in, void* d_out, int out_size, void* d_ws, size_t ws_size, hipStream_t stream) {
    static int grid = 0;
    if (grid == 0) {
        if (n_in != 16 || out_size != MTOK * DM || ws_size < WS_END) { fprintf(stderr, "kernel_launch: unexpected shapes (n_in %d out %d ws %zu)\n", n_in, out_size, ws_size); grid = -1; return; }
        int dev = 0, cus = 0, per_cu = 0;
        if (hipGetDevice(&dev) != hipSuccess || hipDeviceGetAttribute(&cus, hipDeviceAttributeMultiprocessorCount, dev) != hipSuccess) { grid = -1; return; }
        if (hipFuncSetAttribute((const void*)mk_fwd, hipFuncAttributeMaxDynamicSharedMemorySize, LDS_BYTES) != hipSuccess) { fprintf(stderr, "kernel_launch: hipFuncSetAttribute failed\n"); grid = -1; return; }
        if (hipOccupancyMaxActiveBlocksPerMultiprocessor(&per_cu, (const void*)mk_fwd, NTHR, LDS_BYTES) != hipSuccess || per_cu < 1) fprintf(stderr, "kernel_launch: occupancy query says %d\n", per_cu);
        (void)hipGetLastError();
        grid = cus;
    }
    if (grid < 0) return;
    (void)hipMemsetAsync((char*)d_ws + WS_CTL, 0, CTL_ZERO_BYTES, stream);
    Args a{};
    for (int i = 0; i < 16; ++i) a.in[i] = (const float*)d_in[i];
    a.out = (float*)d_out; a.ws = (unsigned char*)d_ws;
    for (int j = 0; j < 16; ++j) a.inv_ax[j] = (float)pow(10000.0, -(double)j / 16.0);
    for (int j = 0; j < 8; ++j) a.inv_1d[j] = (float)pow(500000.0, -(double)j / 8.0);
#if MK_ONE_LAUNCH
    a.ph_lo = 0; a.ph_hi = NPHASES;
    hipLaunchKernelGGL(mk_fwd, dim3(grid), dim3(NTHR), LDS_BYTES, stream, a);
#else
    for (int ph = 0; ph < NPHASES - 1; ++ph) { a.ph_lo = ph; a.ph_hi = ph + 1; hipLaunchKernelGGL(mk_fwd, dim3(grid), dim3(NTHR), LDS_BYTES, stream, a); }
#endif
}
```

```cpp
#include <hip/hip_runtime.h>
#include <hip/hip_bf16.h>
#include <cstdio>
#include <cstdint>
#include <cmath>
namespace pg8 {
#define PG8_LAS __attribute__((address_space(3)))
typedef unsigned short bf16_t;
typedef short bf16x8 __attribute__((ext_vector_type(8)));
typedef float f32x4 __attribute__((ext_vector_type(4)));
typedef unsigned u32x4 __attribute__((ext_vector_type(4)));
constexpr int BM = 256, BK = 64, HALF = 128, HTB = HALF * BK * 2  , STAGE_BYTES = 8 * HTB, NXCD = 8, WGM = 8;

__host__ __device__ __forceinline__ int lds_byte(int r, int c) { const int st = (r >> 4) * 2 + (c >> 5), rr = r & 15, cc = c & 31, ob = rr * 64 + cc * 2; return st * 1024 + (ob ^ (((ob >> 9) & 1) << 5)); }
__host__ __device__ __forceinline__ void stage_rc(int b, int& R, int& C) { const int st = b / 1024, sb = b % 1024, swz = sb ^ (((sb >> 9) & 1) << 5); R = (st >> 1) * 16 + swz / 64; C = (st & 1) * 32 + (swz % 64) / 2; }
__host__ __device__ __forceinline__ int perm32(int rho) { const int n = rho >> 4, i = rho & 15; return 8 * (i >> 2) + 4 * n + (i & 3); }

struct Unit { int pm, pn; };
struct Gemm { const bf16_t* A; const bf16_t* Bt; int M, N, K; };

struct StaticOrder {
    int nM, nN, nwg, G, c;
    __host__ __device__ void init(int M, int N, int G_, int c_) { nM = M / BM; nN = N / BM; nwg = nM * nN; G = G_; c = c_; }
    __host__ __device__ bool next(int i, Unit& u) const {
        const long L = (long)i * G + c; if (L >= nwg) return false;
        int wgid = (int)L; { const int q = nwg / NXCD, r = nwg % NXCD, xcd = wgid % NXCD, off = wgid / NXCD; wgid = (xcd < r ? xcd * (q + 1) : r * (q + 1) + (xcd - r) * q) + off; }
        const int nig = WGM * nN, gid = wgid / nig, fm = gid * WGM, gsz = (nM - fm) < WGM ? (nM - fm) : WGM;
        u.pm = fm + ((wgid % nig) % gsz); u.pn = (wgid % nig) / gsz; return true;
    }
    __device__ __forceinline__ void a_ready(const Unit&) const {}
    __device__ __forceinline__ void done(const Unit&) const {}
};

__device__ __forceinline__ unsigned cvt_pk_bf16(float lo, float hi) { unsigned r; asm volatile("v_cvt_pk_bf16_f32 %0, %1, %2" : "=v"(r) : "v"(lo), "v"(hi)); return r; }
typedef float f32x2 __attribute__((ext_vector_type(2)));
__device__ __forceinline__ f32x2 gelu_pk(f32x2 v) {
    const f32x2 av = __builtin_elementwise_abs(v), d = av * 0.2316418882f + 1.0f;
    f32x2 t; t.x = __builtin_amdgcn_rcpf(d.x); t.y = __builtin_amdgcn_rcpf(d.y);
    f32x2 q = t * 0.5307027145f + (-0.7265760135f); q = q * t + 0.7107068705f; q = q * t + (-0.142248368f); q = q * t + 0.127414796f; q = q * t;
    const f32x2 s = (v * v) * (-0.72134752044f);
    f32x2 e; e.x = __builtin_amdgcn_exp2f(s.x); e.y = __builtin_amdgcn_exp2f(s.y);
    const f32x2 m = v * (q * e), r = v - m;
    f32x2 o; o.x = v.x < 0.f ? m.x : r.x; o.y = v.y < 0.f ? m.y : r.y; return o;
}

template <int ACT  > struct EpiBf16 {
    static constexpr bool PERM = true, AFTER_DRAIN = false; static_assert(ACT == 0 || ACT == 1, "EpiBf16: ACT is 0 (none) or 1 (gelu_pk)");
    bf16_t* O; int ldc; const float* bias; int split_cols; size_t split_stride; float scale0;
    __device__ __forceinline__ void operator()(const f32x4 (&acc)[2][2][4][2], const Unit& u, int wr, int wc, int fr, int fq) const {
        const int row0 = u.pm * BM + wr * 64 + fr; int colt = u.pn * BM; bf16_t* base = O;
        float sc = 1.f; if (split_cols) { const int t = colt / split_cols; base += (size_t)t * split_stride; colt -= t * split_cols; if (t == 0) sc = scale0; }
        const int col0 = colt + wc * 32 + 8 * fq, bcol0 = u.pn * BM + wc * 32 + 8 * fq;
        f32x4 bv[2][2];
#pragma unroll
        for (int bj = 0; bj < 2; ++bj)
#pragma unroll
            for (int n = 0; n < 2; ++n) bv[bj][n] = bias ? *(const f32x4*)(bias + bcol0 + bj * HALF + 4 * n) : (f32x4){0.f, 0.f, 0.f, 0.f};
#pragma unroll
        for (int ai = 0; ai < 2; ++ai)
#pragma unroll
            for (int m = 0; m < 4; ++m) { bf16_t* rowp = base + (size_t)(row0 + ai * HALF + m * 16) * ldc + col0;
#pragma unroll
                for (int bj = 0; bj < 2; ++bj) { f32x4 v0 = acc[ai][bj][m][0] + bv[bj][0], v1 = acc[ai][bj][m][1] + bv[bj][1];
                    if (ACT == 1) { f32x2 a = gelu_pk((f32x2){v0[0], v0[1]}), b = gelu_pk((f32x2){v0[2], v0[3]}), c = gelu_pk((f32x2){v1[0], v1[1]}), d = gelu_pk((f32x2){v1[2], v1[3]});
                        v0 = (f32x4){a.x, a.y, b.x, b.y}; v1 = (f32x4){c.x, c.y, d.x, d.y}; }
                    v0 = v0 * sc; v1 = v1 * sc; u32x4 w; w.x = cvt_pk_bf16(v0[0], v0[1]); w.y = cvt_pk_bf16(v0[2], v0[3]); w.z = cvt_pk_bf16(v1[0], v1[1]); w.w = cvt_pk_bf16(v1[2], v1[3]);
                    *(u32x4*)(rowp + bj * HALF) = w; } }
    }
};

struct PanelStats {
    unsigned* xbuf;
    unsigned* cnt;
    unsigned* tmo;
    int ntn; float eps;
    unsigned code;
    __device__ __forceinline__ bool run(const f32x4 (&v)[2][2][4][2], const Unit& u, int wr, int wc, int fr, int fq, PG8_LAS unsigned char* lds, int wid, int lane) const {
        typedef float f32x2v __attribute__((ext_vector_type(2)));
        PG8_LAS f32x2v* P = (PG8_LAS f32x2v*)lds;
        PG8_LAS f32x2v* S = (PG8_LAS f32x2v*)(lds + 8192);
        PG8_LAS unsigned* flag = (PG8_LAS unsigned*)(lds + 8192 + 2048);
#pragma unroll
        for (int ai = 0; ai < 2; ++ai)
#pragma unroll
            for (int m = 0; m < 4; ++m) {
                float s = 0.f;
#pragma unroll
                for (int bj = 0; bj < 2; ++bj)
#pragma unroll
                    for (int n = 0; n < 2; ++n) { const f32x4 x = v[ai][bj][m][n]; s += (x[0] + x[1]) + (x[2] + x[3]); }
                s += __shfl_xor(s, 16); s += __shfl_xor(s, 32);
                const float mw = s * (1.0f / 64.0f); float q = 0.f;
#pragma unroll
                for (int bj = 0; bj < 2; ++bj)
#pragma unroll
                    for (int n = 0; n < 2; ++n) { const f32x4 d = v[ai][bj][m][n] - mw; q += (d[0] * d[0] + d[1] * d[1]) + (d[2] * d[2] + d[3] * d[3]); }
                q += __shfl_xor(q, 16); q += __shfl_xor(q, 32);
                if (fq == 0) P[(ai * HALF + wr * 64 + m * 16 + fr) * 4 + wc] = (f32x2v){mw, q};
            }
        asm volatile("s_waitcnt lgkmcnt(0)" ::: "memory"); __builtin_amdgcn_s_barrier(); asm volatile("" ::: "memory");
#if defined(BROKEN_EXCHANGE_NO_WAIT)
#warning BROKEN CONTROL BUILD: the row-statistics exchange does not wait; results are wrong by design
        if (blockIdx.x >= 64) { const long long t0_ = clock64(); while (clock64() - t0_ < 60000) __builtin_amdgcn_s_sleep(8); }
#endif
        const int row = wid * 32 + (lane & 31);
        if (lane < 32) {
            const f32x2v a = P[row * 4 + 0], b = P[row * 4 + 1], c = P[row * 4 + 2], d = P[row * 4 + 3];
            const float mt = (a.x + b.x + c.x + d.x) * 0.25f;
            const float da = a.x - mt, db = b.x - mt, dc = c.x - mt, dd = d.x - mt;
            const float m2 = (a.y + b.y) + (c.y + d.y) + 64.0f * ((da * da + db * db) + (dc * dc + dd * dd));
            unsigned long long* slot = (unsigned long long*)xbuf + ((size_t)(u.pm * BM + row) * 4 + u.pn);
            __hip_atomic_store(slot, ((unsigned long long)__float_as_uint(m2) << 32) | __float_as_uint(mt), __ATOMIC_RELAXED, __HIP_MEMORY_SCOPE_AGENT);
        }
        asm volatile("s_waitcnt vmcnt(0)" ::: "memory");
        if (lane == 0) __hip_atomic_fetch_add(cnt + 64 * u.pm, 1u, __ATOMIC_RELAXED, __HIP_MEMORY_SCOPE_AGENT);
        if (wid == 0) {
            bool dead = false; const unsigned long long t0 = __builtin_amdgcn_s_memrealtime(); const unsigned want = 8u * (unsigned)ntn;
            for (;;) {
#if defined(BROKEN_EXCHANGE_NO_WAIT)
                break;
#endif
                if ((unsigned)__builtin_amdgcn_readfirstlane(__hip_atomic_load(cnt + 64 * u.pm, __ATOMIC_RELAXED, __HIP_MEMORY_SCOPE_AGENT)) >= want) break;
                if (__builtin_amdgcn_s_memrealtime() - t0 > 2000000ull) {
                    if (lane == 0) { unsigned expect = 0u; __hip_atomic_compare_exchange_strong(tmo + 1, &expect, code | (unsigned)(u.pm & 0xff), __ATOMIC_RELAXED, __ATOMIC_RELAXED, __HIP_MEMORY_SCOPE_AGENT);
                                     __hip_atomic_store(tmo, 1u, __ATOMIC_RELAXED, __HIP_MEMORY_SCOPE_AGENT); }
                    dead = true; break; }
                __builtin_amdgcn_s_sleep(2);
            }
            __builtin_amdgcn_fence(__ATOMIC_ACQUIRE, "agent");
            if (lane == 0) flag[0] = dead ? 1u : 0u;
        }
        asm volatile("s_waitcnt vmcnt(0) lgkmcnt(0)" ::: "memory"); __builtin_amdgcn_s_barrier(); asm volatile("" ::: "memory");
        const bool bad = flag[0] != 0u;
        if (lane < 32) {
            const unsigned long long* slot = (const unsigned long long*)xbuf + (size_t)(u.pm * BM + row) * 4; float mt[4], m2[4]; float ms = 0.f;
#pragma unroll
            for (int t = 0; t < 4; ++t) { if (t < ntn) { const unsigned long long w = __hip_atomic_load(slot + t, __ATOMIC_RELAXED, __HIP_MEMORY_SCOPE_AGENT); mt[t] = __uint_as_float((unsigned)w); m2[t] = __uint_as_float((unsigned)(w >> 32)); } else { mt[t] = 0.f; m2[t] = 0.f; } ms += mt[t]; }
            const float mean = ms / (float)ntn; float q = 0.f;
#pragma unroll
            for (int t = 0; t < 4; ++t) if (t < ntn) { const float dm = mt[t] - mean; q += m2[t] + 256.0f * dm * dm; }
            S[row] = (f32x2v){mean, 1.0f / sqrtf(q / (256.0f * (float)ntn) + eps)};
        }
        asm volatile("s_waitcnt lgkmcnt(0)" ::: "memory"); __builtin_amdgcn_s_barrier(); asm volatile("" ::: "memory");
        return bad;
    }
};
struct EpiLnRes {
    static constexpr bool PERM = false, AFTER_DRAIN = true;
    const float* base; float* out; int ldc; const float* bias; PanelStats st; unsigned poison;
    __device__ __forceinline__ void fused(f32x4 (&acc)[2][2][4][2], const Unit& u, int wr, int wc, int fr, int fq, PG8_LAS unsigned char* lds, int wid, int lane) const {
        typedef float f32x2v __attribute__((ext_vector_type(2)));
        const PG8_LAS f32x2v* S = (const PG8_LAS f32x2v*)(lds + 8192);
        const int col0 = u.pn * BM + wc * 32 + 4 * fq;
#pragma unroll
        for (int bj = 0; bj < 2; ++bj)
#pragma unroll
            for (int n = 0; n < 2; ++n) { const f32x4 bv = bias ? *(const f32x4*)(bias + col0 + bj * HALF + n * 16) : (f32x4){0.f, 0.f, 0.f, 0.f};
#pragma unroll
                for (int ai = 0; ai < 2; ++ai)
#pragma unroll
                    for (int m = 0; m < 4; ++m) acc[ai][bj][m][n] += bv; }
        f32x4 pre[4][2][2];
#pragma unroll
        for (int m = 0; m < 4; ++m) { const size_t off = (size_t)(u.pm * BM + wr * 64 + m * 16 + fr) * ldc + col0;
#pragma unroll
            for (int bj = 0; bj < 2; ++bj)
#pragma unroll
                for (int n = 0; n < 2; ++n) pre[m][bj][n] = *(const f32x4*)(base + off + bj * HALF + n * 16); }
        const bool bad = st.run(acc, u, wr, wc, fr, fq, lds, wid, lane) || poison != 0u;
        const float qnan = __builtin_nanf("");
#pragma unroll
        for (int ai = 0; ai < 2; ++ai)
#pragma unroll
            for (int m = 0; m < 4; ++m) { const int r = ai * HALF + wr * 64 + m * 16 + fr; const f32x2v sr = S[r]; const size_t off = (size_t)(u.pm * BM + r) * ldc + col0;
#pragma unroll
                for (int bj = 0; bj < 2; ++bj)
#pragma unroll
                    for (int n = 0; n < 2; ++n) { const f32x4 bs = ai == 0 ? pre[m][bj][n] : *(const f32x4*)(base + off + bj * HALF + n * 16); f32x4 o = bs + (acc[ai][bj][m][n] - sr.x) * sr.y;
                        if (bad) o = (f32x4){qnan, qnan, qnan, qnan}; *(f32x4*)(out + off + bj * HALF + n * 16) = o; }
                if (m & 1) asm volatile("" ::: "memory"); }
    }
};
struct EpiLnResLn {
    static constexpr bool PERM = false, AFTER_DRAIN = true;
    const float* base; float* out; bf16_t* xn; int ldc; const float* bias; PanelStats st1, st2; unsigned poison;
    __device__ __forceinline__ void fused(f32x4 (&acc)[2][2][4][2], const Unit& u, int wr, int wc, int fr, int fq, PG8_LAS unsigned char* lds, int wid, int lane) const {
        typedef float f32x2v __attribute__((ext_vector_type(2))); typedef unsigned u32x2v __attribute__((ext_vector_type(2)));
        const PG8_LAS f32x2v* S = (const PG8_LAS f32x2v*)(lds + 8192);
        const int col0 = u.pn * BM + wc * 32 + 4 * fq;
#pragma unroll
        for (int bj = 0; bj < 2; ++bj)
#pragma unroll
            for (int n = 0; n < 2; ++n) { const f32x4 bv = bias ? *(const f32x4*)(bias + col0 + bj * HALF + n * 16) : (f32x4){0.f, 0.f, 0.f, 0.f};
#pragma unroll
                for (int ai = 0; ai < 2; ++ai)
#pragma unroll
                    for (int m = 0; m < 4; ++m) acc[ai][bj][m][n] += bv; }
        bool bad = st1.run(acc, u, wr, wc, fr, fq, lds, wid, lane) || poison != 0u;
        const float qnan = __builtin_nanf("");
#pragma unroll
        for (int ai = 0; ai < 2; ++ai)
#pragma unroll
            for (int m = 0; m < 4; ++m) { const int r = ai * HALF + wr * 64 + m * 16 + fr; const f32x2v sr = S[r]; const size_t off = (size_t)(u.pm * BM + r) * ldc + col0;
#pragma unroll
                for (int bj = 0; bj < 2; ++bj)
#pragma unroll
                    for (int n = 0; n < 2; ++n) { const f32x4 bs = *(const f32x4*)(base + off + bj * HALF + n * 16); acc[ai][bj][m][n] = bs + (acc[ai][bj][m][n] - sr.x) * sr.y; }
                asm volatile("" : "+v"(acc[ai][0][m][0]), "+v"(acc[ai][0][m][1]), "+v"(acc[ai][1][m][0]), "+v"(acc[ai][1][m][1]));
                if (m & 1) asm volatile("" ::: "memory"); }
        const bool bad1 = bad;
        bad = st2.run(acc, u, wr, wc, fr, fq, lds, wid, lane) || bad;
#pragma unroll
        for (int ai = 0; ai < 2; ++ai)
#pragma unroll
            for (int m = 0; m < 4; ++m) { const int r = ai * HALF + wr * 64 + m * 16 + fr; const f32x2v sr = S[r]; const size_t off = (size_t)(u.pm * BM + r) * ldc + col0;
#pragma unroll
                for (int bj = 0; bj < 2; ++bj)
#pragma unroll
                    for (int n = 0; n < 2; ++n) { const f32x4 x1 = acc[ai][bj][m][n]; *(f32x4*)(out + off + bj * HALF + n * 16) = bad1 ? (f32x4){qnan, qnan, qnan, qnan} : x1;
                        const f32x4 o = (x1 - sr.x) * sr.y; u32x2v w; w.x = cvt_pk_bf16(o[0], o[1]); w.y = cvt_pk_bf16(o[2], o[3]);
                        if (bad) { w.x = 0x7fc07fc0u; w.y = 0x7fc07fc0u; } *(u32x2v*)(xn + off + bj * HALF + n * 16) = w; }
                asm volatile("" ::: "memory"); }
    }
};

typedef int pg8_v8i __attribute__((ext_vector_type(8)));
typedef short pg8_s16 __attribute__((ext_vector_type(16)));
__device__ __forceinline__ pg8_v8i cat8(const bf16x8 (&x)[2]) { return __builtin_bit_cast(pg8_v8i, __builtin_shufflevector(x[0], x[1], 0, 1, 2, 3, 4, 5, 6, 7, 8, 9, 10, 11, 12, 13, 14, 15)); }
template <bool F8> __device__ __forceinline__ void mma_pair(f32x4& c, const bf16x8 (&b)[2], const bf16x8 (&a)[2]) {
    if constexpr (F8) { c = __builtin_amdgcn_mfma_scale_f32_16x16x128_f8f6f4(cat8(b), cat8(a), c, 0, 0, 0, 0x7F7F7F7F, 0, 0x7F7F7F7F); }
    else { c = __builtin_amdgcn_mfma_f32_16x16x32_bf16(b[0], a[0], c, 0, 0, 0); c = __builtin_amdgcn_mfma_f32_16x16x32_bf16(b[1], a[1], c, 0, 0, 0); }
}
template <class Epi, class Sched, bool ALIGN_EPI = false, bool SP2 = false, bool GATHER = false, bool F8 = false>
__device__ __forceinline__ void gemm_phase(PG8_LAS unsigned char* lds, const Gemm g, const Sched& S, const Epi& E, const int tid_in, const PG8_LAS int* gtok = nullptr) {
    int tid_l = tid_in; asm volatile("" : "+v"(tid_l));
    const int tid = tid_l, wid = __builtin_amdgcn_readfirstlane(tid >> 6), lane = tid & 63, wr = wid >> 2, wc = wid & 3, fr = lane & 15, fq = lane >> 4;
    const bf16_t* gA_l = g.A; const bf16_t* gB_l = g.Bt; asm volatile("" : "+s"(gA_l), "+s"(gB_l));
    const int K = g.K, nt = K / BK;
    unsigned voffA[2], voffB[2], voffA1[2];
#pragma unroll
    for (int i = 0; i < 2; ++i) { int R, C; stage_rc(tid * 16 + i * 8192, R, C); const int Rb = Epi::PERM ? ((R & ~31) + perm32(R & 31)) : R;
        voffA[i] = (unsigned)(R * K + C) * 2u; voffB[i] = (unsigned)(Rb * K + C) * 2u; voffA1[i] = voffA[i]; }
    if constexpr (GATHER) {
#pragma unroll
        for (int i = 0; i < 2; ++i) { int R, C; stage_rc(tid * 16 + i * 8192, R, C); voffA[i] = (unsigned)(gtok[R] * K + C) * 2u; voffA1[i] = (unsigned)(gtok[HALF + R] * K + C) * 2u; } }
    const size_t kstep = (size_t)(BK * 2);
    const size_t hstep = (size_t)HALF * K * 2;
    const size_t hsA = GATHER ? (size_t)0 : hstep;
    const size_t tstep = 2 * hstep;
    const unsigned ldsw = (unsigned)wid * 1024u;
    const int aoff = lds_byte(wr * 64 + fr, fq * 8), boff = lds_byte(wc * 32 + fr, fq * 8);
#define PG8_SA(b, h) (((b) * 2 + (h)) * HTB)
#define PG8_SB(b, h) ((4 + (b) * 2 + (h)) * HTB)
#define PG8_STAGE(bufoff, gbase, voff) do { _Pragma("unroll") for (int _i = 0; _i < 2; ++_i) \
        __builtin_amdgcn_global_load_lds((const unsigned*)((const char*)(gbase) + (voff)[_i]), (PG8_LAS unsigned*)(lds + (bufoff) + ldsw + _i * 8192), 16, 0, 0); } while (0)
#define PG8_LDA(dst, b, h) do { _Pragma("unroll") for (int m = 0; m < 4; ++m) _Pragma("unroll") for (int k = 0; k < 2; ++k) dst[m][k] = *(const PG8_LAS bf16x8*)(lds + PG8_SA(b, h) + aoff + m * 2048 + k * 1024); } while (0)
#define PG8_LDB(dst, b, h) do { _Pragma("unroll") for (int n = 0; n < 2; ++n) _Pragma("unroll") for (int k = 0; k < 2; ++k) dst[n][k] = *(const PG8_LAS bf16x8*)(lds + PG8_SB(b, h) + boff + n * 2048 + k * 1024); } while (0)
#define PG8_MMA(ai, bj, At, Bt) do { __builtin_amdgcn_s_setprio(1); _Pragma("unroll") for (int m = 0; m < 4; ++m) _Pragma("unroll") for (int n = 0; n < 2; ++n) \
        mma_pair<F8>(acc[ai][bj][m][n], Bt[n], At[m]); __builtin_amdgcn_s_setprio(0); } while (0)
#define PG8_WAIT_V(n) asm volatile("s_waitcnt vmcnt(" #n ")" ::: "memory")
#define PG8_WAIT_L(n) asm volatile("s_waitcnt lgkmcnt(" #n ")" ::: "memory")
#define PG8_BAR __builtin_amdgcn_s_barrier()
#define PG8_SCHED __builtin_amdgcn_sched_barrier(0)
    Unit cur, nxt; int ui = 0;
    if (!S.next(0, cur)) return;
    f32x4 acc[2][2][4][2];
#pragma unroll
    for (int a = 0; a < 2; ++a)
#pragma unroll
        for (int b = 0; b < 2; ++b)
#pragma unroll
            for (int m = 0; m < 4; ++m)
#pragma unroll
                for (int n = 0; n < 2; ++n) acc[a][b][m][n] = (f32x4){0.f, 0.f, 0.f, 0.f};
    bf16x8 At[4][2], B0[2][2], B1[2][2];
    const char* cA = (const char*)gA_l + (GATHER ? (size_t)0 : (size_t)cur.pm * tstep); const char* cB = (const char*)gB_l + (size_t)cur.pn * tstep;
    S.a_ready(cur);
    if constexpr (SP2) {
        PG8_STAGE(PG8_SB(0, 0), cB, voffB); PG8_STAGE(PG8_SB(0, 1), cB + hstep, voffB); PG8_STAGE(PG8_SA(0, 0), cA, voffA); PG8_STAGE(PG8_SA(0, 1), cA + hsA, voffA1);
        if (wr == 1) PG8_BAR;
        PG8_WAIT_V(2); PG8_BAR;
        PG8_STAGE(PG8_SB(1, 0), cB + kstep, voffB); PG8_STAGE(PG8_SA(1, 0), cA + kstep, voffA); PG8_STAGE(PG8_SB(1, 1), cB + hstep + kstep, voffB);
        PG8_WAIT_V(6); PG8_BAR;
    } else {
        PG8_STAGE(PG8_SB(0, 0), cB, voffB); PG8_STAGE(PG8_SA(0, 0), cA, voffA); PG8_STAGE(PG8_SB(0, 1), cB + hstep, voffB); PG8_STAGE(PG8_SA(0, 1), cA + hsA, voffA1);
        if (wr == 1) PG8_BAR;
        PG8_WAIT_V(4); PG8_BAR;
        PG8_STAGE(PG8_SB(1, 0), cB + kstep, voffB); PG8_STAGE(PG8_SA(1, 0), cA + kstep, voffA); PG8_STAGE(PG8_SB(1, 1), cB + hstep + kstep, voffB);
        PG8_WAIT_V(6); PG8_BAR;
    }
    for (;;) {
        const bool has_next = S.next(ui + 1, nxt);
        const char* nA = (has_next && !GATHER) ? (const char*)gA_l + (size_t)nxt.pm * tstep : cA; const char* nB = has_next ? (const char*)gB_l + (size_t)nxt.pn * tstep : cB;
#pragma nounroll
        for (int t = 0; t < nt; t += 2) {
            const bool last = (t == nt - 2);
            const char* a1 = cA + (size_t)(t + 1) * kstep;
            const char* a2 = last ? nA : cA + (size_t)(t + 2) * kstep; const char* b2 = last ? nB : cB + (size_t)(t + 2) * kstep;
            const char* a3 = a2 + kstep; const char* b3 = b2 + kstep;
            if (last && has_next) S.a_ready(nxt);
            if constexpr (SP2) {
            PG8_LDB(B0, 0, 0); PG8_LDB(B1, 0, 1); PG8_SCHED; PG8_LDA(At, 0, 0); PG8_STAGE(PG8_SA(1, 1), a1 + hsA, voffA1);
            if constexpr (GATHER) { if (last && has_next) {
                const PG8_LAS int* nt_ = gtok + (ui + 1) * BM;
#pragma unroll
                for (int i = 0; i < 2; ++i) { int R, C; stage_rc(tid * 16 + i * 8192, R, C); voffA[i] = (unsigned)(nt_[R] * K + C) * 2u; voffA1[i] = (unsigned)(nt_[HALF + R] * K + C) * 2u; } } }
            PG8_WAIT_V(8); PG8_WAIT_L(0); PG8_BAR; PG8_MMA(0, 0, At, B0); PG8_MMA(0, 1, At, B1); PG8_BAR; PG8_SCHED;
            PG8_LDA(At, 0, 1); PG8_STAGE(PG8_SB(0, 0), b2, voffB); PG8_STAGE(PG8_SB(0, 1), b2 + hstep, voffB); PG8_STAGE(PG8_SA(0, 0), a2, voffA);
            PG8_WAIT_V(8); PG8_WAIT_L(0); PG8_BAR; PG8_MMA(1, 0, At, B0); PG8_MMA(1, 1, At, B1); PG8_BAR; PG8_SCHED;
            PG8_LDB(B0, 1, 0); PG8_LDB(B1, 1, 1); PG8_SCHED; PG8_LDA(At, 1, 0); PG8_STAGE(PG8_SA(0, 1), a2 + hsA, voffA1);
            PG8_WAIT_V(8); PG8_WAIT_L(0); PG8_BAR; PG8_MMA(0, 0, At, B0); PG8_MMA(0, 1, At, B1); PG8_BAR; PG8_SCHED;
            PG8_LDA(At, 1, 1); PG8_STAGE(PG8_SB(1, 0), b3, voffB); PG8_STAGE(PG8_SB(1, 1), b3 + hstep, voffB); PG8_STAGE(PG8_SA(1, 0), a3, voffA);
            PG8_WAIT_V(8); PG8_WAIT_L(0); PG8_BAR; PG8_MMA(1, 0, At, B0); PG8_MMA(1, 1, At, B1); PG8_BAR; PG8_SCHED;
            } else {
            PG8_LDB(B0, 0, 0); PG8_SCHED; PG8_LDA(At, 0, 0); PG8_STAGE(PG8_SA(1, 1), a1 + hsA, voffA1);
            PG8_WAIT_L(8); PG8_BAR; PG8_WAIT_L(0); PG8_MMA(0, 0, At, B0); PG8_BAR; PG8_SCHED;
            PG8_LDB(B1, 0, 1); PG8_STAGE(PG8_SB(0, 0), b2, voffB);
            PG8_BAR; PG8_WAIT_L(0); PG8_MMA(0, 1, At, B1); PG8_BAR;
            PG8_LDA(At, 0, 1); PG8_STAGE(PG8_SA(0, 0), a2, voffA);
            PG8_BAR; PG8_WAIT_L(0); PG8_MMA(1, 0, At, B0); PG8_BAR; PG8_SCHED;
            PG8_STAGE(PG8_SB(0, 1), b2 + hstep, voffB);
            PG8_WAIT_V(6); PG8_BAR; PG8_MMA(1, 1, At, B1); PG8_BAR;
            PG8_LDB(B0, 1, 0); PG8_SCHED; PG8_LDA(At, 1, 0); PG8_STAGE(PG8_SA(0, 1), a2 + hsA, voffA1);
            PG8_WAIT_L(8); PG8_BAR; PG8_WAIT_L(0); PG8_MMA(0, 0, At, B0); PG8_BAR; PG8_SCHED;
            PG8_LDB(B1, 1, 1); PG8_STAGE(PG8_SB(1, 0), b3, voffB);
            PG8_BAR; PG8_WAIT_L(0); PG8_MMA(0, 1, At, B1); PG8_BAR;
            PG8_LDA(At, 1, 1); PG8_STAGE(PG8_SA(1, 0), a3, voffA);
            PG8_BAR; PG8_WAIT_L(0); PG8_MMA(1, 0, At, B0); PG8_BAR; PG8_SCHED;
            PG8_STAGE(PG8_SB(1, 1), b3 + hstep, voffB);
            PG8_WAIT_V(6); PG8_BAR; PG8_MMA(1, 1, At, B1); PG8_BAR;
            }
        }
        if constexpr (ALIGN_EPI) { if (wr == 0) PG8_BAR; }
        if constexpr (!Epi::AFTER_DRAIN) { E(acc, cur, wr, wc, fr, fq); S.done(cur); }
        if (!has_next) break;
#pragma unroll
        for (int a = 0; a < 2; ++a)
#pragma unroll
            for (int b = 0; b < 2; ++b)
#pragma unroll
                for (int m = 0; m < 4; ++m)
#pragma unroll
                    for (int n = 0; n < 2; ++n) acc[a][b][m][n] = (f32x4){0.f, 0.f, 0.f, 0.f};
        cur = nxt; cA = nA; cB = nB; ++ui;
        if constexpr (ALIGN_EPI) { if (wr == 1) PG8_BAR; }
    }
    PG8_WAIT_V(0);
    if constexpr (!ALIGN_EPI) { if (wr == 0) PG8_BAR; }
    PG8_BAR;
    if constexpr (Epi::AFTER_DRAIN) { E.fused(acc, cur, wr, wc, fr, fq, lds, wid, lane); S.done(cur); }
#undef PG8_SA
#undef PG8_SB
#undef PG8_STAGE
#undef PG8_LDA
#undef PG8_LDB
#undef PG8_MMA
#undef PG8_WAIT_V
#undef PG8_WAIT_L
#undef PG8_BAR
#undef PG8_SCHED
}
}
namespace attn_body {
using bf16=__hip_bfloat16;
using bf16x8=__attribute__((ext_vector_type(8)))short;
using s16x4=__attribute__((ext_vector_type(4)))short;
using f32x16=__attribute__((ext_vector_type(16)))float;
using u32x4=__attribute__((ext_vector_type(4)))unsigned;
constexpr int SEQ=4096,D=64,DM=2816,OPITCH=1024;
constexpr int NW=8,QBLK=32,QB=QBLK*NW,KVBLK=64,NQB=SEQ/QB;
constexpr int ATTN_PITCH=DM, ATTN_UNIT_ROWS=QB;
__device__ __forceinline__ int crow(int r,int hi){return (r&3)+8*(r>>2)+4*hi;}
#define SBAR() __builtin_amdgcn_sched_barrier(0)
__device__ __forceinline__ void cmask(f32x16&p0,f32x16&p1,int jb,int qrel,int hi){
  const float NEG=-INFINITY; int kb=64*jb+4*hi;
  #pragma unroll
  for(int r=0;r<16;++r){int kv=kb+(r&3)+8*(r>>2); if(kv>qrel)p0[r]=NEG; if(kv+32>qrel)p1[r]=NEG;}
}

constexpr int NSLOT=3, SLOTB=8192;
constexpr int LDS_K=0, LDS_V=NSLOT*SLOTB, LDS_WS=2*NSLOT*SLOTB, LDS_OST=LDS_WS+NW*64*4, LDS_BYTES=LDS_OST+NW*4096;
constexpr float C2=0.125f*1.4426950408889634f;
__device__ __forceinline__ void glds16(const void*gsrc,unsigned lds_dst){unsigned keep;
  asm volatile("s_mov_b32 %0, m0\n\ts_mov_b32 m0, %2\n\ts_nop 0\n\tglobal_load_lds_dwordx4 %1, off\n\ts_mov_b32 m0, %0":"=&s"(keep):"v"(gsrc),"s"(lds_dst):"memory");}
__device__ __forceinline__ float max3f(float a,float b,float c){float r;asm("v_max3_f32 %0, %1, %2, %3":"=v"(r):"v"(a),"v"(b),"v"(c));return r;}
__device__ __forceinline__ float max2f(float a,float b){float r;asm("v_max_f32_e32 %0, %1, %2":"=v"(r):"v"(a),"v"(b));return r;}
__device__ __forceinline__ float fadd_s(float a,float b){float r;asm("v_add_f32_e32 %0, %1, %2":"=v"(r):"v"(a),"v"(b));return r;}
__device__ __forceinline__ float fsub_s(float a,float b){float r;asm("v_sub_f32_e32 %0, %1, %2":"=v"(r):"v"(a),"v"(b));return r;}
typedef float f32x2_t __attribute__((ext_vector_type(2))); typedef __bf16 bf16x2_t __attribute__((ext_vector_type(2)));
__device__ __forceinline__ unsigned cvtpk_s(float lo,float hi){f32x2_t v={lo,hi};bf16x2_t b=__builtin_convertvector(v,bf16x2_t);return __builtin_bit_cast(unsigned,b);}
#define WAIT_BAR(N) asm volatile("s_waitcnt vmcnt(" #N ") lgkmcnt(0)\n\ts_barrier":::"memory")

__device__ __forceinline__ void qkt(f32x16&p0,f32x16&p1,const char*Kslot,const bf16x8*qr,const f32x16&negm,int r32,int hi){
  const char*kb=Kslot+hi*1024+r32*16;
  #pragma unroll
  for(int d0=0;d0<4;++d0){
    const bf16x8 b0=*reinterpret_cast<const bf16x8*>(kb+d0*2048);
    const bf16x8 b1=*reinterpret_cast<const bf16x8*>(kb+d0*2048+512);
    if(d0==0){p0=__builtin_amdgcn_mfma_f32_32x32x16_bf16(b0,qr[0],negm,0,0,0);p1=__builtin_amdgcn_mfma_f32_32x32x16_bf16(b1,qr[0],negm,0,0,0);}
    else{p0=__builtin_amdgcn_mfma_f32_32x32x16_bf16(b0,qr[d0],p0,0,0,0);p1=__builtin_amdgcn_mfma_f32_32x32x16_bf16(b1,qr[d0],p1,0,0,0);}}
}
typedef __attribute__((address_space(3))) const char* lds_cptr;
typedef short v4i16_t __attribute__((ext_vector_type(4)));
__device__ __forceinline__ void kload8(bf16x8*kf,lds_cptr kp){
  kf[0]=*(const __attribute__((address_space(3))) bf16x8*)(kp);      kf[1]=*(const __attribute__((address_space(3))) bf16x8*)(kp+512);
  kf[2]=*(const __attribute__((address_space(3))) bf16x8*)(kp+2048); kf[3]=*(const __attribute__((address_space(3))) bf16x8*)(kp+2560);
  kf[4]=*(const __attribute__((address_space(3))) bf16x8*)(kp+4096); kf[5]=*(const __attribute__((address_space(3))) bf16x8*)(kp+4608);
  kf[6]=*(const __attribute__((address_space(3))) bf16x8*)(kp+6144); kf[7]=*(const __attribute__((address_space(3))) bf16x8*)(kp+6656);
}
__device__ __forceinline__ void kload2(bf16x8*kf,lds_cptr kp,int j){ kf[2*j]=*(const __attribute__((address_space(3))) bf16x8*)(kp+j*2048); kf[2*j+1]=*(const __attribute__((address_space(3))) bf16x8*)(kp+j*2048+512); }
__device__ __forceinline__ int ksoff(int r32,int hi,int d0,int half){ return (r32>>3)*1024+((hi^((r32>>3)&1))*128)+(r32&7)*16+d0*256+half*4096; }
__device__ __forceinline__ void qkt_s(f32x16&p0,f32x16&p1,const char*Kslot,const bf16x8*qr,const f32x16&negm,int r32,int hi){
  #pragma unroll
  for(int d0=0;d0<4;++d0){
    const bf16x8 b0=*reinterpret_cast<const bf16x8*>(Kslot+ksoff(r32,hi,d0,0));
    const bf16x8 b1=*reinterpret_cast<const bf16x8*>(Kslot+ksoff(r32,hi,d0,1));
    if(d0==0){p0=__builtin_amdgcn_mfma_f32_32x32x16_bf16(b0,qr[0],negm,0,0,0);p1=__builtin_amdgcn_mfma_f32_32x32x16_bf16(b1,qr[0],negm,0,0,0);}
    else{p0=__builtin_amdgcn_mfma_f32_32x32x16_bf16(b0,qr[d0],p0,0,0,0);p1=__builtin_amdgcn_mfma_f32_32x32x16_bf16(b1,qr[d0],p1,0,0,0);}}
}
__device__ __forceinline__ void kload2_s(bf16x8*kf,lds_cptr ks,int j,int r32,int hi){ kf[2*j]=*(const __attribute__((address_space(3))) bf16x8*)(ks+ksoff(r32,hi,j,0)); kf[2*j+1]=*(const __attribute__((address_space(3))) bf16x8*)(ks+ksoff(r32,hi,j,1)); }
__device__ __forceinline__ void kload8_s(bf16x8*kf,lds_cptr ks,int r32,int hi){ kload2_s(kf,ks,0,r32,hi); kload2_s(kf,ks,1,r32,hi); kload2_s(kf,ks,2,r32,hi); kload2_s(kf,ks,3,r32,hi); }
__device__ __forceinline__ s16x4 vtr(lds_cptr p){ return __builtin_bit_cast(s16x4,__builtin_amdgcn_ds_read_tr16_b64_v4i16((__attribute__((address_space(3))) v4i16_t*)p)); }
__device__ __forceinline__ float rowmax(const f32x16&p0,const f32x16&p1){
  float a=max3f(p0[0],p0[1],p1[0]),b=max3f(p0[2],p0[3],p1[1]);a=max3f(a,p1[2],p1[3]);
  #pragma unroll
  for(int r=4;r<16;r+=4){a=max3f(a,p0[r],p0[r+1]);b=max3f(b,p0[r+2],p0[r+3]);a=max3f(a,p1[r],p1[r+1]);b=max3f(b,p1[r+2],p1[r+3]);}
  const float m=max2f(a,b);
  auto rr=__builtin_amdgcn_permlane32_swap(__float_as_uint(m),__float_as_uint(m),false,false);
  return max2f(__uint_as_float(rr[0]),__uint_as_float(rr[1]));
}
__device__ __forceinline__ void pv(f32x16*o,int vb,bf16x8 pa0,bf16x8 pa1,bf16x8 pa2,bf16x8 pa3){
  #pragma unroll
  for(int d0=0;d0<2;++d0){s16x4 lo[4],hi[4];
    #pragma unroll
    for(int ks=0;ks<4;++ks){
      asm volatile("ds_read_b64_tr_b16 %0,%1 offset:%c2":"=&v"(lo[ks]):"v"(vb),"i"(d0*4096+ks*1024):"memory");
      asm volatile("ds_read_b64_tr_b16 %0,%1 offset:%c2":"=&v"(hi[ks]):"v"(vb),"i"(d0*4096+ks*1024+512):"memory");}
    asm volatile("s_waitcnt lgkmcnt(0)":::"memory");SBAR();
    #define PK(k) (bf16x8){lo[k][0],lo[k][1],lo[k][2],lo[k][3],hi[k][0],hi[k][1],hi[k][2],hi[k][3]}
    o[d0]=__builtin_amdgcn_mfma_f32_32x32x16_bf16(pa0,PK(0),o[d0],0,0,0);
    o[d0]=__builtin_amdgcn_mfma_f32_32x32x16_bf16(pa1,PK(1),o[d0],0,0,0);
    o[d0]=__builtin_amdgcn_mfma_f32_32x32x16_bf16(pa2,PK(2),o[d0],0,0,0);
    o[d0]=__builtin_amdgcn_mfma_f32_32x32x16_bf16(pa3,PK(3),o[d0],0,0,0);
    #undef PK
  }
}

#ifndef ATTN_STORE16
#define ATTN_STORE16(p,v) (*(u32x4*)(p)=(v))
#endif
template<int THRL> __device__ __forceinline__ void attn_unit(int b,int h,int kvh,int qb,const bf16*Q,const bf16*__restrict__ K,const bf16*__restrict__ V,bf16*O,char*shm,int lane,int wid){
  const int r32=lane&31,hi=lane>>5;
  const long rowbase=(long)b*SEQ; const int q0=qb*QB;
  const bf16*Qw=Q+(rowbase+q0+wid*QBLK)*DM+h*D;
  const bf16*Kh=K+rowbase*DM+kvh*D,*Vh=V+rowbase*DM+kvh*D;
  const unsigned lds0=(unsigned)(uintptr_t)shm;
  float*wsf=(float*)(shm+LDS_WS)+wid*64;
  const bf16*ksrc=Kh+(long)(8*wid+(lane&7))*DM+((lane>>3)^(wid&1))*8;
  const bf16*vsrc=Vh+(long)(16*(wid&3)+(lane>>2))*DM+(wid>>2)*32+(lane&3)*8;
  const unsigned kdst=lds0+LDS_K+wid*1024, vdst=lds0+LDS_V+wid*1024;
  #define DMA_K(t,slot) glds16(ksrc+(long)(t)*KVBLK*DM,(unsigned)__builtin_amdgcn_readfirstlane(kdst+(slot)))
  #define DMA_V(t,slot) glds16(vsrc+(long)(t)*KVBLK*DM,(unsigned)__builtin_amdgcn_readfirstlane(vdst+(slot)))
  const int vb0=(int)(lds0+LDS_V)+((lane>>4)&1)*32+(lane&3)*8+(4*hi+((lane&15)>>2))*64;
  const char*Kbase=shm+LDS_K; bf16x8 kf[8];
  const lds_cptr shm3=(lds_cptr)shm; const lds_cptr kp0=shm3+LDS_K+hi*1024+r32*16; const lds_cptr vp0=shm3+LDS_V+((lane>>4)&1)*32+(lane&3)*8+(4*hi+((lane&15)>>2))*64;
  constexpr int NT=SEQ/KVBLK;
  DMA_K(0,0);DMA_V(0,0);DMA_K(1,SLOTB);
  bf16x8 qr[4];
  #pragma unroll
  for(int d0=0;d0<4;++d0)qr[d0]=*reinterpret_cast<const bf16x8*>(&Qw[(long)r32*DM+d0*16+hi*8]);
  float zz_;asm volatile("v_mov_b32 %0, 0":"=v"(zz_));
  float mhat=zz_,l_reg=zz_;f32x16 o[2];f32x16 negm;
  _Pragma("unroll") for(int r=0;r<16;++r){o[0][r]=zz_;o[1][r]=zz_;negm[r]=zz_;} asm volatile("":"+v"(negm));
  #define CMASK(P0,P1,t) do{}while(0)
  bool resc=false;
  #define START(P0,P1) do{ const float rm=rowmax(P0,P1); resc=false; \
    { const float dl=rm; mhat=fadd_s(mhat,dl); \
      _Pragma("unroll") for(int r=0;r<16;++r){P0[r]=fsub_s(P0[r],dl);P1[r]=fsub_s(P1[r],dl);} \
      _Pragma("unroll") for(int r=0;r<16;++r)negm[r]=-mhat; asm volatile("":"+v"(negm)); } \
    _Pragma("unroll") for(int r=0;r<16;++r)P0[r]=__builtin_amdgcn_exp2f(P0[r]); }while(0)
  #define RESC() do{ if(resc){ asm volatile("s_waitcnt lgkmcnt(0)":::"memory"); \
      _Pragma("unroll") for(int d_=0;d_<2;++d_) _Pragma("unroll") for(int r=0;r<16;++r)o[d_][r]*=wsf[crow(r,hi)]; } }while(0)
  f32x16 pA0,pA1,pB0,pB1;
  int sl_prev=0,sl_cur=0,sl_next=SLOTB;
  #define ROT() do{sl_prev=sl_cur;sl_cur=sl_next;sl_next=(sl_next==(NSLOT-1)*SLOTB)?0:sl_next+SLOTB;}while(0)
  DMA_K(2,2*SLOTB);
  WAIT_BAR(3);
  qkt_s(pA0,pA1,Kbase,qr,negm,r32,hi);asm volatile("s_nop 15\n\ts_nop 7":"+v"(pA0),"+v"(pA1));CMASK(pA0,pA1,0);
  START(pA0,pA1);
  _Pragma("unroll") for(int r=0;r<16;++r)pA1[r]=__builtin_amdgcn_exp2f(pA1[r]);
  WAIT_BAR(0);
  DMA_K(3,0);DMA_V(1,SLOTB);
  ROT();
  kload8_s(kf,shm3+LDS_K+sl_cur,r32,hi);
  WAIT_BAR(2);
  s16x4 vlo[8],vhi[8]; u32x4 pw0,pw1,pw2,pw3;
  #define PKW(P,B) cvtpk_s(P[B],P[B+1])
  #define PAF(k) __builtin_bit_cast(bf16x8,pw##k)
  #define VFR(i) (bf16x8){vlo[i][0],vlo[i][1],vlo[i][2],vlo[i][3],vhi[i][0],vhi[i][1],vhi[i][2],vhi[i][3]}
  #define PIN(x) asm volatile("":"+v"(x))
  #define MX3(a,b,c) __builtin_fmaxf(__builtin_fmaxf((a),(b)),(c))
  #define GAPA(MF,A0,A1,A2,A3,W0,W1,PW) do{ MF; sacc+=A0; sacc+=A1; sacc+=A2; sacc+=A3; PIN(sacc); W0; W1; PIN(PW); SBAR(); }while(0)
  #define EX(v) __builtin_amdgcn_exp2f(v)
  #define GAPB(MF,X,B) do{ MF; X[B]=EX(X[B]); X[B+1]=EX(X[B+1]); X[B+2]=EX(X[B+2]); X[B+3]=EX(X[B+3]); PIN(X); SBAR(); }while(0)
  #define VRD(i) do{ vlo[i]=vtr(vp_+(((i)>>2)*4096+((i)&3)*1024)); vhi[i]=vtr(vp_+(((i)>>2)*4096+((i)&3)*1024+512)); }while(0)
  #define KRD(G,j) do{ if(G){ kload2_s(kf,shm3+LDS_K+sl_next,j,r32,hi); SBAR(); } }while(0)
  #define STEP(C0,C1,P0,P1,t,GK,GV,GL) do{ SBAR(); \
    const lds_cptr vp_=vp0+sl_prev; \
    VRD(0); SBAR(); float sacc=(P0[0]+P0[1]); \
    GAPA(C0=__builtin_amdgcn_mfma_f32_32x32x16_bf16(kf[0],qr[0],negm,0,0,0), P0[2],P0[3],P0[4],P0[5],     pw0[0]=PKW(P0,0), pw0[1]=PKW(P0,2), pw0); \
    VRD(4); SBAR(); GAPA(C1=__builtin_amdgcn_mfma_f32_32x32x16_bf16(kf[1],qr[0],negm,0,0,0), P0[6],P0[7],P0[8],P0[9],     pw0[2]=PKW(P0,4), pw0[3]=PKW(P0,6), pw0); \
    VRD(1); SBAR(); GAPA(C0=__builtin_amdgcn_mfma_f32_32x32x16_bf16(kf[2],qr[1],C0,0,0,0),   P0[10],P0[11],P0[12],P0[13], pw1[0]=PKW(P0,8), pw1[1]=PKW(P0,10), pw1); \
    VRD(5); SBAR(); GAPA(C1=__builtin_amdgcn_mfma_f32_32x32x16_bf16(kf[3],qr[1],C1,0,0,0),   P0[14],P0[15],P1[0],P1[1],   pw1[2]=PKW(P0,12),pw1[3]=PKW(P0,14), pw1); \
    VRD(2); SBAR(); GAPA(C0=__builtin_amdgcn_mfma_f32_32x32x16_bf16(kf[4],qr[2],C0,0,0,0),   P1[2],P1[3],P1[4],P1[5],     pw2[0]=PKW(P1,0), pw2[1]=PKW(P1,2), pw2); \
    VRD(6); SBAR(); GAPA(C1=__builtin_amdgcn_mfma_f32_32x32x16_bf16(kf[5],qr[2],C1,0,0,0),   P1[6],P1[7],P1[8],P1[9],     pw2[2]=PKW(P1,4), pw2[3]=PKW(P1,6), pw2); \
    VRD(3); SBAR(); GAPA(C0=__builtin_amdgcn_mfma_f32_32x32x16_bf16(kf[6],qr[3],C0,0,0,0),   P1[10],P1[11],P1[12],P1[13], pw3[0]=PKW(P1,8), pw3[1]=PKW(P1,10), pw3); \
    VRD(7); SBAR(); GAPA(C1=__builtin_amdgcn_mfma_f32_32x32x16_bf16(kf[7],qr[3],C1,0,0,0),   P1[14],P1[15],0.f,0.f,       pw3[2]=PKW(P1,12),pw3[3]=PKW(P1,14), pw3); \
    l_reg+=sacc; \
    if(GK){DMA_K((t)+3,sl_cur);} if(GV){DMA_V((t)+1,sl_next);} \
    CMASK(C0,C1,t); \
    { float a=MX3(C0[0],C0[1],C1[0]),b=MX3(C0[2],C0[3],C1[1]); a=MX3(a,C1[2],C1[3]); \
      _Pragma("unroll") for(int r=4;r<16;r+=4){a=MX3(a,C0[r],C0[r+1]);b=MX3(b,C0[r+2],C0[r+3]);a=MX3(a,C1[r],C1[r+1]);b=MX3(b,C1[r+2],C1[r+3]);} \
      float rm=__builtin_fmaxf(a,b); { auto rr=__builtin_amdgcn_permlane32_swap(__float_as_uint(rm),__float_as_uint(rm),false,false); rm=__builtin_fmaxf(__uint_as_float(rr[0]),__uint_as_float(rr[1])); } \
      resc=false; \
      if(__builtin_expect(__any(rm>(float)THRL),0)){ const float dl=__builtin_fmaxf(rm,0.f); mhat+=dl; \
        _Pragma("unroll") for(int r=0;r<16;++r){C0[r]-=dl;C1[r]-=dl;} \
        _Pragma("unroll") for(int r=0;r<16;++r)negm[r]=-mhat; asm volatile("":"+v"(negm)); \
        const float f=__builtin_amdgcn_exp2f(-dl); l_reg*=f; if(hi==0)wsf[r32]=f; resc=true; } } \
    SBAR(); \
    GAPB(o[0]=__builtin_amdgcn_mfma_f32_32x32x16_bf16(PAF(0),VFR(0),o[0],0,0,0), C0,0); \
    GAPB(o[1]=__builtin_amdgcn_mfma_f32_32x32x16_bf16(PAF(0),VFR(4),o[1],0,0,0), C0,4); \
    KRD(GL,0); GAPB(o[0]=__builtin_amdgcn_mfma_f32_32x32x16_bf16(PAF(1),VFR(1),o[0],0,0,0), C0,8); \
    KRD(GL,1); GAPB(o[1]=__builtin_amdgcn_mfma_f32_32x32x16_bf16(PAF(1),VFR(5),o[1],0,0,0), C0,12); \
    KRD(GL,2); GAPB(o[0]=__builtin_amdgcn_mfma_f32_32x32x16_bf16(PAF(2),VFR(2),o[0],0,0,0), C1,0); \
    KRD(GL,3); GAPB(o[1]=__builtin_amdgcn_mfma_f32_32x32x16_bf16(PAF(2),VFR(6),o[1],0,0,0), C1,4); \
    GAPB(o[0]=__builtin_amdgcn_mfma_f32_32x32x16_bf16(PAF(3),VFR(3),o[0],0,0,0), C1,8); \
    GAPB(o[1]=__builtin_amdgcn_mfma_f32_32x32x16_bf16(PAF(3),VFR(7),o[1],0,0,0), C1,12); \
    }while(0)
  int t=1;
  #undef CMASK
  #define CMASK(P0,P1,t) do{}while(0)
  for(;t+5<NT;t+=2){
    STEP(pB0,pB1,pA0,pA1,t,true,true,true);     WAIT_BAR(2); RESC(); ROT();
    STEP(pA0,pA1,pB0,pB1,t+1,true,true,true);   WAIT_BAR(2); RESC(); ROT();
  }
  #undef CMASK
  #define CMASK(P0,P1,t) do{}while(0)
  #define ENDW(tt) do{ if((tt)+3<NT){WAIT_BAR(2);} else if((tt)+2<NT){WAIT_BAR(1);} else {WAIT_BAR(0);} }while(0)
  for(;t+1<NT;t+=2){
    STEP(pB0,pB1,pA0,pA1,t,(t+3<NT),(t+1<NT),(t+1<NT));       ENDW(t);   RESC(); ROT();
    STEP(pA0,pA1,pB0,pB1,t+1,(t+4<NT),(t+2<NT),(t+2<NT));     ENDW(t+1); RESC(); ROT();
  }
  STEP(pB0,pB1,pA0,pA1,NT-1,false,false,false); RESC();
  { float sacc=pB0[0]+pB0[1]; _Pragma("unroll") for(int r=2;r<16;++r)sacc+=pB0[r]; _Pragma("unroll") for(int r=0;r<16;++r)sacc+=pB1[r]; l_reg+=sacc;
    pw0=(u32x4){PKW(pB0,0),PKW(pB0,2),PKW(pB0,4),PKW(pB0,6)};pw1=(u32x4){PKW(pB0,8),PKW(pB0,10),PKW(pB0,12),PKW(pB0,14)};pw2=(u32x4){PKW(pB1,0),PKW(pB1,2),PKW(pB1,4),PKW(pB1,6)};pw3=(u32x4){PKW(pB1,8),PKW(pB1,10),PKW(pB1,12),PKW(pB1,14)};
    SBAR(); pv(o,vb0+sl_cur,PAF(0),PAF(1),PAF(2),PAF(3)); }
  #undef PKW
  #undef PAF
  #undef VFR
  #undef PIN
  #undef MX3
  #undef GAPA
  #undef GAPB
  #undef EX
  #undef VRD
  #undef KRD
  #undef STEP
  #undef ENDW
  {auto rr=__builtin_amdgcn_permlane32_swap(__float_as_uint(l_reg),__float_as_uint(l_reg),false,false);l_reg=__uint_as_float(rr[0])+__uint_as_float(rr[1]);}
  if(hi==0)wsf[32+r32]=l_reg;asm volatile("s_waitcnt lgkmcnt(0)":::"memory");
  float rli[16];
  #pragma unroll
  for(int r=0;r<16;++r)rli[r]=__builtin_amdgcn_rcpf(wsf[32+crow(r,hi)]);
  bf16*Ow=O+(rowbase+q0+wid*QBLK)*OPITCH+h*D;
  { bf16*stg=(bf16*)(shm+LDS_OST)+wid*2048;
    #pragma unroll
    for(int r=0;r<16;++r){const int orow=crow(r,hi);
      #pragma unroll
      for(int d0=0;d0<2;++d0)stg[orow*64+d0*32+r32]=__float2bfloat16(o[d0][r]*rli[r]);}
    asm volatile("s_waitcnt lgkmcnt(0)":::"memory");
    #pragma unroll
    for(int i=0;i<4;++i){const int row=i*8+(lane>>3),ch=lane&7; const u32x4 v=*(const u32x4*)(stg+row*64+ch*8); ATTN_STORE16(Ow+(long)row*OPITCH+ch*8,v);} }
  asm volatile("s_waitcnt lgkmcnt(0)\n\ts_barrier":::"memory");
  #undef DMA_K
  #undef DMA_V
  #undef CMASK
  #undef START
  #undef RESC
  #undef ROT
}
template<class Var,int THRL> __device__ __forceinline__ void attn_unit_g(const Var&W,const bf16*Q,const bf16*__restrict__ K,const bf16*__restrict__ V,bf16*O,char*shm,int lane,int wid){
  const int r32=lane&31,hi=lane>>5;
  const unsigned lds0=(unsigned)(uintptr_t)shm;
  float*wsf=(float*)(shm+LDS_WS)+wid*64;
  const bf16*ksrc=K+wid*8;
  const bf16*vsrc=V+(wid>>2)*32+(lane&3)*8; const int vidx=16*(wid&3)+(lane>>2);
  const unsigned kdst=lds0+LDS_K+wid*1024, vdst=lds0+LDS_V+wid*1024;
  #define DMA_K(t,slot) glds16(ksrc+W.krow((t),lane)*DM,(unsigned)__builtin_amdgcn_readfirstlane(kdst+(slot)))
  #define DMA_V(t,slot) glds16(vsrc+W.krow((t),vidx)*DM,(unsigned)__builtin_amdgcn_readfirstlane(vdst+(slot)))
  const int vb0=(int)(lds0+LDS_V)+((lane>>4)&1)*32+(lane&3)*8+(4*hi+((lane&15)>>2))*64;
  const char*Kbase=shm+LDS_K; bf16x8 kf[8];
  const lds_cptr shm3=(lds_cptr)shm; const lds_cptr kp0=shm3+LDS_K+hi*1024+r32*16; const lds_cptr vp0=shm3+LDS_V+((lane>>4)&1)*32+(lane&3)*8+(4*hi+((lane&15)>>2))*64;
  constexpr int NT=Var::NT;
  DMA_K(0,0);DMA_V(0,0);DMA_K(1,SLOTB);
  bf16x8 qr[4];
  #pragma unroll
  for(int d0=0;d0<4;++d0)qr[d0]=*reinterpret_cast<const bf16x8*>(&Q[W.qrow(wid,r32)*DM+d0*16+hi*8]);
  float zz_;asm volatile("v_mov_b32 %0, 0":"=v"(zz_));
  float mhat=zz_,l_reg=zz_;f32x16 o[2];f32x16 negm;
  _Pragma("unroll") for(int r=0;r<16;++r){o[0][r]=zz_;o[1][r]=zz_;negm[r]=zz_;} asm volatile("":"+v"(negm));
  #define CMASK(P0,P1,t) W.mask(P0,P1,(t),wid,r32,hi)
  bool resc=false;
  #define START(P0,P1) do{ const float rm=rowmax(P0,P1); resc=false; \
    { const float dl=__builtin_fmaxf(rm,-30.f); mhat=fadd_s(mhat,dl);   \
      _Pragma("unroll") for(int r=0;r<16;++r){P0[r]=fsub_s(P0[r],dl);P1[r]=fsub_s(P1[r],dl);} \
      _Pragma("unroll") for(int r=0;r<16;++r)negm[r]=-mhat; asm volatile("":"+v"(negm)); } \
    _Pragma("unroll") for(int r=0;r<16;++r)P0[r]=__builtin_amdgcn_exp2f(P0[r]); }while(0)
  #define RESC() do{ if(resc){ asm volatile("s_waitcnt lgkmcnt(0)":::"memory"); \
      _Pragma("unroll") for(int d_=0;d_<2;++d_) _Pragma("unroll") for(int r=0;r<16;++r)o[d_][r]*=wsf[crow(r,hi)]; } }while(0)
  f32x16 pA0,pA1,pB0,pB1;
  int sl_prev=0,sl_cur=0,sl_next=SLOTB;
  #define ROT() do{sl_prev=sl_cur;sl_cur=sl_next;sl_next=(sl_next==(NSLOT-1)*SLOTB)?0:sl_next+SLOTB;}while(0)
  DMA_K(2,2*SLOTB);
  WAIT_BAR(3);
  qkt(pA0,pA1,Kbase,qr,negm,r32,hi);asm volatile("s_nop 15\n\ts_nop 7":"+v"(pA0),"+v"(pA1));CMASK(pA0,pA1,0);
  START(pA0,pA1);
  _Pragma("unroll") for(int r=0;r<16;++r)pA1[r]=__builtin_amdgcn_exp2f(pA1[r]);
  WAIT_BAR(0);
  DMA_K(3,0);DMA_V(1,SLOTB);
  ROT();
  kload8(kf,kp0+sl_cur);
  WAIT_BAR(2);
  s16x4 vlo[8],vhi[8]; u32x4 pw0,pw1,pw2,pw3;
  #define PKW(P,B) cvtpk_s(P[B],P[B+1])
  #define PAF(k) __builtin_bit_cast(bf16x8,pw##k)
  #define VFR(i) (bf16x8){vlo[i][0],vlo[i][1],vlo[i][2],vlo[i][3],vhi[i][0],vhi[i][1],vhi[i][2],vhi[i][3]}
  #define PIN(x) asm volatile("":"+v"(x))
  #define MX3(a,b,c) __builtin_fmaxf(__builtin_fmaxf((a),(b)),(c))
  #define GAPA(MF,A0,A1,A2,A3,W0,W1,PW) do{ if(va_){MF;} sacc+=A0; sacc+=A1; sacc+=A2; sacc+=A3; PIN(sacc); W0; W1; PIN(PW); SBAR(); }while(0)
  #define EX(v) __builtin_amdgcn_exp2f(v)
  #define GAPB(MF,X,B) do{ if(vb_){MF;} X[B]=EX(X[B]); X[B+1]=EX(X[B+1]); X[B+2]=EX(X[B+2]); X[B+3]=EX(X[B+3]); PIN(X); SBAR(); }while(0)
  #define VRD(i) do{ vlo[i]=vtr(vp_+(((i)>>2)*4096+((i)&3)*1024)); vhi[i]=vtr(vp_+(((i)>>2)*4096+((i)&3)*1024+512)); }while(0)
  #define KRD(G,j) do{ if(G){ kload2(kf,kp0+sl_next,j); SBAR(); } }while(0)
  #define STEP(C0,C1,P0,P1,t,GK,GV,GL) do{ SBAR(); \
    const bool va_=W.tile_valid((t),wid), vb_=W.tile_valid((t)-1,wid); \
    if(!va_){ _Pragma("unroll") for(int r=0;r<16;++r){C0[r]=-INFINITY;C1[r]=-INFINITY;} } \
    const lds_cptr vp_=vp0+sl_prev; \
    VRD(0); SBAR(); float sacc=(P0[0]+P0[1]); \
    GAPA(C0=__builtin_amdgcn_mfma_f32_32x32x16_bf16(kf[0],qr[0],negm,0,0,0), P0[2],P0[3],P0[4],P0[5],     pw0[0]=PKW(P0,0), pw0[1]=PKW(P0,2), pw0); \
    VRD(4); SBAR(); GAPA(C1=__builtin_amdgcn_mfma_f32_32x32x16_bf16(kf[1],qr[0],negm,0,0,0), P0[6],P0[7],P0[8],P0[9],     pw0[2]=PKW(P0,4), pw0[3]=PKW(P0,6), pw0); \
    VRD(1); SBAR(); GAPA(C0=__builtin_amdgcn_mfma_f32_32x32x16_bf16(kf[2],qr[1],C0,0,0,0),   P0[10],P0[11],P0[12],P0[13], pw1[0]=PKW(P0,8), pw1[1]=PKW(P0,10), pw1); \
    VRD(5); SBAR(); GAPA(C1=__builtin_amdgcn_mfma_f32_32x32x16_bf16(kf[3],qr[1],C1,0,0,0),   P0[14],P0[15],P1[0],P1[1],   pw1[2]=PKW(P0,12),pw1[3]=PKW(P0,14), pw1); \
    VRD(2); SBAR(); GAPA(C0=__builtin_amdgcn_mfma_f32_32x32x16_bf16(kf[4],qr[2],C0,0,0,0),   P1[2],P1[3],P1[4],P1[5],     pw2[0]=PKW(P1,0), pw2[1]=PKW(P1,2), pw2); \
    VRD(6); SBAR(); GAPA(C1=__builtin_amdgcn_mfma_f32_32x32x16_bf16(kf[5],qr[2],C1,0,0,0),   P1[6],P1[7],P1[8],P1[9],     pw2[2]=PKW(P1,4), pw2[3]=PKW(P1,6), pw2); \
    VRD(3); SBAR(); GAPA(C0=__builtin_amdgcn_mfma_f32_32x32x16_bf16(kf[6],qr[3],C0,0,0,0),   P1[10],P1[11],P1[12],P1[13], pw3[0]=PKW(P1,8), pw3[1]=PKW(P1,10), pw3); \
    VRD(7); SBAR(); GAPA(C1=__builtin_amdgcn_mfma_f32_32x32x16_bf16(kf[7],qr[3],C1,0,0,0),   P1[14],P1[15],0.f,0.f,       pw3[2]=PKW(P1,12),pw3[3]=PKW(P1,14), pw3); \
    l_reg+=sacc; \
    if(GK){DMA_K((t)+3,sl_cur);} if(GV){DMA_V((t)+1,sl_next);} \
    if(va_){CMASK(C0,C1,t);} \
    { float a=MX3(C0[0],C0[1],C1[0]),b=MX3(C0[2],C0[3],C1[1]); a=MX3(a,C1[2],C1[3]); \
      _Pragma("unroll") for(int r=4;r<16;r+=4){a=MX3(a,C0[r],C0[r+1]);b=MX3(b,C0[r+2],C0[r+3]);a=MX3(a,C1[r],C1[r+1]);b=MX3(b,C1[r+2],C1[r+3]);} \
      float rm=__builtin_fmaxf(a,b); { auto rr=__builtin_amdgcn_permlane32_swap(__float_as_uint(rm),__float_as_uint(rm),false,false); rm=__builtin_fmaxf(__uint_as_float(rr[0]),__uint_as_float(rr[1])); } \
      resc=false; \
      if(__builtin_expect(__any(rm>(float)THRL),0)){ const float dl=__builtin_fmaxf(rm,0.f); mhat+=dl; \
        _Pragma("unroll") for(int r=0;r<16;++r){C0[r]-=dl;C1[r]-=dl;} \
        _Pragma("unroll") for(int r=0;r<16;++r)negm[r]=-mhat; asm volatile("":"+v"(negm)); \
        const float f=__builtin_amdgcn_exp2f(-dl); l_reg*=f; { int r_=r32; asm volatile("":"+v"(r_)); if(hi==0)wsf[r_]=f; } resc=true; } } \
    SBAR(); \
    GAPB(o[0]=__builtin_amdgcn_mfma_f32_32x32x16_bf16(PAF(0),VFR(0),o[0],0,0,0), C0,0); \
    GAPB(o[1]=__builtin_amdgcn_mfma_f32_32x32x16_bf16(PAF(0),VFR(4),o[1],0,0,0), C0,4); \
    KRD(GL,0); GAPB(o[0]=__builtin_amdgcn_mfma_f32_32x32x16_bf16(PAF(1),VFR(1),o[0],0,0,0), C0,8); \
    KRD(GL,1); GAPB(o[1]=__builtin_amdgcn_mfma_f32_32x32x16_bf16(PAF(1),VFR(5),o[1],0,0,0), C0,12); \
    KRD(GL,2); GAPB(o[0]=__builtin_amdgcn_mfma_f32_32x32x16_bf16(PAF(2),VFR(2),o[0],0,0,0), C1,0); \
    KRD(GL,3); GAPB(o[1]=__builtin_amdgcn_mfma_f32_32x32x16_bf16(PAF(2),VFR(6),o[1],0,0,0), C1,4); \
    GAPB(o[0]=__builtin_amdgcn_mfma_f32_32x32x16_bf16(PAF(3),VFR(3),o[0],0,0,0), C1,8); \
    GAPB(o[1]=__builtin_amdgcn_mfma_f32_32x32x16_bf16(PAF(3),VFR(7),o[1],0,0,0), C1,12); \
    }while(0)
  int t=1;
  #undef CMASK
  #define CMASK(P0,P1,t) W.mask(P0,P1,(t),wid,r32,hi)
  for(;t+5<NT;t+=2){
    STEP(pB0,pB1,pA0,pA1,t,true,true,true);     WAIT_BAR(2); RESC(); ROT();
    STEP(pA0,pA1,pB0,pB1,t+1,true,true,true);   WAIT_BAR(2); RESC(); ROT();
  }
  #undef CMASK
  #define CMASK(P0,P1,t) W.mask(P0,P1,(t),wid,r32,hi)
  #define ENDW(tt) do{ if((tt)+3<NT){WAIT_BAR(2);} else if((tt)+2<NT){WAIT_BAR(1);} else {WAIT_BAR(0);} }while(0)
  for(;t+1<NT;t+=2){
    STEP(pB0,pB1,pA0,pA1,t,(t+3<NT),(t+1<NT),(t+1<NT));       ENDW(t);   RESC(); ROT();
    STEP(pA0,pA1,pB0,pB1,t+1,(t+4<NT),(t+2<NT),(t+2<NT));     ENDW(t+1); RESC(); ROT();
  }
  STEP(pB0,pB1,pA0,pA1,NT-1,false,false,false); RESC();
  { float sacc=pB0[0]+pB0[1]; _Pragma("unroll") for(int r=2;r<16;++r)sacc+=pB0[r]; _Pragma("unroll") for(int r=0;r<16;++r)sacc+=pB1[r]; l_reg+=sacc;
    pw0=(u32x4){PKW(pB0,0),PKW(pB0,2),PKW(pB0,4),PKW(pB0,6)};pw1=(u32x4){PKW(pB0,8),PKW(pB0,10),PKW(pB0,12),PKW(pB0,14)};pw2=(u32x4){PKW(pB1,0),PKW(pB1,2),PKW(pB1,4),PKW(pB1,6)};pw3=(u32x4){PKW(pB1,8),PKW(pB1,10),PKW(pB1,12),PKW(pB1,14)};
    SBAR(); if(W.tile_valid(NT-1,wid)) pv(o,vb0+sl_cur,PAF(0),PAF(1),PAF(2),PAF(3)); }
  #undef PKW
  #undef PAF
  #undef VFR
  #undef PIN
  #undef MX3
  #undef GAPA
  #undef GAPB
  #undef EX
  #undef VRD
  #undef KRD
  #undef STEP
  #undef ENDW
  {auto rr=__builtin_amdgcn_permlane32_swap(__float_as_uint(l_reg),__float_as_uint(l_reg),false,false);l_reg=__uint_as_float(rr[0])+__uint_as_float(rr[1]);}
  if(hi==0)wsf[32+r32]=l_reg;asm volatile("s_waitcnt lgkmcnt(0)":::"memory");
  float rli[16];
  #pragma unroll
  for(int r=0;r<16;++r)rli[r]=__builtin_amdgcn_rcpf(wsf[32+crow(r,hi)]);
  W.store_lse(wid,r32,hi,mhat,l_reg);
  { bf16*stg=(bf16*)(shm+LDS_OST)+wid*2048;
    #pragma unroll
    for(int r=0;r<16;++r){const int orow=crow(r,hi);
      #pragma unroll
      for(int d0=0;d0<2;++d0)stg[orow*64+d0*32+r32]=__float2bfloat16(o[d0][r]*rli[r]);}
    asm volatile("s_waitcnt lgkmcnt(0)":::"memory");
    #pragma unroll
    for(int i=0;i<4;++i){const int row=i*8+(lane>>3),ch=lane&7; const u32x4 v=*(const u32x4*)(stg+row*64+ch*8); ATTN_STORE16(O+W.qrow(wid,row)*Var::OP+ch*8,v);} }
  asm volatile("s_waitcnt lgkmcnt(0)\n\ts_barrier":::"memory");
  #undef DMA_K
  #undef DMA_V
  #undef CMASK
  #undef START
  #undef RESC
  #undef ROT
}
template<class Var,int THRL> __device__ __forceinline__ void attn_unit_r(const Var&W,const bf16*Q,const bf16*__restrict__ K,const bf16*__restrict__ V,bf16*O,char*shm,int lane,int wid){
  const int r32=lane&31,hi=lane>>5;
  constexpr int NT=Var::NT, RK=0, RV=NT*SLOTB, RWS=2*NT*SLOTB;
  const unsigned lds0=(unsigned)(uintptr_t)shm;
  float*wsf=(float*)(shm+RWS)+wid*64;
  const bf16*vsrc=V+(wid>>2)*32+(lane&3)*8; const int vidx=16*(wid&3)+(lane>>2);
  const unsigned kdst=lds0+RK+wid*1024, vdst=lds0+RV+wid*1024;
  #define DMA_K(t,slot) glds16(K+W.krow((t),8*wid+(lane&7))*DM+((lane>>3)^(wid&1))*8,(unsigned)__builtin_amdgcn_readfirstlane(kdst+(slot)))
  #define DMA_V(t,slot) glds16(vsrc+W.krow((t),vidx)*DM,(unsigned)__builtin_amdgcn_readfirstlane(vdst+(slot)))
  const int vb0=(int)(lds0+RV)+((lane>>4)&1)*32+(lane&3)*8+(4*hi+((lane&15)>>2))*64;
  const char*Kbase=shm+RK; bf16x8 kf[8];
  const lds_cptr shm3=(lds_cptr)shm; const lds_cptr kp0=shm3+RK+hi*1024+r32*16; const lds_cptr vp0=shm3+RV+((lane>>4)&1)*32+(lane&3)*8+(4*hi+((lane&15)>>2))*64;
  _Pragma("unroll") for(int t_=0;t_<NT;++t_){DMA_K(t_,t_*SLOTB);}
  _Pragma("unroll") for(int t_=0;t_<NT;++t_){DMA_V(t_,t_*SLOTB);}
  bf16x8 qr[4];
  #pragma unroll
  for(int d0=0;d0<4;++d0)qr[d0]=*reinterpret_cast<const bf16x8*>(&Q[W.qrow(wid,r32)*DM+d0*16+hi*8]);
  float zz_;asm volatile("v_mov_b32 %0, 0":"=v"(zz_));
  float mhat=zz_,l_reg=zz_;f32x16 o[2];f32x16 negm;
  _Pragma("unroll") for(int r=0;r<16;++r){o[0][r]=zz_;o[1][r]=zz_;negm[r]=zz_;} asm volatile("":"+v"(negm));
  #define CMASK(P0,P1,t) W.mask(P0,P1,(t),wid,r32,hi)
  bool resc=false;
  #define START(P0,P1) do{ const float rm=rowmax(P0,P1); resc=false; \
    { const float dl=__builtin_fmaxf(rm,-30.f); mhat=fadd_s(mhat,dl);   \
      _Pragma("unroll") for(int r=0;r<16;++r){P0[r]=fsub_s(P0[r],dl);P1[r]=fsub_s(P1[r],dl);} \
      _Pragma("unroll") for(int r=0;r<16;++r)negm[r]=-mhat; asm volatile("":"+v"(negm)); } \
    _Pragma("unroll") for(int r=0;r<16;++r)P0[r]=__builtin_amdgcn_exp2f(P0[r]); }while(0)
  #define RESC() do{ if(resc){ asm volatile("s_waitcnt lgkmcnt(0)":::"memory"); \
      _Pragma("unroll") for(int d_=0;d_<2;++d_) _Pragma("unroll") for(int r=0;r<16;++r)o[d_][r]*=wsf[crow(r,hi)]; } }while(0)
  f32x16 pA0,pA1,pB0,pB1;
  const int tb=W.first_tile(wid);
  int sl_prev=0,sl_cur=tb*SLOTB,sl_next=sl_cur+SLOTB;
  #define ROT() do{sl_prev=sl_cur;sl_cur=sl_next;sl_next+=SLOTB;}while(0)
  asm volatile("s_waitcnt vmcnt(0)\n\ts_barrier":::"memory");
  qkt_s(pA0,pA1,Kbase+sl_cur,qr,negm,r32,hi);asm volatile("s_nop 15\n\ts_nop 7":"+v"(pA0),"+v"(pA1));CMASK(pA0,pA1,tb);
  START(pA0,pA1);
  _Pragma("unroll") for(int r=0;r<16;++r)pA1[r]=__builtin_amdgcn_exp2f(pA1[r]);
  ROT();
  kload8_s(kf,shm3+RK+sl_cur,r32,hi);
  s16x4 vlo[8],vhi[8]; u32x4 pw0,pw1,pw2,pw3;
  #define PKW(P,B) cvtpk_s(P[B],P[B+1])
  #define PAF(k) __builtin_bit_cast(bf16x8,pw##k)
  #define VFR(i) (bf16x8){vlo[i][0],vlo[i][1],vlo[i][2],vlo[i][3],vhi[i][0],vhi[i][1],vhi[i][2],vhi[i][3]}
  #define PIN(x) asm volatile("":"+v"(x))
  #define MX3(a,b,c) __builtin_fmaxf(__builtin_fmaxf((a),(b)),(c))
  #define GAPA(MF,A0,A1,A2,A3,W0,W1,PW) do{ if(va_){MF;} sacc+=A0; sacc+=A1; sacc+=A2; sacc+=A3; PIN(sacc); W0; W1; PIN(PW); SBAR(); }while(0)
  #define EX(v) __builtin_amdgcn_exp2f(v)
  #define GAPB(MF,X,B) do{ if(vb_){MF;} X[B]=EX(X[B]); X[B+1]=EX(X[B+1]); X[B+2]=EX(X[B+2]); X[B+3]=EX(X[B+3]); PIN(X); SBAR(); }while(0)
  #define VRD(i) do{ vlo[i]=vtr(vp_+(((i)>>2)*4096+((i)&3)*1024)); vhi[i]=vtr(vp_+(((i)>>2)*4096+((i)&3)*1024+512)); }while(0)
  #define KRD(G,j) do{ if(G){ kload2_s(kf,shm3+RK+sl_next,j,r32,hi); SBAR(); } }while(0)
  #define STEP(C0,C1,P0,P1,t,GK,GV,GL) do{ SBAR(); \
    const bool va_=((t)<NT)&&W.tile_valid((t),wid), vb_=W.tile_valid((t)-1,wid); \
    if(!va_){ _Pragma("unroll") for(int r=0;r<16;++r){C0[r]=-INFINITY;C1[r]=-INFINITY;} } \
    const lds_cptr vp_=vp0+sl_prev; \
    VRD(0); SBAR(); float sacc=(P0[0]+P0[1]); \
    GAPA(C0=__builtin_amdgcn_mfma_f32_32x32x16_bf16(kf[0],qr[0],negm,0,0,0), P0[2],P0[3],P0[4],P0[5],     pw0[0]=PKW(P0,0), pw0[1]=PKW(P0,2), pw0); \
    VRD(4); SBAR(); GAPA(C1=__builtin_amdgcn_mfma_f32_32x32x16_bf16(kf[1],qr[0],negm,0,0,0), P0[6],P0[7],P0[8],P0[9],     pw0[2]=PKW(P0,4), pw0[3]=PKW(P0,6), pw0); \
    VRD(1); SBAR(); GAPA(C0=__builtin_amdgcn_mfma_f32_32x32x16_bf16(kf[2],qr[1],C0,0,0,0),   P0[10],P0[11],P0[12],P0[13], pw1[0]=PKW(P0,8), pw1[1]=PKW(P0,10), pw1); \
    VRD(5); SBAR(); GAPA(C1=__builtin_amdgcn_mfma_f32_32x32x16_bf16(kf[3],qr[1],C1,0,0,0),   P0[14],P0[15],P1[0],P1[1],   pw1[2]=PKW(P0,12),pw1[3]=PKW(P0,14), pw1); \
    VRD(2); SBAR(); GAPA(C0=__builtin_amdgcn_mfma_f32_32x32x16_bf16(kf[4],qr[2],C0,0,0,0),   P1[2],P1[3],P1[4],P1[5],     pw2[0]=PKW(P1,0), pw2[1]=PKW(P1,2), pw2); \
    VRD(6); SBAR(); GAPA(C1=__builtin_amdgcn_mfma_f32_32x32x16_bf16(kf[5],qr[2],C1,0,0,0),   P1[6],P1[7],P1[8],P1[9],     pw2[2]=PKW(P1,4), pw2[3]=PKW(P1,6), pw2); \
    VRD(3); SBAR(); GAPA(C0=__builtin_amdgcn_mfma_f32_32x32x16_bf16(kf[6],qr[3],C0,0,0,0),   P1[10],P1[11],P1[12],P1[13], pw3[0]=PKW(P1,8), pw3[1]=PKW(P1,10), pw3); \
    VRD(7); SBAR(); GAPA(C1=__builtin_amdgcn_mfma_f32_32x32x16_bf16(kf[7],qr[3],C1,0,0,0),   P1[14],P1[15],0.f,0.f,       pw3[2]=PKW(P1,12),pw3[3]=PKW(P1,14), pw3); \
    l_reg+=sacc; \
    if(GK){DMA_K((t)+3,sl_cur);} if(GV){DMA_V((t)+1,sl_next);} \
    if(va_){CMASK(C0,C1,t);} \
    { float a=MX3(C0[0],C0[1],C1[0]),b=MX3(C0[2],C0[3],C1[1]); a=MX3(a,C1[2],C1[3]); \
      _Pragma("unroll") for(int r=4;r<16;r+=4){a=MX3(a,C0[r],C0[r+1]);b=MX3(b,C0[r+2],C0[r+3]);a=MX3(a,C1[r],C1[r+1]);b=MX3(b,C1[r+2],C1[r+3]);} \
      float rm=__builtin_fmaxf(a,b); { auto rr=__builtin_amdgcn_permlane32_swap(__float_as_uint(rm),__float_as_uint(rm),false,false); rm=__builtin_fmaxf(__uint_as_float(rr[0]),__uint_as_float(rr[1])); } \
      resc=false; \
      if(__builtin_expect(__any(rm>(float)THRL),0)){ const float dl=__builtin_fmaxf(rm,0.f); mhat+=dl; \
        _Pragma("unroll") for(int r=0;r<16;++r){C0[r]-=dl;C1[r]-=dl;} \
        _Pragma("unroll") for(int r=0;r<16;++r)negm[r]=-mhat; asm volatile("":"+v"(negm)); \
        const float f=__builtin_amdgcn_exp2f(-dl); l_reg*=f; { int r_=r32; asm volatile("":"+v"(r_)); if(hi==0)wsf[r_]=f; } resc=true; } } \
    SBAR(); \
    GAPB(o[0]=__builtin_amdgcn_mfma_f32_32x32x16_bf16(PAF(0),VFR(0),o[0],0,0,0), C0,0); \
    GAPB(o[1]=__builtin_amdgcn_mfma_f32_32x32x16_bf16(PAF(0),VFR(4),o[1],0,0,0), C0,4); \
    KRD(GL,0); GAPB(o[0]=__builtin_amdgcn_mfma_f32_32x32x16_bf16(PAF(1),VFR(1),o[0],0,0,0), C0,8); \
    KRD(GL,1); GAPB(o[1]=__builtin_amdgcn_mfma_f32_32x32x16_bf16(PAF(1),VFR(5),o[1],0,0,0), C0,12); \
    KRD(GL,2); GAPB(o[0]=__builtin_amdgcn_mfma_f32_32x32x16_bf16(PAF(2),VFR(2),o[0],0,0,0), C1,0); \
    KRD(GL,3); GAPB(o[1]=__builtin_amdgcn_mfma_f32_32x32x16_bf16(PAF(2),VFR(6),o[1],0,0,0), C1,4); \
    GAPB(o[0]=__builtin_amdgcn_mfma_f32_32x32x16_bf16(PAF(3),VFR(3),o[0],0,0,0), C1,8); \
    GAPB(o[1]=__builtin_amdgcn_mfma_f32_32x32x16_bf16(PAF(3),VFR(7),o[1],0,0,0), C1,12); \
    }while(0)
  STEP(pB0,pB1,pA0,pA1,tb+1,false,false,true);  RESC(); ROT();
  STEP(pA0,pA1,pB0,pB1,tb+2,false,false,false); RESC();
  { float sacc=pA0[0]+pA0[1]; _Pragma("unroll") for(int r=2;r<16;++r)sacc+=pA0[r]; _Pragma("unroll") for(int r=0;r<16;++r)sacc+=pA1[r]; l_reg+=sacc;
    pw0=(u32x4){PKW(pA0,0),PKW(pA0,2),PKW(pA0,4),PKW(pA0,6)};pw1=(u32x4){PKW(pA0,8),PKW(pA0,10),PKW(pA0,12),PKW(pA0,14)};pw2=(u32x4){PKW(pA1,0),PKW(pA1,2),PKW(pA1,4),PKW(pA1,6)};pw3=(u32x4){PKW(pA1,8),PKW(pA1,10),PKW(pA1,12),PKW(pA1,14)};
    SBAR(); if((tb+2<NT)&&W.tile_valid(tb+2,wid)) pv(o,vb0+sl_cur,PAF(0),PAF(1),PAF(2),PAF(3)); }
  #undef PKW
  #undef PAF
  #undef VFR
  #undef PIN
  #undef MX3
  #undef GAPA
  #undef GAPB
  #undef EX
  #undef VRD
  #undef KRD
  #undef STEP
  {auto rr=__builtin_amdgcn_permlane32_swap(__float_as_uint(l_reg),__float_as_uint(l_reg),false,false);l_reg=__uint_as_float(rr[0])+__uint_as_float(rr[1]);}
  if(hi==0)wsf[32+r32]=l_reg;asm volatile("s_waitcnt lgkmcnt(0)":::"memory");
  float rli[16];
  #pragma unroll
  for(int r=0;r<16;++r)rli[r]=__builtin_amdgcn_rcpf(wsf[32+crow(r,hi)]);
  W.store_lse(wid,r32,hi,mhat,l_reg);
  asm volatile("s_waitcnt lgkmcnt(0)\n\ts_barrier":::"memory");
  { bf16*stg=(bf16*)(shm+RK)+wid*2048;
    #pragma unroll
    for(int r=0;r<16;++r){const int orow=crow(r,hi);
      #pragma unroll
      for(int d0=0;d0<2;++d0)stg[orow*64+d0*32+r32]=__float2bfloat16(o[d0][r]*rli[r]);}
    asm volatile("s_waitcnt lgkmcnt(0)":::"memory");
    #pragma unroll
    for(int i=0;i<4;++i){const int row=i*8+(lane>>3),ch=lane&7; const u32x4 v=*(const u32x4*)(stg+row*64+ch*8); ATTN_STORE16(O+W.qrow(wid,row)*Var::OP+ch*8,v);} }
  asm volatile("s_waitcnt lgkmcnt(0)\n\ts_barrier":::"memory");
  #undef DMA_K
  #undef DMA_V
  #undef CMASK
  #undef START
  #undef RESC
  #undef ROT
}
template<class Var,int THRL> __device__ __forceinline__ void attn_unit_b(const Var&W,const bf16*Q,const bf16*__restrict__ K,const bf16*__restrict__ V,bf16*O,char*shm,int lane,int wid){
  const int r32=lane&31,hi=lane>>5;
  constexpr int NT=Var::NT, NRS=8, RK=0, RV=NRS*SLOTB, RWS=131584;
  const unsigned lds0=(unsigned)(uintptr_t)shm;
  float*wsf=(float*)(shm+RWS)+wid*64;
  const bf16*vsrc=V+(wid>>2)*32+(lane&3)*8; const int vidx=16*(wid&3)+(lane>>2);
  const unsigned kdst=lds0+RK+wid*1024, vdst=lds0+RV+wid*1024;
  #define DMA_K(t,slot) glds16(K+W.krow((t),8*wid+(lane&7))*DM+((lane>>3)^(wid&1))*8,(unsigned)__builtin_amdgcn_readfirstlane(kdst+(slot)))
  #define DMA_V(t,slot) glds16(vsrc+W.krow((t),vidx)*DM,(unsigned)__builtin_amdgcn_readfirstlane(vdst+(slot)))
  const int vb0=(int)(lds0+RV)+((lane>>4)&1)*32+(lane&3)*8+(4*hi+((lane&15)>>2))*64;
  const char*Kbase=shm+RK; bf16x8 kf[8];
  const lds_cptr shm3=(lds_cptr)shm; const lds_cptr kp0=shm3+RK+hi*1024+r32*16; const lds_cptr vp0=shm3+RV+((lane>>4)&1)*32+(lane&3)*8+(4*hi+((lane&15)>>2))*64;
  _Pragma("unroll") for(int t_=0;t_<NRS;++t_){DMA_K(t_,t_*SLOTB);}
  _Pragma("unroll") for(int t_=0;t_<NRS;++t_){DMA_V(t_,t_*SLOTB);}
  bf16x8 qr[4];
  #pragma unroll
  for(int d0=0;d0<4;++d0)qr[d0]=*reinterpret_cast<const bf16x8*>(&Q[W.qrow(wid,r32)*DM+d0*16+hi*8]);
  float zz_;asm volatile("v_mov_b32 %0, 0":"=v"(zz_));
  float mhat=zz_,l_reg=zz_;f32x16 o[2];f32x16 negm;
  _Pragma("unroll") for(int r=0;r<16;++r){o[0][r]=zz_;o[1][r]=zz_;negm[r]=zz_;} asm volatile("":"+v"(negm));
  #define CMASK(P0,P1,t) W.mask(P0,P1,(t),wid,r32,hi)
  bool resc=false;
  #define START(P0,P1) do{ const float rm=rowmax(P0,P1); resc=false; \
    { const float dl=__builtin_fmaxf(rm,-30.f); mhat=fadd_s(mhat,dl);   \
      _Pragma("unroll") for(int r=0;r<16;++r){P0[r]=fsub_s(P0[r],dl);P1[r]=fsub_s(P1[r],dl);} \
      _Pragma("unroll") for(int r=0;r<16;++r)negm[r]=-mhat; asm volatile("":"+v"(negm)); } \
    _Pragma("unroll") for(int r=0;r<16;++r)P0[r]=__builtin_amdgcn_exp2f(P0[r]); }while(0)
  #define RESC() do{ if(resc){ asm volatile("s_waitcnt lgkmcnt(0)":::"memory"); \
      _Pragma("unroll") for(int d_=0;d_<2;++d_) _Pragma("unroll") for(int r=0;r<16;++r)o[d_][r]*=wsf[crow(r,hi)]; } }while(0)
  f32x16 pA0,pA1,pB0,pB1;
  const int tb=W.first_tile(wid);
  int sl_prev=0,sl_cur=tb*SLOTB,sl_next=sl_cur+SLOTB;
  #define ROT() do{sl_prev=sl_cur;sl_cur=sl_next;sl_next=(sl_next+SLOTB)&(NRS*SLOTB-1);}while(0)
  asm volatile("s_waitcnt vmcnt(0)\n\ts_barrier":::"memory");
  qkt_s(pA0,pA1,Kbase+sl_cur,qr,negm,r32,hi);asm volatile("s_nop 15\n\ts_nop 7":"+v"(pA0),"+v"(pA1));CMASK(pA0,pA1,tb);
  START(pA0,pA1);
  _Pragma("unroll") for(int r=0;r<16;++r)pA1[r]=__builtin_amdgcn_exp2f(pA1[r]);
  ROT();
  kload8_s(kf,shm3+RK+sl_cur,r32,hi);
  s16x4 vlo[8],vhi[8]; u32x4 pw0,pw1,pw2,pw3;
  #define PKW(P,B) cvtpk_s(P[B],P[B+1])
  #define PAF(k) __builtin_bit_cast(bf16x8,pw##k)
  #define VFR(i) (bf16x8){vlo[i][0],vlo[i][1],vlo[i][2],vlo[i][3],vhi[i][0],vhi[i][1],vhi[i][2],vhi[i][3]}
  #define PIN(x) asm volatile("":"+v"(x))
  #define MX3(a,b,c) __builtin_fmaxf(__builtin_fmaxf((a),(b)),(c))
  #define GAPA(MF,A0,A1,A2,A3,W0,W1,PW) do{ if(va_){MF;} sacc+=A0; sacc+=A1; sacc+=A2; sacc+=A3; PIN(sacc); W0; W1; PIN(PW); SBAR(); }while(0)
  #define EX(v) __builtin_amdgcn_exp2f(v)
  #define GAPB(MF,X,B) do{ if(vb_){MF;} X[B]=EX(X[B]); X[B+1]=EX(X[B+1]); X[B+2]=EX(X[B+2]); X[B+3]=EX(X[B+3]); PIN(X); SBAR(); }while(0)
  #define VRD(i) do{ vlo[i]=vtr(vp_+(((i)>>2)*4096+((i)&3)*1024)); vhi[i]=vtr(vp_+(((i)>>2)*4096+((i)&3)*1024+512)); }while(0)
  #define KRD(G,j) do{ if(G){ kload2_s(kf,shm3+RK+sl_next,j,r32,hi); SBAR(); } }while(0)
  #define STEP(C0,C1,P0,P1,t,GK,GV,GL) do{ SBAR(); \
    const bool va_=((t)<NT)&&W.tile_valid((t),wid), vb_=W.tile_valid((t)-1,wid); \
    if(!va_){ _Pragma("unroll") for(int r=0;r<16;++r){C0[r]=-INFINITY;C1[r]=-INFINITY;} } \
    const lds_cptr vp_=vp0+sl_prev; \
    VRD(0); SBAR(); float sacc=(P0[0]+P0[1]); \
    GAPA(C0=__builtin_amdgcn_mfma_f32_32x32x16_bf16(kf[0],qr[0],negm,0,0,0), P0[2],P0[3],P0[4],P0[5],     pw0[0]=PKW(P0,0), pw0[1]=PKW(P0,2), pw0); \
    VRD(4); SBAR(); GAPA(C1=__builtin_amdgcn_mfma_f32_32x32x16_bf16(kf[1],qr[0],negm,0,0,0), P0[6],P0[7],P0[8],P0[9],     pw0[2]=PKW(P0,4), pw0[3]=PKW(P0,6), pw0); \
    VRD(1); SBAR(); GAPA(C0=__builtin_amdgcn_mfma_f32_32x32x16_bf16(kf[2],qr[1],C0,0,0,0),   P0[10],P0[11],P0[12],P0[13], pw1[0]=PKW(P0,8), pw1[1]=PKW(P0,10), pw1); \
    VRD(5); SBAR(); GAPA(C1=__builtin_amdgcn_mfma_f32_32x32x16_bf16(kf[3],qr[1],C1,0,0,0),   P0[14],P0[15],P1[0],P1[1],   pw1[2]=PKW(P0,12),pw1[3]=PKW(P0,14), pw1); \
    VRD(2); SBAR(); GAPA(C0=__builtin_amdgcn_mfma_f32_32x32x16_bf16(kf[4],qr[2],C0,0,0,0),   P1[2],P1[3],P1[4],P1[5],     pw2[0]=PKW(P1,0), pw2[1]=PKW(P1,2), pw2); \
    VRD(6); SBAR(); GAPA(C1=__builtin_amdgcn_mfma_f32_32x32x16_bf16(kf[5],qr[2],C1,0,0,0),   P1[6],P1[7],P1[8],P1[9],     pw2[2]=PKW(P1,4), pw2[3]=PKW(P1,6), pw2); \
    VRD(3); SBAR(); GAPA(C0=__builtin_amdgcn_mfma_f32_32x32x16_bf16(kf[6],qr[3],C0,0,0,0),   P1[10],P1[11],P1[12],P1[13], pw3[0]=PKW(P1,8), pw3[1]=PKW(P1,10), pw3); \
    VRD(7); SBAR(); GAPA(C1=__builtin_amdgcn_mfma_f32_32x32x16_bf16(kf[7],qr[3],C1,0,0,0),   P1[14],P1[15],0.f,0.f,       pw3[2]=PKW(P1,12),pw3[3]=PKW(P1,14), pw3); \
    l_reg+=sacc; \
    if(GK){DMA_K((t)+3,sl_cur);} if(GV){DMA_V((t)+1,sl_next);} \
    if(va_){CMASK(C0,C1,t);} \
    { float a=MX3(C0[0],C0[1],C1[0]),b=MX3(C0[2],C0[3],C1[1]); a=MX3(a,C1[2],C1[3]); \
      _Pragma("unroll") for(int r=4;r<16;r+=4){a=MX3(a,C0[r],C0[r+1]);b=MX3(b,C0[r+2],C0[r+3]);a=MX3(a,C1[r],C1[r+1]);b=MX3(b,C1[r+2],C1[r+3]);} \
      float rm=__builtin_fmaxf(a,b); { auto rr=__builtin_amdgcn_permlane32_swap(__float_as_uint(rm),__float_as_uint(rm),false,false); rm=__builtin_fmaxf(__uint_as_float(rr[0]),__uint_as_float(rr[1])); } \
      resc=false; \
      if(__builtin_expect(__any(rm>(float)THRL),0)){ const float dl=__builtin_fmaxf(rm,0.f); mhat+=dl; \
        _Pragma("unroll") for(int r=0;r<16;++r){C0[r]-=dl;C1[r]-=dl;} \
        _Pragma("unroll") for(int r=0;r<16;++r)negm[r]=-mhat; asm volatile("":"+v"(negm)); \
        const float f=__builtin_amdgcn_exp2f(-dl); l_reg*=f; { int r_=r32; asm volatile("":"+v"(r_)); if(hi==0)wsf[r_]=f; } resc=true; } } \
    SBAR(); \
    GAPB(o[0]=__builtin_amdgcn_mfma_f32_32x32x16_bf16(PAF(0),VFR(0),o[0],0,0,0), C0,0); \
    GAPB(o[1]=__builtin_amdgcn_mfma_f32_32x32x16_bf16(PAF(0),VFR(4),o[1],0,0,0), C0,4); \
    KRD(GL,0); GAPB(o[0]=__builtin_amdgcn_mfma_f32_32x32x16_bf16(PAF(1),VFR(1),o[0],0,0,0), C0,8); \
    KRD(GL,1); GAPB(o[1]=__builtin_amdgcn_mfma_f32_32x32x16_bf16(PAF(1),VFR(5),o[1],0,0,0), C0,12); \
    KRD(GL,2); GAPB(o[0]=__builtin_amdgcn_mfma_f32_32x32x16_bf16(PAF(2),VFR(2),o[0],0,0,0), C1,0); \
    KRD(GL,3); GAPB(o[1]=__builtin_amdgcn_mfma_f32_32x32x16_bf16(PAF(2),VFR(6),o[1],0,0,0), C1,4); \
    GAPB(o[0]=__builtin_amdgcn_mfma_f32_32x32x16_bf16(PAF(3),VFR(3),o[0],0,0,0), C1,8); \
    GAPB(o[1]=__builtin_amdgcn_mfma_f32_32x32x16_bf16(PAF(3),VFR(7),o[1],0,0,0), C1,12); \
    }while(0)
  #define BARV(N) asm volatile("s_waitcnt vmcnt(" #N ") lgkmcnt(0)\n\ts_barrier":::"memory")
  STEP(pB0,pB1,pA0,pA1,tb+1,false,false,true); RESC(); ROT(); BARV(0); DMA_K(8,0);       DMA_V(8,0);
  STEP(pA0,pA1,pB0,pB1,tb+2,false,false,true); RESC(); ROT(); BARV(2); DMA_K(9,SLOTB);   DMA_V(9,SLOTB);
  STEP(pB0,pB1,pA0,pA1,tb+3,false,false,true); RESC(); ROT(); BARV(2); DMA_K(10,2*SLOTB);DMA_V(10,2*SLOTB);
  STEP(pA0,pA1,pB0,pB1,tb+4,false,false,true); RESC(); ROT(); BARV(2);
  STEP(pB0,pB1,pA0,pA1,tb+5,false,false,true); RESC(); ROT(); BARV(0);
  STEP(pA0,pA1,pB0,pB1,tb+6,false,false,true); RESC(); ROT();
  STEP(pB0,pB1,pA0,pA1,tb+7,false,false,false); RESC();
  #undef BARV
  { float sacc=pB0[0]+pB0[1]; _Pragma("unroll") for(int r=2;r<16;++r)sacc+=pB0[r]; _Pragma("unroll") for(int r=0;r<16;++r)sacc+=pB1[r]; l_reg+=sacc;
    pw0=(u32x4){PKW(pB0,0),PKW(pB0,2),PKW(pB0,4),PKW(pB0,6)};pw1=(u32x4){PKW(pB0,8),PKW(pB0,10),PKW(pB0,12),PKW(pB0,14)};pw2=(u32x4){PKW(pB1,0),PKW(pB1,2),PKW(pB1,4),PKW(pB1,6)};pw3=(u32x4){PKW(pB1,8),PKW(pB1,10),PKW(pB1,12),PKW(pB1,14)};
    SBAR(); pv(o,vb0+sl_cur,PAF(0),PAF(1),PAF(2),PAF(3)); }
  #undef PKW
  #undef PAF
  #undef VFR
  #undef PIN
  #undef MX3
  #undef GAPA
  #undef GAPB
  #undef EX
  #undef VRD
  #undef KRD
  #undef STEP
  {auto rr=__builtin_amdgcn_permlane32_swap(__float_as_uint(l_reg),__float_as_uint(l_reg),false,false);l_reg=__uint_as_float(rr[0])+__uint_as_float(rr[1]);}
  if(hi==0)wsf[32+r32]=l_reg;asm volatile("s_waitcnt lgkmcnt(0)":::"memory");
  float rli[16];
  #pragma unroll
  for(int r=0;r<16;++r)rli[r]=__builtin_amdgcn_rcpf(wsf[32+crow(r,hi)]);
  W.store_lse(wid,r32,hi,mhat,l_reg);
  asm volatile("s_waitcnt lgkmcnt(0)\n\ts_barrier":::"memory");
  { bf16*stg=(bf16*)(shm+RK)+wid*2048;
    #pragma unroll
    for(int r=0;r<16;++r){const int orow=crow(r,hi);
      #pragma unroll
      for(int d0=0;d0<2;++d0)stg[orow*64+d0*32+r32]=__float2bfloat16(o[d0][r]*rli[r]);}
    asm volatile("s_waitcnt lgkmcnt(0)":::"memory");
    #pragma unroll
    for(int i=0;i<4;++i){const int row=i*8+(lane>>3),ch=lane&7; const u32x4 v=*(const u32x4*)(stg+row*64+ch*8); ATTN_STORE16(O+W.qrow(wid,row)*Var::OP+ch*8,v);} }
  asm volatile("s_waitcnt lgkmcnt(0)\n\ts_barrier":::"memory");
  #undef DMA_K
  #undef DMA_V
  #undef CMASK
  #undef START
  #undef RESC
  #undef ROT
}
constexpr int ATTN_LDS_BYTES=LDS_BYTES;
struct AttnTensors { const bf16* Q; const bf16* K; const bf16* V; bf16* O; };
struct AttnUnit { int b, h, kvh, qb; };
struct StaticOrder {
  int xcd, j, G;
  __device__ __forceinline__ explicit StaticOrder(int grid,int block):xcd(block&7),j(block>>3),G(grid){}
  __device__ __forceinline__ bool next(int i,AttnUnit&u)const{
    if(G==256){ if(i>=2)return false; const int pair=2*xcd+i; u.b=pair>>1; u.kvh=pair&1; u.h=u.kvh*2+(j>>4); u.qb=j&15; return true; }
    const int L=i*G+(xcd+8*j); if(L>=512)return false; u.qb=L&15; u.h=(L>>4)&3; u.kvh=u.h>>1; u.b=L>>6; return true; }
};
template<class Sched,int THRL=8> __device__ __forceinline__ void attn_phase(char*lds,const AttnTensors&T,const Sched&S,int lane,int wid){
  AttnUnit u;
  for(int i=0;S.next(i,u);++i){ attn_unit<THRL>(u.b,u.h,u.kvh,u.qb,T.Q,T.K,T.V,T.O,lds,lane,wid); }
}

template<int NTT> struct VarC_ {
  static constexpr int NT=NTT, OP=384;
  int rowb, dil, cls, u0, L, toff; float* lse; int h;
  __device__ __forceinline__ long qrow(int wid,int r)const{ return (long)rowb+(long)(u0+32*wid+r)*dil+cls; }
  __device__ __forceinline__ long krow(int t,int idx)const{ int u=u0-64+64*(t+toff)+idx; u=u<0?0:(u>L-1?L-1:u); return (long)rowb+(long)u*dil+cls; }
  __device__ __forceinline__ void mask(f32x16&P0,f32x16&P1,int t,int wid,int r32,int hi)const{
    const int tt=t+toff, ulo=u0-64+64*tt, A=32*wid+r32-64*tt;
    int lo=A>-ulo?A:-ulo; const int hb=A+128<L-1-ulo?A+128:L-1-ulo; const bool none=hb<lo;
    const unsigned span=(unsigned)(hb-lo); lo-=4*hi;
    #pragma unroll
    for(int r=0;r<16;++r){ const int kk=(r&3)+8*(r>>2);
      const bool ok0=!none&&((unsigned)(kk-lo)<=span), ok1=!none&&((unsigned)(kk+32-lo)<=span);
      P0[r]=ok0?P0[r]:-INFINITY; P1[r]=ok1?P1[r]:-INFINITY; }
  }
  __device__ __forceinline__ bool tile_valid(int t,int wid)const{ const int lo=wid>>1, tt=t+toff; return tt>=lo&&tt<=lo+2; }
  __device__ __forceinline__ int first_tile(int wid)const{ const int t=(wid>>1)-toff; return t<0?0:t; }
  __device__ __forceinline__ void store_lse(int wid,int r32,int hi,float mhat,float l)const{ if(hi==0) lse[qrow(wid,r32)*6+h]=mhat+__builtin_amdgcn_logf(l); }
};
typedef VarC_<6> VarC;
struct VarB {
  static constexpr int NT=12, OP=1024;
  int rowb, r0, rs0; const float* tab;
  __device__ __forceinline__ long qrow(int wid,int r)const{ return (long)rowb+(r0+(wid>>1))*64+32*(wid&1)+r; }
  __device__ __forceinline__ long krow(int t,int idx)const{ int kr=rs0+t; kr=kr>63?63:kr; return (long)rowb+kr*64+idx; }
  __device__ __forceinline__ void mask(f32x16&P0,f32x16&P1,int t,int wid,int r32,int hi)const{
    const int r=r0+(wid>>1), c=32*(wid&1)+r32, kr=rs0+t;
    int rs=r-4; rs=rs<0?0:(rs>56?56:rs); int cs=c-8; cs=cs<0?0:(cs>48?48:cs);
    const bool rowok=(kr>=rs)&&(kr<rs+8);
    if(!rowok){
      #pragma unroll
      for(int q=0;q<16;++q){P0[q]=-INFINITY;P1[q]=-INFINITY;}
    } else {
      const int cb=4*hi-cs; const float*tb=tab+((kr-r+7)*31+4*hi-c+15);
      #pragma unroll
      for(int g=0;g<4;++g){ float b0[4],b1[4];
        #pragma unroll
        for(int e=0;e<4;++e){ b0[e]=tb[8*g+e]; b1[e]=tb[8*g+e+32]; }
        asm volatile("":"+v"(b0[0]),"+v"(b0[1]),"+v"(b0[2]),"+v"(b0[3]),"+v"(b1[0]),"+v"(b1[1]),"+v"(b1[2]),"+v"(b1[3]));
        #pragma unroll
        for(int e=0;e<4;++e){ const int q=4*g+e, kk=8*g+e;
          const bool ok0=((unsigned)(cb+kk)<16u), ok1=((unsigned)(cb+kk+32)<16u);
          P0[q]=ok0?P0[q]+b0[e]:-INFINITY; P1[q]=ok1?P1[q]+b1[e]:-INFINITY; }
        asm volatile("":::"memory"); }
    }
  }
  __device__ __forceinline__ bool tile_valid(int t,int wid)const{ const int r=r0+(wid>>1); int rs=r-4; rs=rs<0?0:(rs>56?56:rs); const int kr=rs0+t; return kr>=rs&&kr<rs+8; }
  __device__ __forceinline__ int first_tile(int wid)const{ const int r=r0+(wid>>1); int rs=r-4; rs=rs<0?0:(rs>56?56:rs); return rs-rs0; }
  __device__ __forceinline__ void store_lse(int,int,int,float,float)const{}
};
constexpr int LDS_TAB_B=133632;
constexpr int LDS_TAB=86016;
constexpr int ATTN_G_LDS_BYTES=LDS_TAB+6*465*4;
__device__ __forceinline__ void attnB_phase(char*lds,const bf16*qkv,int cq,int ck,int cv,const float*nab,bf16*ao,int G,int bid,int lane,int wid){
  float*tab=(float*)(lds+LDS_TAB_B);
  { float tv[6];
    #pragma unroll
    for(int q=0;q<6;++q){ const int i=wid*64+lane+512*q; tv[q]=(i<6*465)?nab[i]:0.f; }
    #pragma unroll
    for(int q=0;q<6;++q){ const int i=wid*64+lane+512*q; if(i<6*465)tab[i]=tv[q]*1.4426950408889634f; } }
  asm volatile("s_waitcnt lgkmcnt(0)\n\ts_barrier":::"memory");
  for(int it0=bid;it0<8*6*16;it0+=G){ const int it=(G==256)?((((bid&7)+8*(2*(it0>>8)+(bid>>7)))<<4)|((bid>>3)&15)):it0; const int rb=it&15,bh=it>>4,h=bh%6,b=bh/6; asm volatile("":"+v"(lane));
    VarB W; W.rowb=b*SEQ; W.r0=4*rb; int rs0=4*rb-4; W.rs0=rs0<0?0:(rs0>56?56:rs0); W.tab=tab+h*465;
    attn_unit_b<VarB,8>(W,qkv+cq+h*64,qkv+ck+h*64,qkv+cv+h*64,ao+256+h*64,lds,lane,wid); }
}
__device__ __forceinline__ void attnC_phase(char*lds,const bf16*qkv,int cq,int ck,int cv,bf16*part,float*lse,int G,int bid,int lane,int wid){
  auto c1=[&](int it){ const int k=it&15,br=(it>>4)&1,bh=it>>5,h=bh%6,b=bh/6; asm volatile("":"+v"(lane));
    VarC W; W.rowb=b*SEQ; W.dil=1<<(2*br); W.L=SEQ>>(2*br); W.h=h; W.toff=0;
    if(br==0){W.cls=0;W.u0=256*k;} else {W.cls=k&3;W.u0=256*(k>>2);}
    W.lse=lse+(size_t)br*(8*SEQ*6);
    attn_unit_r<VarC,8>(W,qkv+cq+h*64,qkv+ck+h*64,qkv+cv+h*64,part+(size_t)br*(8*SEQ*384)+h*64,lds,lane,wid); };
  auto c2=[&](int it){ const int k=it&15,bh=it>>4,h=bh%6,b=bh/6; asm volatile("":"+v"(lane));
    VarC_<4> W; W.rowb=b*SEQ; W.dil=16; W.L=256; W.h=h; W.toff=1; W.cls=k; W.u0=0;
    W.lse=lse+(size_t)2*(8*SEQ*6);
    attn_unit_r<VarC_<4>,8>(W,qkv+cq+h*64,qkv+ck+h*64,qkv+cv+h*64,part+(size_t)2*(8*SEQ*384)+h*64,lds,lane,wid); };
  const int n1=(8*6*2*16-bid+G-1)/G, n2=(8*6*16-bid+G-1)/G, ns=(G==256)?9:n1+n2;
  for(int s_=0;s_<ns;++s_){ bool kind; int it;
    if(G==256){ const int i=s_/3,r=s_-3*i; kind=(r==2); it=kind?((((bid&7)+8*(2*i+(bid>>7)))<<4)|((bid>>3)&15)):((((bid&7)+8*(2*i+r))<<5)|(bid>>3)); }
    else { kind=(s_>=n1); it=kind?bid+(s_-n1)*G:bid+s_*G; }
    if(kind) c2(it); else c1(it); }
}
template<class Var> __device__ __forceinline__ void attn_wave_item(const Var&W,const bf16*Q,const bf16*__restrict__ K,const bf16*__restrict__ V,bf16*O,char*shm,float*wsf,int lane){
  const int r32=lane&31,hi=lane>>5;
  const unsigned lds0=(unsigned)(uintptr_t)shm;
  const int vb0=(int)(lds0+8192)+((lane>>4)&1)*32+(lane&3)*8+(4*hi+((lane&15)>>2))*64;
  #define WDMA_K(t) do{ const bf16*s_=K+W.krow((t),lane)*DM; _Pragma("unroll") for(int c_=0;c_<8;++c_) glds16(s_+c_*8,(unsigned)__builtin_amdgcn_readfirstlane(lds0+c_*1024)); }while(0)
  #define WDMA_V(t) do{ _Pragma("unroll") for(int g_=0;g_<4;++g_){ const bf16*s_=V+W.krow((t),16*g_+(lane>>2))*DM+(lane&3)*8; \
      glds16(s_,(unsigned)__builtin_amdgcn_readfirstlane(lds0+8192+g_*1024)); glds16(s_+32,(unsigned)__builtin_amdgcn_readfirstlane(lds0+8192+(4+g_)*1024)); } }while(0)
  bf16x8 qr[4];
  { const bf16*qp=Q+W.qrow(r32)*DM+hi*8;
    #pragma unroll
    for(int d0=0;d0<4;++d0)qr[d0]=*reinterpret_cast<const bf16x8*>(qp+d0*16); }
  WDMA_K(0); WDMA_V(0);
  float zz_;asm volatile("v_mov_b32 %0, 0":"=v"(zz_));
  float mhat=zz_,l_reg=zz_;f32x16 o[2];f32x16 negm;
  _Pragma("unroll") for(int r=0;r<16;++r){o[0][r]=zz_;o[1][r]=zz_;negm[r]=zz_;} asm volatile("":"+v"(negm));
  for(int t=0;t<Var::NT;++t){
    asm volatile("s_waitcnt vmcnt(8)":::"memory");
    f32x16 p0,p1; qkt(p0,p1,shm,qr,negm,r32,hi); asm volatile("s_nop 15\n\ts_nop 7":"+v"(p0),"+v"(p1));
    asm volatile("s_waitcnt lgkmcnt(0)":::"memory");
    if(t+1<Var::NT){ WDMA_K(t+1); }
    W.mask(p0,p1,t,r32,hi);
    const float rm=rowmax(p0,p1);
    if(t==0){ const float dl=__builtin_fmaxf(rm,-30.f); mhat+=dl;
      _Pragma("unroll") for(int r=0;r<16;++r){p0[r]-=dl;p1[r]-=dl;}
      _Pragma("unroll") for(int r=0;r<16;++r)negm[r]=-mhat; asm volatile("":"+v"(negm)); }
    else if(__any(rm>8.f)){ const float dl=__builtin_fmaxf(rm,0.f); mhat+=dl;
      _Pragma("unroll") for(int r=0;r<16;++r){p0[r]-=dl;p1[r]-=dl;}
      _Pragma("unroll") for(int r=0;r<16;++r)negm[r]=-mhat; asm volatile("":"+v"(negm));
      const float f=__builtin_amdgcn_exp2f(-dl); l_reg*=f; if(hi==0)wsf[r32]=f;
      asm volatile("s_waitcnt lgkmcnt(0)":::"memory");
      _Pragma("unroll") for(int d_=0;d_<2;++d_) _Pragma("unroll") for(int r=0;r<16;++r)o[d_][r]*=wsf[crow(r,hi)];
      asm volatile("s_waitcnt lgkmcnt(0)":::"memory"); }
    float sacc=0.f;
    _Pragma("unroll") for(int r=0;r<16;++r){p0[r]=__builtin_amdgcn_exp2f(p0[r]);p1[r]=__builtin_amdgcn_exp2f(p1[r]);sacc+=p0[r]+p1[r];}
    l_reg+=sacc;
    u32x4 pw0,pw1,pw2,pw3;
    pw0=(u32x4){cvtpk_s(p0[0],p0[1]),cvtpk_s(p0[2],p0[3]),cvtpk_s(p0[4],p0[5]),cvtpk_s(p0[6],p0[7])};
    pw1=(u32x4){cvtpk_s(p0[8],p0[9]),cvtpk_s(p0[10],p0[11]),cvtpk_s(p0[12],p0[13]),cvtpk_s(p0[14],p0[15])};
    pw2=(u32x4){cvtpk_s(p1[0],p1[1]),cvtpk_s(p1[2],p1[3]),cvtpk_s(p1[4],p1[5]),cvtpk_s(p1[6],p1[7])};
    pw3=(u32x4){cvtpk_s(p1[8],p1[9]),cvtpk_s(p1[10],p1[11]),cvtpk_s(p1[12],p1[13]),cvtpk_s(p1[14],p1[15])};
    if(t+1<Var::NT){ asm volatile("s_waitcnt vmcnt(8)":::"memory"); } else { asm volatile("s_waitcnt vmcnt(0)":::"memory"); }
    __builtin_amdgcn_sched_barrier(0);
    pv(o,vb0,__builtin_bit_cast(bf16x8,pw0),__builtin_bit_cast(bf16x8,pw1),__builtin_bit_cast(bf16x8,pw2),__builtin_bit_cast(bf16x8,pw3));
    if(t+1<Var::NT){ WDMA_V(t+1); }
  }
  {auto rr=__builtin_amdgcn_permlane32_swap(__float_as_uint(l_reg),__float_as_uint(l_reg),false,false);l_reg=__uint_as_float(rr[0])+__uint_as_float(rr[1]);}
  if(hi==0)wsf[32+r32]=l_reg;asm volatile("s_waitcnt lgkmcnt(0)":::"memory");
  float rli[16];
  #pragma unroll
  for(int r=0;r<16;++r)rli[r]=__builtin_amdgcn_rcpf(wsf[32+crow(r,hi)]);
  W.store_lse(r32,hi,mhat,l_reg);
  { bf16*stg=(bf16*)shm;
    #pragma unroll
    for(int r=0;r<16;++r){const int orow=crow(r,hi);
      #pragma unroll
      for(int d0=0;d0<2;++d0)stg[orow*64+d0*32+r32]=__float2bfloat16(o[d0][r]*rli[r]);}
    asm volatile("s_waitcnt lgkmcnt(0)":::"memory");
    #pragma unroll
    for(int i=0;i<4;++i){const int row=i*8+(lane>>3),ch=lane&7; const u32x4 v=*(const u32x4*)(stg+row*64+ch*8); ATTN_STORE16(O+W.qrow(row)*Var::OP+ch*8,v);}
    asm volatile("s_waitcnt lgkmcnt(0)":::"memory"); }
  #undef WDMA_K
  #undef WDMA_V
}
struct VarCw {
  static constexpr int NT=3, OP=384;
  int rowb, dil, cls, u0, L; float* lse; int h;
  __device__ __forceinline__ long qrow(int r)const{ return (long)rowb+(long)(u0+r)*dil+cls; }
  __device__ __forceinline__ long krow(int t,int idx)const{ int u=u0-64+64*t+idx; u=u<0?0:(u>L-1?L-1:u); return (long)rowb+(long)u*dil+cls; }
  __device__ __forceinline__ void mask(f32x16&P0,f32x16&P1,int t,int r32,int hi)const{
    const int dbase=64*t-64+4*hi-r32, ubase=u0-64+64*t+4*hi;
    #pragma unroll
    for(int r=0;r<16;++r){ const int kk=(r&3)+8*(r>>2);
      const bool ok0=((unsigned)(dbase+kk+64)<=128u)&&((unsigned)(ubase+kk)<(unsigned)L);
      const bool ok1=((unsigned)(dbase+kk+32+64)<=128u)&&((unsigned)(ubase+kk+32)<(unsigned)L);
      P0[r]=ok0?P0[r]:-INFINITY; P1[r]=ok1?P1[r]:-INFINITY; }
  }
  __device__ __forceinline__ void store_lse(int r32,int hi,float mhat,float l)const{ if(hi==0) lse[qrow(r32)*6+h]=mhat+__builtin_amdgcn_logf(l); }
};
struct VarBw {
  static constexpr int NT=8, OP=1024;
  int rowb, r, c0, rs; const float* tab;
  __device__ __forceinline__ long qrow(int rr)const{ return (long)rowb+r*64+c0+rr; }
  __device__ __forceinline__ long krow(int t,int idx)const{ return (long)rowb+(rs+t)*64+idx; }
  __device__ __forceinline__ void mask(f32x16&P0,f32x16&P1,int t,int r32,int hi)const{
    const int c=c0+r32, kr=rs+t; int cs=c-8; cs=cs<0?0:(cs>48?48:cs);
    const int cb=4*hi-cs; const float*tb=tab+((kr-r+7)*31+4*hi-c+15);
    #pragma unroll
    for(int q=0;q<16;++q){ const int kk=(q&3)+8*(q>>2);
      const bool ok0=((unsigned)(cb+kk)<16u), ok1=((unsigned)(cb+kk+32)<16u);
      const float b0=tb[kk], b1=tb[kk+32];
      P0[q]=ok0?P0[q]+b0:-INFINITY; P1[q]=ok1?P1[q]+b1:-INFINITY;
      if((q&3)==3)asm volatile("":::"memory"); }
  }
  __device__ __forceinline__ void store_lse(int,int,float,float)const{}
};
constexpr int WV_WSF=132096, WV_TAB=134144;
__device__ __forceinline__ void attnB_wave_phase(char*lds,const bf16*qkv,int cq,int ck,int cv,const float*nab,bf16*ao,int G,int bid,int lane,int wid){
  float*tab=(float*)(lds+WV_TAB); float*wsf=(float*)(lds+WV_WSF)+wid*64; char*shm=lds+wid*16384;
  const int h=bid%6, j=bid/6, nbh=(G-h+5)/6;
  { const int i=wid*64+lane; if(i<15*31)tab[i]=nab[h*465+i]*1.4426950408889634f; }
  asm volatile("s_waitcnt lgkmcnt(0)\n\ts_barrier":::"memory");
  for(int it=j*8+wid;it<8*128;it+=nbh*8){ const int b=it>>7,r=(it>>1)&63,half=it&1;
    VarBw W; W.rowb=b*SEQ; W.r=r; W.c0=32*half; int rs=r-4; W.rs=rs<0?0:(rs>56?56:rs); W.tab=tab;
    attn_wave_item<VarBw>(W,qkv+cq+h*64,qkv+ck+h*64,qkv+cv+h*64,ao+256+h*64,shm,wsf,lane); }
}
__device__ __forceinline__ void attnC_wave_phase(char*lds,const bf16*qkv,int cq,int ck,int cv,bf16*part,float*lse,int G,int bid,int lane,int wid){
  float*wsf=(float*)(lds+WV_WSF)+wid*64; char*shm=lds+wid*16384;
  for(int it=bid*8+wid;it<8*6*3*128;it+=G*8){ const int k=it&127,rest=it>>7,br=rest%3,bh=rest/3,h=bh%6,b=bh/6;
    VarCw W; W.rowb=b*SEQ; W.dil=1<<(2*br); W.L=SEQ>>(2*br); W.h=h;
    if(br==0){W.cls=0;W.u0=32*k;} else if(br==1){W.cls=k&3;W.u0=32*(k>>2);} else {W.cls=k&15;W.u0=32*(k>>4);}
    W.lse=lse+(size_t)br*(8*SEQ*6);
    attn_wave_item<VarCw>(W,qkv+cq+h*64,qkv+ck+h*64,qkv+cv+h*64,part+(size_t)br*(8*SEQ*384)+h*64,shm,wsf,lane); }
}
#undef SBAR
#undef WAIT_BAR
}
#define GAS __attribute__((address_space(1)))
#define LAS __attribute__((address_space(3)))
typedef unsigned short bf16;
typedef unsigned v4u __attribute__((ext_vector_type(4)));
typedef float f32x4 __attribute__((ext_vector_type(4)));
typedef short bf16x8 __attribute__((ext_vector_type(8)));
typedef GAS unsigned gu32;
typedef GAS unsigned long long gu64;
#define RLX_AGENT __ATOMIC_RELAXED, __HIP_MEMORY_SCOPE_AGENT
#define LDS_WAIT() asm volatile("s_waitcnt lgkmcnt(0)" ::: "memory")
#define VM_WAIT() asm volatile("s_waitcnt vmcnt(0)" ::: "memory")
__device__ __forceinline__ unsigned long long rt() { return __builtin_amdgcn_s_memrealtime(); }
__device__ __forceinline__ unsigned f2bf(float f) { unsigned u = __builtin_bit_cast(unsigned, f); return (u + 0x7fffu + ((u >> 16) & 1u)) >> 16; }
typedef float pk_f32x2 __attribute__((ext_vector_type(2))); typedef __bf16 pk_bf16x2 __attribute__((ext_vector_type(2)));
__device__ __forceinline__ unsigned pk2(float lo, float hi) { pk_f32x2 v = {lo, hi}; pk_bf16x2 b = __builtin_convertvector(v, pk_bf16x2); return __builtin_bit_cast(unsigned, b); }

#define XB_TMO      128
#define XB_XCNT(j)  (256  + 64 * (j))
#define XB_XSUB(j)  (1280 + 64 * (j))
#define XB_XGEN(j)  (2304 + 64 * (j))
#define XB_TOP      3328
#define XB_TOPGEN   3392
#define XCD_BAR_WORDS 3456
#define XB_SPIN_CAP (1u << 18)

__device__ __forceinline__ unsigned xb_ld(unsigned* p)              { return __hip_atomic_load(p, __ATOMIC_RELAXED, __HIP_MEMORY_SCOPE_AGENT); }
__device__ __forceinline__ unsigned xb_add(unsigned* p, unsigned v) { return __hip_atomic_fetch_add(p, v, __ATOMIC_RELAXED, __HIP_MEMORY_SCOPE_AGENT); }
__device__ __forceinline__ unsigned xb_xcc_id() { return (unsigned)__builtin_amdgcn_s_getreg((3 << 11) | 20) & 0xFu; }
#define XB_SPIN(cond, bar) do { unsigned _sp = 0; while (cond) { __builtin_amdgcn_s_sleep(1); \
    if ((++_sp & 255u) == 0u) { if (xb_ld(&(bar)[XB_TMO])) break; if (_sp > XB_SPIN_CAP) { atomicAdd(&(bar)[XB_TMO], 1u); break; } } } } while (0)

struct XcdBarrier {
    unsigned* bar; unsigned x;
    volatile LAS unsigned* st;
};

__device__ __forceinline__ XcdBarrier xcd_barrier_post(unsigned* bar, volatile LAS unsigned* st) {
    XcdBarrier b; b.bar = bar; b.x = xb_xcc_id(); b.st = st;
    if (threadIdx.x == 0) (void)xb_add(&bar[XB_XCNT(b.x)], 1u);
    return b;
}
__device__ __forceinline__ void xcd_barrier_complete(unsigned* bar, unsigned x, unsigned& nloc, unsigned& nx) {
    const unsigned G = gridDim.x * gridDim.y * gridDim.z;
    unsigned sum, cnt, mine, sp = 0u;
    for (;;) {
        sum = 0u; cnt = 0u; mine = 0u;
#pragma unroll
        for (unsigned j = 0; j < 16; ++j) { const unsigned c = xb_ld(&bar[XB_XCNT(j)]); sum += c; cnt += (c > 0u) ? 1u : 0u; mine = (j == x) ? c : mine; }
        if (sum == G) break;
        __builtin_amdgcn_s_sleep(1);
        if ((++sp & 255u) == 0u) { if (xb_ld(&bar[XB_TMO])) break; if (sp > XB_SPIN_CAP) { atomicAdd(&bar[XB_TMO], 1u); break; } }
    }
    nloc = mine > 0u ? mine : 1u; nx = cnt > 0u ? cnt : 1u;
}

__device__ __forceinline__ void xcd_barrier(const XcdBarrier& b) {
    asm volatile("s_waitcnt vmcnt(0)" ::: "memory");
    __syncthreads();
    if (threadIdx.x == 0) {
        unsigned* bar = b.bar;
        __builtin_amdgcn_s_waitcnt(0);
        unsigned nloc = b.st[0], nx = b.st[1];
        if (nloc == 0u) { xcd_barrier_complete(bar, b.x, nloc, nx); b.st[0] = nloc; b.st[1] = nx; }
        const unsigned old = xb_add(&bar[XB_XSUB(b.x)], 1u);
        const unsigned gen = old / nloc;
        if (old + 1u == (gen + 1u) * nloc) {
            __builtin_amdgcn_fence(__ATOMIC_RELEASE, "agent");
            asm volatile("s_waitcnt vmcnt(0)" ::: "memory");
            const unsigned og = xb_add(&bar[XB_TOP], 1u);
            const unsigned tg = og / nx;
            if (og + 1u == (tg + 1u) * nx) xb_add(&bar[XB_TOPGEN], 1u);
            else XB_SPIN(xb_ld(&bar[XB_TOPGEN]) == tg, bar);
            __builtin_amdgcn_fence(__ATOMIC_ACQUIRE, "agent");
            xb_add(&bar[XB_XGEN(b.x)], 1u);
            asm volatile("s_waitcnt vmcnt(0)" ::: "memory");
        } else {
            XB_SPIN(xb_ld(&bar[XB_XGEN(b.x)]) == gen, bar);
            __builtin_amdgcn_fence(__ATOMIC_ACQUIRE, "agent");
            asm volatile("s_waitcnt vmcnt(0)" ::: "memory");
        }
    }
    __syncthreads();
}

constexpr int NB = 8, SEQ = 4096, DM = 1024, DEPTH = 4, MTOK = NB * SEQ;
constexpr int NQKV = 2816, NE = 16, CAP = 512, DFF = 1024, DPLE = 256, MR = NE * NB * CAP;
constexpr int NWAVES = 8, NTHR = NWAVES * 64;
constexpr float RMS_EPS = 1e-6f;
constexpr float LOG2E = 1.4426950408889634f, QSCALE = 0.125f * LOG2E;
constexpr int C_QA = 0, C_KA = 256, C_VA = 384, C_QB = 512, C_KB = 896, C_VB = 1280, C_QC = 1664, C_KC = 2048, C_VC = 2432;
constexpr int NPH_LAYER = 12, NPHASES = 1 + DEPTH * NPH_LAYER;

constexpr size_t MiB = 1u << 20;
constexpr size_t WS_CTL = 0, CTL_ZERO_BYTES = 128 * 1024;
constexpr size_t WS_TAB = 1 * MiB;
constexpr size_t WS_AFF = 2 * MiB;
constexpr size_t WS_IDX = 4 * MiB;
constexpr size_t WS_GATE = 5 * MiB;
constexpr size_t WS_SEL = 6 * MiB;
constexpr size_t WS_RSZ = 8 * MiB;
constexpr size_t WS_RSY = 8 * MiB + 256 * 1024;
constexpr size_t WS_RSA = 8 * MiB + 512 * 1024;
constexpr size_t WS_RSG = 9 * MiB;
constexpr size_t WS_SSQ = 10 * MiB;
constexpr size_t WS_WPG_ALT = 12 * MiB;
constexpr size_t WS_WOUT_ALT = 14 * MiB;
constexpr size_t WS_WIN = 16 * MiB;
constexpr size_t WS_WOUT = 22 * MiB;
constexpr size_t WS_WPG = 24 * MiB;
constexpr size_t WS_WPP = 26 * MiB;
constexpr size_t WS_WGU = 28 * MiB;
constexpr size_t WS_WD = 92 * MiB;
constexpr size_t WS_PBF = 124 * MiB;
constexpr size_t WS_AN = 140 * MiB;
constexpr size_t WS_QKV = 204 * MiB;
constexpr size_t WS_AO = 380 * MiB;
constexpr size_t WS_XG = 444 * MiB;
constexpr size_t WS_HID = 572 * MiB;
constexpr size_t WS_HY8 = WS_HID + 64 * MiB;
constexpr size_t WS_PP = 700 * MiB;
constexpr size_t WS_MIX = 764 * MiB;
constexpr size_t WS_Y = 828 * MiB;
constexpr size_t WS_END = 956 * MiB;
constexpr int CW_BAR = 4096;
constexpr int CW_XRANK = 8192;
constexpr int CW_GRP = 16384;

constexpr int RING_OFF = 0, RING_BYTES = 131072;
constexpr int LDSCTL_OFF = RING_BYTES, MISC_OFF = LDSCTL_OFF + 320;
constexpr int LDS_BYTES = 147456;
constexpr int GTOK_OFF = 136192, GTOK_UNITS = 8;

struct float2_t { float x, y; };
typedef unsigned u32x2 __attribute__((ext_vector_type(2)));

#ifndef ROUTER_MFMA
#define ROUTER_MFMA 1
#endif
#ifndef XCD_TRUE
#define XCD_TRUE 0
#endif
#ifndef FUSE_RT
#define FUSE_RT 1
#endif
#ifndef NT_STORES
#define NT_STORES 0
#endif
__device__ __forceinline__ void st16(void* p, v4u v) { if (NT_STORES) __builtin_nontemporal_store(v, (v4u*)p); else *(v4u*)p = v; }
#define PIN4V(a) asm volatile("" : "+v"((a)[0]), "+v"((a)[1]), "+v"((a)[2]), "+v"((a)[3]))

__device__ __forceinline__ int dpp_i(int v, const int ctrl_unused) { return v; }
#define DPP_ADD_I(v, ctrl) ((v) + __builtin_amdgcn_update_dpp(0, (v), (ctrl), 0xf, 0xf, true))
__device__ __forceinline__ int xor16_add_i(int v) { auto r = __builtin_amdgcn_permlane16_swap((unsigned)v, (unsigned)v, false, false); return (int)(r[0] + r[1]); }
__device__ __forceinline__ int xor32_add_i(int v) { auto r = __builtin_amdgcn_permlane32_swap((unsigned)v, (unsigned)v, false, false); return (int)(r[0] + r[1]); }
__device__ __forceinline__ float xor16_add(float v) { auto r = __builtin_amdgcn_permlane16_swap(__float_as_uint(v), __float_as_uint(v), false, false); return __uint_as_float(r[0]) + __uint_as_float(r[1]); }
__device__ __forceinline__ float xor32_add(float v) { auto r = __builtin_amdgcn_permlane32_swap(__float_as_uint(v), __float_as_uint(v), false, false); return __uint_as_float(r[0]) + __uint_as_float(r[1]); }
__device__ __forceinline__ float dpp_f(float v, int) { return v; }
#define DPP_ADD_F(v, ctrl) ((v) + __int_as_float(__builtin_amdgcn_update_dpp(0, __float_as_int(v), (ctrl), 0xf, 0xf, true)))
__device__ __forceinline__ float wave_sum(float v) {
    v = DPP_ADD_F(v, 0xB1); v = DPP_ADD_F(v, 0x4E); v = DPP_ADD_F(v, 0x141); v = DPP_ADD_F(v, 0x140);
    v = xor16_add(v); v = xor32_add(v);
    return v;
}
__device__ __forceinline__ int wave_sum_i(int v) {
    v = DPP_ADD_I(v, 0xB1); v = DPP_ADD_I(v, 0x4E); v = DPP_ADD_I(v, 0x141); v = DPP_ADD_I(v, 0x140);
    v = xor16_add_i(v); v = xor32_add_i(v);
    return v;
}
__device__ __forceinline__ int lane_id() { int l; asm volatile("v_mbcnt_lo_u32_b32 %0, -1, 0\n\tv_mbcnt_hi_u32_b32 %0, -1, %0" : "=v"(l)); return l; }
constexpr float F8_SC_W = 64.0f, F8_SC_WD = 16.0f, F8_SC_HID = 1.0f;
__device__ __forceinline__ unsigned pk4_f8(float a, float b, float c, float d) {
    int r = __builtin_amdgcn_cvt_pk_fp8_f32(a, b, 0, false); r = __builtin_amdgcn_cvt_pk_fp8_f32(c, d, r, true); return (unsigned)r; }
__device__ __forceinline__ float bflo(unsigned u) { return __uint_as_float(u << 16); }
__device__ __forceinline__ float bfhi(unsigned u) { return __uint_as_float(u & 0xffff0000u); }

__device__ __forceinline__ void sincos_acc(float ang, float& c, float& s) {
    const double a = (double)ang;
    const double q = __builtin_rint(a * 0.63661977236758134308);
    const double t = a - q * 1.57079632679489661923;
    const int qi = (int)q;
    const double t2 = t * t;
    const double sn = t * (1.0 + t2 * (-1.0 / 6.0 + t2 * (1.0 / 120.0 + t2 * (-1.0 / 5040.0 + t2 * (1.0 / 362880.0 + t2 * (-1.0 / 39916800.0))))));
    const double cs = 1.0 + t2 * (-0.5 + t2 * (1.0 / 24.0 + t2 * (-1.0 / 720.0 + t2 * (1.0 / 40320.0 + t2 * (-1.0 / 3628800.0 + t2 * (1.0 / 479001600.0))))));
    const int k = qi & 3;
    const double cc = (k == 0) ? cs : (k == 1) ? -sn : (k == 2) ? -cs : sn;
    const double ss = (k == 0) ? sn : (k == 1) ? cs : (k == 2) ? -sn : -cs;
    c = (float)cc; s = (float)ss;
}

__device__ __forceinline__ void norm_row2_bf16(const float* x0, const float* x1, const float* gain, bf16* o0, bf16* o1, int lane) {
    const f32x4* xr0 = (const f32x4*)x0 + lane; const f32x4* xr1 = (const f32x4*)x1 + lane;
    const f32x4* gr = (const f32x4*)gain + lane;
    f32x4 v[4], w[4], g[4]; float s = 0.f, q = 0.f;
#pragma unroll
    for (int j = 0; j < 4; ++j) { v[j] = xr0[64 * j]; w[j] = xr1[64 * j]; g[j] = gr[64 * j]; }
    PIN4V(v); PIN4V(w);
#pragma unroll
    for (int j = 0; j < 4; ++j) { s += (v[j].x * v[j].x + v[j].y * v[j].y) + (v[j].z * v[j].z + v[j].w * v[j].w); q += (w[j].x * w[j].x + w[j].y * w[j].y) + (w[j].z * w[j].z + w[j].w * w[j].w); }
    const float rs = 1.0f / sqrtf(wave_sum(s) * (1.0f / DM) + RMS_EPS), rq = 1.0f / sqrtf(wave_sum(q) * (1.0f / DM) + RMS_EPS);
    unsigned long long* a8 = (unsigned long long*)o0 + lane; unsigned long long* b8 = (unsigned long long*)o1 + lane;
#pragma unroll
    for (int j = 0; j < 4; ++j) {
        a8[64 * j] = (unsigned long long)pk2(v[j].x * rs * g[j].x, v[j].y * rs * g[j].y) | ((unsigned long long)pk2(v[j].z * rs * g[j].z, v[j].w * rs * g[j].w) << 32);
        b8[64 * j] = (unsigned long long)pk2(w[j].x * rq * g[j].x, w[j].y * rq * g[j].y) | ((unsigned long long)pk2(w[j].z * rq * g[j].z, w[j].w * rq * g[j].w) << 32); }
}

__device__ __forceinline__ void cast_row2(const float* x0, const float* x1, bf16* o0, bf16* o1, float* rs0, float* rs1, int lane) {
    const f32x4* xr0 = (const f32x4*)x0 + lane; const f32x4* xr1 = (const f32x4*)x1 + lane;
    f32x4 v[4], w[4]; float s = 0.f, q = 0.f;
#pragma unroll
    for (int j = 0; j < 4; ++j) { v[j] = xr0[64 * j]; w[j] = xr1[64 * j]; }
    PIN4V(v); PIN4V(w);
    unsigned long long* a8 = (unsigned long long*)o0 + lane; unsigned long long* b8 = (unsigned long long*)o1 + lane;
#pragma unroll
    for (int j = 0; j < 4; ++j) { s += (v[j].x * v[j].x + v[j].y * v[j].y) + (v[j].z * v[j].z + v[j].w * v[j].w); q += (w[j].x * w[j].x + w[j].y * w[j].y) + (w[j].z * w[j].z + w[j].w * w[j].w);
        a8[64 * j] = (unsigned long long)pk2(v[j].x, v[j].y) | ((unsigned long long)pk2(v[j].z, v[j].w) << 32);
        b8[64 * j] = (unsigned long long)pk2(w[j].x, w[j].y) | ((unsigned long long)pk2(w[j].z, w[j].w) << 32); }
    const float rs = 1.0f / sqrtf(wave_sum(s) * (1.0f / DM) + RMS_EPS), rq = 1.0f / sqrtf(wave_sum(q) * (1.0f / DM) + RMS_EPS);
    if (lane == 0) { *rs0 = rs; *rs1 = rq; }
}
__device__ __forceinline__ void norm_row2_h16(const bf16* x0, const bf16* x1, const float* gain, bf16* o0, bf16* o1, int lane) {
    const unsigned long long* xr0 = (const unsigned long long*)x0 + lane; const unsigned long long* xr1 = (const unsigned long long*)x1 + lane;
    const f32x4* gr = (const f32x4*)gain + lane;
    unsigned long long a[4], b[4]; f32x4 v[4], w[4], g[4]; float s = 0.f, q = 0.f;
#pragma unroll
    for (int j = 0; j < 4; ++j) { a[j] = xr0[64 * j]; b[j] = xr1[64 * j]; g[j] = gr[64 * j]; }
    PIN4V(a); PIN4V(b);
#pragma unroll
    for (int j = 0; j < 4; ++j) { const unsigned a0 = (unsigned)a[j], a1 = (unsigned)(a[j] >> 32), b0 = (unsigned)b[j], b1 = (unsigned)(b[j] >> 32);
        v[j] = (f32x4){bflo(a0), bfhi(a0), bflo(a1), bfhi(a1)}; w[j] = (f32x4){bflo(b0), bfhi(b0), bflo(b1), bfhi(b1)};
        s += (v[j].x * v[j].x + v[j].y * v[j].y) + (v[j].z * v[j].z + v[j].w * v[j].w); q += (w[j].x * w[j].x + w[j].y * w[j].y) + (w[j].z * w[j].z + w[j].w * w[j].w); }
    const float rs = 1.0f / sqrtf(wave_sum(s) * (1.0f / DM) + RMS_EPS), rq = 1.0f / sqrtf(wave_sum(q) * (1.0f / DM) + RMS_EPS);
    unsigned long long* a8 = (unsigned long long*)o0 + lane; unsigned long long* b8 = (unsigned long long*)o1 + lane;
#pragma unroll
    for (int j = 0; j < 4; ++j) {
        a8[64 * j] = (unsigned long long)pk2(v[j].x * rs * g[j].x, v[j].y * rs * g[j].y) | ((unsigned long long)pk2(v[j].z * rs * g[j].z, v[j].w * rs * g[j].w) << 32);
        b8[64 * j] = (unsigned long long)pk2(w[j].x * rq * g[j].x, w[j].y * rq * g[j].y) | ((unsigned long long)pk2(w[j].z * rq * g[j].z, w[j].w * rq * g[j].w) << 32); }
}

struct TrJob { const float* src; bf16* dst; const float* gain; int ldw, ldt; float sc; };
struct Args { const float* in[16]; float* out; unsigned char* ws; float inv_ax[16]; float inv_1d[8]; int ph_lo, ph_hi; };
constexpr int TR_I_IN = 16 * 88, TR_I_SQ = 16 * 32, TR_I_PP = 4 * 32, TR_I_EXP = 16 * 512, TR_NITEMS = TR_I_IN + 2 * TR_I_SQ + TR_I_PP + 3 * TR_I_EXP;
__device__ __forceinline__ TrJob tr_decode(const __attribute__((address_space(4))) Args* ka, int l, int it) {
    TrJob J; J.gain = nullptr; J.sc = 1.0f; int r = it; unsigned char* ws = ka->ws;
    if (r < TR_I_IN) { const int kb = r / 88, nb = r % 88, n0 = 32 * nb, tile = n0 >> 8, lw = n0 & 255, wc = lw >> 6, bj = (lw >> 5) & 1;
        J.ldw = NQKV; J.ldt = DM; J.src = ka->in[3] + (size_t)l * DM * NQKV + (size_t)(64 * kb) * NQKV + n0; J.dst = (bf16*)(ws + WS_WIN) + (size_t)(tile * 256 + 128 * bj + 32 * wc) * DM + 64 * kb; J.gain = ka->in[2] + (size_t)l * DM + 64 * kb; return J; } r -= TR_I_IN;
    if (r < TR_I_SQ) { const int kb = r >> 5, nb = r & 31; J.ldw = DM; J.ldt = DM; J.src = ka->in[7] + (size_t)l * DM * DM + (size_t)(64 * kb) * DM + 32 * nb; J.dst = (bf16*)(ws + ((l & 1) ? WS_WOUT_ALT : WS_WOUT)) + (size_t)(32 * nb) * DM + 64 * kb; return J; } r -= TR_I_SQ;
    if (r < TR_I_SQ) { const int kb = r >> 5, nb = r & 31; J.ldw = DM; J.ldt = DM; J.src = ka->in[14] + (size_t)l * DM * DM + (size_t)(64 * kb) * DM + 32 * nb; J.dst = (bf16*)(ws + ((l & 1) ? WS_WPG_ALT : WS_WPG) + (size_t)(32 * nb) * DM + 64 * kb); J.gain = ka->in[13] + (size_t)l * DM + 64 * kb; J.sc = F8_SC_W; return J; } r -= TR_I_SQ;
    if (r < TR_I_PP) { const int kb = r >> 5, nb = r & 31; J.ldw = DM; J.ldt = DPLE; J.src = ka->in[15] + (size_t)l * DPLE * DM + (size_t)(64 * kb) * DM + 32 * nb; J.dst = (bf16*)(ws + WS_WPP) + (size_t)(32 * nb) * DPLE + 64 * kb; return J; } r -= TR_I_PP;
    const int which = r / TR_I_EXP; r -= which * TR_I_EXP;
    const int e = r >> 9, rr = r & 511, kb = rr >> 5, nb = rr & 31, n0 = 32 * nb;
    J.ldw = DM; J.ldt = DM; J.sc = F8_SC_W;
    if (which < 2) J.gain = ka->in[8] + (size_t)l * DM + 64 * kb;
    if (which == 0) { J.src = ka->in[10] + (size_t)(l * NE + e) * DM * DFF + (size_t)(64 * kb) * DFF + n0; J.dst = (bf16*)(ws + WS_WGU + (size_t)(l & 1) * (32 * MiB) + (size_t)(e * 2048 + (n0 >> 7) * 256 + (n0 & 127)) * DM + 64 * kb); }
    else if (which == 1) { J.src = ka->in[11] + (size_t)(l * NE + e) * DM * DFF + (size_t)(64 * kb) * DFF + n0; J.dst = (bf16*)(ws + WS_WGU + (size_t)(l & 1) * (32 * MiB) + (size_t)(e * 2048 + (n0 >> 7) * 256 + 128 + (n0 & 127)) * DM + 64 * kb); }
    else { J.src = ka->in[12] + (size_t)(l * NE + e) * DFF * DM + (size_t)(64 * kb) * DM + n0; J.dst = (bf16*)(ws + WS_WD + (size_t)(l & 1) * (16 * MiB) + (size_t)(e * 1024 + n0) * DFF + 64 * kb); J.sc = F8_SC_WD; }
    return J;
}
__device__ __forceinline__ void tr_load(const TrJob& J, f32x4 (&v)[8], float (&gk)[8], int lane) {
    const int kq = lane >> 3, nq = (lane & 7) * 4;
#pragma unroll
    for (int i = 0; i < 8; ++i) v[i] = __builtin_nontemporal_load((const f32x4*)(J.src + (size_t)(8 * i + kq) * J.ldw + nq));
    if (J.gain) {
#pragma unroll
        for (int i = 0; i < 8; ++i) gk[i] = J.gain[8 * i + kq] * J.sc;
    } else {
#pragma unroll
        for (int i = 0; i < 8; ++i) gk[i] = J.sc;
    }
}
__device__ __forceinline__ void tr_store(const TrJob& J, const f32x4 (&v)[8], const float (&gk)[8], LAS float* scr, int lane) {
    const int kq = lane >> 3, nq = (lane & 7) * 4;
#pragma unroll
    for (int i = 0; i < 8; ++i) { LAS float* d = scr + (8 * i + kq) * 33 + nq; d[0] = v[i].x * gk[i]; d[1] = v[i].y * gk[i]; d[2] = v[i].z * gk[i]; d[3] = v[i].w * gk[i]; }
    LDS_WAIT(); asm volatile("" ::: "memory");
    const int c = lane & 7;
    if (J.sc != 1.0f) {
#pragma unroll
        for (int j = 0; j < 4; ++j) { const int n = (lane >> 3) + 8 * j; const LAS float* s = scr + (8 * c) * 33 + n;
            u32x2 o; o.x = pk4_f8(s[0 * 33], s[1 * 33], s[2 * 33], s[3 * 33]); o.y = pk4_f8(s[4 * 33], s[5 * 33], s[6 * 33], s[7 * 33]);
            *(u32x2*)((unsigned char*)J.dst + (size_t)n * J.ldt + 8 * c) = o; }
    } else {
#pragma unroll
    for (int j = 0; j < 4; ++j) { const int n = (lane >> 3) + 8 * j; const LAS float* s = scr + (8 * c) * 33 + n;
        v4u o; o.x = pk2(s[0 * 33], s[1 * 33]); o.y = pk2(s[2 * 33], s[3 * 33]); o.z = pk2(s[4 * 33], s[5 * 33]); o.w = pk2(s[6 * 33], s[7 * 33]);
        *(v4u*)(J.dst + (size_t)n * J.ldt + 8 * c) = o; }
    }
    LDS_WAIT(); asm volatile("" ::: "memory");
}
constexpr int TR_N_LATE = 2 * TR_I_SQ + 3 * TR_I_EXP, TR_N_EARLY = TR_I_IN + TR_I_PP;
__device__ __forceinline__ TrJob tr_decode_m(const __attribute__((address_space(4))) Args* ka, int mode, int l, int it) {
    if (mode == 1) {
        if (it < 2 * TR_I_SQ) return tr_decode(ka, l, TR_I_IN + it);
        it -= 2 * TR_I_SQ; if (it < 3 * TR_I_EXP) return tr_decode(ka, l, TR_I_IN + 2 * TR_I_SQ + TR_I_PP + it);
        it -= 3 * TR_I_EXP; ++l;
    }
    return tr_decode(ka, l, it < TR_I_IN ? it : 2 * TR_I_SQ + it);
}
__device__ __forceinline__ void convert_layer(const __attribute__((address_space(4))) Args* ka, int mode, int l, LAS unsigned char* lds, int gw, int NGW, int wave, int lane, int gtid, int NGT) {
    LAS float* scr = (LAS float*)(lds + RING_OFF + wave * 16384);
    const bool early = (mode == 0) || (l + 1 < DEPTH);
    const int NIT = (mode == 0) ? TR_N_EARLY : TR_N_LATE + (early ? TR_N_EARLY : 0);
    f32x4 va[8], vb[8]; float ga[8], gb[8]; TrJob Ja, Jb;
    int it = gw;
    if (it < NIT) { Ja = tr_decode_m(ka, mode, l, it); tr_load(Ja, va, ga, lane); }
    while (it < NIT) {
        const int it1 = it + NGW; if (it1 < NIT) { Jb = tr_decode_m(ka, mode, l, it1); tr_load(Jb, vb, gb, lane); }
        tr_store(Ja, va, ga, scr, lane);
        const int it2 = it1 + NGW; if (it2 < NIT) { Ja = tr_decode_m(ka, mode, l, it2); tr_load(Ja, va, ga, lane); }
        if (it1 < NIT) tr_store(Jb, vb, gb, scr, lane);
        it = it2;
    }
    if (!early) return;
    const int le = (mode == 0) ? 0 : l + 1;
    const f32x4* ps = (const f32x4*)(ka->in[1] + (size_t)le * MTOK * DPLE);
    v4u* pd = (v4u*)(ka->ws + WS_PBF);
    constexpr int NP = MTOK * DPLE / 8;
    for (int i = gtid; i < NP / 2; i += NGT) { const f32x4 a = __builtin_nontemporal_load(ps + 2 * i), b = __builtin_nontemporal_load(ps + 2 * i + 1), c = __builtin_nontemporal_load(ps + 2 * (i + NP / 2)), d = __builtin_nontemporal_load(ps + 2 * (i + NP / 2) + 1);
        v4u o; o.x = pk2(a.x, a.y); o.y = pk2(a.z, a.w); o.z = pk2(b.x, b.y); o.w = pk2(b.z, b.w); pd[i] = o;
        v4u q; q.x = pk2(c.x, c.y); q.y = pk2(c.z, c.w); q.z = pk2(d.x, d.y); q.w = pk2(d.z, d.w); pd[i + NP / 2] = q; }
}

struct GroupedOrder {
    pg8::StaticOrder so; int nN;
    __device__ __forceinline__ void init(int N, int G, int c) { so.init(MR, N, G, c); nN = N / 256; }
    __device__ __forceinline__ bool next(int i, pg8::Unit& u) const { if (!so.next(i, u)) return false; u.pn = (u.pm >> 4) * nN + u.pn; return true; }
    __device__ __forceinline__ void a_ready(const pg8::Unit&) const {}
    __device__ __forceinline__ void done(const pg8::Unit&) const {}
};

#ifndef ALIGN_RMW
#define ALIGN_RMW false
#endif
#ifndef PROBE_GDUP
#define PROBE_GDUP 0
#endif
template <int BIT> struct DupStatic {
    pg8::StaticOrder so;
    __device__ __forceinline__ void init(int M, int N, int G, int c) { so.init(M, N, G, c); }
    __device__ __forceinline__ bool next(int i, pg8::Unit& u) const { return so.next(((PROBE_GDUP >> BIT) & 1) ? (i >> 1) : i, u); }
    __device__ __forceinline__ void a_ready(const pg8::Unit&) const {}
    __device__ __forceinline__ void done(const pg8::Unit&) const {}
};
struct EpiQKV {
    static constexpr bool PERM = true, AFTER_DRAIN = false;
    bf16* qkv; const float* qg; const float2_t* cs_ax; const float2_t* cs_1d; const float* rs;
    __device__ __forceinline__ void operator()(const f32x4 (&acc)[2][2][4][2], const pg8::Unit& u, int wr, int wc, int fr, int fq) const {
        { const int l_ = lane_id(); fr = l_ & 15; fq = l_ >> 4; } asm volatile("" : "+s"(wr), "+s"(wc));
        const int hs = u.pn * 4 + wc;
        int kind, gi;
        if (hs < 4) { kind = 2; gi = 0; } else if (hs < 6) { kind = 2; gi = 1; } else if (hs < 8) { kind = 0; gi = 0; }
        else if (hs < 14) { kind = 1; gi = 2; } else if (hs < 20) { kind = 1; gi = 3; } else if (hs < 26) { kind = 0; gi = 0; }
        else if (hs < 32) { kind = 3; gi = 4; } else if (hs < 38) { kind = 3; gi = 5; } else { kind = 0; gi = 0; }
        const bool isq = (hs < 4) || (hs >= 8 && hs < 14) || (hs >= 26 && hs < 32);
        f32x4 gv[2][2];
#pragma unroll
        for (int bj = 0; bj < 2; ++bj)
#pragma unroll
            for (int n = 0; n < 2; ++n) gv[bj][n] = *(const f32x4*)(qg + gi * 64 + 32 * bj + 8 * fq + 4 * n);
        const int colbase = u.pn * 256 + wc * 64 + 8 * fq;
#pragma unroll
        for (int ai = 0; ai < 2; ++ai) {
            f32x4 rowcs[4]; float rsr[4];
#pragma unroll
            for (int m = 0; m < 4; ++m) rsr[m] = __hip_atomic_load(rs + (u.pm * 256 + ai * 128 + wr * 64 + m * 16 + fr), __ATOMIC_RELAXED, __HIP_MEMORY_SCOPE_AGENT);
            if (kind == 2) { const f32x4* p = (const f32x4*)(cs_ax + ((4 * u.pm + 2 * ai + wr) & 63) * 16 + 8 * (fq & 1));
#pragma unroll
                for (int k = 0; k < 4; ++k) rowcs[k] = p[k]; }
#pragma unroll
            for (int mp = 0; mp < 2; ++mp) {
                f32x4 tab[2][4];
                if (kind == 2) {
#pragma unroll
                    for (int mm = 0; mm < 2; ++mm) { const f32x4* p = (const f32x4*)(cs_ax + (16 * (2 * mp + mm) + fr) * 16 + 8 * (fq & 1));
#pragma unroll
                        for (int k = 0; k < 4; ++k) tab[mm][k] = p[k]; }
                }
                if (kind == 3) {
#pragma unroll
                    for (int mm = 0; mm < 2; ++mm) { const int s = (u.pm * 256 + ai * 128 + wr * 64 + (2 * mp + mm) * 16 + fr) & (SEQ - 1); const f32x4* p = (const f32x4*)(cs_1d + s * 8);
#pragma unroll
                        for (int k = 0; k < 4; ++k) tab[mm][k] = p[k]; }
                }
#pragma unroll
                for (int mm = 0; mm < 2; ++mm) { const int m = 2 * mp + mm;
                    const int row = u.pm * 256 + ai * 128 + wr * 64 + m * 16 + fr;
                    f32x4 v[2][2];
#pragma unroll
                    for (int bj = 0; bj < 2; ++bj)
#pragma unroll
                        for (int n = 0; n < 2; ++n) v[bj][n] = acc[ai][bj][m][n] * rsr[m];
                    if (kind != 0) {
                        float ss = 0.f;
#pragma unroll
                        for (int bj = 0; bj < 2; ++bj)
#pragma unroll
                            for (int n = 0; n < 2; ++n) ss += (v[bj][n].x * v[bj][n].x + v[bj][n].y * v[bj][n].y) + (v[bj][n].z * v[bj][n].z + v[bj][n].w * v[bj][n].w);
                        ss = xor16_add(ss); ss = xor32_add(ss);
                        const float rstd = __builtin_amdgcn_rsqf(ss * (1.0f / 64.0f) + RMS_EPS);
#pragma unroll
                        for (int bj = 0; bj < 2; ++bj)
#pragma unroll
                            for (int n = 0; n < 2; ++n) v[bj][n] = v[bj][n] * rstd * gv[bj][n];
                        if (kind == 2) {
#pragma unroll
                            for (int bj = 0; bj < 2; ++bj)
#pragma unroll
                                for (int n = 0; n < 2; ++n)
#pragma unroll
                                    for (int e = 0; e < 4; ++e) { const int k = 4 * n + e; const f32x4 cs4 = bj ? tab[mm][k >> 1] : rowcs[k >> 1]; const float c = cs4[2 * (k & 1)], sn = cs4[2 * (k & 1) + 1];
                                        const float own = v[bj][n][e]; auto sw = __builtin_amdgcn_permlane32_swap(__float_as_uint(own), __float_as_uint(own), false, false); const float oth = __uint_as_float(fq < 2 ? sw[1] : sw[0]);
                                        v[bj][n][e] = (fq < 2) ? (own * c - oth * sn) : (oth * sn + own * c); }
                        } else if (kind == 3) {
#pragma unroll
                            for (int n = 0; n < 2; ++n)
#pragma unroll
                                for (int e = 0; e < 4; ++e) { const int k = 4 * n + e; const f32x4 cs4 = tab[mm][k >> 1]; const float c = cs4[2 * (k & 1)], sn = cs4[2 * (k & 1) + 1];
                                    const float own = v[0][n][e]; auto sw = __builtin_amdgcn_permlane16_swap(__float_as_uint(own), __float_as_uint(own), false, false); const float oth = __uint_as_float((fq & 1) ? sw[0] : sw[1]);
                                    const float rot = (fq == 0) ? (own * c - oth * sn) : (oth * sn + own * c);
                                    v[0][n][e] = (fq < 2) ? rot : own; }
                        }
                    }
                    if (isq) {
#pragma unroll
                        for (int bj = 0; bj < 2; ++bj)
#pragma unroll
                            for (int n = 0; n < 2; ++n) v[bj][n] = v[bj][n] * QSCALE;
                    }
                    bf16* rp = qkv + (size_t)row * NQKV + colbase;
#pragma unroll
                    for (int bj = 0; bj < 2; ++bj) { v4u w; w.x = pk2(v[bj][0].x, v[bj][0].y); w.y = pk2(v[bj][0].z, v[bj][0].w); w.z = pk2(v[bj][1].x, v[bj][1].y); w.w = pk2(v[bj][1].z, v[bj][1].w); st16(rp + 32 * bj, w); }
                }
                asm volatile("" ::: "memory");
            }
        }
    }
};

struct EpiResid {
    static constexpr bool PERM = true, AFTER_DRAIN = false;
    const bf16* baseh; bf16* out; unsigned char* out8;
    __device__ __forceinline__ void operator()(const f32x4 (&acc)[2][2][4][2], const pg8::Unit& u, int wr, int wc, int fr, int fq) const {
        { const int l_ = lane_id(); fr = l_ & 15; fq = l_ >> 4; } asm volatile("" : "+s"(wr), "+s"(wc));
        const int col0 = u.pn * 256 + wc * 32 + 8 * fq;
#pragma unroll
        for (int ai = 0; ai < 2; ++ai) {
            {
                v4u b[4][2];
#pragma unroll
                for (int m = 0; m < 4; ++m) { const size_t off = (size_t)(u.pm * 256 + ai * 128 + wr * 64 + m * 16 + fr) * DM + col0;
#pragma unroll
                    for (int bj = 0; bj < 2; ++bj) b[m][bj] = *(const v4u*)(baseh + off + bj * 128); }
#pragma unroll
                for (int m = 0; m < 4; ++m) { const size_t off = (size_t)(u.pm * 256 + ai * 128 + wr * 64 + m * 16 + fr) * DM + col0;
#pragma unroll
                    for (int bj = 0; bj < 2; ++bj) { const f32x4 a0 = acc[ai][bj][m][0], a1 = acc[ai][bj][m][1]; const v4u p = b[m][bj];
                        const f32x4 o0 = (f32x4){bflo(p.x) + a0.x, bfhi(p.x) + a0.y, bflo(p.y) + a0.z, bfhi(p.y) + a0.w}, o1 = (f32x4){bflo(p.z) + a1.x, bfhi(p.z) + a1.y, bflo(p.w) + a1.z, bfhi(p.w) + a1.w};
                        v4u w; w.x = pk2(o0.x, o0.y); w.y = pk2(o0.z, o0.w); w.z = pk2(o1.x, o1.y); w.w = pk2(o1.z, o1.w);
                        st16(out + off + bj * 128, w);
                        u32x2 w8; w8.x = pk4_f8(o0.x, o0.y, o0.z, o0.w); w8.y = pk4_f8(o1.x, o1.y, o1.z, o1.w); *(u32x2*)(out8 + off + bj * 128) = w8; } }
            }
            asm volatile("" ::: "memory");
        }
    }
};

struct EpiStoreBf16NP {
    static constexpr bool PERM = false, AFTER_DRAIN = false;
    bf16* O;
    __device__ __forceinline__ void operator()(const f32x4 (&acc)[2][2][4][2], const pg8::Unit& u, int wr, int wc, int fr, int fq) const {
        { const int l_ = lane_id(); fr = l_ & 15; fq = l_ >> 4; } asm volatile("" : "+s"(wr), "+s"(wc));
        const int col0 = (u.pn & 3) * 256 + wc * 32 + 4 * fq;
#pragma unroll
        for (int ai = 0; ai < 2; ++ai)
#pragma unroll
            for (int m = 0; m < 4; ++m) { bf16* rp = O + (size_t)(u.pm * 256 + ai * 128 + wr * 64 + m * 16 + fr) * DM + col0;
#pragma unroll
                for (int bj = 0; bj < 2; ++bj)
#pragma unroll
                    for (int n = 0; n < 2; ++n) { const f32x4 a = acc[ai][bj][m][n]; u32x2 w; w.x = pk2(a.x, a.y); w.y = pk2(a.z, a.w); *(u32x2*)(rp + bj * 128 + n * 16) = w; } }
    }
};
struct EpiStoreBf16 {
    static constexpr bool PERM = true, AFTER_DRAIN = false;
    bf16* O;
    __device__ __forceinline__ void operator()(const f32x4 (&acc)[2][2][4][2], const pg8::Unit& u, int wr, int wc, int fr, int fq) const {
        { const int l_ = lane_id(); fr = l_ & 15; fq = l_ >> 4; } asm volatile("" : "+s"(wr), "+s"(wc));
        const int col0 = (u.pn & 3) * 256 + wc * 32 + 8 * fq;
#pragma unroll
        for (int ai = 0; ai < 2; ++ai)
#pragma unroll
            for (int m = 0; m < 4; ++m) { bf16* rp = O + (size_t)(u.pm * 256 + ai * 128 + wr * 64 + m * 16 + fr) * DM + col0;
#pragma unroll
                for (int bj = 0; bj < 2; ++bj) { const f32x4 a = acc[ai][bj][m][0], b = acc[ai][bj][m][1]; v4u w; w.x = pk2(a.x, a.y); w.y = pk2(a.z, a.w); w.z = pk2(b.x, b.y); w.w = pk2(b.z, b.w); st16(rp + bj * 128, w); } }
    }
};

struct EpiStoreF8 {
    static constexpr bool PERM = true, AFTER_DRAIN = false;
    unsigned char* O;
    __device__ __forceinline__ void operator()(const f32x4 (&acc)[2][2][4][2], const pg8::Unit& u, int wr, int wc, int fr, int fq) const {
        { const int l_ = lane_id(); fr = l_ & 15; fq = l_ >> 4; } asm volatile("" : "+s"(wr), "+s"(wc));
        const int col0 = (u.pn & 3) * 256 + wc * 32 + 8 * fq;
#pragma unroll
        for (int ai = 0; ai < 2; ++ai)
#pragma unroll
            for (int m = 0; m < 4; ++m) { unsigned char* rp = O + (size_t)(u.pm * 256 + ai * 128 + wr * 64 + m * 16 + fr) * DM + col0;
#pragma unroll
                for (int bj = 0; bj < 2; ++bj) { const f32x4 a = acc[ai][bj][m][0], b = acc[ai][bj][m][1]; u32x2 w; w.x = pk4_f8(a.x, a.y, a.z, a.w); w.y = pk4_f8(b.x, b.y, b.z, b.w); *(u32x2*)(rp + bj * 128) = w; } }
    }
};
struct EpiSwiGLU {
    static constexpr bool PERM = true, AFTER_DRAIN = false;
    unsigned char* H; const float* rs;
    __device__ __forceinline__ void operator()(const f32x4 (&acc)[2][2][4][2], const pg8::Unit& u, int wr, int wc, int fr, int fq) const {
        { const int l_ = lane_id(); fr = l_ & 15; fq = l_ >> 4; } asm volatile("" : "+s"(wr), "+s"(wc));
        const int col0 = (u.pn & 7) * 128 + wc * 32 + 8 * fq;
        float rsr[2][4];
#pragma unroll
        for (int ai = 0; ai < 2; ++ai)
#pragma unroll
            for (int m = 0; m < 4; ++m) rsr[ai][m] = rs[u.pm * 256 + ai * 128 + wr * 64 + m * 16 + fr] * (1.0f / F8_SC_W);
#pragma unroll
        for (int ai = 0; ai < 2; ++ai)
#pragma unroll
            for (int m = 0; m < 4; ++m) { unsigned char* rp = H + (size_t)(u.pm * 256 + ai * 128 + wr * 64 + m * 16 + fr) * DFF + col0; const float r1 = rsr[ai][m], r1u = r1 * F8_SC_HID;
                f32x4 h[2];
#pragma unroll
                for (int n = 0; n < 2; ++n) { const f32x4 g = acc[ai][0][m][n] * r1, up = acc[ai][1][m][n] * r1u;
#pragma unroll
                    for (int e = 0; e < 4; ++e) h[n][e] = g[e] * __builtin_amdgcn_rcpf(1.0f + __builtin_amdgcn_exp2f(-LOG2E * g[e])) * up[e]; }
                u32x2 w; w.x = pk4_f8(h[0].x, h[0].y, h[0].z, h[0].w); w.y = pk4_f8(h[1].x, h[1].y, h[1].z, h[1].w); *(u32x2*)rp = w; }
    }
};

struct EpiPLE {
    static constexpr bool PERM = true, AFTER_DRAIN = false;
    const bf16* hz; float* outf; bf16* outh; const bf16* pp; const float* rs; float* ssq;
    __device__ __forceinline__ void operator()(const f32x4 (&acc)[2][2][4][2], const pg8::Unit& u, int wr, int wc, int fr, int fq) const {
        { const int l_ = lane_id(); fr = l_ & 15; fq = l_ >> 4; } asm volatile("" : "+s"(wr), "+s"(wc));
        const int col0 = u.pn * 256 + wc * 32 + 8 * fq;
#pragma unroll
        for (int ai = 0; ai < 2; ++ai) {
            v4u hv[4][2], pw[4][2]; float rsr[4];
#pragma unroll
            for (int m = 0; m < 4; ++m) { const size_t off = (size_t)(u.pm * 256 + ai * 128 + wr * 64 + m * 16 + fr) * DM + col0; rsr[m] = rs[u.pm * 256 + ai * 128 + wr * 64 + m * 16 + fr];
#pragma unroll
                for (int bj = 0; bj < 2; ++bj) { hv[m][bj] = *(const v4u*)(hz + off + bj * 128); pw[m][bj] = *(const v4u*)(pp + off + bj * 128); } }
#pragma unroll
            for (int m = 0; m < 4; ++m) { const size_t off = (size_t)(u.pm * 256 + ai * 128 + wr * 64 + m * 16 + fr) * DM + col0; float sq = 0.f;
#pragma unroll
                for (int bj = 0; bj < 2; ++bj) { const v4u p4 = pw[m][bj], h4 = hv[m][bj]; f32x4 o[2];
#pragma unroll
                    for (int n = 0; n < 2; ++n) { const f32x4 a = acc[ai][bj][m][n] * (-LOG2E * rsr[m]); const unsigned p0 = n ? p4.z : p4.x, p1 = n ? p4.w : p4.y, h0 = n ? h4.z : h4.x, h1 = n ? h4.w : h4.y;
                        o[n].x = bflo(h0) + bflo(p0) * __builtin_amdgcn_rcpf(1.0f + __builtin_amdgcn_exp2f(a.x)); o[n].y = bfhi(h0) + bfhi(p0) * __builtin_amdgcn_rcpf(1.0f + __builtin_amdgcn_exp2f(a.y));
                        o[n].z = bflo(h1) + bflo(p1) * __builtin_amdgcn_rcpf(1.0f + __builtin_amdgcn_exp2f(a.z)); o[n].w = bfhi(h1) + bfhi(p1) * __builtin_amdgcn_rcpf(1.0f + __builtin_amdgcn_exp2f(a.w));
                        sq += (o[n].x * o[n].x + o[n].y * o[n].y) + (o[n].z * o[n].z + o[n].w * o[n].w); }
                    if (outf) { *(f32x4*)(outf + off + bj * 128) = o[0]; *(f32x4*)(outf + off + bj * 128 + 4) = o[1]; }
                    else { v4u w; w.x = pk2(o[0].x, o[0].y); w.y = pk2(o[0].z, o[0].w); w.z = pk2(o[1].x, o[1].y); w.w = pk2(o[1].z, o[1].w); st16(outh + off + bj * 128, w); } }
                if (!outf) { sq = xor16_add(sq); sq = xor32_add(sq); if (fq == 0) ssq[(size_t)(u.pm * 256 + ai * 128 + wr * 64 + m * 16 + fr) * 16 + u.pn * 4 + wc] = sq; } }
            asm volatile("" ::: "memory");
        }
    }
};

__device__ __forceinline__ void load_row64(const bf16* p, float (&q)[64], float sc) {
    const v4u* p4 = (const v4u*)p;
#pragma unroll
    for (int c = 0; c < 8; ++c) { const v4u u = p4[c];
        q[8 * c + 0] = bflo(u.x) * sc; q[8 * c + 1] = bfhi(u.x) * sc; q[8 * c + 2] = bflo(u.y) * sc; q[8 * c + 3] = bfhi(u.y) * sc;
        q[8 * c + 4] = bflo(u.z) * sc; q[8 * c + 5] = bfhi(u.z) * sc; q[8 * c + 6] = bflo(u.w) * sc; q[8 * c + 7] = bfhi(u.w) * sc; }
}
__device__ __forceinline__ float dot64(const float (&q)[64], const bf16* kp) {
    const v4u* p4 = (const v4u*)kp; float s0 = 0.f, s1 = 0.f;
#pragma unroll
    for (int c = 0; c < 8; ++c) { const v4u u = p4[c];
        s0 = fmaf(q[8 * c + 0], bflo(u.x), s0); s1 = fmaf(q[8 * c + 1], bfhi(u.x), s1); s0 = fmaf(q[8 * c + 2], bflo(u.y), s0); s1 = fmaf(q[8 * c + 3], bfhi(u.y), s1);
        s0 = fmaf(q[8 * c + 4], bflo(u.z), s0); s1 = fmaf(q[8 * c + 5], bfhi(u.z), s1); s0 = fmaf(q[8 * c + 6], bflo(u.w), s0); s1 = fmaf(q[8 * c + 7], bfhi(u.w), s1); }
    return s0 + s1;
}
__device__ __forceinline__ void online_update(float s, bool valid, const bf16* vp, float (&o)[64], float& m, float& l) {
    const float sm = valid ? s : -1e30f;
    if (__any(sm > m)) { const float mn = fmaxf(m, sm); const float corr = __builtin_amdgcn_exp2f(m - mn); l *= corr;
#pragma unroll
        for (int d = 0; d < 64; ++d) o[d] *= corr;
        m = mn; }
    const float p = valid ? __builtin_amdgcn_exp2f(s - m) : 0.f;
    l += p;
    const v4u* p4 = (const v4u*)vp;
#pragma unroll
    for (int c = 0; c < 8; ++c) { const v4u u = p4[c];
        o[8 * c + 0] = fmaf(p, bflo(u.x), o[8 * c + 0]); o[8 * c + 1] = fmaf(p, bfhi(u.x), o[8 * c + 1]); o[8 * c + 2] = fmaf(p, bflo(u.y), o[8 * c + 2]); o[8 * c + 3] = fmaf(p, bfhi(u.y), o[8 * c + 3]);
        o[8 * c + 4] = fmaf(p, bflo(u.z), o[8 * c + 4]); o[8 * c + 5] = fmaf(p, bfhi(u.z), o[8 * c + 5]); o[8 * c + 6] = fmaf(p, bflo(u.w), o[8 * c + 6]); o[8 * c + 7] = fmaf(p, bfhi(u.w), o[8 * c + 7]); }
}
__device__ __forceinline__ void store_row64(bf16* p, const float (&o)[64], float sc) {
    v4u* p4 = (v4u*)p;
#pragma unroll
    for (int c = 0; c < 8; ++c) { v4u w; w.x = pk2(o[8 * c + 0] * sc, o[8 * c + 1] * sc); w.y = pk2(o[8 * c + 2] * sc, o[8 * c + 3] * sc);
        w.z = pk2(o[8 * c + 4] * sc, o[8 * c + 5] * sc); w.w = pk2(o[8 * c + 6] * sc, o[8 * c + 7] * sc); p4[c] = w; }
}
__device__ __forceinline__ void attnA_naive(const bf16* qkv, bf16* ao, int item, int lane) {
    const int chunk = item & 63, hq = (item >> 6) & 3, b = item >> 8, kvh = hq >> 1, t = chunk * 64 + lane;
    float q[64], o[64];
    load_row64(qkv + (size_t)(b * SEQ + t) * NQKV + C_QA + hq * 64, q, 1.0f);
#pragma unroll
    for (int d = 0; d < 64; ++d) o[d] = 0.f;
    float m = -1e30f, l = 0.f;
    const bf16* kb = qkv + (size_t)b * SEQ * NQKV + C_KA + kvh * 64;
    const bf16* vb = qkv + (size_t)b * SEQ * NQKV + C_VA + kvh * 64;
    for (int j = 0; j < SEQ; ++j) { const float s = dot64(q, kb + (size_t)j * NQKV); online_update(s, true, vb + (size_t)j * NQKV, o, m, l); }
    store_row64(ao + (size_t)(b * SEQ + t) * DM + hq * 64, o, 1.0f / l);
}
__device__ __forceinline__ void attnB_naive(const bf16* qkv, const float* nab, bf16* ao, int item, int lane) {
    const int r = item & 63, bh = item >> 6, h = bh % 6, b = bh / 6, c = lane;
    const int rs = min(max(r - 4, 0), 56), cs = min(max(c - 8, 0), 48);
    float q[64], o[64];
    load_row64(qkv + (size_t)(b * SEQ + r * 64 + c) * NQKV + C_QB + h * 64, q, 1.0f);
#pragma unroll
    for (int d = 0; d < 64; ++d) o[d] = 0.f;
    float m = -1e30f, l = 0.f;
    for (int i = 0; i < 8; ++i)
        for (int jj = 0; jj < 16; ++jj) {
            const size_t krow = (size_t)(b * SEQ + (rs + i) * 64 + cs + jj) * NQKV;
            const float bias = nab[(h * 15 + (rs + i - r + 7)) * 31 + (cs + jj - c + 15)];
            const float s = dot64(q, qkv + krow + C_KB + h * 64) + bias * LOG2E;
            online_update(s, true, qkv + krow + C_VB + h * 64, o, m, l);
        }
    store_row64(ao + (size_t)(b * SEQ + r * 64 + c) * DM + 256 + h * 64, o, 1.0f / l);
}
__device__ __forceinline__ void attnC_naive(const bf16* qkv, bf16* ao, int item, int lane) {
    const int chunk = item & 63, bh = item >> 6, h = bh % 6, b = bh / 6, t = chunk * 64 + lane;
    float q[64], o[64];
    load_row64(qkv + (size_t)(b * SEQ + t) * NQKV + C_QC + h * 64, q, 1.0f);
#pragma unroll
    for (int d = 0; d < 64; ++d) o[d] = 0.f;
    float m = -1e30f, l = 0.f;
    for (int br = 0; br < 3; ++br) { const int dil = 1 << (2 * br);
        for (int j = -64; j <= 64; ++j) { const int pos = t + dil * j; const bool valid = (unsigned)pos < (unsigned)SEQ; const int pc = valid ? pos : t;
            const size_t krow = (size_t)(b * SEQ + pc) * NQKV;
            const float s = dot64(q, qkv + krow + C_KC + h * 64);
            online_update(s, valid, qkv + krow + C_VC + h * 64, o, m, l); } }
    store_row64(ao + (size_t)(b * SEQ + t) * DM + 640 + h * 64, o, 1.0f / l);
}

__device__ __forceinline__ void unpack16(const v4u u0, const v4u u1, float (&v)[16]) {
    v[0] = bflo(u0.x); v[1] = bfhi(u0.x); v[2] = bflo(u0.y); v[3] = bfhi(u0.y); v[4] = bflo(u0.z); v[5] = bfhi(u0.z); v[6] = bflo(u0.w); v[7] = bfhi(u0.w);
    v[8] = bflo(u1.x); v[9] = bfhi(u1.x); v[10] = bflo(u1.y); v[11] = bfhi(u1.y); v[12] = bflo(u1.z); v[13] = bfhi(u1.z); v[14] = bflo(u1.w); v[15] = bfhi(u1.w);
}
__device__ __forceinline__ void groupnorm_row2(const bf16* ao_, const bf16* part, const float* lse, int m0, int m1, const float* gout, bf16* mix_, int lane) {
    const int ms[2] = {m0, m1};
    v4u ld[2][6]; float ls[2][3];
    const int cc = 16 * lane - 640, hh = cc >> 6;
#pragma unroll
    for (int q = 0; q < 2; ++q) {
        if (lane < 40) { const v4u* a4 = (const v4u*)(ao_ + (size_t)ms[q] * DM) + 2 * lane; ld[q][0] = a4[0]; ld[q][1] = a4[1]; }
        else {
#pragma unroll
            for (int br = 0; br < 3; ++br) { const v4u* p4 = (const v4u*)(part + (size_t)br * MTOK * 384 + (size_t)ms[q] * 384 + cc); ld[q][2 * br] = p4[0]; ld[q][2 * br + 1] = p4[1];
                ls[q][br] = lse[(size_t)br * MTOK * 6 + (size_t)ms[q] * 6 + hh]; }
        }
    }
    const f32x4* g4 = (const f32x4*)gout + 4 * lane;
    const f32x4 g0 = g4[0], g1 = g4[1], g2 = g4[2], g3 = g4[3];
    if (lane < 40) { asm volatile("" : "+v"(ld[0][0]), "+v"(ld[0][1]), "+v"(ld[1][0]), "+v"(ld[1][1])); }
    else { asm volatile("" : "+v"(ld[0][0]), "+v"(ld[0][1]), "+v"(ld[0][2]), "+v"(ld[0][3]), "+v"(ld[0][4]), "+v"(ld[0][5]), "+v"(ld[1][0]), "+v"(ld[1][1]), "+v"(ld[1][2]), "+v"(ld[1][3]), "+v"(ld[1][4]), "+v"(ld[1][5])); }
    const int grp = lane < 16 ? 0 : (lane < 40 ? 1 : 2);
#pragma unroll
    for (int q = 0; q < 2; ++q) {
        float v[16];
        if (lane < 40) unpack16(ld[q][0], ld[q][1], v);
        else {
            const float l0 = ls[q][0], l1 = ls[q][1], l2 = ls[q][2];
            const float mx = fmaxf(l0, fmaxf(l1, l2));
            float w0 = __builtin_amdgcn_exp2f(l0 - mx), w1 = __builtin_amdgcn_exp2f(l1 - mx), w2 = __builtin_amdgcn_exp2f(l2 - mx);
            const float inv = 1.0f / (w0 + w1 + w2); w0 *= inv; w1 *= inv; w2 *= inv;
            float a[16], b[16], c[16];
            unpack16(ld[q][0], ld[q][1], a); unpack16(ld[q][2], ld[q][3], b); unpack16(ld[q][4], ld[q][5], c);
#pragma unroll
            for (int i = 0; i < 16; ++i) v[i] = w0 * a[i] + w1 * b[i] + w2 * c[i];
        }
        float ss = 0.f;
#pragma unroll
        for (int i = 0; i < 16; ++i) ss += v[i] * v[i];
        const float sa = wave_sum(grp == 0 ? ss : 0.f), sb = wave_sum(grp == 1 ? ss : 0.f), sc = wave_sum(grp == 2 ? ss : 0.f);
        const float rstd = (grp == 0) ? 1.0f / sqrtf(sa * (1.0f / 256.0f) + RMS_EPS) : (grp == 1) ? 1.0f / sqrtf(sb * (1.0f / 384.0f) + RMS_EPS) : 1.0f / sqrtf(sc * (1.0f / 384.0f) + RMS_EPS);
        v4u o0, o1;
        o0.x = pk2(v[0] * rstd * g0.x, v[1] * rstd * g0.y); o0.y = pk2(v[2] * rstd * g0.z, v[3] * rstd * g0.w); o0.z = pk2(v[4] * rstd * g1.x, v[5] * rstd * g1.y); o0.w = pk2(v[6] * rstd * g1.z, v[7] * rstd * g1.w);
        o1.x = pk2(v[8] * rstd * g2.x, v[9] * rstd * g2.y); o1.y = pk2(v[10] * rstd * g2.z, v[11] * rstd * g2.w); o1.z = pk2(v[12] * rstd * g3.x, v[13] * rstd * g3.y); o1.w = pk2(v[14] * rstd * g3.z, v[15] * rstd * g3.w);
        v4u* o4 = (v4u*)(mix_ + (size_t)ms[q] * DM) + 2 * lane; o4[0] = o0; o4[1] = o1;
    }
}

#define DPP_MOV_F(v, ctrl) __int_as_float(__builtin_amdgcn_update_dpp(0, __float_as_int(v), (ctrl), 0xf, 0xf, true))
__device__ __forceinline__ float swap32_add(float a, float b) { auto r = __builtin_amdgcn_permlane32_swap(__float_as_uint(a), __float_as_uint(b), false, false); return __uint_as_float(r[0]) + __uint_as_float(r[1]); }
__device__ __forceinline__ float swap16_add(float a, float b) { auto r = __builtin_amdgcn_permlane16_swap(__float_as_uint(a), __float_as_uint(b), false, false); return __uint_as_float(r[0]) + __uint_as_float(r[1]); }
__device__ __forceinline__ void router_phase(const bf16* h, const float* gffn, const float* wr, float* rs_, float* aff_, LAS unsigned char* lds, int tid, int lane, int q0, int qstep, int qend) {
    LAS float* wrT = (LAS float*)(lds + RING_OFF);
    for (int i = tid; i < DM * NE; i += NTHR) { const int col = i >> 4, e = i & 15; wrT[e * DM + col] = wr[i]; }
    __syncthreads();
    const bool b3 = (lane & 8) != 0, b2 = (lane & 4) != 0, b1 = (lane & 2) != 0, b0 = (lane & 1) != 0;
    for (int q4 = q0; q4 < qend; q4 += qstep) {
        const int m0 = q4 * 4;
        f32x4 v[4][4]; f32x4 g[4]; unsigned long long hx[4][4];
#pragma unroll
        for (int r = 0; r < 4; ++r) { const unsigned long long* xr = (const unsigned long long*)(h + (size_t)(m0 + r) * DM) + lane;
#pragma unroll
            for (int j = 0; j < 4; ++j) hx[r][j] = xr[64 * j]; }
#pragma unroll
        for (int r = 0; r < 4; ++r) PIN4V(hx[r]);
#pragma unroll
        for (int r = 0; r < 4; ++r)
#pragma unroll
            for (int j = 0; j < 4; ++j) { const unsigned long long x8 = hx[r][j]; const unsigned x0 = (unsigned)x8, x1 = (unsigned)(x8 >> 32); v[r][j] = (f32x4){bflo(x0), bfhi(x0), bflo(x1), bfhi(x1)}; }
#pragma unroll
        for (int j = 0; j < 4; ++j) g[j] = ((const f32x4*)gffn + lane)[64 * j];
#pragma unroll
        for (int r = 0; r < 4; ++r) { float s = 0.f;
#pragma unroll
            for (int j = 0; j < 4; ++j) s += (v[r][j].x * v[r][j].x + v[r][j].y * v[r][j].y) + (v[r][j].z * v[r][j].z + v[r][j].w * v[r][j].w);
            const float rstd = 1.0f / sqrtf(wave_sum(s) * (1.0f / DM) + RMS_EPS);
            if (lane == 0) { if (FUSE_RT) __hip_atomic_store(rs_ + m0 + r, rstd, __ATOMIC_RELAXED, __HIP_MEMORY_SCOPE_AGENT); else rs_[m0 + r] = rstd; }
#pragma unroll
            for (int j = 0; j < 4; ++j) { v[r][j].x = v[r][j].x * rstd * g[j].x; v[r][j].y = v[r][j].y * rstd * g[j].y; v[r][j].z = v[r][j].z * rstd * g[j].z; v[r][j].w = v[r][j].w * rstd * g[j].w; } }
        float pa[64];
#pragma unroll
        for (int e = 0; e < 16; ++e) { f32x4 w[4];
#pragma unroll
            for (int j = 0; j < 4; ++j) w[j] = *(const LAS f32x4*)(wrT + e * DM + 4 * lane + 256 * j);
#pragma unroll
            for (int r = 0; r < 4; ++r) { typedef float f2 __attribute__((ext_vector_type(2))); f2 a2 = {0.f, 0.f};
#pragma unroll
                for (int j = 0; j < 4; ++j) { a2 += (f2){v[r][j].x, v[r][j].y} * (f2){w[j].x, w[j].y}; a2 += (f2){v[r][j].z, v[r][j].w} * (f2){w[j].z, w[j].w}; }
                pa[16 * r + e] = a2.x + a2.y; }
            if ((e & 3) == 3) asm volatile("" ::: "memory"); }
        float p32[32], p16[16], p8[8], p4[4], p2[2];
#pragma unroll
        for (int i = 0; i < 32; ++i) p32[i] = swap32_add(pa[i], pa[i + 32]);
#pragma unroll
        for (int i = 0; i < 16; ++i) p16[i] = swap16_add(p32[i], p32[i + 16]);
#pragma unroll
        for (int i = 0; i < 8; ++i) { const float keep = b3 ? p16[i + 8] : p16[i], send = b3 ? p16[i] : p16[i + 8]; p8[i] = keep + DPP_MOV_F(send, 0x128); }
#pragma unroll
        for (int i = 0; i < 4; ++i) { const float keep = b2 ? p8[i + 4] : p8[i], send = b2 ? p8[i] : p8[i + 4]; const float hm = DPP_MOV_F(send, 0x141); p4[i] = keep + DPP_MOV_F(hm, 0x1B); }
#pragma unroll
        for (int i = 0; i < 2; ++i) { const float keep = b1 ? p4[i + 2] : p4[i], send = b1 ? p4[i] : p4[i + 2]; p2[i] = keep + DPP_MOV_F(send, 0x4E); }
        float lg; { const float keep = b0 ? p2[1] : p2[0], send = b0 ? p2[0] : p2[1]; lg = keep + DPP_MOV_F(send, 0xB1); }
        float mx = lg;
        mx = fmaxf(mx, DPP_MOV_F(mx, 0xB1)); mx = fmaxf(mx, DPP_MOV_F(mx, 0x4E)); mx = fmaxf(mx, DPP_MOV_F(mx, 0x141)); mx = fmaxf(mx, DPP_MOV_F(mx, 0x140));
        const float pe = expf(lg - mx);
        float sm = pe; sm = DPP_ADD_F(sm, 0xB1); sm = DPP_ADD_F(sm, 0x4E); sm = DPP_ADD_F(sm, 0x141); sm = DPP_ADD_F(sm, 0x140);
        { const int r = lane >> 4, e = lane & 15, b = m0 >> 12, sidx = (m0 & (SEQ - 1)) + r; if (FUSE_RT) __hip_atomic_store(aff_ + (size_t)(b * NE + e) * SEQ + sidx, pe / sm, __ATOMIC_RELAXED, __HIP_MEMORY_SCOPE_AGENT); else aff_[(size_t)(b * NE + e) * SEQ + sidx] = pe / sm; }
    }
    __syncthreads();
}

__device__ __forceinline__ unsigned short bf16_rne(float f) { return (unsigned short)(pk2(f, 0.f) & 0xffffu); }
__device__ __forceinline__ void router_mfma_phase(const bf16* h, const float* gffn, const float* wr, float* rs_, float* aff_, LAS unsigned char* lds, int tid, int lane, int gw, int NGW, bool wthru = false) {
    constexpr int WP = 1032;
    LAS unsigned short* wt = (LAS unsigned short*)(lds + RING_OFF);
#pragma unroll
    for (int bt = 0; bt < 4; ++bt) { float wv[8], gv[8];
#pragma unroll
        for (int j = 0; j < 8; ++j) { const int i = tid + NTHR * (8 * bt + j); wv[j] = wr[i]; gv[j] = gffn[i >> 4]; }
        asm volatile("" : "+v"(wv[0]), "+v"(wv[1]), "+v"(wv[2]), "+v"(wv[3]), "+v"(wv[4]), "+v"(wv[5]), "+v"(wv[6]), "+v"(wv[7]));
#pragma unroll
        for (int j = 0; j < 8; ++j) { const int i = tid + NTHR * (8 * bt + j); const int k = i >> 4, e = i & 15; const float w = wv[j] * gv[j];
            const unsigned short hi = bf16_rne(w); const float r1 = w - __uint_as_float((unsigned)hi << 16);
            const unsigned short lo = bf16_rne(r1); const float r2 = r1 - __uint_as_float((unsigned)lo << 16);
            const unsigned short l2 = bf16_rne(r2);
            wt[(0 * 16 + e) * WP + k] = hi; wt[(1 * 16 + e) * WP + k] = lo; wt[(2 * 16 + e) * WP + k] = l2; } }
    __syncthreads();
    const int r = lane & 15, kq = lane >> 4;
    for (int g = gw; g < MTOK / 16; g += NGW) {
        const v4u* ap = (const v4u*)(h + (size_t)(16 * g + r) * DM + 8 * kq);
        f32x4 acc = {0.f, 0.f, 0.f, 0.f}; float ss = 0.f;
#pragma unroll
        for (int hf = 0; hf < 2; ++hf) {
            v4u a[16];
#pragma unroll
            for (int s = 0; s < 16; ++s) a[s] = ap[(16 * hf + s) * 4];
            PIN4V(a); PIN4V(a + 4); PIN4V(a + 8); PIN4V(a + 12);
#pragma unroll
            for (int s = 0; s < 16; ++s) { const int ks = 16 * hf + s; const v4u u = a[s];
                ss += (bflo(u.x) * bflo(u.x) + bfhi(u.x) * bfhi(u.x)) + (bflo(u.y) * bflo(u.y) + bfhi(u.y) * bfhi(u.y)) + (bflo(u.z) * bflo(u.z) + bfhi(u.z) * bfhi(u.z)) + (bflo(u.w) * bflo(u.w) + bfhi(u.w) * bfhi(u.w));
                const bf16x8 af = __builtin_bit_cast(bf16x8, u);
#pragma unroll
                for (int tm = 0; tm < 3; ++tm) { const bf16x8 bfr = *(const LAS bf16x8*)(wt + (tm * 16 + r) * WP + 32 * ks + 8 * kq);
                    acc = __builtin_amdgcn_mfma_f32_16x16x32_bf16(af, bfr, acc, 0, 0, 0); } }
        }
        ss = xor16_add(ss); ss = xor32_add(ss);
        const float rstd = 1.0f / sqrtf(ss * (1.0f / DM) + RMS_EPS);
        if (kq == 0) { if (wthru) __hip_atomic_store(rs_ + 16 * g + r, rstd, __ATOMIC_RELAXED, __HIP_MEMORY_SCOPE_AGENT); else rs_[16 * g + r] = rstd; }
        f32x4 o;
#pragma unroll
        for (int j = 0; j < 4; ++j) { const float rr = __int_as_float(__builtin_amdgcn_ds_bpermute((4 * kq + j) << 2, __float_as_int(rstd))); const float lg = acc[j] * rr;
            float mx = lg; mx = fmaxf(mx, DPP_MOV_F(mx, 0xB1)); mx = fmaxf(mx, DPP_MOV_F(mx, 0x4E)); mx = fmaxf(mx, DPP_MOV_F(mx, 0x141)); mx = fmaxf(mx, DPP_MOV_F(mx, 0x140));
            const float pe = expf(lg - mx);
            float sm = pe; sm = DPP_ADD_F(sm, 0xB1); sm = DPP_ADD_F(sm, 0x4E); sm = DPP_ADD_F(sm, 0x141); sm = DPP_ADD_F(sm, 0x140);
            o[j] = pe / sm; }
        { const int m0 = 16 * g, b = m0 >> 12, s0 = m0 & (SEQ - 1); float* ap_ = aff_ + (size_t)(b * NE + r) * SEQ + s0 + 4 * kq;
          if (wthru) asm volatile("global_store_dwordx4 %0, %1, off sc1" :: "v"(ap_), "v"(o) : "memory"); else *(f32x4*)ap_ = o; }
    }
    __syncthreads();
}

__device__ __forceinline__ void topk_item(const float* aff_, int* idx_, float* gval_, int* sel_, const bf16* an_, const float* rs_, float* rsg_, bf16* xg_, int b, int e, int half, int nhalf, LAS unsigned char* lds, int tid, int lane, int wave) {
    LAS int* lidx = (LAS int*)(lds + RING_OFF + 1024);
    LAS int* sc = (LAS int*)(lds + RING_OFF);
    const f32x4* a4 = (const f32x4*)(aff_ + (size_t)(b * NE + e) * SEQ) + 2 * tid;
    const f32x4 x0 = a4[0], x1 = a4[1];
    unsigned v[8] = {__float_as_uint(x0.x), __float_as_uint(x0.y), __float_as_uint(x0.z), __float_as_uint(x0.w), __float_as_uint(x1.x), __float_as_uint(x1.y), __float_as_uint(x1.z), __float_as_uint(x1.w)};
    unsigned T = 0u;
    for (int bit = 30; bit >= 0; --bit) {
        const unsigned cand = T | (1u << bit);
        int c = 0;
#pragma unroll
        for (int i = 0; i < 8; ++i) c += (v[i] >= cand) ? 1 : 0;
        c = wave_sum_i(c);
        const int par = (bit & 1) * 8;
        if (lane == 0) sc[par + wave] = c;
        __syncthreads();
        int tot = 0;
#pragma unroll
        for (int w = 0; w < 8; ++w) tot += sc[par + w];
        if (tot >= CAP) T = cand;
    }
    int cg = 0, ce = 0;
#pragma unroll
    for (int i = 0; i < 8; ++i) { cg += (v[i] > T) ? 1 : 0; ce += (v[i] == T) ? 1 : 0; }
    int sg = cg, se = ce;
#pragma unroll
    for (int o = 1; o < 64; o <<= 1) { const int src = ((lane - o) & 63) << 2; const int tg = __builtin_amdgcn_ds_bpermute(src, sg), te = __builtin_amdgcn_ds_bpermute(src, se); if (lane >= o) { sg += tg; se += te; } }
    if (lane == 63) { sc[32 + wave] = sg; sc[48 + wave] = se; }
    __syncthreads();
    int baseg = 0, basee = 0, totg = 0;
#pragma unroll
    for (int w = 0; w < 8; ++w) { const int g = sc[32 + w], q = sc[48 + w]; if (w < wave) { baseg += g; basee += q; } totg += g; }
    int pg = baseg + sg - cg, pe = basee + se - ce;
    const int need = CAP - totg;
    const int R0 = (e * NB + b) * CAP;
#pragma unroll
    for (int i = 0; i < 8; ++i) { const int s = tid * 8 + i; int slot = -1;
        if (v[i] > T) { slot = pg; ++pg; }
        else if (v[i] == T) { if (pe < need) slot = totg + pe; ++pe; }
        if (half == 0) sel_[(size_t)(b * SEQ + s) * NE + e] = slot;
        if (slot >= 0) { lidx[slot] = s; if (half == 0) { idx_[R0 + slot] = s; gval_[R0 + slot] = __uint_as_float(v[i]) * (1.0f / (F8_SC_HID * F8_SC_WD)); } } }
    __syncthreads();
    const int per = CAP / nhalf;
    for (int c = half * per + wave * 64 + lane; c < (half + 1) * per; c += NWAVES * 64) rsg_[R0 + c] = rs_[b * SEQ + lidx[c]];
    __syncthreads();
}

#ifndef ONLY_PHASE
#define ONLY_PHASE -1
#endif
#define PHEN(k) (ONLY_PHASE < 0 || ONLY_PHASE == (k))
#ifndef PROBE_DUP
#define PROBE_DUP 0
#endif
#define PROBE_REPS 2
#define REP(k) _Pragma("unroll") for (int rep_ = 0; rep_ < ((PROBE_DUP >> (k)) & 1) + 1; ++rep_)
#define KAS __attribute__((address_space(4)))
#define PHV int ll = lane_id(); int gwl = gw, wvl = wave; asm volatile("" : "+s"(gwl), "+s"(wvl)); int tl = wvl * 64 + ll; (void)tl; (void)ll; (void)gwl; (void)wvl; \
    const KAS Args* ka = (const KAS Args*)__builtin_amdgcn_kernarg_segment_ptr(); asm volatile("" : "+s"(ka)); unsigned char* const ws = ka->ws; float* const hout = ka->out; (void)ws; (void)hout


#define cs_ax ((float2_t*)(ws + WS_TAB))
#define cs_1d ((float2_t*)(ws + WS_TAB + 65536))
#define aff ((float*)(ws + WS_AFF))
#define idx ((int*)(ws + WS_IDX))
#define gval ((float*)(ws + WS_GATE))
#define sel ((int*)(ws + WS_SEL))
#define Win_t ((bf16*)(ws + WS_WIN))
#define Wout_t ((bf16*)(ws + ((l & 1) ? WS_WOUT_ALT : WS_WOUT)))
#define Wpg_t ((bf16*)(ws + ((l & 1) ? WS_WPG_ALT : WS_WPG)))
#define Wpp_t ((bf16*)(ws + WS_WPP))
#define Wgu_t ((bf16*)(ws + WS_WGU + (size_t)(l & 1) * (32 * MiB)))
#define Wd_t ((bf16*)(ws + WS_WD + (size_t)(l & 1) * (16 * MiB)))
#define hY8 ((unsigned char*)(ws + WS_HY8))
#define pbf ((bf16*)(ws + WS_PBF))
#define an ((bf16*)(ws + WS_AN))
#define qkv ((bf16*)(ws + WS_QKV))
#define ao ((bf16*)(ws + WS_AO))
#define xg ((bf16*)(ws + WS_XG))
#define hid ((unsigned char*)(ws + WS_HID))
#define pp ((bf16*)(ws + WS_PP))
#define mix ((bf16*)(ws + WS_MIX))
#define yb ((bf16*)(ws + WS_Y))
#define y8 ((unsigned char*)(ws + WS_Y))
#define rsZ ((float*)(ws + WS_RSZ))
#define rsY ((float*)(ws + WS_RSY))
#define rsA ((float*)(ws + WS_RSA))
#define rsG ((float*)(ws + WS_RSG))
#define ssqP ((float*)(ws + WS_SSQ))
#define hY ((bf16*)(ws + WS_QKV))
#define hZ8 ((unsigned char*)(ws + WS_XG + 96 * MiB))
#define hZ ((bf16*)(ws + WS_XG))
#define cpart ((bf16*)(ws + WS_XG))
#define clse ((float*)(ws + WS_XG + 80 * MiB))
#define IN_X (ka->in[0])
#define IN_P (ka->in[1])
#define IN_GMIX (ka->in[2])
#define IN_WIN (ka->in[3])
#define IN_QKG (ka->in[4])
#define IN_NAB (ka->in[5])
#define IN_GOUT (ka->in[6])
#define IN_WOUT (ka->in[7])
#define IN_GFFN (ka->in[8])
#define IN_WR (ka->in[9])
#define IN_WG (ka->in[10])
#define IN_WU (ka->in[11])
#define IN_WD (ka->in[12])
#define IN_GPLE (ka->in[13])
#define IN_WPG (ka->in[14])
#define IN_WPP (ka->in[15])
__global__ void __launch_bounds__(NTHR, 2) mk_fwd(Args args) {
    extern __shared__ __attribute__((aligned(16))) unsigned char lds_raw[];
    LAS unsigned char* lds = (LAS unsigned char*)lds_raw;
    volatile LAS unsigned* MISC = (volatile LAS unsigned*)(lds + MISC_OFF);
    __builtin_amdgcn_s_setreg((0 << 11) | (23 << 6) | 1, 1);
    const int wave = __builtin_amdgcn_readfirstlane((int)threadIdx.x >> 6);
    const int G = gridDim.x;
    gu32* ctl = (gu32*)(args.ws + WS_CTL);
    int bid = blockIdx.x;
#if XCD_TRUE
    if (G == 256 && (args.ph_hi - args.ph_lo) > 1) {
        if (wave == 0 && lane_id() == 0) { const unsigned x = (unsigned)__builtin_amdgcn_s_getreg((3 << 11) | 20) & 0xFu; const unsigned r = __hip_atomic_fetch_add(ctl + CW_XRANK + 64 * x, 1u, __ATOMIC_RELAXED, __HIP_MEMORY_SCOPE_AGENT);
            unsigned sp = 0; bool ok = true;
            for (;;) { unsigned tot = 0, bad = 0;
#pragma unroll
                for (int j = 0; j < 16; ++j) { const unsigned c = __hip_atomic_load(ctl + CW_XRANK + 64 * j, __ATOMIC_RELAXED, __HIP_MEMORY_SCOPE_AGENT); tot += c; bad |= (j < 8) ? (c > 32u) : (c != 0u); }
                if (bad) { ok = false; break; } if (tot == 256u) break;
                __builtin_amdgcn_s_sleep(1); if (++sp > (1u << 20)) { ok = false; break; } }
            ((LAS int*)(lds + MISC_OFF))[16] = ok ? (int)(x + 8u * r) : -1; }
        __syncthreads();
        const int vb = ((LAS int*)(lds + MISC_OFF))[16]; if (vb >= 0) bid = vb;
        __syncthreads();
    }
#endif
    const int gw = bid * NWAVES + wave, NGW = G * NWAVES, NGT = G * NTHR;

    for (int u = wave * 64 + lane_id(); u < (LDS_BYTES - LDSCTL_OFF) / 4; u += NTHR) ((LAS unsigned*)(lds + LDSCTL_OFF))[u] = 0u;
    __syncthreads();
    const int lo = args.ph_lo, hi = args.ph_hi;
    const bool use_bar = (hi - lo) > 1;
    XcdBarrier bar; bar.bar = (unsigned*)(ctl + CW_BAR); bar.x = 0; bar.st = nullptr;
    if (use_bar) bar = xcd_barrier_post((unsigned*)(ctl + CW_BAR), MISC + 8);
#define IN(k) (lo <= (k) && (k) < hi)
#define SEAM(k) do { if (IN(k) && IN((k) + 1)) xcd_barrier(bar); } while (0)

    if (PHEN(100) && IN(0)) { PHV;
        const int gtid0 = bid * NTHR + tl;
        for (int i = gtid0; i < 64 * 16 + SEQ * 8; i += NGT) {
            float c, s;
            if (i < 1024) { const int pos = i >> 4, j = i & 15; sincos_acc((float)pos * ka->inv_ax[j], c, s); cs_ax[i].x = c; cs_ax[i].y = s; }
            else { const int k = i - 1024, pos = k >> 3, j = k & 7; sincos_acc((float)pos * ka->inv_1d[j], c, s); cs_1d[k].x = c; cs_1d[k].y = s; }
        }
        for (int m = gwl; m < MTOK / 2; m += NGW) cast_row2(IN_X + (size_t)m * DM, IN_X + (size_t)(m + MTOK / 2) * DM, an + (size_t)m * DM, an + (size_t)(m + MTOK / 2) * DM, rsA + m, rsA + m + MTOK / 2, ll);
        convert_layer(ka, 0, 0, lds, gwl, NGW, wvl, ll, gtid0, NGT);
    }
    SEAM(0);

    for (int l = 0; l < DEPTH; ++l) {
        const int pb = 1 + l * NPH_LAYER;
        if (PHEN(0) && IN(pb + 0)) REP(0) { PHV;
            pg8::Gemm g{(l == 0) ? an : (bf16*)hout, Win_t, MTOK, NQKV, DM}; DupStatic<0> S; S.init(MTOK, NQKV, G, bid);
            if (l > 0) {
                for (int i0 = 0; ; i0 += 3) {
                    pg8::Unit uu; int rw[3]; f32x4 pa[3][4]; bool any = false;
#pragma unroll
                    for (int i = 0; i < 3; ++i) { const bool v = S.next(i0 + i, uu); any |= v; rw[i] = v ? uu.pm * 256 + (tl & 255) : -1; const f32x4* p4 = (const f32x4*)(ssqP + (size_t)(v ? rw[i] : 0) * 16);
#pragma unroll
                        for (int q = 0; q < 4; ++q) pa[i][q] = p4[q]; }
                    if (!any) break;
#pragma unroll
                    for (int i = 0; i < 3; ++i) if (tl < 256 && rw[i] >= 0) { const f32x4 a = pa[i][0], b = pa[i][1], c = pa[i][2], d = pa[i][3];
                        const float s = ((a.x + a.y) + (a.z + a.w)) + ((b.x + b.y) + (b.z + b.w)) + ((c.x + c.y) + (c.z + c.w)) + ((d.x + d.y) + (d.z + d.w));
                        rsA[rw[i]] = 1.0f / sqrtf(s * (1.0f / DM) + RMS_EPS); }
                }
                asm volatile("s_waitcnt vmcnt(0)" ::: "memory"); __syncthreads();
            }
            EpiQKV E{qkv, IN_QKG + (size_t)l * 3 * 2 * 64, cs_ax, cs_1d, rsA};
            pg8::gemm_phase<EpiQKV, DupStatic<0>, true, true>(lds + RING_OFF, g, S, E, tl);
            { const bool split = (G == 256); const int g2 = split ? 128 : G, c2 = split ? bid - 128 : bid;
              if (c2 >= 0) { pg8::Gemm gp{pbf, Wpp_t, MTOK, DM, DPLE}; pg8::StaticOrder S2; S2.init(MTOK, DM, g2, c2);
                EpiStoreBf16NP E2{pp};
                pg8::gemm_phase<EpiStoreBf16NP, pg8::StaticOrder, true, true>(lds + RING_OFF, gp, S2, E2, wvl * 64 + lane_id()); } }
        }
        SEAM(pb + 0);
        if (PHEN(1) && IN(pb + 1)) REP(1) { PHV;
#pragma unroll 1
          for (int pass_ = 0; pass_ < 2; ++pass_) {
            if (pass_ == (bid & 1)) {
                asm volatile("s_waitcnt vmcnt(0) lgkmcnt(0)" ::: "memory"); __syncthreads();
                { const int l2_ = lane_id(); int w2_ = wvl; asm volatile("" : "+s"(w2_));
                  convert_layer(ka, 1, l, lds, bid * NWAVES + w2_, NGW, w2_, l2_, bid * NTHR + w2_ * 64 + l2_, NGT); }
                asm volatile("s_waitcnt vmcnt(0) lgkmcnt(0)" ::: "memory"); __syncthreads();
            }
            if (pass_ == 0) {
#ifdef NAIVE_ATTA
            for (int it = gwl; it < NB * 4 * 64; it += NGW) attnA_naive(qkv, ao, it, ll);
#else
            { const attn_body::AttnTensors AT{(const attn_body::bf16*)(qkv + C_QA), (const attn_body::bf16*)(qkv + C_KA), (const attn_body::bf16*)(qkv + C_VA), (attn_body::bf16*)ao};
              const attn_body::StaticOrder S(G, bid);
              attn_body::attn_phase<attn_body::StaticOrder>((char*)lds_raw + RING_OFF, AT, S, lane_id(), wvl); }
#endif
#ifdef NAIVE_ATTBC
            for (int it = gwl; it < NB * 6 * 64; it += NGW) attnB_naive(qkv, IN_NAB + (size_t)l * 6 * 15 * 31, ao, it, ll);
            for (int it = gwl; it < NB * 6 * 64; it += NGW) attnC_naive(qkv, ao, it, ll);
#else
#ifndef PROBE_DUPB
#define PROBE_DUPB 0
#endif
#ifndef PROBE_DUPC
#define PROBE_DUPC 0
#endif
#ifndef WAVE_B
#define WAVE_B 0
#endif
#ifndef WAVE_C
#define WAVE_C 0
#endif
#if WAVE_B
            attn_body::attnB_wave_phase((char*)lds_raw, (const attn_body::bf16*)qkv, C_QB, C_KB, C_VB, IN_NAB + (size_t)l * 6 * 15 * 31, (attn_body::bf16*)ao, G, bid, lane_id(), wvl);
            asm volatile("s_waitcnt vmcnt(0) lgkmcnt(0)\n\ts_barrier" ::: "memory");
#else
            for (int rb_ = 0; rb_ < 1 + PROBE_DUPB; ++rb_) attn_body::attnB_phase((char*)lds_raw + RING_OFF, (const attn_body::bf16*)qkv, C_QB, C_KB, C_VB, IN_NAB + (size_t)l * 6 * 15 * 31, (attn_body::bf16*)ao, G, bid, lane_id(), wvl);
#endif
#if WAVE_C
            attn_body::attnC_wave_phase((char*)lds_raw, (const attn_body::bf16*)qkv, C_QC, C_KC, C_VC, (attn_body::bf16*)cpart, clse, G, bid, lane_id(), wvl);
            asm volatile("s_waitcnt vmcnt(0) lgkmcnt(0)\n\ts_barrier" ::: "memory");
#else
            for (int rc_ = 0; rc_ < 1 + PROBE_DUPC; ++rc_) attn_body::attnC_phase((char*)lds_raw + RING_OFF, (const attn_body::bf16*)qkv, C_QC, C_KC, C_VC, (attn_body::bf16*)cpart, clse, G, bid, lane_id(), wvl);
#endif
#endif
            }
          }
        }
        SEAM(pb + 1);
        if (PHEN(2) && IN(pb + 2)) REP(2) { PHV;
            for (int m = gwl; m < MTOK / 2; m += NGW) groupnorm_row2(ao, cpart, clse, m, m + MTOK / 2, IN_GOUT + (size_t)l * DM, mix, ll);
        }
        SEAM(pb + 2);
        if (PHEN(3) && IN(pb + 3)) REP(3) { PHV;
            pg8::Gemm g{mix, Wout_t, MTOK, DM, DM}; DupStatic<3> S; S.init(MTOK, DM, G, bid);
            EpiResid E{(l == 0) ? (const bf16*)an : (const bf16*)hout, hY, hY8};
            pg8::gemm_phase<EpiResid, DupStatic<3>, ALIGN_RMW, true>(lds + RING_OFF, g, S, E, tl);
        }
        SEAM(pb + 3);
        if (PHEN(4) && IN(pb + 4)) REP(4) { PHV;
            if (FUSE_RT && G == 256 && IN(pb + 5)) {
                const int bat = bid >> 5, j = bid & 31;
                router_mfma_phase(hY, IN_GFFN + (size_t)l * DM, IN_WR + (size_t)l * DM * NE, rsY, aff, lds, tl, ll, bat * 256 + j * 8 + wvl, MTOK / 16, true);
                asm volatile("s_waitcnt vmcnt(0)" ::: "memory"); __syncthreads();
                if (tl == 0) { gu32* cnt = ctl + CW_GRP + ((l * PROBE_REPS + rep_) * NB + bat) * 64;
                    __hip_atomic_fetch_add(cnt, 1u, __ATOMIC_RELAXED, __HIP_MEMORY_SCOPE_AGENT);
                    unsigned sp = 0; while (__hip_atomic_load(cnt, __ATOMIC_RELAXED, __HIP_MEMORY_SCOPE_AGENT) < 32u) { __builtin_amdgcn_s_sleep(1); if (++sp > (1u << 22)) { __hip_atomic_store(ctl + 0, 0xDEAD0004u, __ATOMIC_RELAXED, __HIP_MEMORY_SCOPE_AGENT); break; } }
                    __builtin_amdgcn_fence(__ATOMIC_ACQUIRE, "agent"); asm volatile("s_waitcnt vmcnt(0)" ::: "memory"); }
                __syncthreads();
                __builtin_amdgcn_fence(__ATOMIC_ACQUIRE, "agent"); asm volatile("s_waitcnt vmcnt(0)" ::: "memory");
                topk_item(aff, idx, gval, sel, hY, rsY, rsG, xg, bat, j >> 1, j & 1, 2, lds, tl, ll, wvl);
            } else if (ROUTER_MFMA) router_mfma_phase(hY, IN_GFFN + (size_t)l * DM, IN_WR + (size_t)l * DM * NE, rsY, aff, lds, tl, ll, gwl, NGW);
            else router_phase(hY, IN_GFFN + (size_t)l * DM, IN_WR + (size_t)l * DM * NE, rsY, aff, lds, tl, ll, gwl, NGW, MTOK / 4);
        }
        if (!(FUSE_RT && G == 256 && IN(pb + 4) && IN(pb + 5))) SEAM(pb + 4);
        if (PHEN(5) && IN(pb + 5) && !(FUSE_RT && G == 256 && IN(pb + 4))) REP(5) { PHV;
            const int nh = (G >= 2 * NB * NE) ? 2 : 1, ng = G / nh;
            if (bid < ng * nh) for (int it = bid / nh; it < NB * NE; it += ng) topk_item(aff, idx, gval, sel, hY, rsY, rsG, xg, it >> 4, it & 15, bid % nh, nh, lds, tl, ll, wvl);
        }
        SEAM(pb + 5);
        if (PHEN(7) && IN(pb + 7)) REP(7) { PHV;
            GroupedOrder S; S.init(2048, G, bid);
            LAS int* gtok = (LAS int*)(lds + GTOK_OFF);
            { pg8::Unit uu; int Rv[GTOK_UNITS], iv[GTOK_UNITS];
#pragma unroll
              for (int i = 0; i < GTOK_UNITS; ++i) { Rv[i] = S.next(i, uu) ? uu.pm * 256 + (tl & 255) : -1; iv[i] = (Rv[i] >= 0) ? idx[Rv[i]] : 0; }
#pragma unroll
              for (int i = 0; i < GTOK_UNITS; ++i) if (tl < 256 && Rv[i] >= 0) gtok[i * 256 + tl] = ((Rv[i] >> 9) & 7) * SEQ + iv[i]; }
            __syncthreads();
            pg8::Gemm g{(const bf16*)hY8, Wgu_t, MR, 2048, DM / 2};
            EpiSwiGLU E{hid, rsG};
            pg8::gemm_phase<EpiSwiGLU, GroupedOrder, true, true, true, true>(lds + RING_OFF, g, S, E, tl, gtok);
        }
        SEAM(pb + 7);
        if (PHEN(8) && IN(pb + 8)) REP(8) { PHV;
            pg8::Gemm g{(const bf16*)hid, Wd_t, MR, DM, DFF / 2}; GroupedOrder S; S.init(DM, G, bid);
            LAS int* gtok = (LAS int*)(lds + GTOK_OFF);
            { pg8::Unit uu;
#pragma unroll
              for (int i = 0; i < GTOK_UNITS; ++i) if (S.next(i, uu) && tl < 256) gtok[i * 256 + tl] = uu.pm * 256 + tl; }
            __syncthreads();
            EpiStoreF8 E{y8};
            pg8::gemm_phase<EpiStoreF8, GroupedOrder, true, true, true, true>(lds + RING_OFF, g, S, E, tl, gtok);
        }
        SEAM(pb + 8);
        if (PHEN(9) && IN(pb + 9)) REP(9) { PHV;
            for (int q4 = gwl; q4 < MTOK / 4; q4 += NGW) {
                const int m0 = q4 * 4, b = m0 >> 12;
                f32x4 v[4][4]; unsigned long long hx[4][4];
#pragma unroll
                for (int r = 0; r < 4; ++r) { const unsigned long long* hr = (const unsigned long long*)(hY + (size_t)(m0 + r) * DM) + ll;
#pragma unroll
                    for (int j = 0; j < 4; ++j) hx[r][j] = hr[64 * j]; }
                const int slot = sel[(size_t)m0 * NE + ll];
                const int Rv = ((ll & 15) * NB + b) * CAP + (slot < 0 ? 0 : slot);
                const float gv = gval[Rv];
                const unsigned long long msk = __ballot(slot >= 0);
                unsigned mj[4] = {(unsigned)(msk & 0xffffu), (unsigned)((msk >> 16) & 0xffffu), (unsigned)((msk >> 32) & 0xffffu), (unsigned)((msk >> 48) & 0xffffu)};
#pragma unroll
                for (int r = 0; r < 4; ++r)
#pragma unroll
                    for (int j = 0; j < 4; ++j) v[r][j] = (f32x4){0.f, 0.f, 0.f, 0.f};
                while ((mj[0] | mj[1] | mj[2] | mj[3]) != 0u) {
                    unsigned yv[4][4]; float gt[4];
#pragma unroll
                    for (int r = 0; r < 4; ++r) { const bool has = mj[r] != 0u; const int i = has ? __builtin_ctz(mj[r]) : 0; mj[r] &= mj[r] - 1u;
                        const int R = __builtin_amdgcn_readlane(Rv, 16 * r + i); const float g = __uint_as_float(__builtin_amdgcn_readlane(__float_as_uint(gv), 16 * r + i)); gt[r] = has ? g : 0.f;
                        const unsigned* yr = (const unsigned*)(y8 + (size_t)R * DM) + ll;
#pragma unroll
                        for (int j = 0; j < 4; ++j) yv[r][j] = yr[64 * j]; }
#pragma unroll
                    for (int r = 0; r < 4; ++r) PIN4V(yv[r]);
#pragma unroll
                    for (int r = 0; r < 4; ++r)
#pragma unroll
                        for (int j = 0; j < 4; ++j) { const auto lo = __builtin_amdgcn_cvt_pk_f32_fp8((int)yv[r][j], false), hi2 = __builtin_amdgcn_cvt_pk_f32_fp8((int)yv[r][j], true);
                            v[r][j].x += gt[r] * lo[0]; v[r][j].y += gt[r] * lo[1]; v[r][j].z += gt[r] * hi2[0]; v[r][j].w += gt[r] * hi2[1]; }
                }
#pragma unroll
                for (int r = 0; r < 4; ++r) PIN4V(hx[r]);
#pragma unroll
                for (int r = 0; r < 4; ++r)
#pragma unroll
                    for (int j = 0; j < 4; ++j) { const unsigned long long x8 = hx[r][j]; const unsigned x0 = (unsigned)x8, x1 = (unsigned)(x8 >> 32); v[r][j].x += bflo(x0); v[r][j].y += bfhi(x0); v[r][j].z += bflo(x1); v[r][j].w += bfhi(x1); }
#pragma unroll
                for (int r = 0; r < 4; ++r) { unsigned long long* hw = (unsigned long long*)(hZ + (size_t)(m0 + r) * DM) + ll; unsigned* hw8 = (unsigned*)(hZ8 + (size_t)(m0 + r) * DM) + ll; float s = 0.f;
#pragma unroll
                    for (int j = 0; j < 4; ++j) { hw[64 * j] = (unsigned long long)pk2(v[r][j].x, v[r][j].y) | ((unsigned long long)pk2(v[r][j].z, v[r][j].w) << 32); hw8[64 * j] = pk4_f8(v[r][j].x, v[r][j].y, v[r][j].z, v[r][j].w); s += (v[r][j].x * v[r][j].x + v[r][j].y * v[r][j].y) + (v[r][j].z * v[r][j].z + v[r][j].w * v[r][j].w); }
                    const float rstd = 1.0f / sqrtf(wave_sum(s) * (1.0f / DM) + RMS_EPS);
                    if (ll == 0) rsZ[m0 + r] = rstd * (1.0f / F8_SC_W); }
            }
        }
        SEAM(pb + 9);
        if (PHEN(10) && IN(pb + 10)) REP(10) { PHV;
            pg8::Gemm g{(const bf16*)hZ8, Wpg_t, MTOK, DM, DM / 2}; DupStatic<10> S; S.init(MTOK, DM, G, bid);
            LAS int* gtok = (LAS int*)(lds + GTOK_OFF);
            { pg8::Unit uu;
#pragma unroll
              for (int i = 0; i < GTOK_UNITS; ++i) if (S.next(i, uu) && tl < 256) gtok[i * 256 + tl] = uu.pm * 256 + tl; }
            __syncthreads();
            EpiPLE E{hZ, (l == DEPTH - 1) ? hout : (float*)nullptr, (bf16*)hout, pp, rsZ, ssqP};
            pg8::gemm_phase<EpiPLE, DupStatic<10>, ALIGN_RMW, true, true, true>(lds + RING_OFF, g, S, E, tl, gtok);
        }
        SEAM(pb + 10);
    }
#undef IN
#undef SEAM
}

#ifndef MK_ONE_LAUNCH
#define MK_ONE_LAUNCH 1
#endif
extern "C" void kernel_launch(void* const* d_in, const int* in_sizes, int n_in, void* d_out, int out_size, void* d_ws, size_t ws_size, hipStream_t stream) {
    static int grid = 0;
    if (grid == 0) {
        if (n_in != 16 || out_size != MTOK * DM || ws_size < WS_END) { fprintf(stderr, "kernel_launch: unexpected shapes (n_in %d out %d ws %zu)\n", n_in, out_size, ws_size); grid = -1; return; }
        int dev = 0, cus = 0, per_cu = 0;
        if (hipGetDevice(&dev) != hipSuccess || hipDeviceGetAttribute(&cus, hipDeviceAttributeMultiprocessorCount, dev) != hipSuccess) { grid = -1; return; }
        if (hipFuncSetAttribute((const void*)mk_fwd, hipFuncAttributeMaxDynamicSharedMemorySize, LDS_BYTES) != hipSuccess) { fprintf(stderr, "kernel_launch: hipFuncSetAttribute failed\n"); grid = -1; return; }
        if (hipOccupancyMaxActiveBlocksPerMultiprocessor(&per_cu, (const void*)mk_fwd, NTHR, LDS_BYTES) != hipSuccess || per_cu < 1) fprintf(stderr, "kernel_launch: occupancy query says %d\n", per_cu);
        (void)hipGetLastError();
        grid = cus;
        if (grid * GTOK_UNITS * 256 < MR * 8) { fprintf(stderr, "kernel_launch: built for >= 256 CUs (the expert GEMM's row table holds %d units per workgroup); got %d\n", GTOK_UNITS, grid); grid = -1; return; }
    }
    if (grid < 0) return;
    (void)hipMemsetAsync((char*)d_ws + WS_CTL, 0, CTL_ZERO_BYTES, stream);
    Args a{};
    for (int i = 0; i < 16; ++i) a.in[i] = (const float*)d_in[i];
    a.out = (float*)d_out; a.ws = (unsigned char*)d_ws;
    for (int j = 0; j < 16; ++j) a.inv_ax[j] = (float)pow(10000.0, -(double)j / 16.0);
    for (int j = 0; j < 8; ++j) a.inv_1d[j] = (float)pow(500000.0, -(double)j / 8.0);
#if MK_ONE_LAUNCH
    a.ph_lo = 0; a.ph_hi = NPHASES;
    hipLaunchKernelGGL(mk_fwd, dim3(grid), dim3(NTHR), LDS_BYTES, stream, a);
#else
    for (int ph = 0; ph < NPHASES - 1; ++ph) { a.ph_lo = ph; a.ph_hi = ph + 1; hipLaunchKernelGGL(mk_fwd, dim3(grid), dim3(NTHR), LDS_BYTES, stream, a); }
#endif
}
```

```cpp
#include <hip/hip_runtime.h>
#include <hip/hip_bf16.h>
#include <cstdio>
#include <cstdint>
#include <cmath>
namespace pg8 {
#define PG8_LAS __attribute__((address_space(3)))
typedef unsigned short bf16_t;
typedef short bf16x8 __attribute__((ext_vector_type(8)));
typedef float f32x4 __attribute__((ext_vector_type(4)));
typedef unsigned u32x4 __attribute__((ext_vector_type(4)));
constexpr int BM = 256, BK = 64, HALF = 128, HTB = HALF * BK * 2  , STAGE_BYTES = 8 * HTB, NXCD = 8, WGM = 8;

__host__ __device__ __forceinline__ int lds_byte(int r, int c) { const int st = (r >> 4) * 2 + (c >> 5), rr = r & 15, cc = c & 31, ob = rr * 64 + cc * 2; return st * 1024 + (ob ^ (((ob >> 9) & 1) << 5)); }
__host__ __device__ __forceinline__ void stage_rc(int b, int& R, int& C) { const int st = b / 1024, sb = b % 1024, swz = sb ^ (((sb >> 9) & 1) << 5); R = (st >> 1) * 16 + swz / 64; C = (st & 1) * 32 + (swz % 64) / 2; }
__host__ __device__ __forceinline__ int perm32(int rho) { const int n = rho >> 4, i = rho & 15; return 8 * (i >> 2) + 4 * n + (i & 3); }

struct Unit { int pm, pn; };
struct Gemm { const bf16_t* A; const bf16_t* Bt; int M, N, K; };

struct StaticOrder {
    int nM, nN, nwg, G, c;
    __host__ __device__ void init(int M, int N, int G_, int c_) { nM = M / BM; nN = N / BM; nwg = nM * nN; G = G_; c = c_; }
    __host__ __device__ bool next(int i, Unit& u) const {
        const long L = (long)i * G + c; if (L >= nwg) return false;
        int wgid = (int)L; { const int q = nwg / NXCD, r = nwg % NXCD, xcd = wgid % NXCD, off = wgid / NXCD; wgid = (xcd < r ? xcd * (q + 1) : r * (q + 1) + (xcd - r) * q) + off; }
        const int nig = WGM * nN, gid = wgid / nig, fm = gid * WGM, gsz = (nM - fm) < WGM ? (nM - fm) : WGM;
        u.pm = fm + ((wgid % nig) % gsz); u.pn = (wgid % nig) / gsz; return true;
    }
    __device__ __forceinline__ void a_ready(const Unit&) const {}
    __device__ __forceinline__ void done(const Unit&) const {}
};

__device__ __forceinline__ unsigned cvt_pk_bf16(float lo, float hi) { unsigned r; asm volatile("v_cvt_pk_bf16_f32 %0, %1, %2" : "=v"(r) : "v"(lo), "v"(hi)); return r; }
typedef float f32x2 __attribute__((ext_vector_type(2)));
__device__ __forceinline__ f32x2 gelu_pk(f32x2 v) {
    const f32x2 av = __builtin_elementwise_abs(v), d = av * 0.2316418882f + 1.0f;
    f32x2 t; t.x = __builtin_amdgcn_rcpf(d.x); t.y = __builtin_amdgcn_rcpf(d.y);
    f32x2 q = t * 0.5307027145f + (-0.7265760135f); q = q * t + 0.7107068705f; q = q * t + (-0.142248368f); q = q * t + 0.127414796f; q = q * t;
    const f32x2 s = (v * v) * (-0.72134752044f);
    f32x2 e; e.x = __builtin_amdgcn_exp2f(s.x); e.y = __builtin_amdgcn_exp2f(s.y);
    const f32x2 m = v * (q * e), r = v - m;
    f32x2 o; o.x = v.x < 0.f ? m.x : r.x; o.y = v.y < 0.f ? m.y : r.y; return o;
}

template <int ACT  > struct EpiBf16 {
    static constexpr bool PERM = true, AFTER_DRAIN = false; static_assert(ACT == 0 || ACT == 1, "EpiBf16: ACT is 0 (none) or 1 (gelu_pk)");
    bf16_t* O; int ldc; const float* bias; int split_cols; size_t split_stride; float scale0;
    __device__ __forceinline__ void operator()(const f32x4 (&acc)[2][2][4][2], const Unit& u, int wr, int wc, int fr, int fq) const {
        const int row0 = u.pm * BM + wr * 64 + fr; int colt = u.pn * BM; bf16_t* base = O;
        float sc = 1.f; if (split_cols) { const int t = colt / split_cols; base += (size_t)t * split_stride; colt -= t * split_cols; if (t == 0) sc = scale0; }
        const int col0 = colt + wc * 32 + 8 * fq, bcol0 = u.pn * BM + wc * 32 + 8 * fq;
        f32x4 bv[2][2];
#pragma unroll
        for (int bj = 0; bj < 2; ++bj)
#pragma unroll
            for (int n = 0; n < 2; ++n) bv[bj][n] = bias ? *(const f32x4*)(bias + bcol0 + bj * HALF + 4 * n) : (f32x4){0.f, 0.f, 0.f, 0.f};
#pragma unroll
        for (int ai = 0; ai < 2; ++ai)
#pragma unroll
            for (int m = 0; m < 4; ++m) { bf16_t* rowp = base + (size_t)(row0 + ai * HALF + m * 16) * ldc + col0;
#pragma unroll
                for (int bj = 0; bj < 2; ++bj) { f32x4 v0 = acc[ai][bj][m][0] + bv[bj][0], v1 = acc[ai][bj][m][1] + bv[bj][1];
                    if (ACT == 1) { f32x2 a = gelu_pk((f32x2){v0[0], v0[1]}), b = gelu_pk((f32x2){v0[2], v0[3]}), c = gelu_pk((f32x2){v1[0], v1[1]}), d = gelu_pk((f32x2){v1[2], v1[3]});
                        v0 = (f32x4){a.x, a.y, b.x, b.y}; v1 = (f32x4){c.x, c.y, d.x, d.y}; }
                    v0 = v0 * sc; v1 = v1 * sc; u32x4 w; w.x = cvt_pk_bf16(v0[0], v0[1]); w.y = cvt_pk_bf16(v0[2], v0[3]); w.z = cvt_pk_bf16(v1[0], v1[1]); w.w = cvt_pk_bf16(v1[2], v1[3]);
                    *(u32x4*)(rowp + bj * HALF) = w; } }
    }
};

struct PanelStats {
    unsigned* xbuf;
    unsigned* cnt;
    unsigned* tmo;
    int ntn; float eps;
    unsigned code;
    __device__ __forceinline__ bool run(const f32x4 (&v)[2][2][4][2], const Unit& u, int wr, int wc, int fr, int fq, PG8_LAS unsigned char* lds, int wid, int lane) const {
        typedef float f32x2v __attribute__((ext_vector_type(2)));
        PG8_LAS f32x2v* P = (PG8_LAS f32x2v*)lds;
        PG8_LAS f32x2v* S = (PG8_LAS f32x2v*)(lds + 8192);
        PG8_LAS unsigned* flag = (PG8_LAS unsigned*)(lds + 8192 + 2048);
#pragma unroll
        for (int ai = 0; ai < 2; ++ai)
#pragma unroll
            for (int m = 0; m < 4; ++m) {
                float s = 0.f;
#pragma unroll
                for (int bj = 0; bj < 2; ++bj)
#pragma unroll
                    for (int n = 0; n < 2; ++n) { const f32x4 x = v[ai][bj][m][n]; s += (x[0] + x[1]) + (x[2] + x[3]); }
                s += __shfl_xor(s, 16); s += __shfl_xor(s, 32);
                const float mw = s * (1.0f / 64.0f); float q = 0.f;
#pragma unroll
                for (int bj = 0; bj < 2; ++bj)
#pragma unroll
                    for (int n = 0; n < 2; ++n) { const f32x4 d = v[ai][bj][m][n] - mw; q += (d[0] * d[0] + d[1] * d[1]) + (d[2] * d[2] + d[3] * d[3]); }
                q += __shfl_xor(q, 16); q += __shfl_xor(q, 32);
                if (fq == 0) P[(ai * HALF + wr * 64 + m * 16 + fr) * 4 + wc] = (f32x2v){mw, q};
            }
        asm volatile("s_waitcnt lgkmcnt(0)" ::: "memory"); __builtin_amdgcn_s_barrier(); asm volatile("" ::: "memory");
#if defined(BROKEN_EXCHANGE_NO_WAIT)
#warning BROKEN CONTROL BUILD: the row-statistics exchange does not wait; results are wrong by design
        if (blockIdx.x >= 64) { const long long t0_ = clock64(); while (clock64() - t0_ < 60000) __builtin_amdgcn_s_sleep(8); }
#endif
        const int row = wid * 32 + (lane & 31);
        if (lane < 32) {
            const f32x2v a = P[row * 4 + 0], b = P[row * 4 + 1], c = P[row * 4 + 2], d = P[row * 4 + 3];
            const float mt = (a.x + b.x + c.x + d.x) * 0.25f;
            const float da = a.x - mt, db = b.x - mt, dc = c.x - mt, dd = d.x - mt;
            const float m2 = (a.y + b.y) + (c.y + d.y) + 64.0f * ((da * da + db * db) + (dc * dc + dd * dd));
            unsigned long long* slot = (unsigned long long*)xbuf + ((size_t)(u.pm * BM + row) * 4 + u.pn);
            __hip_atomic_store(slot, ((unsigned long long)__float_as_uint(m2) << 32) | __float_as_uint(mt), __ATOMIC_RELAXED, __HIP_MEMORY_SCOPE_AGENT);
        }
        asm volatile("s_waitcnt vmcnt(0)" ::: "memory");
        if (lane == 0) __hip_atomic_fetch_add(cnt + 64 * u.pm, 1u, __ATOMIC_RELAXED, __HIP_MEMORY_SCOPE_AGENT);
        if (wid == 0) {
            bool dead = false; const unsigned long long t0 = __builtin_amdgcn_s_memrealtime(); const unsigned want = 8u * (unsigned)ntn;
            for (;;) {
#if defined(BROKEN_EXCHANGE_NO_WAIT)
                break;
#endif
                if ((unsigned)__builtin_amdgcn_readfirstlane(__hip_atomic_load(cnt + 64 * u.pm, __ATOMIC_RELAXED, __HIP_MEMORY_SCOPE_AGENT)) >= want) break;
                if (__builtin_amdgcn_s_memrealtime() - t0 > 2000000ull) {
                    if (lane == 0) { unsigned expect = 0u; __hip_atomic_compare_exchange_strong(tmo + 1, &expect, code | (unsigned)(u.pm & 0xff), __ATOMIC_RELAXED, __ATOMIC_RELAXED, __HIP_MEMORY_SCOPE_AGENT);
                                     __hip_atomic_store(tmo, 1u, __ATOMIC_RELAXED, __HIP_MEMORY_SCOPE_AGENT); }
                    dead = true; break; }
                __builtin_amdgcn_s_sleep(2);
            }
            __builtin_amdgcn_fence(__ATOMIC_ACQUIRE, "agent");
            if (lane == 0) flag[0] = dead ? 1u : 0u;
        }
        asm volatile("s_waitcnt vmcnt(0) lgkmcnt(0)" ::: "memory"); __builtin_amdgcn_s_barrier(); asm volatile("" ::: "memory");
        const bool bad = flag[0] != 0u;
        if (lane < 32) {
            const unsigned long long* slot = (const unsigned long long*)xbuf + (size_t)(u.pm * BM + row) * 4; float mt[4], m2[4]; float ms = 0.f;
#pragma unroll
            for (int t = 0; t < 4; ++t) { if (t < ntn) { const unsigned long long w = __hip_atomic_load(slot + t, __ATOMIC_RELAXED, __HIP_MEMORY_SCOPE_AGENT); mt[t] = __uint_as_float((unsigned)w); m2[t] = __uint_as_float((unsigned)(w >> 32)); } else { mt[t] = 0.f; m2[t] = 0.f; } ms += mt[t]; }
            const float mean = ms / (float)ntn; float q = 0.f;
#pragma unroll
            for (int t = 0; t < 4; ++t) if (t < ntn) { const float dm = mt[t] - mean; q += m2[t] + 256.0f * dm * dm; }
            S[row] = (f32x2v){mean, 1.0f / sqrtf(q / (256.0f * (float)ntn) + eps)};
        }
        asm volatile("s_waitcnt lgkmcnt(0)" ::: "memory"); __builtin_amdgcn_s_barrier(); asm volatile("" ::: "memory");
        return bad;
    }
};
struct EpiLnRes {
    static constexpr bool PERM = false, AFTER_DRAIN = true;
    const float* base; float* out; int ldc; const float* bias; PanelStats st; unsigned poison;
    __device__ __forceinline__ void fused(f32x4 (&acc)[2][2][4][2], const Unit& u, int wr, int wc, int fr, int fq, PG8_LAS unsigned char* lds, int wid, int lane) const {
        typedef float f32x2v __attribute__((ext_vector_type(2)));
        const PG8_LAS f32x2v* S = (const PG8_LAS f32x2v*)(lds + 8192);
        const int col0 = u.pn * BM + wc * 32 + 4 * fq;
#pragma unroll
        for (int bj = 0; bj < 2; ++bj)
#pragma unroll
            for (int n = 0; n < 2; ++n) { const f32x4 bv = bias ? *(const f32x4*)(bias + col0 + bj * HALF + n * 16) : (f32x4){0.f, 0.f, 0.f, 0.f};
#pragma unroll
                for (int ai = 0; ai < 2; ++ai)
#pragma unroll
                    for (int m = 0; m < 4; ++m) acc[ai][bj][m][n] += bv; }
        f32x4 pre[4][2][2];
#pragma unroll
        for (int m = 0; m < 4; ++m) { const size_t off = (size_t)(u.pm * BM + wr * 64 + m * 16 + fr) * ldc + col0;
#pragma unroll
            for (int bj = 0; bj < 2; ++bj)
#pragma unroll
                for (int n = 0; n < 2; ++n) pre[m][bj][n] = *(const f32x4*)(base + off + bj * HALF + n * 16); }
        const bool bad = st.run(acc, u, wr, wc, fr, fq, lds, wid, lane) || poison != 0u;
        const float qnan = __builtin_nanf("");
#pragma unroll
        for (int ai = 0; ai < 2; ++ai)
#pragma unroll
            for (int m = 0; m < 4; ++m) { const int r = ai * HALF + wr * 64 + m * 16 + fr; const f32x2v sr = S[r]; const size_t off = (size_t)(u.pm * BM + r) * ldc + col0;
#pragma unroll
                for (int bj = 0; bj < 2; ++bj)
#pragma unroll
                    for (int n = 0; n < 2; ++n) { const f32x4 bs = ai == 0 ? pre[m][bj][n] : *(const f32x4*)(base + off + bj * HALF + n * 16); f32x4 o = bs + (acc[ai][bj][m][n] - sr.x) * sr.y;
                        if (bad) o = (f32x4){qnan, qnan, qnan, qnan}; *(f32x4*)(out + off + bj * HALF + n * 16) = o; }
                if (m & 1) asm volatile("" ::: "memory"); }
    }
};
struct EpiLnResLn {
    static constexpr bool PERM = false, AFTER_DRAIN = true;
    const float* base; float* out; bf16_t* xn; int ldc; const float* bias; PanelStats st1, st2; unsigned poison;
    __device__ __forceinline__ void fused(f32x4 (&acc)[2][2][4][2], const Unit& u, int wr, int wc, int fr, int fq, PG8_LAS unsigned char* lds, int wid, int lane) const {
        typedef float f32x2v __attribute__((ext_vector_type(2))); typedef unsigned u32x2v __attribute__((ext_vector_type(2)));
        const PG8_LAS f32x2v* S = (const PG8_LAS f32x2v*)(lds + 8192);
        const int col0 = u.pn * BM + wc * 32 + 4 * fq;
#pragma unroll
        for (int bj = 0; bj < 2; ++bj)
#pragma unroll
            for (int n = 0; n < 2; ++n) { const f32x4 bv = bias ? *(const f32x4*)(bias + col0 + bj * HALF + n * 16) : (f32x4){0.f, 0.f, 0.f, 0.f};
#pragma unroll
                for (int ai = 0; ai < 2; ++ai)
#pragma unroll
                    for (int m = 0; m < 4; ++m) acc[ai][bj][m][n] += bv; }
        bool bad = st1.run(acc, u, wr, wc, fr, fq, lds, wid, lane) || poison != 0u;
        const float qnan = __builtin_nanf("");
#pragma unroll
        for (int ai = 0; ai < 2; ++ai)
#pragma unroll
            for (int m = 0; m < 4; ++m) { const int r = ai * HALF + wr * 64 + m * 16 + fr; const f32x2v sr = S[r]; const size_t off = (size_t)(u.pm * BM + r) * ldc + col0;
#pragma unroll
                for (int bj = 0; bj < 2; ++bj)
#pragma unroll
                    for (int n = 0; n < 2; ++n) { const f32x4 bs = *(const f32x4*)(base + off + bj * HALF + n * 16); acc[ai][bj][m][n] = bs + (acc[ai][bj][m][n] - sr.x) * sr.y; }
                asm volatile("" : "+v"(acc[ai][0][m][0]), "+v"(acc[ai][0][m][1]), "+v"(acc[ai][1][m][0]), "+v"(acc[ai][1][m][1]));
                if (m & 1) asm volatile("" ::: "memory"); }
        const bool bad1 = bad;
        bad = st2.run(acc, u, wr, wc, fr, fq, lds, wid, lane) || bad;
#pragma unroll
        for (int ai = 0; ai < 2; ++ai)
#pragma unroll
            for (int m = 0; m < 4; ++m) { const int r = ai * HALF + wr * 64 + m * 16 + fr; const f32x2v sr = S[r]; const size_t off = (size_t)(u.pm * BM + r) * ldc + col0;
#pragma unroll
                for (int bj = 0; bj < 2; ++bj)
#pragma unroll
                    for (int n = 0; n < 2; ++n) { const f32x4 x1 = acc[ai][bj][m][n]; *(f32x4*)(out + off + bj * HALF + n * 16) = bad1 ? (f32x4){qnan, qnan, qnan, qnan} : x1;
                        const f32x4 o = (x1 - sr.x) * sr.y; u32x2v w; w.x = cvt_pk_bf16(o[0], o[1]); w.y = cvt_pk_bf16(o[2], o[3]);
                        if (bad) { w.x = 0x7fc07fc0u; w.y = 0x7fc07fc0u; } *(u32x2v*)(xn + off + bj * HALF + n * 16) = w; }
                asm volatile("" ::: "memory"); }
    }
};

typedef int pg8_v8i __attribute__((ext_vector_type(8)));
typedef short pg8_s16 __attribute__((ext_vector_type(16)));
__device__ __forceinline__ pg8_v8i cat8(const bf16x8 (&x)[2]) { return __builtin_bit_cast(pg8_v8i, __builtin_shufflevector(x[0], x[1], 0, 1, 2, 3, 4, 5, 6, 7, 8, 9, 10, 11, 12, 13, 14, 15)); }
template <bool F8> __device__ __forceinline__ void mma_pair(f32x4& c, const bf16x8 (&b)[2], const bf16x8 (&a)[2]) {
    if constexpr (F8) { c = __builtin_amdgcn_mfma_scale_f32_16x16x128_f8f6f4(cat8(b), cat8(a), c, 0, 0, 0, 0x7F7F7F7F, 0, 0x7F7F7F7F); }
    else { c = __builtin_amdgcn_mfma_f32_16x16x32_bf16(b[0], a[0], c, 0, 0, 0); c = __builtin_amdgcn_mfma_f32_16x16x32_bf16(b[1], a[1], c, 0, 0, 0); }
}
template <class Epi, class Sched, bool ALIGN_EPI = false, bool SP2 = false, bool GATHER = false, bool F8 = false>
__device__ __forceinline__ void gemm_phase(PG8_LAS unsigned char* lds, const Gemm g, const Sched& S, const Epi& E, const int tid_in, const PG8_LAS int* gtok = nullptr) {
    int tid_l = tid_in; asm volatile("" : "+v"(tid_l));
    const int tid = tid_l, wid = __builtin_amdgcn_readfirstlane(tid >> 6), lane = tid & 63, wr = wid >> 2, wc = wid & 3, fr = lane & 15, fq = lane >> 4;
    const bf16_t* gA_l = g.A; const bf16_t* gB_l = g.Bt; asm volatile("" : "+s"(gA_l), "+s"(gB_l));
    const int K = g.K, nt = K / BK;
    unsigned voffA[2], voffB[2], voffA1[2];
#pragma unroll
    for (int i = 0; i < 2; ++i) { int R, C; stage_rc(tid * 16 + i * 8192, R, C); const int Rb = Epi::PERM ? ((R & ~31) + perm32(R & 31)) : R;
        voffA[i] = (unsigned)(R * K + C) * 2u; voffB[i] = (unsigned)(Rb * K + C) * 2u; voffA1[i] = voffA[i]; }
    if constexpr (GATHER) {
#pragma unroll
        for (int i = 0; i < 2; ++i) { int R, C; stage_rc(tid * 16 + i * 8192, R, C); voffA[i] = (unsigned)(gtok[R] * K + C) * 2u; voffA1[i] = (unsigned)(gtok[HALF + R] * K + C) * 2u; } }
    const size_t kstep = (size_t)(BK * 2);
    const size_t hstep = (size_t)HALF * K * 2;
    const size_t hsA = GATHER ? (size_t)0 : hstep;
    const size_t tstep = 2 * hstep;
    const unsigned ldsw = (unsigned)wid * 1024u;
    const int aoff = lds_byte(wr * 64 + fr, fq * 8), boff = lds_byte(wc * 32 + fr, fq * 8);
#define PG8_SA(b, h) (((b) * 2 + (h)) * HTB)
#define PG8_SB(b, h) ((4 + (b) * 2 + (h)) * HTB)
#define PG8_STAGE(bufoff, gbase, voff) do { _Pragma("unroll") for (int _i = 0; _i < 2; ++_i) \
        __builtin_amdgcn_global_load_lds((const unsigned*)((const char*)(gbase) + (voff)[_i]), (PG8_LAS unsigned*)(lds + (bufoff) + ldsw + _i * 8192), 16, 0, 0); } while (0)
#define PG8_LDA(dst, b, h) do { _Pragma("unroll") for (int m = 0; m < 4; ++m) _Pragma("unroll") for (int k = 0; k < 2; ++k) dst[m][k] = *(const PG8_LAS bf16x8*)(lds + PG8_SA(b, h) + aoff + m * 2048 + k * 1024); } while (0)
#define PG8_LDB(dst, b, h) do { _Pragma("unroll") for (int n = 0; n < 2; ++n) _Pragma("unroll") for (int k = 0; k < 2; ++k) dst[n][k] = *(const PG8_LAS bf16x8*)(lds + PG8_SB(b, h) + boff + n * 2048 + k * 1024); } while (0)
#define PG8_MMA(ai, bj, At, Bt) do { __builtin_amdgcn_s_setprio(1); _Pragma("unroll") for (int m = 0; m < 4; ++m) _Pragma("unroll") for (int n = 0; n < 2; ++n) \
        mma_pair<F8>(acc[ai][bj][m][n], Bt[n], At[m]); __builtin_amdgcn_s_setprio(0); } while (0)
#define PG8_WAIT_V(n) asm volatile("s_waitcnt vmcnt(" #n ")" ::: "memory")
#define PG8_WAIT_L(n) asm volatile("s_waitcnt lgkmcnt(" #n ")" ::: "memory")
#define PG8_BAR __builtin_amdgcn_s_barrier()
#define PG8_SCHED __builtin_amdgcn_sched_barrier(0)
    Unit cur, nxt; int ui = 0;
    if (!S.next(0, cur)) return;
    f32x4 acc[2][2][4][2];
#pragma unroll
    for (int a = 0; a < 2; ++a)
#pragma unroll
        for (int b = 0; b < 2; ++b)
#pragma unroll
            for (int m = 0; m < 4; ++m)
#pragma unroll
                for (int n = 0; n < 2; ++n) acc[a][b][m][n] = (f32x4){0.f, 0.f, 0.f, 0.f};
    bf16x8 At[4][2], B0[2][2], B1[2][2];
    const char* cA = (const char*)gA_l + (GATHER ? (size_t)0 : (size_t)cur.pm * tstep); const char* cB = (const char*)gB_l + (size_t)cur.pn * tstep;
    S.a_ready(cur);
    if constexpr (SP2) {
        PG8_STAGE(PG8_SB(0, 0), cB, voffB); PG8_STAGE(PG8_SB(0, 1), cB + hstep, voffB); PG8_STAGE(PG8_SA(0, 0), cA, voffA); PG8_STAGE(PG8_SA(0, 1), cA + hsA, voffA1);
        if (wr == 1) PG8_BAR;
        PG8_WAIT_V(2); PG8_BAR;
        PG8_STAGE(PG8_SB(1, 0), cB + kstep, voffB); PG8_STAGE(PG8_SA(1, 0), cA + kstep, voffA); PG8_STAGE(PG8_SB(1, 1), cB + hstep + kstep, voffB);
        PG8_WAIT_V(6); PG8_BAR;
    } else {
        PG8_STAGE(PG8_SB(0, 0), cB, voffB); PG8_STAGE(PG8_SA(0, 0), cA, voffA); PG8_STAGE(PG8_SB(0, 1), cB + hstep, voffB); PG8_STAGE(PG8_SA(0, 1), cA + hsA, voffA1);
        if (wr == 1) PG8_BAR;
        PG8_WAIT_V(4); PG8_BAR;
        PG8_STAGE(PG8_SB(1, 0), cB + kstep, voffB); PG8_STAGE(PG8_SA(1, 0), cA + kstep, voffA); PG8_STAGE(PG8_SB(1, 1), cB + hstep + kstep, voffB);
        PG8_WAIT_V(6); PG8_BAR;
    }
    for (;;) {
        const bool has_next = S.next(ui + 1, nxt);
        const char* nA = (has_next && !GATHER) ? (const char*)gA_l + (size_t)nxt.pm * tstep : cA; const char* nB = has_next ? (const char*)gB_l + (size_t)nxt.pn * tstep : cB;
#pragma nounroll
        for (int t = 0; t < nt; t += 2) {
            const bool last = (t == nt - 2);
            const char* a1 = cA + (size_t)(t + 1) * kstep;
            const char* a2 = last ? nA : cA + (size_t)(t + 2) * kstep; const char* b2 = last ? nB : cB + (size_t)(t + 2) * kstep;
            const char* a3 = a2 + kstep; const char* b3 = b2 + kstep;
            if (last && has_next) S.a_ready(nxt);
            if constexpr (SP2) {
            PG8_LDB(B0, 0, 0); PG8_LDB(B1, 0, 1); PG8_SCHED; PG8_LDA(At, 0, 0); PG8_STAGE(PG8_SA(1, 1), a1 + hsA, voffA1);
            if constexpr (GATHER) { if (last && has_next) {
                const PG8_LAS int* nt_ = gtok + (ui + 1) * BM;
#pragma unroll
                for (int i = 0; i < 2; ++i) { int R, C; stage_rc(tid * 16 + i * 8192, R, C); voffA[i] = (unsigned)(nt_[R] * K + C) * 2u; voffA1[i] = (unsigned)(nt_[HALF + R] * K + C) * 2u; } } }
            PG8_WAIT_V(8); PG8_WAIT_L(0); PG8_BAR; PG8_MMA(0, 0, At, B0); PG8_MMA(0, 1, At, B1); PG8_BAR; PG8_SCHED;
            PG8_LDA(At, 0, 1); PG8_STAGE(PG8_SB(0, 0), b2, voffB); PG8_STAGE(PG8_SB(0, 1), b2 + hstep, voffB); PG8_STAGE(PG8_SA(0, 0), a2, voffA);
            PG8_WAIT_V(8); PG8_WAIT_L(0); PG8_BAR; PG8_MMA(1, 0, At, B0); PG8_MMA(1, 1, At, B1); PG8_BAR; PG8_SCHED;
            PG8_LDB(B0, 1, 0); PG8_LDB(B1, 1, 1); PG8_SCHED; PG8_LDA(At, 1, 0); PG8_STAGE(PG8_SA(0, 1), a2 + hsA, voffA1);
            PG8_WAIT_V(8); PG8_WAIT_L(0); PG8_BAR; PG8_MMA(0, 0, At, B0); PG8_MMA(0, 1, At, B1); PG8_BAR; PG8_SCHED;
            PG8_LDA(At, 1, 1); PG8_STAGE(PG8_SB(1, 0), b3, voffB); PG8_STAGE(PG8_SB(1, 1), b3 + hstep, voffB); PG8_STAGE(PG8_SA(1, 0), a3, voffA);
            PG8_WAIT_V(8); PG8_WAIT_L(0); PG8_BAR; PG8_MMA(1, 0, At, B0); PG8_MMA(1, 1, At, B1); PG8_BAR; PG8_SCHED;
            } else {
            PG8_LDB(B0, 0, 0); PG8_SCHED; PG8_LDA(At, 0, 0); PG8_STAGE(PG8_SA(1, 1), a1 + hsA, voffA1);
            PG8_WAIT_L(8); PG8_BAR; PG8_WAIT_L(0); PG8_MMA(0, 0, At, B0); PG8_BAR; PG8_SCHED;
            PG8_LDB(B1, 0, 1); PG8_STAGE(PG8_SB(0, 0), b2, voffB);
            PG8_BAR; PG8_WAIT_L(0); PG8_MMA(0, 1, At, B1); PG8_BAR;
            PG8_LDA(At, 0, 1); PG8_STAGE(PG8_SA(0, 0), a2, voffA);
            PG8_BAR; PG8_WAIT_L(0); PG8_MMA(1, 0, At, B0); PG8_BAR; PG8_SCHED;
            PG8_STAGE(PG8_SB(0, 1), b2 + hstep, voffB);
            PG8_WAIT_V(6); PG8_BAR; PG8_MMA(1, 1, At, B1); PG8_BAR;
            PG8_LDB(B0, 1, 0); PG8_SCHED; PG8_LDA(At, 1, 0); PG8_STAGE(PG8_SA(0, 1), a2 + hsA, voffA1);
            PG8_WAIT_L(8); PG8_BAR; PG8_WAIT_L(0); PG8_MMA(0, 0, At, B0); PG8_BAR; PG8_SCHED;
            PG8_LDB(B1, 1, 1); PG8_STAGE(PG8_SB(1, 0), b3, voffB);
            PG8_BAR; PG8_WAIT_L(0); PG8_MMA(0, 1, At, B1); PG8_BAR;
            PG8_LDA(At, 1, 1); PG8_STAGE(PG8_SA(1, 0), a3, voffA);
            PG8_BAR; PG8_WAIT_L(0); PG8_MMA(1, 0, At, B0); PG8_BAR; PG8_SCHED;
            PG8_STAGE(PG8_SB(1, 1), b3 + hstep, voffB);
            PG8_WAIT_V(6); PG8_BAR; PG8_MMA(1, 1, At, B1); PG8_BAR;
            }
        }
        if constexpr (ALIGN_EPI) { if (wr == 0) PG8_BAR; }
        if constexpr (!Epi::AFTER_DRAIN) { E(acc, cur, wr, wc, fr, fq); S.done(cur); }
        if (!has_next) break;
#pragma unroll
        for (int a = 0; a < 2; ++a)
#pragma unroll
            for (int b = 0; b < 2; ++b)
#pragma unroll
                for (int m = 0; m < 4; ++m)
#pragma unroll
                    for (int n = 0; n < 2; ++n) acc[a][b][m][n] = (f32x4){0.f, 0.f, 0.f, 0.f};
        cur = nxt; cA = nA; cB = nB; ++ui;
        if constexpr (ALIGN_EPI) { if (wr == 1) PG8_BAR; }
    }
    PG8_WAIT_V(0);
    if constexpr (!ALIGN_EPI) { if (wr == 0) PG8_BAR; }
    PG8_BAR;
    if constexpr (Epi::AFTER_DRAIN) { E.fused(acc, cur, wr, wc, fr, fq, lds, wid, lane); S.done(cur); }
#undef PG8_SA
#undef PG8_SB
#undef PG8_STAGE
#undef PG8_LDA
#undef PG8_LDB
#undef PG8_MMA
#undef PG8_WAIT_V
#undef PG8_WAIT_L
#undef PG8_BAR
#undef PG8_SCHED
}
}
namespace attn_body {
using bf16=__hip_bfloat16;
using bf16x8=__attribute__((ext_vector_type(8)))short;
using s16x4=__attribute__((ext_vector_type(4)))short;
using f32x16=__attribute__((ext_vector_type(16)))float;
using u32x4=__attribute__((ext_vector_type(4)))unsigned;
constexpr int SEQ=4096,D=64,DM=2816,OPITCH=1024;
constexpr int NW=8,QBLK=32,QB=QBLK*NW,KVBLK=64,NQB=SEQ/QB;
constexpr int ATTN_PITCH=DM, ATTN_UNIT_ROWS=QB;
__device__ __forceinline__ int crow(int r,int hi){return (r&3)+8*(r>>2)+4*hi;}
#define SBAR() __builtin_amdgcn_sched_barrier(0)
__device__ __forceinline__ void cmask(f32x16&p0,f32x16&p1,int jb,int qrel,int hi){
  const float NEG=-INFINITY; int kb=64*jb+4*hi;
  #pragma unroll
  for(int r=0;r<16;++r){int kv=kb+(r&3)+8*(r>>2); if(kv>qrel)p0[r]=NEG; if(kv+32>qrel)p1[r]=NEG;}
}

constexpr int NSLOT=3, SLOTB=8192;
constexpr int LDS_K=0, LDS_V=NSLOT*SLOTB, LDS_WS=2*NSLOT*SLOTB, LDS_OST=LDS_WS+NW*64*4, LDS_BYTES=LDS_OST+NW*4096;
constexpr float C2=0.125f*1.4426950408889634f;
__device__ __forceinline__ void glds16(const void*gsrc,unsigned lds_dst){unsigned keep;
  asm volatile("s_mov_b32 %0, m0\n\ts_mov_b32 m0, %2\n\ts_nop 0\n\tglobal_load_lds_dwordx4 %1, off\n\ts_mov_b32 m0, %0":"=&s"(keep):"v"(gsrc),"s"(lds_dst):"memory");}
__device__ __forceinline__ float max3f(float a,float b,float c){float r;asm("v_max3_f32 %0, %1, %2, %3":"=v"(r):"v"(a),"v"(b),"v"(c));return r;}
__device__ __forceinline__ float max2f(float a,float b){float r;asm("v_max_f32_e32 %0, %1, %2":"=v"(r):"v"(a),"v"(b));return r;}
__device__ __forceinline__ float fadd_s(float a,float b){float r;asm("v_add_f32_e32 %0, %1, %2":"=v"(r):"v"(a),"v"(b));return r;}
__device__ __forceinline__ float fsub_s(float a,float b){float r;asm("v_sub_f32_e32 %0, %1, %2":"=v"(r):"v"(a),"v"(b));return r;}
typedef float f32x2_t __attribute__((ext_vector_type(2))); typedef __bf16 bf16x2_t __attribute__((ext_vector_type(2)));
__device__ __forceinline__ unsigned cvtpk_s(float lo,float hi){f32x2_t v={lo,hi};bf16x2_t b=__builtin_convertvector(v,bf16x2_t);return __builtin_bit_cast(unsigned,b);}
#define WAIT_BAR(N) asm volatile("s_waitcnt vmcnt(" #N ") lgkmcnt(0)\n\ts_barrier":::"memory")

__device__ __forceinline__ void qkt(f32x16&p0,f32x16&p1,const char*Kslot,const bf16x8*qr,const f32x16&negm,int r32,int hi){
  const char*kb=Kslot+hi*1024+r32*16;
  #pragma unroll
  for(int d0=0;d0<4;++d0){
    const bf16x8 b0=*reinterpret_cast<const bf16x8*>(kb+d0*2048);
    const bf16x8 b1=*reinterpret_cast<const bf16x8*>(kb+d0*2048+512);
    if(d0==0){p0=__builtin_amdgcn_mfma_f32_32x32x16_bf16(b0,qr[0],negm,0,0,0);p1=__builtin_amdgcn_mfma_f32_32x32x16_bf16(b1,qr[0],negm,0,0,0);}
    else{p0=__builtin_amdgcn_mfma_f32_32x32x16_bf16(b0,qr[d0],p0,0,0,0);p1=__builtin_amdgcn_mfma_f32_32x32x16_bf16(b1,qr[d0],p1,0,0,0);}}
}
typedef __attribute__((address_space(3))) const char* lds_cptr;
typedef short v4i16_t __attribute__((ext_vector_type(4)));
__device__ __forceinline__ void kload8(bf16x8*kf,lds_cptr kp){
  kf[0]=*(const __attribute__((address_space(3))) bf16x8*)(kp);      kf[1]=*(const __attribute__((address_space(3))) bf16x8*)(kp+512);
  kf[2]=*(const __attribute__((address_space(3))) bf16x8*)(kp+2048); kf[3]=*(const __attribute__((address_space(3))) bf16x8*)(kp+2560);
  kf[4]=*(const __attribute__((address_space(3))) bf16x8*)(kp+4096); kf[5]=*(const __attribute__((address_space(3))) bf16x8*)(kp+4608);
  kf[6]=*(const __attribute__((address_space(3))) bf16x8*)(kp+6144); kf[7]=*(const __attribute__((address_space(3))) bf16x8*)(kp+6656);
}
__device__ __forceinline__ void kload2(bf16x8*kf,lds_cptr kp,int j){ kf[2*j]=*(const __attribute__((address_space(3))) bf16x8*)(kp+j*2048); kf[2*j+1]=*(const __attribute__((address_space(3))) bf16x8*)(kp+j*2048+512); }
__device__ __forceinline__ int ksoff(int r32,int hi,int d0,int half){ return (r32>>3)*1024+((hi^((r32>>3)&1))*128)+(r32&7)*16+d0*256+half*4096; }
__device__ __forceinline__ void qkt_s(f32x16&p0,f32x16&p1,const char*Kslot,const bf16x8*qr,const f32x16&negm,int r32,int hi){
  #pragma unroll
  for(int d0=0;d0<4;++d0){
    const bf16x8 b0=*reinterpret_cast<const bf16x8*>(Kslot+ksoff(r32,hi,d0,0));
    const bf16x8 b1=*reinterpret_cast<const bf16x8*>(Kslot+ksoff(r32,hi,d0,1));
    if(d0==0){p0=__builtin_amdgcn_mfma_f32_32x32x16_bf16(b0,qr[0],negm,0,0,0);p1=__builtin_amdgcn_mfma_f32_32x32x16_bf16(b1,qr[0],negm,0,0,0);}
    else{p0=__builtin_amdgcn_mfma_f32_32x32x16_bf16(b0,qr[d0],p0,0,0,0);p1=__builtin_amdgcn_mfma_f32_32x32x16_bf16(b1,qr[d0],p1,0,0,0);}}
}
__device__ __forceinline__ void kload2_s(bf16x8*kf,lds_cptr ks,int j,int r32,int hi){ kf[2*j]=*(const __attribute__((address_space(3))) bf16x8*)(ks+ksoff(r32,hi,j,0)); kf[2*j+1]=*(const __attribute__((address_space(3))) bf16x8*)(ks+ksoff(r32,hi,j,1)); }
__device__ __forceinline__ void kload8_s(bf16x8*kf,lds_cptr ks,int r32,int hi){ kload2_s(kf,ks,0,r32,hi); kload2_s(kf,ks,1,r32,hi); kload2_s(kf,ks,2,r32,hi); kload2_s(kf,ks,3,r32,hi); }
__device__ __forceinline__ s16x4 vtr(lds_cptr p){ return __builtin_bit_cast(s16x4,__builtin_amdgcn_ds_read_tr16_b64_v4i16((__attribute__((address_space(3))) v4i16_t*)p)); }
__device__ __forceinline__ float rowmax(const f32x16&p0,const f32x16&p1){
  float a=max3f(p0[0],p0[1],p1[0]),b=max3f(p0[2],p0[3],p1[1]);a=max3f(a,p1[2],p1[3]);
  #pragma unroll
  for(int r=4;r<16;r+=4){a=max3f(a,p0[r],p0[r+1]);b=max3f(b,p0[r+2],p0[r+3]);a=max3f(a,p1[r],p1[r+1]);b=max3f(b,p1[r+2],p1[r+3]);}
  const float m=max2f(a,b);
  auto rr=__builtin_amdgcn_permlane32_swap(__float_as_uint(m),__float_as_uint(m),false,false);
  return max2f(__uint_as_float(rr[0]),__uint_as_float(rr[1]));
}
__device__ __forceinline__ void pv(f32x16*o,int vb,bf16x8 pa0,bf16x8 pa1,bf16x8 pa2,bf16x8 pa3){
  #pragma unroll
  for(int d0=0;d0<2;++d0){s16x4 lo[4],hi[4];
    #pragma unroll
    for(int ks=0;ks<4;++ks){
      asm volatile("ds_read_b64_tr_b16 %0,%1 offset:%c2":"=&v"(lo[ks]):"v"(vb),"i"(d0*4096+ks*1024):"memory");
      asm volatile("ds_read_b64_tr_b16 %0,%1 offset:%c2":"=&v"(hi[ks]):"v"(vb),"i"(d0*4096+ks*1024+512):"memory");}
    asm volatile("s_waitcnt lgkmcnt(0)":::"memory");SBAR();
    #define PK(k) (bf16x8){lo[k][0],lo[k][1],lo[k][2],lo[k][3],hi[k][0],hi[k][1],hi[k][2],hi[k][3]}
    o[d0]=__builtin_amdgcn_mfma_f32_32x32x16_bf16(pa0,PK(0),o[d0],0,0,0);
    o[d0]=__builtin_amdgcn_mfma_f32_32x32x16_bf16(pa1,PK(1),o[d0],0,0,0);
    o[d0]=__builtin_amdgcn_mfma_f32_32x32x16_bf16(pa2,PK(2),o[d0],0,0,0);
    o[d0]=__builtin_amdgcn_mfma_f32_32x32x16_bf16(pa3,PK(3),o[d0],0,0,0);
    #undef PK
  }
}

#ifndef ATTN_STORE16
#define ATTN_STORE16(p,v) (*(u32x4*)(p)=(v))
#endif
template<int THRL> __device__ __forceinline__ void attn_unit(int b,int h,int kvh,int qb,const bf16*Q,const bf16*__restrict__ K,const bf16*__restrict__ V,bf16*O,char*shm,int lane,int wid){
  const int r32=lane&31,hi=lane>>5;
  const long rowbase=(long)b*SEQ; const int q0=qb*QB;
  const bf16*Qw=Q+(rowbase+q0+wid*QBLK)*DM+h*D;
  const bf16*Kh=K+rowbase*DM+kvh*D,*Vh=V+rowbase*DM+kvh*D;
  const unsigned lds0=(unsigned)(uintptr_t)shm;
  float*wsf=(float*)(shm+LDS_WS)+wid*64;
  const bf16*ksrc=Kh+(long)(8*wid+(lane&7))*DM+((lane>>3)^(wid&1))*8;
  const bf16*vsrc=Vh+(long)(16*(wid&3)+(lane>>2))*DM+(wid>>2)*32+(lane&3)*8;
  const unsigned kdst=lds0+LDS_K+wid*1024, vdst=lds0+LDS_V+wid*1024;
  #define DMA_K(t,slot) glds16(ksrc+(long)(t)*KVBLK*DM,(unsigned)__builtin_amdgcn_readfirstlane(kdst+(slot)))
  #define DMA_V(t,slot) glds16(vsrc+(long)(t)*KVBLK*DM,(unsigned)__builtin_amdgcn_readfirstlane(vdst+(slot)))
  const int vb0=(int)(lds0+LDS_V)+((lane>>4)&1)*32+(lane&3)*8+(4*hi+((lane&15)>>2))*64;
  const char*Kbase=shm+LDS_K; bf16x8 kf[8];
  const lds_cptr shm3=(lds_cptr)shm; const lds_cptr kp0=shm3+LDS_K+hi*1024+r32*16; const lds_cptr vp0=shm3+LDS_V+((lane>>4)&1)*32+(lane&3)*8+(4*hi+((lane&15)>>2))*64;
  constexpr int NT=SEQ/KVBLK;
  DMA_K(0,0);DMA_V(0,0);DMA_K(1,SLOTB);
  bf16x8 qr[4];
  #pragma unroll
  for(int d0=0;d0<4;++d0)qr[d0]=*reinterpret_cast<const bf16x8*>(&Qw[(long)r32*DM+d0*16+hi*8]);
  float zz_;asm volatile("v_mov_b32 %0, 0":"=v"(zz_));
  float mhat=zz_,l_reg=zz_;f32x16 o[2];f32x16 negm;
  _Pragma("unroll") for(int r=0;r<16;++r){o[0][r]=zz_;o[1][r]=zz_;negm[r]=zz_;} asm volatile("":"+v"(negm));
  #define CMASK(P0,P1,t) do{}while(0)
  bool resc=false;
  #define START(P0,P1) do{ const float rm=rowmax(P0,P1); resc=false; \
    { const float dl=rm; mhat=fadd_s(mhat,dl); \
      _Pragma("unroll") for(int r=0;r<16;++r){P0[r]=fsub_s(P0[r],dl);P1[r]=fsub_s(P1[r],dl);} \
      _Pragma("unroll") for(int r=0;r<16;++r)negm[r]=-mhat; asm volatile("":"+v"(negm)); } \
    _Pragma("unroll") for(int r=0;r<16;++r)P0[r]=__builtin_amdgcn_exp2f(P0[r]); }while(0)
  #define RESC() do{ if(resc){ asm volatile("s_waitcnt lgkmcnt(0)":::"memory"); \
      _Pragma("unroll") for(int d_=0;d_<2;++d_) _Pragma("unroll") for(int r=0;r<16;++r)o[d_][r]*=wsf[crow(r,hi)]; } }while(0)
  f32x16 pA0,pA1,pB0,pB1;
  int sl_prev=0,sl_cur=0,sl_next=SLOTB;
  #define ROT() do{sl_prev=sl_cur;sl_cur=sl_next;sl_next=(sl_next==(NSLOT-1)*SLOTB)?0:sl_next+SLOTB;}while(0)
  DMA_K(2,2*SLOTB);
  WAIT_BAR(3);
  qkt_s(pA0,pA1,Kbase,qr,negm,r32,hi);asm volatile("s_nop 15\n\ts_nop 7":"+v"(pA0),"+v"(pA1));CMASK(pA0,pA1,0);
  START(pA0,pA1);
  _Pragma("unroll") for(int r=0;r<16;++r)pA1[r]=__builtin_amdgcn_exp2f(pA1[r]);
  WAIT_BAR(0);
  DMA_K(3,0);DMA_V(1,SLOTB);
  ROT();
  kload8_s(kf,shm3+LDS_K+sl_cur,r32,hi);
  WAIT_BAR(2);
  s16x4 vlo[8],vhi[8]; u32x4 pw0,pw1,pw2,pw3;
  #define PKW(P,B) cvtpk_s(P[B],P[B+1])
  #define PAF(k) __builtin_bit_cast(bf16x8,pw##k)
  #define VFR(i) (bf16x8){vlo[i][0],vlo[i][1],vlo[i][2],vlo[i][3],vhi[i][0],vhi[i][1],vhi[i][2],vhi[i][3]}
  #define PIN(x) asm volatile("":"+v"(x))
  #define MX3(a,b,c) __builtin_fmaxf(__builtin_fmaxf((a),(b)),(c))
  #define GAPA(MF,A0,A1,A2,A3,W0,W1,PW) do{ MF; sacc+=A0; sacc+=A1; sacc+=A2; sacc+=A3; PIN(sacc); W0; W1; PIN(PW); SBAR(); }while(0)
  #define EX(v) __builtin_amdgcn_exp2f(v)
  #define GAPB(MF,X,B) do{ MF; X[B]=EX(X[B]); X[B+1]=EX(X[B+1]); X[B+2]=EX(X[B+2]); X[B+3]=EX(X[B+3]); PIN(X); SBAR(); }while(0)
  #define VRD(i) do{ vlo[i]=vtr(vp_+(((i)>>2)*4096+((i)&3)*1024)); vhi[i]=vtr(vp_+(((i)>>2)*4096+((i)&3)*1024+512)); }while(0)
  #define KRD(G,j) do{ if(G){ kload2_s(kf,shm3+LDS_K+sl_next,j,r32,hi); SBAR(); } }while(0)
  #define STEP(C0,C1,P0,P1,t,GK,GV,GL) do{ SBAR(); \
    const lds_cptr vp_=vp0+sl_prev; \
    VRD(0); SBAR(); float sacc=(P0[0]+P0[1]); \
    GAPA(C0=__builtin_amdgcn_mfma_f32_32x32x16_bf16(kf[0],qr[0],negm,0,0,0), P0[2],P0[3],P0[4],P0[5],     pw0[0]=PKW(P0,0), pw0[1]=PKW(P0,2), pw0); \
    VRD(4); SBAR(); GAPA(C1=__builtin_amdgcn_mfma_f32_32x32x16_bf16(kf[1],qr[0],negm,0,0,0), P0[6],P0[7],P0[8],P0[9],     pw0[2]=PKW(P0,4), pw0[3]=PKW(P0,6), pw0); \
    VRD(1); SBAR(); GAPA(C0=__builtin_amdgcn_mfma_f32_32x32x16_bf16(kf[2],qr[1],C0,0,0,0),   P0[10],P0[11],P0[12],P0[13], pw1[0]=PKW(P0,8), pw1[1]=PKW(P0,10), pw1); \
    VRD(5); SBAR(); GAPA(C1=__builtin_amdgcn_mfma_f32_32x32x16_bf16(kf[3],qr[1],C1,0,0,0),   P0[14],P0[15],P1[0],P1[1],   pw1[2]=PKW(P0,12),pw1[3]=PKW(P0,14), pw1); \
    VRD(2); SBAR(); GAPA(C0=__builtin_amdgcn_mfma_f32_32x32x16_bf16(kf[4],qr[2],C0,0,0,0),   P1[2],P1[3],P1[4],P1[5],     pw2[0]=PKW(P1,0), pw2[1]=PKW(P1,2), pw2); \
    VRD(6); SBAR(); GAPA(C1=__builtin_amdgcn_mfma_f32_32x32x16_bf16(kf[5],qr[2],C1,0,0,0),   P1[6],P1[7],P1[8],P1[9],     pw2[2]=PKW(P1,4), pw2[3]=PKW(P1,6), pw2); \
    VRD(3); SBAR(); GAPA(C0=__builtin_amdgcn_mfma_f32_32x32x16_bf16(kf[6],qr[3],C0,0,0,0),   P1[10],P1[11],P1[12],P1[13], pw3[0]=PKW(P1,8), pw3[1]=PKW(P1,10), pw3); \
    VRD(7); SBAR(); GAPA(C1=__builtin_amdgcn_mfma_f32_32x32x16_bf16(kf[7],qr[3],C1,0,0,0),   P1[14],P1[15],0.f,0.f,       pw3[2]=PKW(P1,12),pw3[3]=PKW(P1,14), pw3); \
    l_reg+=sacc; \
    if(GK){DMA_K((t)+3,sl_cur);} if(GV){DMA_V((t)+1,sl_next);} \
    CMASK(C0,C1,t); \
    { float a=MX3(C0[0],C0[1],C1[0]),b=MX3(C0[2],C0[3],C1[1]); a=MX3(a,C1[2],C1[3]); \
      _Pragma("unroll") for(int r=4;r<16;r+=4){a=MX3(a,C0[r],C0[r+1]);b=MX3(b,C0[r+2],C0[r+3]);a=MX3(a,C1[r],C1[r+1]);b=MX3(b,C1[r+2],C1[r+3]);} \
      float rm=__builtin_fmaxf(a,b); { auto rr=__builtin_amdgcn_permlane32_swap(__float_as_uint(rm),__float_as_uint(rm),false,false); rm=__builtin_fmaxf(__uint_as_float(rr[0]),__uint_as_float(rr[1])); } \
      resc=false; \
      if(__builtin_expect(__any(rm>(float)THRL),0)){ const float dl=__builtin_fmaxf(rm,0.f); mhat+=dl; \
        _Pragma("unroll") for(int r=0;r<16;++r){C0[r]-=dl;C1[r]-=dl;} \
        _Pragma("unroll") for(int r=0;r<16;++r)negm[r]=-mhat; asm volatile("":"+v"(negm)); \
        const float f=__builtin_amdgcn_exp2f(-dl); l_reg*=f; if(hi==0)wsf[r32]=f; resc=true; } } \
    SBAR(); \
    GAPB(o[0]=__builtin_amdgcn_mfma_f32_32x32x16_bf16(PAF(0),VFR(0),o[0],0,0,0), C0,0); \
    GAPB(o[1]=__builtin_amdgcn_mfma_f32_32x32x16_bf16(PAF(0),VFR(4),o[1],0,0,0), C0,4); \
    KRD(GL,0); GAPB(o[0]=__builtin_amdgcn_mfma_f32_32x32x16_bf16(PAF(1),VFR(1),o[0],0,0,0), C0,8); \
    KRD(GL,1); GAPB(o[1]=__builtin_amdgcn_mfma_f32_32x32x16_bf16(PAF(1),VFR(5),o[1],0,0,0), C0,12); \
    KRD(GL,2); GAPB(o[0]=__builtin_amdgcn_mfma_f32_32x32x16_bf16(PAF(2),VFR(2),o[0],0,0,0), C1,0); \
    KRD(GL,3); GAPB(o[1]=__builtin_amdgcn_mfma_f32_32x32x16_bf16(PAF(2),VFR(6),o[1],0,0,0), C1,4); \
    GAPB(o[0]=__builtin_amdgcn_mfma_f32_32x32x16_bf16(PAF(3),VFR(3),o[0],0,0,0), C1,8); \
    GAPB(o[1]=__builtin_amdgcn_mfma_f32_32x32x16_bf16(PAF(3),VFR(7),o[1],0,0,0), C1,12); \
    }while(0)
  int t=1;
  #undef CMASK
  #define CMASK(P0,P1,t) do{}while(0)
  for(;t+5<NT;t+=2){
    STEP(pB0,pB1,pA0,pA1,t,true,true,true);     WAIT_BAR(2); RESC(); ROT();
    STEP(pA0,pA1,pB0,pB1,t+1,true,true,true);   WAIT_BAR(2); RESC(); ROT();
  }
  #undef CMASK
  #define CMASK(P0,P1,t) do{}while(0)
  #define ENDW(tt) do{ if((tt)+3<NT){WAIT_BAR(2);} else if((tt)+2<NT){WAIT_BAR(1);} else {WAIT_BAR(0);} }while(0)
  for(;t+1<NT;t+=2){
    STEP(pB0,pB1,pA0,pA1,t,(t+3<NT),(t+1<NT),(t+1<NT));       ENDW(t);   RESC(); ROT();
    STEP(pA0,pA1,pB0,pB1,t+1,(t+4<NT),(t+2<NT),(t+2<NT));     ENDW(t+1); RESC(); ROT();
  }
  STEP(pB0,pB1,pA0,pA1,NT-1,false,false,false); RESC();
  { float sacc=pB0[0]+pB0[1]; _Pragma("unroll") for(int r=2;r<16;++r)sacc+=pB0[r]; _Pragma("unroll") for(int r=0;r<16;++r)sacc+=pB1[r]; l_reg+=sacc;
    pw0=(u32x4){PKW(pB0,0),PKW(pB0,2),PKW(pB0,4),PKW(pB0,6)};pw1=(u32x4){PKW(pB0,8),PKW(pB0,10),PKW(pB0,12),PKW(pB0,14)};pw2=(u32x4){PKW(pB1,0),PKW(pB1,2),PKW(pB1,4),PKW(pB1,6)};pw3=(u32x4){PKW(pB1,8),PKW(pB1,10),PKW(pB1,12),PKW(pB1,14)};
    SBAR(); pv(o,vb0+sl_cur,PAF(0),PAF(1),PAF(2),PAF(3)); }
  #undef PKW
  #undef PAF
  #undef VFR
  #undef PIN
  #undef MX3
  #undef GAPA
  #undef GAPB
  #undef EX
  #undef VRD
  #undef KRD
  #undef STEP
  #undef ENDW
  {auto rr=__builtin_amdgcn_permlane32_swap(__float_as_uint(l_reg),__float_as_uint(l_reg),false,false);l_reg=__uint_as_float(rr[0])+__uint_as_float(rr[1]);}
  if(hi==0)wsf[32+r32]=l_reg;asm volatile("s_waitcnt lgkmcnt(0)":::"memory");
  float rli[16];
  #pragma unroll
  for(int r=0;r<16;++r)rli[r]=__builtin_amdgcn_rcpf(wsf[32+crow(r,hi)]);
  bf16*Ow=O+(rowbase+q0+wid*QBLK)*OPITCH+h*D;
  { bf16*stg=(bf16*)(shm+LDS_OST)+wid*2048;
    #pragma unroll
    for(int r=0;r<16;++r){const int orow=crow(r,hi);
      #pragma unroll
      for(int d0=0;d0<2;++d0)stg[orow*64+d0*32+r32]=__float2bfloat16(o[d0][r]*rli[r]);}
    asm volatile("s_waitcnt lgkmcnt(0)":::"memory");
    #pragma unroll
    for(int i=0;i<4;++i){const int row=i*8+(lane>>3),ch=lane&7; const u32x4 v=*(const u32x4*)(stg+row*64+ch*8); ATTN_STORE16(Ow+(long)row*OPITCH+ch*8,v);} }
  asm volatile("s_waitcnt lgkmcnt(0)\n\ts_barrier":::"memory");
  #undef DMA_K
  #undef DMA_V
  #undef CMASK
  #undef START
  #undef RESC
  #undef ROT
}
template<class Var,int THRL> __device__ __forceinline__ void attn_unit_g(const Var&W,const bf16*Q,const bf16*__restrict__ K,const bf16*__restrict__ V,bf16*O,char*shm,int lane,int wid){
  const int r32=lane&31,hi=lane>>5;
  const unsigned lds0=(unsigned)(uintptr_t)shm;
  float*wsf=(float*)(shm+LDS_WS)+wid*64;
  const bf16*ksrc=K+wid*8;
  const bf16*vsrc=V+(wid>>2)*32+(lane&3)*8; const int vidx=16*(wid&3)+(lane>>2);
  const unsigned kdst=lds0+LDS_K+wid*1024, vdst=lds0+LDS_V+wid*1024;
  #define DMA_K(t,slot) glds16(ksrc+W.krow((t),lane)*DM,(unsigned)__builtin_amdgcn_readfirstlane(kdst+(slot)))
  #define DMA_V(t,slot) glds16(vsrc+W.krow((t),vidx)*DM,(unsigned)__builtin_amdgcn_readfirstlane(vdst+(slot)))
  const int vb0=(int)(lds0+LDS_V)+((lane>>4)&1)*32+(lane&3)*8+(4*hi+((lane&15)>>2))*64;
  const char*Kbase=shm+LDS_K; bf16x8 kf[8];
  const lds_cptr shm3=(lds_cptr)shm; const lds_cptr kp0=shm3+LDS_K+hi*1024+r32*16; const lds_cptr vp0=shm3+LDS_V+((lane>>4)&1)*32+(lane&3)*8+(4*hi+((lane&15)>>2))*64;
  constexpr int NT=Var::NT;
  DMA_K(0,0);DMA_V(0,0);DMA_K(1,SLOTB);
  bf16x8 qr[4];
  #pragma unroll
  for(int d0=0;d0<4;++d0)qr[d0]=*reinterpret_cast<const bf16x8*>(&Q[W.qrow(wid,r32)*DM+d0*16+hi*8]);
  float zz_;asm volatile("v_mov_b32 %0, 0":"=v"(zz_));
  float mhat=zz_,l_reg=zz_;f32x16 o[2];f32x16 negm;
  _Pragma("unroll") for(int r=0;r<16;++r){o[0][r]=zz_;o[1][r]=zz_;negm[r]=zz_;} asm volatile("":"+v"(negm));
  #define CMASK(P0,P1,t) W.mask(P0,P1,(t),wid,r32,hi)
  bool resc=false;
  #define START(P0,P1) do{ const float rm=rowmax(P0,P1); resc=false; \
    { const float dl=__builtin_fmaxf(rm,-30.f); mhat=fadd_s(mhat,dl);   \
      _Pragma("unroll") for(int r=0;r<16;++r){P0[r]=fsub_s(P0[r],dl);P1[r]=fsub_s(P1[r],dl);} \
      _Pragma("unroll") for(int r=0;r<16;++r)negm[r]=-mhat; asm volatile("":"+v"(negm)); } \
    _Pragma("unroll") for(int r=0;r<16;++r)P0[r]=__builtin_amdgcn_exp2f(P0[r]); }while(0)
  #define RESC() do{ if(resc){ asm volatile("s_waitcnt lgkmcnt(0)":::"memory"); \
      _Pragma("unroll") for(int d_=0;d_<2;++d_) _Pragma("unroll") for(int r=0;r<16;++r)o[d_][r]*=wsf[crow(r,hi)]; } }while(0)
  f32x16 pA0,pA1,pB0,pB1;
  int sl_prev=0,sl_cur=0,sl_next=SLOTB;
  #define ROT() do{sl_prev=sl_cur;sl_cur=sl_next;sl_next=(sl_next==(NSLOT-1)*SLOTB)?0:sl_next+SLOTB;}while(0)
  DMA_K(2,2*SLOTB);
  WAIT_BAR(3);
  qkt(pA0,pA1,Kbase,qr,negm,r32,hi);asm volatile("s_nop 15\n\ts_nop 7":"+v"(pA0),"+v"(pA1));CMASK(pA0,pA1,0);
  START(pA0,pA1);
  _Pragma("unroll") for(int r=0;r<16;++r)pA1[r]=__builtin_amdgcn_exp2f(pA1[r]);
  WAIT_BAR(0);
  DMA_K(3,0);DMA_V(1,SLOTB);
  ROT();
  kload8(kf,kp0+sl_cur);
  WAIT_BAR(2);
  s16x4 vlo[8],vhi[8]; u32x4 pw0,pw1,pw2,pw3;
  #define PKW(P,B) cvtpk_s(P[B],P[B+1])
  #define PAF(k) __builtin_bit_cast(bf16x8,pw##k)
  #define VFR(i) (bf16x8){vlo[i][0],vlo[i][1],vlo[i][2],vlo[i][3],vhi[i][0],vhi[i][1],vhi[i][2],vhi[i][3]}
  #define PIN(x) asm volatile("":"+v"(x))
  #define MX3(a,b,c) __builtin_fmaxf(__builtin_fmaxf((a),(b)),(c))
  #define GAPA(MF,A0,A1,A2,A3,W0,W1,PW) do{ if(va_){MF;} sacc+=A0; sacc+=A1; sacc+=A2; sacc+=A3; PIN(sacc); W0; W1; PIN(PW); SBAR(); }while(0)
  #define EX(v) __builtin_amdgcn_exp2f(v)
  #define GAPB(MF,X,B) do{ if(vb_){MF;} X[B]=EX(X[B]); X[B+1]=EX(X[B+1]); X[B+2]=EX(X[B+2]); X[B+3]=EX(X[B+3]); PIN(X); SBAR(); }while(0)
  #define VRD(i) do{ vlo[i]=vtr(vp_+(((i)>>2)*4096+((i)&3)*1024)); vhi[i]=vtr(vp_+(((i)>>2)*4096+((i)&3)*1024+512)); }while(0)
  #define KRD(G,j) do{ if(G){ kload2(kf,kp0+sl_next,j); SBAR(); } }while(0)
  #define STEP(C0,C1,P0,P1,t,GK,GV,GL) do{ SBAR(); \
    const bool va_=W.tile_valid((t),wid), vb_=W.tile_valid((t)-1,wid); \
    if(!va_){ _Pragma("unroll") for(int r=0;r<16;++r){C0[r]=-INFINITY;C1[r]=-INFINITY;} } \
    const lds_cptr vp_=vp0+sl_prev; \
    VRD(0); SBAR(); float sacc=(P0[0]+P0[1]); \
    GAPA(C0=__builtin_amdgcn_mfma_f32_32x32x16_bf16(kf[0],qr[0],negm,0,0,0), P0[2],P0[3],P0[4],P0[5],     pw0[0]=PKW(P0,0), pw0[1]=PKW(P0,2), pw0); \
    VRD(4); SBAR(); GAPA(C1=__builtin_amdgcn_mfma_f32_32x32x16_bf16(kf[1],qr[0],negm,0,0,0), P0[6],P0[7],P0[8],P0[9],     pw0[2]=PKW(P0,4), pw0[3]=PKW(P0,6), pw0); \
    VRD(1); SBAR(); GAPA(C0=__builtin_amdgcn_mfma_f32_32x32x16_bf16(kf[2],qr[1],C0,0,0,0),   P0[10],P0[11],P0[12],P0[13], pw1[0]=PKW(P0,8), pw1[1]=PKW(P0,10), pw1); \
    VRD(5); SBAR(); GAPA(C1=__builtin_amdgcn_mfma_f32_32x32x16_bf16(kf[3],qr[1],C1,0,0,0),   P0[14],P0[15],P1[0],P1[1],   pw1[2]=PKW(P0,12),pw1[3]=PKW(P0,14), pw1); \
    VRD(2); SBAR(); GAPA(C0=__builtin_amdgcn_mfma_f32_32x32x16_bf16(kf[4],qr[2],C0,0,0,0),   P1[2],P1[3],P1[4],P1[5],     pw2[0]=PKW(P1,0), pw2[1]=PKW(P1,2), pw2); \
    VRD(6); SBAR(); GAPA(C1=__builtin_amdgcn_mfma_f32_32x32x16_bf16(kf[5],qr[2],C1,0,0,0),   P1[6],P1[7],P1[8],P1[9],     pw2[2]=PKW(P1,4), pw2[3]=PKW(P1,6), pw2); \
    VRD(3); SBAR(); GAPA(C0=__builtin_amdgcn_mfma_f32_32x32x16_bf16(kf[6],qr[3],C0,0,0,0),   P1[10],P1[11],P1[12],P1[13], pw3[0]=PKW(P1,8), pw3[1]=PKW(P1,10), pw3); \
    VRD(7); SBAR(); GAPA(C1=__builtin_amdgcn_mfma_f32_32x32x16_bf16(kf[7],qr[3],C1,0,0,0),   P1[14],P1[15],0.f,0.f,       pw3[2]=PKW(P1,12),pw3[3]=PKW(P1,14), pw3); \
    l_reg+=sacc; \
    if(GK){DMA_K((t)+3,sl_cur);} if(GV){DMA_V((t)+1,sl_next);} \
    if(va_){CMASK(C0,C1,t);} \
    { float a=MX3(C0[0],C0[1],C1[0]),b=MX3(C0[2],C0[3],C1[1]); a=MX3(a,C1[2],C1[3]); \
      _Pragma("unroll") for(int r=4;r<16;r+=4){a=MX3(a,C0[r],C0[r+1]);b=MX3(b,C0[r+2],C0[r+3]);a=MX3(a,C1[r],C1[r+1]);b=MX3(b,C1[r+2],C1[r+3]);} \
      float rm=__builtin_fmaxf(a,b); { auto rr=__builtin_amdgcn_permlane32_swap(__float_as_uint(rm),__float_as_uint(rm),false,false); rm=__builtin_fmaxf(__uint_as_float(rr[0]),__uint_as_float(rr[1])); } \
      resc=false; \
      if(__builtin_expect(__any(rm>(float)THRL),0)){ const float dl=__builtin_fmaxf(rm,0.f); mhat+=dl; \
        _Pragma("unroll") for(int r=0;r<16;++r){C0[r]-=dl;C1[r]-=dl;} \
        _Pragma("unroll") for(int r=0;r<16;++r)negm[r]=-mhat; asm volatile("":"+v"(negm)); \
        const float f=__builtin_amdgcn_exp2f(-dl); l_reg*=f; { int r_=r32; asm volatile("":"+v"(r_)); if(hi==0)wsf[r_]=f; } resc=true; } } \
    SBAR(); \
    GAPB(o[0]=__builtin_amdgcn_mfma_f32_32x32x16_bf16(PAF(0),VFR(0),o[0],0,0,0), C0,0); \
    GAPB(o[1]=__builtin_amdgcn_mfma_f32_32x32x16_bf16(PAF(0),VFR(4),o[1],0,0,0), C0,4); \
    KRD(GL,0); GAPB(o[0]=__builtin_amdgcn_mfma_f32_32x32x16_bf16(PAF(1),VFR(1),o[0],0,0,0), C0,8); \
    KRD(GL,1); GAPB(o[1]=__builtin_amdgcn_mfma_f32_32x32x16_bf16(PAF(1),VFR(5),o[1],0,0,0), C0,12); \
    KRD(GL,2); GAPB(o[0]=__builtin_amdgcn_mfma_f32_32x32x16_bf16(PAF(2),VFR(2),o[0],0,0,0), C1,0); \
    KRD(GL,3); GAPB(o[1]=__builtin_amdgcn_mfma_f32_32x32x16_bf16(PAF(2),VFR(6),o[1],0,0,0), C1,4); \
    GAPB(o[0]=__builtin_amdgcn_mfma_f32_32x32x16_bf16(PAF(3),VFR(3),o[0],0,0,0), C1,8); \
    GAPB(o[1]=__builtin_amdgcn_mfma_f32_32x32x16_bf16(PAF(3),VFR(7),o[1],0,0,0), C1,12); \
    }while(0)
  int t=1;
  #undef CMASK
  #define CMASK(P0,P1,t) W.mask(P0,P1,(t),wid,r32,hi)
  for(;t+5<NT;t+=2){
    STEP(pB0,pB1,pA0,pA1,t,true,true,true);     WAIT_BAR(2); RESC(); ROT();
    STEP(pA0,pA1,pB0,pB1,t+1,true,true,true);   WAIT_BAR(2); RESC(); ROT();
  }
  #undef CMASK
  #define CMASK(P0,P1,t) W.mask(P0,P1,(t),wid,r32,hi)
  #define ENDW(tt) do{ if((tt)+3<NT){WAIT_BAR(2);} else if((tt)+2<NT){WAIT_BAR(1);} else {WAIT_BAR(0);} }while(0)
  for(;t+1<NT;t+=2){
    STEP(pB0,pB1,pA0,pA1,t,(t+3<NT),(t+1<NT),(t+1<NT));       ENDW(t);   RESC(); ROT();
    STEP(pA0,pA1,pB0,pB1,t+1,(t+4<NT),(t+2<NT),(t+2<NT));     ENDW(t+1); RESC(); ROT();
  }
  STEP(pB0,pB1,pA0,pA1,NT-1,false,false,false); RESC();
  { float sacc=pB0[0]+pB0[1]; _Pragma("unroll") for(int r=2;r<16;++r)sacc+=pB0[r]; _Pragma("unroll") for(int r=0;r<16;++r)sacc+=pB1[r]; l_reg+=sacc;
    pw0=(u32x4){PKW(pB0,0),PKW(pB0,2),PKW(pB0,4),PKW(pB0,6)};pw1=(u32x4){PKW(pB0,8),PKW(pB0,10),PKW(pB0,12),PKW(pB0,14)};pw2=(u32x4){PKW(pB1,0),PKW(pB1,2),PKW(pB1,4),PKW(pB1,6)};pw3=(u32x4){PKW(pB1,8),PKW(pB1,10),PKW(pB1,12),PKW(pB1,14)};
    SBAR(); if(W.tile_valid(NT-1,wid)) pv(o,vb0+sl_cur,PAF(0),PAF(1),PAF(2),PAF(3)); }
  #undef PKW
  #undef PAF
  #undef VFR
  #undef PIN
  #undef MX3
  #undef GAPA
  #undef GAPB
  #undef EX
  #undef VRD
  #undef KRD
  #undef STEP
  #undef ENDW
  {auto rr=__builtin_amdgcn_permlane32_swap(__float_as_uint(l_reg),__float_as_uint(l_reg),false,false);l_reg=__uint_as_float(rr[0])+__uint_as_float(rr[1]);}
  if(hi==0)wsf[32+r32]=l_reg;asm volatile("s_waitcnt lgkmcnt(0)":::"memory");
  float rli[16];
  #pragma unroll
  for(int r=0;r<16;++r)rli[r]=__builtin_amdgcn_rcpf(wsf[32+crow(r,hi)]);
  W.store_lse(wid,r32,hi,mhat,l_reg);
  { bf16*stg=(bf16*)(shm+LDS_OST)+wid*2048;
    #pragma unroll
    for(int r=0;r<16;++r){const int orow=crow(r,hi);
      #pragma unroll
      for(int d0=0;d0<2;++d0)stg[orow*64+d0*32+r32]=__float2bfloat16(o[d0][r]*rli[r]);}
    asm volatile("s_waitcnt lgkmcnt(0)":::"memory");
    #pragma unroll
    for(int i=0;i<4;++i){const int row=i*8+(lane>>3),ch=lane&7; const u32x4 v=*(const u32x4*)(stg+row*64+ch*8); ATTN_STORE16(O+W.qrow(wid,row)*Var::OP+ch*8,v);} }
  asm volatile("s_waitcnt lgkmcnt(0)\n\ts_barrier":::"memory");
  #undef DMA_K
  #undef DMA_V
  #undef CMASK
  #undef START
  #undef RESC
  #undef ROT
}
template<class Var,int THRL> __device__ __forceinline__ void attn_unit_r(const Var&W,const bf16*Q,const bf16*__restrict__ K,const bf16*__restrict__ V,bf16*O,char*shm,int lane,int wid){
  const int r32=lane&31,hi=lane>>5;
  constexpr int NT=Var::NT, RK=0, RV=NT*SLOTB, RWS=2*NT*SLOTB;
  const unsigned lds0=(unsigned)(uintptr_t)shm;
  float*wsf=(float*)(shm+RWS)+wid*64;
  const bf16*vsrc=V+(wid>>2)*32+(lane&3)*8; const int vidx=16*(wid&3)+(lane>>2);
  const unsigned kdst=lds0+RK+wid*1024, vdst=lds0+RV+wid*1024;
  #define DMA_K(t,slot) glds16(K+W.krow((t),8*wid+(lane&7))*DM+((lane>>3)^(wid&1))*8,(unsigned)__builtin_amdgcn_readfirstlane(kdst+(slot)))
  #define DMA_V(t,slot) glds16(vsrc+W.krow((t),vidx)*DM,(unsigned)__builtin_amdgcn_readfirstlane(vdst+(slot)))
  const int vb0=(int)(lds0+RV)+((lane>>4)&1)*32+(lane&3)*8+(4*hi+((lane&15)>>2))*64;
  const char*Kbase=shm+RK; bf16x8 kf[8];
  const lds_cptr shm3=(lds_cptr)shm; const lds_cptr kp0=shm3+RK+hi*1024+r32*16; const lds_cptr vp0=shm3+RV+((lane>>4)&1)*32+(lane&3)*8+(4*hi+((lane&15)>>2))*64;
  _Pragma("unroll") for(int t_=0;t_<NT;++t_){DMA_K(t_,t_*SLOTB);}
  _Pragma("unroll") for(int t_=0;t_<NT;++t_){DMA_V(t_,t_*SLOTB);}
  bf16x8 qr[4];
  #pragma unroll
  for(int d0=0;d0<4;++d0)qr[d0]=*reinterpret_cast<const bf16x8*>(&Q[W.qrow(wid,r32)*DM+d0*16+hi*8]);
  float zz_;asm volatile("v_mov_b32 %0, 0":"=v"(zz_));
  float mhat=zz_,l_reg=zz_;f32x16 o[2];f32x16 negm;
  _Pragma("unroll") for(int r=0;r<16;++r){o[0][r]=zz_;o[1][r]=zz_;negm[r]=zz_;} asm volatile("":"+v"(negm));
  #define CMASK(P0,P1,t) W.mask(P0,P1,(t),wid,r32,hi)
  bool resc=false;
  #define START(P0,P1) do{ const float rm=rowmax(P0,P1); resc=false; \
    { const float dl=__builtin_fmaxf(rm,-30.f); mhat=fadd_s(mhat,dl);   \
      _Pragma("unroll") for(int r=0;r<16;++r){P0[r]=fsub_s(P0[r],dl);P1[r]=fsub_s(P1[r],dl);} \
      _Pragma("unroll") for(int r=0;r<16;++r)negm[r]=-mhat; asm volatile("":"+v"(negm)); } \
    _Pragma("unroll") for(int r=0;r<16;++r)P0[r]=__builtin_amdgcn_exp2f(P0[r]); }while(0)
  #define RESC() do{ if(resc){ asm volatile("s_waitcnt lgkmcnt(0)":::"memory"); \
      _Pragma("unroll") for(int d_=0;d_<2;++d_) _Pragma("unroll") for(int r=0;r<16;++r)o[d_][r]*=wsf[crow(r,hi)]; } }while(0)
  f32x16 pA0,pA1,pB0,pB1;
  const int tb=W.first_tile(wid);
  int sl_prev=0,sl_cur=tb*SLOTB,sl_next=sl_cur+SLOTB;
  #define ROT() do{sl_prev=sl_cur;sl_cur=sl_next;sl_next+=SLOTB;}while(0)
  asm volatile("s_waitcnt vmcnt(0)\n\ts_barrier":::"memory");
  qkt_s(pA0,pA1,Kbase+sl_cur,qr,negm,r32,hi);asm volatile("s_nop 15\n\ts_nop 7":"+v"(pA0),"+v"(pA1));CMASK(pA0,pA1,tb);
  START(pA0,pA1);
  _Pragma("unroll") for(int r=0;r<16;++r)pA1[r]=__builtin_amdgcn_exp2f(pA1[r]);
  ROT();
  kload8_s(kf,shm3+RK+sl_cur,r32,hi);
  s16x4 vlo[8],vhi[8]; u32x4 pw0,pw1,pw2,pw3;
  #define PKW(P,B) cvtpk_s(P[B],P[B+1])
  #define PAF(k) __builtin_bit_cast(bf16x8,pw##k)
  #define VFR(i) (bf16x8){vlo[i][0],vlo[i][1],vlo[i][2],vlo[i][3],vhi[i][0],vhi[i][1],vhi[i][2],vhi[i][3]}
  #define PIN(x) asm volatile("":"+v"(x))
  #define MX3(a,b,c) __builtin_fmaxf(__builtin_fmaxf((a),(b)),(c))
  #define GAPA(MF,A0,A1,A2,A3,W0,W1,PW) do{ if(va_){MF;} sacc+=A0; sacc+=A1; sacc+=A2; sacc+=A3; PIN(sacc); W0; W1; PIN(PW); SBAR(); }while(0)
  #define EX(v) __builtin_amdgcn_exp2f(v)
  #define GAPB(MF,X,B) do{ if(vb_){MF;} X[B]=EX(X[B]); X[B+1]=EX(X[B+1]); X[B+2]=EX(X[B+2]); X[B+3]=EX(X[B+3]); PIN(X); SBAR(); }while(0)
  #define VRD(i) do{ vlo[i]=vtr(vp_+(((i)>>2)*4096+((i)&3)*1024)); vhi[i]=vtr(vp_+(((i)>>2)*4096+((i)&3)*1024+512)); }while(0)
  #define KRD(G,j) do{ if(G){ kload2_s(kf,shm3+RK+sl_next,j,r32,hi); SBAR(); } }while(0)
  #define STEP(C0,C1,P0,P1,t,GK,GV,GL) do{ SBAR(); \
    const bool va_=((t)<NT)&&W.tile_valid((t),wid), vb_=W.tile_valid((t)-1,wid); \
    if(!va_){ _Pragma("unroll") for(int r=0;r<16;++r){C0[r]=-INFINITY;C1[r]=-INFINITY;} } \
    const lds_cptr vp_=vp0+sl_prev; \
    VRD(0); SBAR(); float sacc=(P0[0]+P0[1]); \
    GAPA(C0=__builtin_amdgcn_mfma_f32_32x32x16_bf16(kf[0],qr[0],negm,0,0,0), P0[2],P0[3],P0[4],P0[5],     pw0[0]=PKW(P0,0), pw0[1]=PKW(P0,2), pw0); \
    VRD(4); SBAR(); GAPA(C1=__builtin_amdgcn_mfma_f32_32x32x16_bf16(kf[1],qr[0],negm,0,0,0), P0[6],P0[7],P0[8],P0[9],     pw0[2]=PKW(P0,4), pw0[3]=PKW(P0,6), pw0); \
    VRD(1); SBAR(); GAPA(C0=__builtin_amdgcn_mfma_f32_32x32x16_bf16(kf[2],qr[1],C0,0,0,0),   P0[10],P0[11],P0[12],P0[13], pw1[0]=PKW(P0,8), pw1[1]=PKW(P0,10), pw1); \
    VRD(5); SBAR(); GAPA(C1=__builtin_amdgcn_mfma_f32_32x32x16_bf16(kf[3],qr[1],C1,0,0,0),   P0[14],P0[15],P1[0],P1[1],   pw1[2]=PKW(P0,12),pw1[3]=PKW(P0,14), pw1); \
    VRD(2); SBAR(); GAPA(C0=__builtin_amdgcn_mfma_f32_32x32x16_bf16(kf[4],qr[2],C0,0,0,0),   P1[2],P1[3],P1[4],P1[5],     pw2[0]=PKW(P1,0), pw2[1]=PKW(P1,2), pw2); \
    VRD(6); SBAR(); GAPA(C1=__builtin_amdgcn_mfma_f32_32x32x16_bf16(kf[5],qr[2],C1,0,0,0),   P1[6],P1[7],P1[8],P1[9],     pw2[2]=PKW(P1,4), pw2[3]=PKW(P1,6), pw2); \
    VRD(3); SBAR(); GAPA(C0=__builtin_amdgcn_mfma_f32_32x32x16_bf16(kf[6],qr[3],C0,0,0,0),   P1[10],P1[11],P1[12],P1[13], pw3[0]=PKW(P1,8), pw3[1]=PKW(P1,10), pw3); \
    VRD(7); SBAR(); GAPA(C1=__builtin_amdgcn_mfma_f32_32x32x16_bf16(kf[7],qr[3],C1,0,0,0),   P1[14],P1[15],0.f,0.f,       pw3[2]=PKW(P1,12),pw3[3]=PKW(P1,14), pw3); \
    l_reg+=sacc; \
    if(GK){DMA_K((t)+3,sl_cur);} if(GV){DMA_V((t)+1,sl_next);} \
    if(va_){CMASK(C0,C1,t);} \
    { float a=MX3(C0[0],C0[1],C1[0]),b=MX3(C0[2],C0[3],C1[1]); a=MX3(a,C1[2],C1[3]); \
      _Pragma("unroll") for(int r=4;r<16;r+=4){a=MX3(a,C0[r],C0[r+1]);b=MX3(b,C0[r+2],C0[r+3]);a=MX3(a,C1[r],C1[r+1]);b=MX3(b,C1[r+2],C1[r+3]);} \
      float rm=__builtin_fmaxf(a,b); { auto rr=__builtin_amdgcn_permlane32_swap(__float_as_uint(rm),__float_as_uint(rm),false,false); rm=__builtin_fmaxf(__uint_as_float(rr[0]),__uint_as_float(rr[1])); } \
      resc=false; \
      if(__builtin_expect(__any(rm>(float)THRL),0)){ const float dl=__builtin_fmaxf(rm,0.f); mhat+=dl; \
        _Pragma("unroll") for(int r=0;r<16;++r){C0[r]-=dl;C1[r]-=dl;} \
        _Pragma("unroll") for(int r=0;r<16;++r)negm[r]=-mhat; asm volatile("":"+v"(negm)); \
        const float f=__builtin_amdgcn_exp2f(-dl); l_reg*=f; { int r_=r32; asm volatile("":"+v"(r_)); if(hi==0)wsf[r_]=f; } resc=true; } } \
    SBAR(); \
    GAPB(o[0]=__builtin_amdgcn_mfma_f32_32x32x16_bf16(PAF(0),VFR(0),o[0],0,0,0), C0,0); \
    GAPB(o[1]=__builtin_amdgcn_mfma_f32_32x32x16_bf16(PAF(0),VFR(4),o[1],0,0,0), C0,4); \
    KRD(GL,0); GAPB(o[0]=__builtin_amdgcn_mfma_f32_32x32x16_bf16(PAF(1),VFR(1),o[0],0,0,0), C0,8); \
    KRD(GL,1); GAPB(o[1]=__builtin_amdgcn_mfma_f32_32x32x16_bf16(PAF(1),VFR(5),o[1],0,0,0), C0,12); \
    KRD(GL,2); GAPB(o[0]=__builtin_amdgcn_mfma_f32_32x32x16_bf16(PAF(2),VFR(2),o[0],0,0,0), C1,0); \
    KRD(GL,3); GAPB(o[1]=__builtin_amdgcn_mfma_f32_32x32x16_bf16(PAF(2),VFR(6),o[1],0,0,0), C1,4); \
    GAPB(o[0]=__builtin_amdgcn_mfma_f32_32x32x16_bf16(PAF(3),VFR(3),o[0],0,0,0), C1,8); \
    GAPB(o[1]=__builtin_amdgcn_mfma_f32_32x32x16_bf16(PAF(3),VFR(7),o[1],0,0,0), C1,12); \
    }while(0)
  STEP(pB0,pB1,pA0,pA1,tb+1,false,false,true);  RESC(); ROT();
  STEP(pA0,pA1,pB0,pB1,tb+2,false,false,false); RESC();
  { float sacc=pA0[0]+pA0[1]; _Pragma("unroll") for(int r=2;r<16;++r)sacc+=pA0[r]; _Pragma("unroll") for(int r=0;r<16;++r)sacc+=pA1[r]; l_reg+=sacc;
    pw0=(u32x4){PKW(pA0,0),PKW(pA0,2),PKW(pA0,4),PKW(pA0,6)};pw1=(u32x4){PKW(pA0,8),PKW(pA0,10),PKW(pA0,12),PKW(pA0,14)};pw2=(u32x4){PKW(pA1,0),PKW(pA1,2),PKW(pA1,4),PKW(pA1,6)};pw3=(u32x4){PKW(pA1,8),PKW(pA1,10),PKW(pA1,12),PKW(pA1,14)};
    SBAR(); if((tb+2<NT)&&W.tile_valid(tb+2,wid)) pv(o,vb0+sl_cur,PAF(0),PAF(1),PAF(2),PAF(3)); }
  #undef PKW
  #undef PAF
  #undef VFR
  #undef PIN
  #undef MX3
  #undef GAPA
  #undef GAPB
  #undef EX
  #undef VRD
  #undef KRD
  #undef STEP
  {auto rr=__builtin_amdgcn_permlane32_swap(__float_as_uint(l_reg),__float_as_uint(l_reg),false,false);l_reg=__uint_as_float(rr[0])+__uint_as_float(rr[1]);}
  if(hi==0)wsf[32+r32]=l_reg;asm volatile("s_waitcnt lgkmcnt(0)":::"memory");
  float rli[16];
  #pragma unroll
  for(int r=0;r<16;++r)rli[r]=__builtin_amdgcn_rcpf(wsf[32+crow(r,hi)]);
  W.store_lse(wid,r32,hi,mhat,l_reg);
  asm volatile("s_waitcnt lgkmcnt(0)\n\ts_barrier":::"memory");
  { bf16*stg=(bf16*)(shm+RK)+wid*2048;
    #pragma unroll
    for(int r=0;r<16;++r){const int orow=crow(r,hi);
      #pragma unroll
      for(int d0=0;d0<2;++d0)stg[orow*64+d0*32+r32]=__float2bfloat16(o[d0][r]*rli[r]);}
    asm volatile("s_waitcnt lgkmcnt(0)":::"memory");
    #pragma unroll
    for(int i=0;i<4;++i){const int row=i*8+(lane>>3),ch=lane&7; const u32x4 v=*(const u32x4*)(stg+row*64+ch*8); ATTN_STORE16(O+W.qrow(wid,row)*Var::OP+ch*8,v);} }
  asm volatile("s_waitcnt lgkmcnt(0)\n\ts_barrier":::"memory");
  #undef DMA_K
  #undef DMA_V
  #undef CMASK
  #undef START
  #undef RESC
  #undef ROT
}
template<class Var,int THRL> __device__ __forceinline__ void attn_unit_b(const Var&W,const bf16*Q,const bf16*__restrict__ K,const bf16*__restrict__ V,bf16*O,char*shm,int lane,int wid){
  const int r32=lane&31,hi=lane>>5;
  constexpr int NT=Var::NT, NRS=8, RK=0, RV=NRS*SLOTB, RWS=131584;
  const unsigned lds0=(unsigned)(uintptr_t)shm;
  float*wsf=(float*)(shm+RWS)+wid*64;
  const bf16*vsrc=V+(wid>>2)*32+(lane&3)*8; const int vidx=16*(wid&3)+(lane>>2);
  const unsigned kdst=lds0+RK+wid*1024, vdst=lds0+RV+wid*1024;
  #define DMA_K(t,slot) glds16(K+W.krow((t),8*wid+(lane&7))*DM+((lane>>3)^(wid&1))*8,(unsigned)__builtin_amdgcn_readfirstlane(kdst+(slot)))
  #define DMA_V(t,slot) glds16(vsrc+W.krow((t),vidx)*DM,(unsigned)__builtin_amdgcn_readfirstlane(vdst+(slot)))
  const int vb0=(int)(lds0+RV)+((lane>>4)&1)*32+(lane&3)*8+(4*hi+((lane&15)>>2))*64;
  const char*Kbase=shm+RK; bf16x8 kf[8];
  const lds_cptr shm3=(lds_cptr)shm; const lds_cptr kp0=shm3+RK+hi*1024+r32*16; const lds_cptr vp0=shm3+RV+((lane>>4)&1)*32+(lane&3)*8+(4*hi+((lane&15)>>2))*64;
  _Pragma("unroll") for(int t_=0;t_<NRS;++t_){DMA_K(t_,t_*SLOTB);}
  _Pragma("unroll") for(int t_=0;t_<NRS;++t_){DMA_V(t_,t_*SLOTB);}
  bf16x8 qr[4];
  #pragma unroll
  for(int d0=0;d0<4;++d0)qr[d0]=*reinterpret_cast<const bf16x8*>(&Q[W.qrow(wid,r32)*DM+d0*16+hi*8]);
  float zz_;asm volatile("v_mov_b32 %0, 0":"=v"(zz_));
  float mhat=zz_,l_reg=zz_;f32x16 o[2];f32x16 negm;
  _Pragma("unroll") for(int r=0;r<16;++r){o[0][r]=zz_;o[1][r]=zz_;negm[r]=zz_;} asm volatile("":"+v"(negm));
  #define CMASK(P0,P1,t) W.mask(P0,P1,(t),wid,r32,hi)
  bool resc=false;
  #define START(P0,P1) do{ const float rm=rowmax(P0,P1); resc=false; \
    { const float dl=__builtin_fmaxf(rm,-30.f); mhat=fadd_s(mhat,dl);   \
      _Pragma("unroll") for(int r=0;r<16;++r){P0[r]=fsub_s(P0[r],dl);P1[r]=fsub_s(P1[r],dl);} \
      _Pragma("unroll") for(int r=0;r<16;++r)negm[r]=-mhat; asm volatile("":"+v"(negm)); } \
    _Pragma("unroll") for(int r=0;r<16;++r)P0[r]=__builtin_amdgcn_exp2f(P0[r]); }while(0)
  #define RESC() do{ if(resc){ asm volatile("s_waitcnt lgkmcnt(0)":::"memory"); \
      _Pragma("unroll") for(int d_=0;d_<2;++d_) _Pragma("unroll") for(int r=0;r<16;++r)o[d_][r]*=wsf[crow(r,hi)]; } }while(0)
  f32x16 pA0,pA1,pB0,pB1;
  const int tb=W.first_tile(wid);
  int sl_prev=0,sl_cur=tb*SLOTB,sl_next=sl_cur+SLOTB;
  #define ROT() do{sl_prev=sl_cur;sl_cur=sl_next;sl_next=(sl_next+SLOTB)&(NRS*SLOTB-1);}while(0)
  asm volatile("s_waitcnt vmcnt(0)\n\ts_barrier":::"memory");
  qkt_s(pA0,pA1,Kbase+sl_cur,qr,negm,r32,hi);asm volatile("s_nop 15\n\ts_nop 7":"+v"(pA0),"+v"(pA1));CMASK(pA0,pA1,tb);
  START(pA0,pA1);
  _Pragma("unroll") for(int r=0;r<16;++r)pA1[r]=__builtin_amdgcn_exp2f(pA1[r]);
  ROT();
  kload8_s(kf,shm3+RK+sl_cur,r32,hi);
  s16x4 vlo[8],vhi[8]; u32x4 pw0,pw1,pw2,pw3;
  #define PKW(P,B) cvtpk_s(P[B],P[B+1])
  #define PAF(k) __builtin_bit_cast(bf16x8,pw##k)
  #define VFR(i) (bf16x8){vlo[i][0],vlo[i][1],vlo[i][2],vlo[i][3],vhi[i][0],vhi[i][1],vhi[i][2],vhi[i][3]}
  #define PIN(x) asm volatile("":"+v"(x))
  #define MX3(a,b,c) __builtin_fmaxf(__builtin_fmaxf((a),(b)),(c))
  #define GAPA(MF,A0,A1,A2,A3,W0,W1,PW) do{ if(va_){MF;} sacc+=A0; sacc+=A1; sacc+=A2; sacc+=A3; PIN(sacc); W0; W1; PIN(PW); SBAR(); }while(0)
  #define EX(v) __builtin_amdgcn_exp2f(v)
  #define GAPB(MF,X,B) do{ if(vb_){MF;} X[B]=EX(X[B]); X[B+1]=EX(X[B+1]); X[B+2]=EX(X[B+2]); X[B+3]=EX(X[B+3]); PIN(X); SBAR(); }while(0)
  #define VRD(i) do{ vlo[i]=vtr(vp_+(((i)>>2)*4096+((i)&3)*1024)); vhi[i]=vtr(vp_+(((i)>>2)*4096+((i)&3)*1024+512)); }while(0)
  #define KRD(G,j) do{ if(G){ kload2_s(kf,shm3+RK+sl_next,j,r32,hi); SBAR(); } }while(0)
  #define STEP(C0,C1,P0,P1,t,GK,GV,GL) do{ SBAR(); \
    const bool va_=((t)<NT)&&W.tile_valid((t),wid), vb_=W.tile_valid((t)-1,wid); \
    if(!va_){ _Pragma("unroll") for(int r=0;r<16;++r){C0[r]=-INFINITY;C1[r]=-INFINITY;} } \
    const lds_cptr vp_=vp0+sl_prev; \
    VRD(0); SBAR(); float sacc=(P0[0]+P0[1]); \
    GAPA(C0=__builtin_amdgcn_mfma_f32_32x32x16_bf16(kf[0],qr[0],negm,0,0,0), P0[2],P0[3],P0[4],P0[5],     pw0[0]=PKW(P0,0), pw0[1]=PKW(P0,2), pw0); \
    VRD(4); SBAR(); GAPA(C1=__builtin_amdgcn_mfma_f32_32x32x16_bf16(kf[1],qr[0],negm,0,0,0), P0[6],P0[7],P0[8],P0[9],     pw0[2]=PKW(P0,4), pw0[3]=PKW(P0,6), pw0); \
    VRD(1); SBAR(); GAPA(C0=__builtin_amdgcn_mfma_f32_32x32x16_bf16(kf[2],qr[1],C0,0,0,0),   P0[10],P0[11],P0[12],P0[13], pw1[0]=PKW(P0,8), pw1[1]=PKW(P0,10), pw1); \
    VRD(5); SBAR(); GAPA(C1=__builtin_amdgcn_mfma_f32_32x32x16_bf16(kf[3],qr[1],C1,0,0,0),   P0[14],P0[15],P1[0],P1[1],   pw1[2]=PKW(P0,12),pw1[3]=PKW(P0,14), pw1); \
    VRD(2); SBAR(); GAPA(C0=__builtin_amdgcn_mfma_f32_32x32x16_bf16(kf[4],qr[2],C0,0,0,0),   P1[2],P1[3],P1[4],P1[5],     pw2[0]=PKW(P1,0), pw2[1]=PKW(P1,2), pw2); \
    VRD(6); SBAR(); GAPA(C1=__builtin_amdgcn_mfma_f32_32x32x16_bf16(kf[5],qr[2],C1,0,0,0),   P1[6],P1[7],P1[8],P1[9],     pw2[2]=PKW(P1,4), pw2[3]=PKW(P1,6), pw2); \
    VRD(3); SBAR(); GAPA(C0=__builtin_amdgcn_mfma_f32_32x32x16_bf16(kf[6],qr[3],C0,0,0,0),   P1[10],P1[11],P1[12],P1[13], pw3[0]=PKW(P1,8), pw3[1]=PKW(P1,10), pw3); \
    VRD(7); SBAR(); GAPA(C1=__builtin_amdgcn_mfma_f32_32x32x16_bf16(kf[7],qr[3],C1,0,0,0),   P1[14],P1[15],0.f,0.f,       pw3[2]=PKW(P1,12),pw3[3]=PKW(P1,14), pw3); \
    l_reg+=sacc; \
    if(GK){DMA_K((t)+3,sl_cur);} if(GV){DMA_V((t)+1,sl_next);} \
    if(va_){CMASK(C0,C1,t);} \
    { float a=MX3(C0[0],C0[1],C1[0]),b=MX3(C0[2],C0[3],C1[1]); a=MX3(a,C1[2],C1[3]); \
      _Pragma("unroll") for(int r=4;r<16;r+=4){a=MX3(a,C0[r],C0[r+1]);b=MX3(b,C0[r+2],C0[r+3]);a=MX3(a,C1[r],C1[r+1]);b=MX3(b,C1[r+2],C1[r+3]);} \
      float rm=__builtin_fmaxf(a,b); { auto rr=__builtin_amdgcn_permlane32_swap(__float_as_uint(rm),__float_as_uint(rm),false,false); rm=__builtin_fmaxf(__uint_as_float(rr[0]),__uint_as_float(rr[1])); } \
      resc=false; \
      if(__builtin_expect(__any(rm>(float)THRL),0)){ const float dl=__builtin_fmaxf(rm,0.f); mhat+=dl; \
        _Pragma("unroll") for(int r=0;r<16;++r){C0[r]-=dl;C1[r]-=dl;} \
        _Pragma("unroll") for(int r=0;r<16;++r)negm[r]=-mhat; asm volatile("":"+v"(negm)); \
        const float f=__builtin_amdgcn_exp2f(-dl); l_reg*=f; { int r_=r32; asm volatile("":"+v"(r_)); if(hi==0)wsf[r_]=f; } resc=true; } } \
    SBAR(); \
    GAPB(o[0]=__builtin_amdgcn_mfma_f32_32x32x16_bf16(PAF(0),VFR(0),o[0],0,0,0), C0,0); \
    GAPB(o[1]=__builtin_amdgcn_mfma_f32_32x32x16_bf16(PAF(0),VFR(4),o[1],0,0,0), C0,4); \
    KRD(GL,0); GAPB(o[0]=__builtin_amdgcn_mfma_f32_32x32x16_bf16(PAF(1),VFR(1),o[0],0,0,0), C0,8); \
    KRD(GL,1); GAPB(o[1]=__builtin_amdgcn_mfma_f32_32x32x16_bf16(PAF(1),VFR(5),o[1],0,0,0), C0,12); \
    KRD(GL,2); GAPB(o[0]=__builtin_amdgcn_mfma_f32_32x32x16_bf16(PAF(2),VFR(2),o[0],0,0,0), C1,0); \
    KRD(GL,3); GAPB(o[1]=__builtin_amdgcn_mfma_f32_32x32x16_bf16(PAF(2),VFR(6),o[1],0,0,0), C1,4); \
    GAPB(o[0]=__builtin_amdgcn_mfma_f32_32x32x16_bf16(PAF(3),VFR(3),o[0],0,0,0), C1,8); \
    GAPB(o[1]=__builtin_amdgcn_mfma_f32_32x32x16_bf16(PAF(3),VFR(7),o[1],0,0,0), C1,12); \
    }while(0)
  #define BARV(N) asm volatile("s_waitcnt vmcnt(" #N ") lgkmcnt(0)\n\ts_barrier":::"memory")
  STEP(pB0,pB1,pA0,pA1,tb+1,false,false,true); RESC(); ROT(); BARV(0); DMA_K(8,0);       DMA_V(8,0);
  STEP(pA0,pA1,pB0,pB1,tb+2,false,false,true); RESC(); ROT(); BARV(2); DMA_K(9,SLOTB);   DMA_V(9,SLOTB);
  STEP(pB0,pB1,pA0,pA1,tb+3,false,false,true); RESC(); ROT(); BARV(2); DMA_K(10,2*SLOTB);DMA_V(10,2*SLOTB);
  STEP(pA0,pA1,pB0,pB1,tb+4,false,false,true); RESC(); ROT(); BARV(2);
  STEP(pB0,pB1,pA0,pA1,tb+5,false,false,true); RESC(); ROT(); BARV(0);
  STEP(pA0,pA1,pB0,pB1,tb+6,false,false,true); RESC(); ROT();
  STEP(pB0,pB1,pA0,pA1,tb+7,false,false,false); RESC();
  #undef BARV
  { float sacc=pB0[0]+pB0[1]; _Pragma("unroll") for(int r=2;r<16;++r)sacc+=pB0[r]; _Pragma("unroll") for(int r=0;r<16;++r)sacc+=pB1[r]; l_reg+=sacc;
    pw0=(u32x4){PKW(pB0,0),PKW(pB0,2),PKW(pB0,4),PKW(pB0,6)};pw1=(u32x4){PKW(pB0,8),PKW(pB0,10),PKW(pB0,12),PKW(pB0,14)};pw2=(u32x4){PKW(pB1,0),PKW(pB1,2),PKW(pB1,4),PKW(pB1,6)};pw3=(u32x4){PKW(pB1,8),PKW(pB1,10),PKW(pB1,12),PKW(pB1,14)};
    SBAR(); pv(o,vb0+sl_cur,PAF(0),PAF(1),PAF(2),PAF(3)); }
  #undef PKW
  #undef PAF
  #undef VFR
  #undef PIN
  #undef MX3
  #undef GAPA
  #undef GAPB
  #undef EX
  #undef VRD
  #undef KRD
  #undef STEP
  {auto rr=__builtin_amdgcn_permlane32_swap(__float_as_uint(l_reg),__float_as_uint(l_reg),false,false);l_reg=__uint_as_float(rr[0])+__uint_as_float(rr[1]);}
  if(hi==0)wsf[32+r32]=l_reg;asm volatile("s_waitcnt lgkmcnt(0)":::"memory");
  float rli[16];
  #pragma unroll
  for(int r=0;r<16;++r)rli[r]=__builtin_amdgcn_rcpf(wsf[32+crow(r,hi)]);
  W.store_lse(wid,r32,hi,mhat,l_reg);
  asm volatile("s_waitcnt lgkmcnt(0)\n\ts_barrier":::"memory");
  { bf16*stg=(bf16*)(shm+RK)+wid*2048;
    #pragma unroll
    for(int r=0;r<16;++r){const int orow=crow(r,hi);
      #pragma unroll
      for(int d0=0;d0<2;++d0)stg[orow*64+d0*32+r32]=__float2bfloat16(o[d0][r]*rli[r]);}
    asm volatile("s_waitcnt lgkmcnt(0)":::"memory");
    #pragma unroll
    for(int i=0;i<4;++i){const int row=i*8+(lane>>3),ch=lane&7; const u32x4 v=*(const u32x4*)(stg+row*64+ch*8); ATTN_STORE16(O+W.qrow(wid,row)*Var::OP+ch*8,v);} }
  asm volatile("s_waitcnt lgkmcnt(0)\n\ts_barrier":::"memory");
  #undef DMA_K
  #undef DMA_V
  #undef CMASK
  #undef START
  #undef RESC
  #undef ROT
}
constexpr int ATTN_LDS_BYTES=LDS_BYTES;
struct AttnTensors { const bf16* Q; const bf16* K; const bf16* V; bf16* O; };
struct AttnUnit { int b, h, kvh, qb; };
struct StaticOrder {
  int xcd, j, G;
  __device__ __forceinline__ explicit StaticOrder(int grid,int block):xcd(block&7),j(block>>3),G(grid){}
  __device__ __forceinline__ bool next(int i,AttnUnit&u)const{
    if(G==256){ if(i>=2)return false; const int pair=2*xcd+i; u.b=pair>>1; u.kvh=pair&1; u.h=u.kvh*2+(j>>4); u.qb=j&15; return true; }
    const int L=i*G+(xcd+8*j); if(L>=512)return false; u.qb=L&15; u.h=(L>>4)&3; u.kvh=u.h>>1; u.b=L>>6; return true; }
};
template<class Sched,int THRL=8> __device__ __forceinline__ void attn_phase(char*lds,const AttnTensors&T,const Sched&S,int lane,int wid){
  AttnUnit u;
  for(int i=0;S.next(i,u);++i){ attn_unit<THRL>(u.b,u.h,u.kvh,u.qb,T.Q,T.K,T.V,T.O,lds,lane,wid); }
}

template<int NTT> struct VarC_ {
  static constexpr int NT=NTT, OP=384;
  int rowb, dil, cls, u0, L, toff; float* lse; int h;
  __device__ __forceinline__ long qrow(int wid,int r)const{ return (long)rowb+(long)(u0+32*wid+r)*dil+cls; }
  __device__ __forceinline__ long krow(int t,int idx)const{ int u=u0-64+64*(t+toff)+idx; u=u<0?0:(u>L-1?L-1:u); return (long)rowb+(long)u*dil+cls; }
  __device__ __forceinline__ void mask(f32x16&P0,f32x16&P1,int t,int wid,int r32,int hi)const{
    const int tt=t+toff, ulo=u0-64+64*tt, A=32*wid+r32-64*tt;
    int lo=A>-ulo?A:-ulo; const int hb=A+128<L-1-ulo?A+128:L-1-ulo; const bool none=hb<lo;
    const unsigned span=(unsigned)(hb-lo); lo-=4*hi;
    #pragma unroll
    for(int r=0;r<16;++r){ const int kk=(r&3)+8*(r>>2);
      const bool ok0=!none&&((unsigned)(kk-lo)<=span), ok1=!none&&((unsigned)(kk+32-lo)<=span);
      P0[r]=ok0?P0[r]:-INFINITY; P1[r]=ok1?P1[r]:-INFINITY; }
  }
  __device__ __forceinline__ bool tile_valid(int t,int wid)const{ const int lo=wid>>1, tt=t+toff; return tt>=lo&&tt<=lo+2; }
  __device__ __forceinline__ int first_tile(int wid)const{ const int t=(wid>>1)-toff; return t<0?0:t; }
  __device__ __forceinline__ void store_lse(int wid,int r32,int hi,float mhat,float l)const{ if(hi==0) lse[qrow(wid,r32)*6+h]=mhat+__builtin_amdgcn_logf(l); }
};
typedef VarC_<6> VarC;
struct VarB {
  static constexpr int NT=12, OP=1024;
  int rowb, r0, rs0; const float* tab;
  __device__ __forceinline__ long qrow(int wid,int r)const{ return (long)rowb+(r0+(wid>>1))*64+32*(wid&1)+r; }
  __device__ __forceinline__ long krow(int t,int idx)const{ int kr=rs0+t; kr=kr>63?63:kr; return (long)rowb+kr*64+idx; }
  __device__ __forceinline__ void mask(f32x16&P0,f32x16&P1,int t,int wid,int r32,int hi)const{
    const int r=r0+(wid>>1), c=32*(wid&1)+r32, kr=rs0+t;
    int rs=r-4; rs=rs<0?0:(rs>56?56:rs); int cs=c-8; cs=cs<0?0:(cs>48?48:cs);
    const bool rowok=(kr>=rs)&&(kr<rs+8);
    if(!rowok){
      #pragma unroll
      for(int q=0;q<16;++q){P0[q]=-INFINITY;P1[q]=-INFINITY;}
    } else {
      const int cb=4*hi-cs; const float*tb=tab+((kr-r+7)*31+4*hi-c+15);
      #pragma unroll
      for(int g=0;g<4;++g){ float b0[4],b1[4];
        #pragma unroll
        for(int e=0;e<4;++e){ b0[e]=tb[8*g+e]; b1[e]=tb[8*g+e+32]; }
        asm volatile("":"+v"(b0[0]),"+v"(b0[1]),"+v"(b0[2]),"+v"(b0[3]),"+v"(b1[0]),"+v"(b1[1]),"+v"(b1[2]),"+v"(b1[3]));
        #pragma unroll
        for(int e=0;e<4;++e){ const int q=4*g+e, kk=8*g+e;
          const bool ok0=((unsigned)(cb+kk)<16u), ok1=((unsigned)(cb+kk+32)<16u);
          P0[q]=ok0?P0[q]+b0[e]:-INFINITY; P1[q]=ok1?P1[q]+b1[e]:-INFINITY; }
        asm volatile("":::"memory"); }
    }
  }
  __device__ __forceinline__ bool tile_valid(int t,int wid)const{ const int r=r0+(wid>>1); int rs=r-4; rs=rs<0?0:(rs>56?56:rs); const int kr=rs0+t; return kr>=rs&&kr<rs+8; }
  __device__ __forceinline__ int first_tile(int wid)const{ const int r=r0+(wid>>1); int rs=r-4; rs=rs<0?0:(rs>56?56:rs); return rs-rs0; }
  __device__ __forceinline__ void store_lse(int,int,int,float,float)const{}
};
constexpr int LDS_TAB_B=133632;
constexpr int LDS_TAB=86016;
constexpr int ATTN_G_LDS_BYTES=LDS_TAB+6*465*4;
__device__ __forceinline__ void attnB_phase(char*lds,const bf16*qkv,int cq,int ck,int cv,const float*nab,bf16*ao,int G,int bid,int lane,int wid){
  float*tab=(float*)(lds+LDS_TAB_B);
  { float tv[6];
    #pragma unroll
    for(int q=0;q<6;++q){ const int i=wid*64+lane+512*q; tv[q]=(i<6*465)?nab[i]:0.f; }
    #pragma unroll
    for(int q=0;q<6;++q){ const int i=wid*64+lane+512*q; if(i<6*465)tab[i]=tv[q]*1.4426950408889634f; } }
  asm volatile("s_waitcnt lgkmcnt(0)\n\ts_barrier":::"memory");
  for(int it0=bid;it0<8*6*16;it0+=G){ const int it=(G==256)?((((bid&7)+8*(2*(it0>>8)+(bid>>7)))<<4)|((bid>>3)&15)):it0; const int rb=it&15,bh=it>>4,h=bh%6,b=bh/6; asm volatile("":"+v"(lane));
    VarB W; W.rowb=b*SEQ; W.r0=4*rb; int rs0=4*rb-4; W.rs0=rs0<0?0:(rs0>56?56:rs0); W.tab=tab+h*465;
    attn_unit_b<VarB,8>(W,qkv+cq+h*64,qkv+ck+h*64,qkv+cv+h*64,ao+256+h*64,lds,lane,wid); }
}
__device__ __forceinline__ void attnC_phase(char*lds,const bf16*qkv,int cq,int ck,int cv,bf16*part,float*lse,int G,int bid,int lane,int wid){
  auto c1=[&](int it){ const int k=it&15,br=(it>>4)&1,bh=it>>5,h=bh%6,b=bh/6; asm volatile("":"+v"(lane));
    VarC W; W.rowb=b*SEQ; W.dil=1<<(2*br); W.L=SEQ>>(2*br); W.h=h; W.toff=0;
    if(br==0){W.cls=0;W.u0=256*k;} else {W.cls=k&3;W.u0=256*(k>>2);}
    W.lse=lse+(size_t)br*(8*SEQ*6);
    attn_unit_r<VarC,8>(W,qkv+cq+h*64,qkv+ck+h*64,qkv+cv+h*64,part+(size_t)br*(8*SEQ*384)+h*64,lds,lane,wid); };
  auto c2=[&](int it){ const int k=it&15,bh=it>>4,h=bh%6,b=bh/6; asm volatile("":"+v"(lane));
    VarC_<4> W; W.rowb=b*SEQ; W.dil=16; W.L=256; W.h=h; W.toff=1; W.cls=k; W.u0=0;
    W.lse=lse+(size_t)2*(8*SEQ*6);
    attn_unit_r<VarC_<4>,8>(W,qkv+cq+h*64,qkv+ck+h*64,qkv+cv+h*64,part+(size_t)2*(8*SEQ*384)+h*64,lds,lane,wid); };
  const int n1=(8*6*2*16-bid+G-1)/G, n2=(8*6*16-bid+G-1)/G, ns=(G==256)?9:n1+n2;
  for(int s_=0;s_<ns;++s_){ bool kind; int it;
    if(G==256){ const int i=s_/3,r=s_-3*i; kind=(r==2); it=kind?((((bid&7)+8*(2*i+(bid>>7)))<<4)|((bid>>3)&15)):((((bid&7)+8*(2*i+r))<<5)|(bid>>3)); }
    else { kind=(s_>=n1); it=kind?bid+(s_-n1)*G:bid+s_*G; }
    if(kind) c2(it); else c1(it); }
}
template<class Var> __device__ __forceinline__ void attn_wave_item(const Var&W,const bf16*Q,const bf16*__restrict__ K,const bf16*__restrict__ V,bf16*O,char*shm,float*wsf,int lane){
  const int r32=lane&31,hi=lane>>5;
  const unsigned lds0=(unsigned)(uintptr_t)shm;
  const int vb0=(int)(lds0+8192)+((lane>>4)&1)*32+(lane&3)*8+(4*hi+((lane&15)>>2))*64;
  #define WDMA_K(t) do{ const bf16*s_=K+W.krow((t),lane)*DM; _Pragma("unroll") for(int c_=0;c_<8;++c_) glds16(s_+c_*8,(unsigned)__builtin_amdgcn_readfirstlane(lds0+c_*1024)); }while(0)
  #define WDMA_V(t) do{ _Pragma("unroll") for(int g_=0;g_<4;++g_){ const bf16*s_=V+W.krow((t),16*g_+(lane>>2))*DM+(lane&3)*8; \
      glds16(s_,(unsigned)__builtin_amdgcn_readfirstlane(lds0+8192+g_*1024)); glds16(s_+32,(unsigned)__builtin_amdgcn_readfirstlane(lds0+8192+(4+g_)*1024)); } }while(0)
  bf16x8 qr[4];
  { const bf16*qp=Q+W.qrow(r32)*DM+hi*8;
    #pragma unroll
    for(int d0=0;d0<4;++d0)qr[d0]=*reinterpret_cast<const bf16x8*>(qp+d0*16); }
  WDMA_K(0); WDMA_V(0);
  float zz_;asm volatile("v_mov_b32 %0, 0":"=v"(zz_));
  float mhat=zz_,l_reg=zz_;f32x16 o[2];f32x16 negm;
  _Pragma("unroll") for(int r=0;r<16;++r){o[0][r]=zz_;o[1][r]=zz_;negm[r]=zz_;} asm volatile("":"+v"(negm));
  for(int t=0;t<Var::NT;++t){
    asm volatile("s_waitcnt vmcnt(8)":::"memory");
    f32x16 p0,p1; qkt(p0,p1,shm,qr,negm,r32,hi); asm volatile("s_nop 15\n\ts_nop 7":"+v"(p0),"+v"(p1));
    asm volatile("s_waitcnt lgkmcnt(0)":::"memory");
    if(t+1<Var::NT){ WDMA_K(t+1); }
    W.mask(p0,p1,t,r32,hi);
    const float rm=rowmax(p0,p1);
    if(t==0){ const float dl=__builtin_fmaxf(rm,-30.f); mhat+=dl;
      _Pragma("unroll") for(int r=0;r<16;++r){p0[r]-=dl;p1[r]-=dl;}
      _Pragma("unroll") for(int r=0;r<16;++r)negm[r]=-mhat; asm volatile("":"+v"(negm)); }
    else if(__any(rm>8.f)){ const float dl=__builtin_fmaxf(rm,0.f); mhat+=dl;
      _Pragma("unroll") for(int r=0;r<16;++r){p0[r]-=dl;p1[r]-=dl;}
      _Pragma("unroll") for(int r=0;r<16;++r)negm[r]=-mhat; asm volatile("":"+v"(negm));
      const float f=__builtin_amdgcn_exp2f(-dl); l_reg*=f; if(hi==0)wsf[r32]=f;
      asm volatile("s_waitcnt lgkmcnt(0)":::"memory");
      _Pragma("unroll") for(int d_=0;d_<2;++d_) _Pragma("unroll") for(int r=0;r<16;++r)o[d_][r]*=wsf[crow(r,hi)];
      asm volatile("s_waitcnt lgkmcnt(0)":::"memory"); }
    float sacc=0.f;
    _Pragma("unroll") for(int r=0;r<16;++r){p0[r]=__builtin_amdgcn_exp2f(p0[r]);p1[r]=__builtin_amdgcn_exp2f(p1[r]);sacc+=p0[r]+p1[r];}
    l_reg+=sacc;
    u32x4 pw0,pw1,pw2,pw3;
    pw0=(u32x4){cvtpk_s(p0[0],p0[1]),cvtpk_s(p0[2],p0[3]),cvtpk_s(p0[4],p0[5]),cvtpk_s(p0[6],p0[7])};
    pw1=(u32x4){cvtpk_s(p0[8],p0[9]),cvtpk_s(p0[10],p0[11]),cvtpk_s(p0[12],p0[13]),cvtpk_s(p0[14],p0[15])};
    pw2=(u32x4){cvtpk_s(p1[0],p1[1]),cvtpk_s(p1[2],p1[3]),cvtpk_s(p1[4],p1[5]),cvtpk_s(p1[6],p1[7])};
    pw3=(u32x4){cvtpk_s(p1[8],p1[9]),cvtpk_s(p1[10],p1[11]),cvtpk_s(p1[12],p1[13]),cvtpk_s(p1[14],p1[15])};
    if(t+1<Var::NT){ asm volatile("s_waitcnt vmcnt(8)":::"memory"); } else { asm volatile("s_waitcnt vmcnt(0)":::"memory"); }
    __builtin_amdgcn_sched_barrier(0);
    pv(o,vb0,__builtin_bit_cast(bf16x8,pw0),__builtin_bit_cast(bf16x8,pw1),__builtin_bit_cast(bf16x8,pw2),__builtin_bit_cast(bf16x8,pw3));
    if(t+1<Var::NT){ WDMA_V(t+1); }
  }
  {auto rr=__builtin_amdgcn_permlane32_swap(__float_as_uint(l_reg),__float_as_uint(l_reg),false,false);l_reg=__uint_as_float(rr[0])+__uint_as_float(rr[1]);}
  if(hi==0)wsf[32+r32]=l_reg;asm volatile("s_waitcnt lgkmcnt(0)":::"memory");
  float rli[16];
  #pragma unroll
  for(int r=0;r<16;++r)rli[r]=__builtin_amdgcn_rcpf(wsf[32+crow(r,hi)]);
  W.store_lse(r32,hi,mhat,l_reg);
  { bf16*stg=(bf16*)shm;
    #pragma unroll
    for(int r=0;r<16;++r){const int orow=crow(r,hi);
      #pragma unroll
      for(int d0=0;d0<2;++d0)stg[orow*64+d0*32+r32]=__float2bfloat16(o[d0][r]*rli[r]);}
    asm volatile("s_waitcnt lgkmcnt(0)":::"memory");
    #pragma unroll
    for(int i=0;i<4;++i){const int row=i*8+(lane>>3),ch=lane&7; const u32x4 v=*(const u32x4*)(stg+row*64+ch*8); ATTN_STORE16(O+W.qrow(row)*Var::OP+ch*8,v);}
    asm volatile("s_waitcnt lgkmcnt(0)":::"memory"); }
  #undef WDMA_K
  #undef WDMA_V
}
struct VarCw {
  static constexpr int NT=3, OP=384;
  int rowb, dil, cls, u0, L; float* lse; int h;
  __device__ __forceinline__ long qrow(int r)const{ return (long)rowb+(long)(u0+r)*dil+cls; }
  __device__ __forceinline__ long krow(int t,int idx)const{ int u=u0-64+64*t+idx; u=u<0?0:(u>L-1?L-1:u); return (long)rowb+(long)u*dil+cls; }
  __device__ __forceinline__ void mask(f32x16&P0,f32x16&P1,int t,int r32,int hi)const{
    const int dbase=64*t-64+4*hi-r32, ubase=u0-64+64*t+4*hi;
    #pragma unroll
    for(int r=0;r<16;++r){ const int kk=(r&3)+8*(r>>2);
      const bool ok0=((unsigned)(dbase+kk+64)<=128u)&&((unsigned)(ubase+kk)<(unsigned)L);
      const bool ok1=((unsigned)(dbase+kk+32+64)<=128u)&&((unsigned)(ubase+kk+32)<(unsigned)L);
      P0[r]=ok0?P0[r]:-INFINITY; P1[r]=ok1?P1[r]:-INFINITY; }
  }
  __device__ __forceinline__ void store_lse(int r32,int hi,float mhat,float l)const{ if(hi==0) lse[qrow(r32)*6+h]=mhat+__builtin_amdgcn_logf(l); }
};
struct VarBw {
  static constexpr int NT=8, OP=1024;
  int rowb, r, c0, rs; const float* tab;
  __device__ __forceinline__ long qrow(int rr)const{ return (long)rowb+r*64+c0+rr; }
  __device__ __forceinline__ long krow(int t,int idx)const{ return (long)rowb+(rs+t)*64+idx; }
  __device__ __forceinline__ void mask(f32x16&P0,f32x16&P1,int t,int r32,int hi)const{
    const int c=c0+r32, kr=rs+t; int cs=c-8; cs=cs<0?0:(cs>48?48:cs);
    const int cb=4*hi-cs; const float*tb=tab+((kr-r+7)*31+4*hi-c+15);
    #pragma unroll
    for(int q=0;q<16;++q){ const int kk=(q&3)+8*(q>>2);
      const bool ok0=((unsigned)(cb+kk)<16u), ok1=((unsigned)(cb+kk+32)<16u);
      const float b0=tb[kk], b1=tb[kk+32];
      P0[q]=ok0?P0[q]+b0:-INFINITY; P1[q]=ok1?P1[q]+b1:-INFINITY;
      if((q&3)==3)asm volatile("":::"memory"); }
  }
  __device__ __forceinline__ void store_lse(int,int,float,float)const{}
};
constexpr int WV_WSF=132096, WV_TAB=134144;
__device__ __forceinline__ void attnB_wave_phase(char*lds,const bf16*qkv,int cq,int ck,int cv,const float*nab,bf16*ao,int G,int bid,int lane,int wid){
  float*tab=(float*)(lds+WV_TAB); float*wsf=(float*)(lds+WV_WSF)+wid*64; char*shm=lds+wid*16384;
  const int h=bid%6, j=bid/6, nbh=(G-h+5)/6;
  { const int i=wid*64+lane; if(i<15*31)tab[i]=nab[h*465+i]*1.4426950408889634f; }
  asm volatile("s_waitcnt lgkmcnt(0)\n\ts_barrier":::"memory");
  for(int it=j*8+wid;it<8*128;it+=nbh*8){ const int b=it>>7,r=(it>>1)&63,half=it&1;
    VarBw W; W.rowb=b*SEQ; W.r=r; W.c0=32*half; int rs=r-4; W.rs=rs<0?0:(rs>56?56:rs); W.tab=tab;
    attn_wave_item<VarBw>(W,qkv+cq+h*64,qkv+ck+h*64,qkv+cv+h*64,ao+256+h*64,shm,wsf,lane); }
}
__device__ __forceinline__ void attnC_wave_phase(char*lds,const bf16*qkv,int cq,int ck,int cv,bf16*part,float*lse,int G,int bid,int lane,int wid){
  float*wsf=(float*)(lds+WV_WSF)+wid*64; char*shm=lds+wid*16384;
  for(int it=bid*8+wid;it<8*6*3*128;it+=G*8){ const int k=it&127,rest=it>>7,br=rest%3,bh=rest/3,h=bh%6,b=bh/6;
    VarCw W; W.rowb=b*SEQ; W.dil=1<<(2*br); W.L=SEQ>>(2*br); W.h=h;
    if(br==0){W.cls=0;W.u0=32*k;} else if(br==1){W.cls=k&3;W.u0=32*(k>>2);} else {W.cls=k&15;W.u0=32*(k>>4);}
    W.lse=lse+(size_t)br*(8*SEQ*6);
    attn_wave_item<VarCw>(W,qkv+cq+h*64,qkv+ck+h*64,qkv+cv+h*64,part+(size_t)br*(8*SEQ*384)+h*64,shm,wsf,lane); }
}
#undef SBAR
#undef WAIT_BAR
}
#define GAS __attribute__((address_space(1)))
#define LAS __attribute__((address_space(3)))
typedef unsigned short bf16;
typedef unsigned v4u __attribute__((ext_vector_type(4)));
typedef float f32x4 __attribute__((ext_vector_type(4)));
typedef short bf16x8 __attribute__((ext_vector_type(8)));
typedef GAS unsigned gu32;
typedef GAS unsigned long long gu64;
#define RLX_AGENT __ATOMIC_RELAXED, __HIP_MEMORY_SCOPE_AGENT
#define LDS_WAIT() asm volatile("s_waitcnt lgkmcnt(0)" ::: "memory")
#define VM_WAIT() asm volatile("s_waitcnt vmcnt(0)" ::: "memory")
__device__ __forceinline__ unsigned long long rt() { return __builtin_amdgcn_s_memrealtime(); }
__device__ __forceinline__ unsigned f2bf(float f) { unsigned u = __builtin_bit_cast(unsigned, f); return (u + 0x7fffu + ((u >> 16) & 1u)) >> 16; }
typedef float pk_f32x2 __attribute__((ext_vector_type(2))); typedef __bf16 pk_bf16x2 __attribute__((ext_vector_type(2)));
__device__ __forceinline__ unsigned pk2(float lo, float hi) { pk_f32x2 v = {lo, hi}; pk_bf16x2 b = __builtin_convertvector(v, pk_bf16x2); return __builtin_bit_cast(unsigned, b); }

#define XB_TMO      128
#define XB_XCNT(j)  (256  + 64 * (j))
#define XB_XSUB(j)  (1280 + 64 * (j))
#define XB_XGEN(j)  (2304 + 64 * (j))
#define XB_TOP      3328
#define XB_TOPGEN   3392
#define XCD_BAR_WORDS 3456
#define XB_SPIN_CAP (1u << 18)

__device__ __forceinline__ unsigned xb_ld(unsigned* p)              { return __hip_atomic_load(p, __ATOMIC_RELAXED, __HIP_MEMORY_SCOPE_AGENT); }
__device__ __forceinline__ unsigned xb_add(unsigned* p, unsigned v) { return __hip_atomic_fetch_add(p, v, __ATOMIC_RELAXED, __HIP_MEMORY_SCOPE_AGENT); }
__device__ __forceinline__ unsigned xb_xcc_id() { return (unsigned)__builtin_amdgcn_s_getreg((3 << 11) | 20) & 0xFu; }
#define XB_SPIN(cond, bar) do { unsigned _sp = 0; while (cond) { __builtin_amdgcn_s_sleep(1); \
    if ((++_sp & 255u) == 0u) { if (xb_ld(&(bar)[XB_TMO])) break; if (_sp > XB_SPIN_CAP) { atomicAdd(&(bar)[XB_TMO], 1u); break; } } } } while (0)

struct XcdBarrier {
    unsigned* bar; unsigned x;
    volatile LAS unsigned* st;
};

__device__ __forceinline__ XcdBarrier xcd_barrier_post(unsigned* bar, volatile LAS unsigned* st) {
    XcdBarrier b; b.bar = bar; b.x = xb_xcc_id(); b.st = st;
    if (threadIdx.x == 0) (void)xb_add(&bar[XB_XCNT(b.x)], 1u);
    return b;
}
__device__ __forceinline__ void xcd_barrier_complete(unsigned* bar, unsigned x, unsigned& nloc, unsigned& nx) {
    const unsigned G = gridDim.x * gridDim.y * gridDim.z;
    unsigned sum, cnt, mine, sp = 0u;
    for (;;) {
        sum = 0u; cnt = 0u; mine = 0u;
#pragma unroll
        for (unsigned j = 0; j < 16; ++j) { const unsigned c = xb_ld(&bar[XB_XCNT(j)]); sum += c; cnt += (c > 0u) ? 1u : 0u; mine = (j == x) ? c : mine; }
        if (sum == G) break;
        __builtin_amdgcn_s_sleep(1);
        if ((++sp & 255u) == 0u) { if (xb_ld(&bar[XB_TMO])) break; if (sp > XB_SPIN_CAP) { atomicAdd(&bar[XB_TMO], 1u); break; } }
    }
    nloc = mine > 0u ? mine : 1u; nx = cnt > 0u ? cnt : 1u;
}

__device__ __forceinline__ void xcd_barrier(const XcdBarrier& b) {
    asm volatile("s_waitcnt vmcnt(0)" ::: "memory");
    __syncthreads();
    if (threadIdx.x == 0) {
        unsigned* bar = b.bar;
        __builtin_amdgcn_s_waitcnt(0);
        unsigned nloc = b.st[0], nx = b.st[1];
        if (nloc == 0u) { xcd_barrier_complete(bar, b.x, nloc, nx); b.st[0] = nloc; b.st[1] = nx; }
        const unsigned old = xb_add(&bar[XB_XSUB(b.x)], 1u);
        const unsigned gen = old / nloc;
        if (old + 1u == (gen + 1u) * nloc) {
            __builtin_amdgcn_fence(__ATOMIC_RELEASE, "agent");
            asm volatile("s_waitcnt vmcnt(0)" ::: "memory");
            const unsigned og = xb_add(&bar[XB_TOP], 1u);
            const unsigned tg = og / nx;
            if (og + 1u == (tg + 1u) * nx) xb_add(&bar[XB_TOPGEN], 1u);
            else XB_SPIN(xb_ld(&bar[XB_TOPGEN]) == tg, bar);
            __builtin_amdgcn_fence(__ATOMIC_ACQUIRE, "agent");
            xb_add(&bar[XB_XGEN(b.x)], 1u);
            asm volatile("s_waitcnt vmcnt(0)" ::: "memory");
        } else {
            XB_SPIN(xb_ld(&bar[XB_XGEN(b.x)]) == gen, bar);
            __builtin_amdgcn_fence(__ATOMIC_ACQUIRE, "agent");
            asm volatile("s_waitcnt vmcnt(0)" ::: "memory");
        }
    }
    __syncthreads();
}

constexpr int NB = 8, SEQ = 4096, DM = 1024, DEPTH = 4, MTOK = NB * SEQ;
constexpr int NQKV = 2816, NE = 16, CAP = 512, DFF = 1024, DPLE = 256, MR = NE * NB * CAP;
constexpr int NWAVES = 8, NTHR = NWAVES * 64;
constexpr float RMS_EPS = 1e-6f;
constexpr float LOG2E = 1.4426950408889634f, QSCALE = 0.125f * LOG2E;
constexpr int C_QA = 0, C_KA = 256, C_VA = 384, C_QB = 512, C_KB = 896, C_VB = 1280, C_QC = 1664, C_KC = 2048, C_VC = 2432;
constexpr int NPH_LAYER = 12, NPHASES = 1 + DEPTH * NPH_LAYER;

constexpr size_t MiB = 1u << 20;
constexpr size_t WS_CTL = 0, CTL_ZERO_BYTES = 128 * 1024;
constexpr size_t WS_TAB = 1 * MiB;
constexpr size_t WS_AFF = 2 * MiB;
constexpr size_t WS_IDX = 4 * MiB;
constexpr size_t WS_GATE = 5 * MiB;
constexpr size_t WS_SEL = 6 * MiB;
constexpr size_t WS_RSZ = 8 * MiB;
constexpr size_t WS_RSY = 8 * MiB + 256 * 1024;
constexpr size_t WS_RSA = 8 * MiB + 512 * 1024;
constexpr size_t WS_RSG = 9 * MiB;
constexpr size_t WS_SSQ = 10 * MiB;
constexpr size_t WS_WPG_ALT = 12 * MiB;
constexpr size_t WS_WOUT_ALT = 14 * MiB;
constexpr size_t WS_WIN = 16 * MiB;
constexpr size_t WS_WOUT = 22 * MiB;
constexpr size_t WS_WPG = 24 * MiB;
constexpr size_t WS_WPP = 26 * MiB;
constexpr size_t WS_WGU = 28 * MiB;
constexpr size_t WS_WD = 92 * MiB;
constexpr size_t WS_PBF = 124 * MiB;
constexpr size_t WS_AN = 140 * MiB;
constexpr size_t WS_QKV = 204 * MiB;
constexpr size_t WS_AO = 380 * MiB;
constexpr size_t WS_XG = 444 * MiB;
constexpr size_t WS_HID = 572 * MiB;
constexpr size_t WS_HY8 = WS_HID + 64 * MiB;
constexpr size_t WS_PP = 700 * MiB;
constexpr size_t WS_MIX = 764 * MiB;
constexpr size_t WS_Y = 828 * MiB;
constexpr size_t WS_END = 956 * MiB;
constexpr int CW_BAR = 4096;
constexpr int CW_XRANK = 8192;
constexpr int CW_GRP = 16384;

constexpr int RING_OFF = 0, RING_BYTES = 131072;
constexpr int LDSCTL_OFF = RING_BYTES, MISC_OFF = LDSCTL_OFF + 320;
constexpr int LDS_BYTES = 147456;
constexpr int GTOK_OFF = 136192, GTOK_UNITS = 8;

struct float2_t { float x, y; };
typedef unsigned u32x2 __attribute__((ext_vector_type(2)));

#ifndef ROUTER_MFMA
#define ROUTER_MFMA 1
#endif
#ifndef XCD_TRUE
#define XCD_TRUE 0
#endif
#ifndef FUSE_RT
#define FUSE_RT 0
#endif
#ifndef NT_STORES
#define NT_STORES 0
#endif
__device__ __forceinline__ void st16(void* p, v4u v) { if (NT_STORES) __builtin_nontemporal_store(v, (v4u*)p); else *(v4u*)p = v; }
#define PIN4V(a) asm volatile("" : "+v"((a)[0]), "+v"((a)[1]), "+v"((a)[2]), "+v"((a)[3]))

__device__ __forceinline__ int dpp_i(int v, const int ctrl_unused) { return v; }
#define DPP_ADD_I(v, ctrl) ((v) + __builtin_amdgcn_update_dpp(0, (v), (ctrl), 0xf, 0xf, true))
__device__ __forceinline__ int xor16_add_i(int v) { auto r = __builtin_amdgcn_permlane16_swap((unsigned)v, (unsigned)v, false, false); return (int)(r[0] + r[1]); }
__device__ __forceinline__ int xor32_add_i(int v) { auto r = __builtin_amdgcn_permlane32_swap((unsigned)v, (unsigned)v, false, false); return (int)(r[0] + r[1]); }
__device__ __forceinline__ float xor16_add(float v) { auto r = __builtin_amdgcn_permlane16_swap(__float_as_uint(v), __float_as_uint(v), false, false); return __uint_as_float(r[0]) + __uint_as_float(r[1]); }
__device__ __forceinline__ float xor32_add(float v) { auto r = __builtin_amdgcn_permlane32_swap(__float_as_uint(v), __float_as_uint(v), false, false); return __uint_as_float(r[0]) + __uint_as_float(r[1]); }
__device__ __forceinline__ float dpp_f(float v, int) { return v; }
#define DPP_ADD_F(v, ctrl) ((v) + __int_as_float(__builtin_amdgcn_update_dpp(0, __float_as_int(v), (ctrl), 0xf, 0xf, true)))
__device__ __forceinline__ float wave_sum(float v) {
    v = DPP_ADD_F(v, 0xB1); v = DPP_ADD_F(v, 0x4E); v = DPP_ADD_F(v, 0x141); v = DPP_ADD_F(v, 0x140);
    v = xor16_add(v); v = xor32_add(v);
    return v;
}
__device__ __forceinline__ int wave_sum_i(int v) {
    v = DPP_ADD_I(v, 0xB1); v = DPP_ADD_I(v, 0x4E); v = DPP_ADD_I(v, 0x141); v = DPP_ADD_I(v, 0x140);
    v = xor16_add_i(v); v = xor32_add_i(v);
    return v;
}
__device__ __forceinline__ int lane_id() { int l; asm volatile("v_mbcnt_lo_u32_b32 %0, -1, 0\n\tv_mbcnt_hi_u32_b32 %0, -1, %0" : "=v"(l)); return l; }
constexpr float F8_SC_W = 64.0f, F8_SC_WD = 16.0f, F8_SC_HID = 1.0f;
__device__ __forceinline__ unsigned pk4_f8(float a, float b, float c, float d) {
    int r = __builtin_amdgcn_cvt_pk_fp8_f32(a, b, 0, false); r = __builtin_amdgcn_cvt_pk_fp8_f32(c, d, r, true); return (unsigned)r; }
__device__ __forceinline__ float bflo(unsigned u) { return __uint_as_float(u << 16); }
__device__ __forceinline__ float bfhi(unsigned u) { return __uint_as_float(u & 0xffff0000u); }

__device__ __forceinline__ void sincos_acc(float ang, float& c, float& s) {
    const double a = (double)ang;
    const double q = __builtin_rint(a * 0.63661977236758134308);
    const double t = a - q * 1.57079632679489661923;
    const int qi = (int)q;
    const double t2 = t * t;
    const double sn = t * (1.0 + t2 * (-1.0 / 6.0 + t2 * (1.0 / 120.0 + t2 * (-1.0 / 5040.0 + t2 * (1.0 / 362880.0 + t2 * (-1.0 / 39916800.0))))));
    const double cs = 1.0 + t2 * (-0.5 + t2 * (1.0 / 24.0 + t2 * (-1.0 / 720.0 + t2 * (1.0 / 40320.0 + t2 * (-1.0 / 3628800.0 + t2 * (1.0 / 479001600.0))))));
    const int k = qi & 3;
    const double cc = (k == 0) ? cs : (k == 1) ? -sn : (k == 2) ? -cs : sn;
    const double ss = (k == 0) ? sn : (k == 1) ? cs : (k == 2) ? -sn : -cs;
    c = (float)cc; s = (float)ss;
}

__device__ __forceinline__ void norm_row2_bf16(const float* x0, const float* x1, const float* gain, bf16* o0, bf16* o1, int lane) {
    const f32x4* xr0 = (const f32x4*)x0 + lane; const f32x4* xr1 = (const f32x4*)x1 + lane;
    const f32x4* gr = (const f32x4*)gain + lane;
    f32x4 v[4], w[4], g[4]; float s = 0.f, q = 0.f;
#pragma unroll
    for (int j = 0; j < 4; ++j) { v[j] = xr0[64 * j]; w[j] = xr1[64 * j]; g[j] = gr[64 * j]; }
    PIN4V(v); PIN4V(w);
#pragma unroll
    for (int j = 0; j < 4; ++j) { s += (v[j].x * v[j].x + v[j].y * v[j].y) + (v[j].z * v[j].z + v[j].w * v[j].w); q += (w[j].x * w[j].x + w[j].y * w[j].y) + (w[j].z * w[j].z + w[j].w * w[j].w); }
    const float rs = 1.0f / sqrtf(wave_sum(s) * (1.0f / DM) + RMS_EPS), rq = 1.0f / sqrtf(wave_sum(q) * (1.0f / DM) + RMS_EPS);
    unsigned long long* a8 = (unsigned long long*)o0 + lane; unsigned long long* b8 = (unsigned long long*)o1 + lane;
#pragma unroll
    for (int j = 0; j < 4; ++j) {
        a8[64 * j] = (unsigned long long)pk2(v[j].x * rs * g[j].x, v[j].y * rs * g[j].y) | ((unsigned long long)pk2(v[j].z * rs * g[j].z, v[j].w * rs * g[j].w) << 32);
        b8[64 * j] = (unsigned long long)pk2(w[j].x * rq * g[j].x, w[j].y * rq * g[j].y) | ((unsigned long long)pk2(w[j].z * rq * g[j].z, w[j].w * rq * g[j].w) << 32); }
}

__device__ __forceinline__ void cast_row2(const float* x0, const float* x1, bf16* o0, bf16* o1, float* rs0, float* rs1, int lane) {
    const f32x4* xr0 = (const f32x4*)x0 + lane; const f32x4* xr1 = (const f32x4*)x1 + lane;
    f32x4 v[4], w[4]; float s = 0.f, q = 0.f;
#pragma unroll
    for (int j = 0; j < 4; ++j) { v[j] = xr0[64 * j]; w[j] = xr1[64 * j]; }
    PIN4V(v); PIN4V(w);
    unsigned long long* a8 = (unsigned long long*)o0 + lane; unsigned long long* b8 = (unsigned long long*)o1 + lane;
#pragma unroll
    for (int j = 0; j < 4; ++j) { s += (v[j].x * v[j].x + v[j].y * v[j].y) + (v[j].z * v[j].z + v[j].w * v[j].w); q += (w[j].x * w[j].x + w[j].y * w[j].y) + (w[j].z * w[j].z + w[j].w * w[j].w);
        a8[64 * j] = (unsigned long long)pk2(v[j].x, v[j].y) | ((unsigned long long)pk2(v[j].z, v[j].w) << 32);
        b8[64 * j] = (unsigned long long)pk2(w[j].x, w[j].y) | ((unsigned long long)pk2(w[j].z, w[j].w) << 32); }
    const float rs = 1.0f / sqrtf(wave_sum(s) * (1.0f / DM) + RMS_EPS), rq = 1.0f / sqrtf(wave_sum(q) * (1.0f / DM) + RMS_EPS);
    if (lane == 0) { *rs0 = rs; *rs1 = rq; }
}
__device__ __forceinline__ void norm_row2_h16(const bf16* x0, const bf16* x1, const float* gain, bf16* o0, bf16* o1, int lane) {
    const unsigned long long* xr0 = (const unsigned long long*)x0 + lane; const unsigned long long* xr1 = (const unsigned long long*)x1 + lane;
    const f32x4* gr = (const f32x4*)gain + lane;
    unsigned long long a[4], b[4]; f32x4 v[4], w[4], g[4]; float s = 0.f, q = 0.f;
#pragma unroll
    for (int j = 0; j < 4; ++j) { a[j] = xr0[64 * j]; b[j] = xr1[64 * j]; g[j] = gr[64 * j]; }
    PIN4V(a); PIN4V(b);
#pragma unroll
    for (int j = 0; j < 4; ++j) { const unsigned a0 = (unsigned)a[j], a1 = (unsigned)(a[j] >> 32), b0 = (unsigned)b[j], b1 = (unsigned)(b[j] >> 32);
        v[j] = (f32x4){bflo(a0), bfhi(a0), bflo(a1), bfhi(a1)}; w[j] = (f32x4){bflo(b0), bfhi(b0), bflo(b1), bfhi(b1)};
        s += (v[j].x * v[j].x + v[j].y * v[j].y) + (v[j].z * v[j].z + v[j].w * v[j].w); q += (w[j].x * w[j].x + w[j].y * w[j].y) + (w[j].z * w[j].z + w[j].w * w[j].w); }
    const float rs = 1.0f / sqrtf(wave_sum(s) * (1.0f / DM) + RMS_EPS), rq = 1.0f / sqrtf(wave_sum(q) * (1.0f / DM) + RMS_EPS);
    unsigned long long* a8 = (unsigned long long*)o0 + lane; unsigned long long* b8 = (unsigned long long*)o1 + lane;
#pragma unroll
    for (int j = 0; j < 4; ++j) {
        a8[64 * j] = (unsigned long long)pk2(v[j].x * rs * g[j].x, v[j].y * rs * g[j].y) | ((unsigned long long)pk2(v[j].z * rs * g[j].z, v[j].w * rs * g[j].w) << 32);
        b8[64 * j] = (unsigned long long)pk2(w[j].x * rq * g[j].x, w[j].y * rq * g[j].y) | ((unsigned long long)pk2(w[j].z * rq * g[j].z, w[j].w * rq * g[j].w) << 32); }
}

struct TrJob { const float* src; bf16* dst; const float* gain; int ldw, ldt; float sc; };
struct Args { const float* in[16]; float* out; unsigned char* ws; float inv_ax[16]; float inv_1d[8]; int ph_lo, ph_hi; };
constexpr int TR_I_IN = 16 * 88, TR_I_SQ = 16 * 32, TR_I_PP = 4 * 32, TR_I_EXP = 16 * 512, TR_NITEMS = TR_I_IN + 2 * TR_I_SQ + TR_I_PP + 3 * TR_I_EXP;
__device__ __forceinline__ TrJob tr_decode(const __attribute__((address_space(4))) Args* ka, int l, int it) {
    TrJob J; J.gain = nullptr; J.sc = 1.0f; int r = it; unsigned char* ws = ka->ws;
    if (r < TR_I_IN) { const int kb = r / 88, nb = r % 88, n0 = 32 * nb, tile = n0 >> 8, lw = n0 & 255, wc = lw >> 6, bj = (lw >> 5) & 1;
        J.ldw = NQKV; J.ldt = DM; J.src = ka->in[3] + (size_t)l * DM * NQKV + (size_t)(64 * kb) * NQKV + n0; J.dst = (bf16*)(ws + WS_WIN) + (size_t)(tile * 256 + 128 * bj + 32 * wc) * DM + 64 * kb; J.gain = ka->in[2] + (size_t)l * DM + 64 * kb; return J; } r -= TR_I_IN;
    if (r < TR_I_SQ) { const int kb = r >> 5, nb = r & 31; J.ldw = DM; J.ldt = DM; J.src = ka->in[7] + (size_t)l * DM * DM + (size_t)(64 * kb) * DM + 32 * nb; J.dst = (bf16*)(ws + ((l & 1) ? WS_WOUT_ALT : WS_WOUT)) + (size_t)(32 * nb) * DM + 64 * kb; return J; } r -= TR_I_SQ;
    if (r < TR_I_SQ) { const int kb = r >> 5, nb = r & 31; J.ldw = DM; J.ldt = DM; J.src = ka->in[14] + (size_t)l * DM * DM + (size_t)(64 * kb) * DM + 32 * nb; J.dst = (bf16*)(ws + ((l & 1) ? WS_WPG_ALT : WS_WPG) + (size_t)(32 * nb) * DM + 64 * kb); J.gain = ka->in[13] + (size_t)l * DM + 64 * kb; J.sc = F8_SC_W; return J; } r -= TR_I_SQ;
    if (r < TR_I_PP) { const int kb = r >> 5, nb = r & 31; J.ldw = DM; J.ldt = DPLE; J.src = ka->in[15] + (size_t)l * DPLE * DM + (size_t)(64 * kb) * DM + 32 * nb; J.dst = (bf16*)(ws + WS_WPP) + (size_t)(32 * nb) * DPLE + 64 * kb; return J; } r -= TR_I_PP;
    const int which = r / TR_I_EXP; r -= which * TR_I_EXP;
    const int e = r >> 9, rr = r & 511, kb = rr >> 5, nb = rr & 31, n0 = 32 * nb;
    J.ldw = DM; J.ldt = DM; J.sc = F8_SC_W;
    if (which < 2) J.gain = ka->in[8] + (size_t)l * DM + 64 * kb;
    if (which == 0) { J.src = ka->in[10] + (size_t)(l * NE + e) * DM * DFF + (size_t)(64 * kb) * DFF + n0; J.dst = (bf16*)(ws + WS_WGU + (size_t)(l & 1) * (32 * MiB) + (size_t)(e * 2048 + (n0 >> 7) * 256 + (n0 & 127)) * DM + 64 * kb); }
    else if (which == 1) { J.src = ka->in[11] + (size_t)(l * NE + e) * DM * DFF + (size_t)(64 * kb) * DFF + n0; J.dst = (bf16*)(ws + WS_WGU + (size_t)(l & 1) * (32 * MiB) + (size_t)(e * 2048 + (n0 >> 7) * 256 + 128 + (n0 & 127)) * DM + 64 * kb); }
    else { J.src = ka->in[12] + (size_t)(l * NE + e) * DFF * DM + (size_t)(64 * kb) * DM + n0; J.dst = (bf16*)(ws + WS_WD + (size_t)(l & 1) * (16 * MiB) + (size_t)(e * 1024 + n0) * DFF + 64 * kb); J.sc = F8_SC_WD; }
    return J;
}
__device__ __forceinline__ void tr_load(const TrJob& J, f32x4 (&v)[8], float (&gk)[8], int lane) {
    const int kq = lane >> 3, nq = (lane & 7) * 4;
#pragma unroll
    for (int i = 0; i < 8; ++i) v[i] = __builtin_nontemporal_load((const f32x4*)(J.src + (size_t)(8 * i + kq) * J.ldw + nq));
    if (J.gain) {
#pragma unroll
        for (int i = 0; i < 8; ++i) gk[i] = J.gain[8 * i + kq] * J.sc;
    } else {
#pragma unroll
        for (int i = 0; i < 8; ++i) gk[i] = J.sc;
    }
}
__device__ __forceinline__ void tr_store(const TrJob& J, const f32x4 (&v)[8], const float (&gk)[8], LAS float* scr, int lane) {
    const int kq = lane >> 3, nq = (lane & 7) * 4;
#pragma unroll
    for (int i = 0; i < 8; ++i) { LAS float* d = scr + (8 * i + kq) * 33 + nq; d[0] = v[i].x * gk[i]; d[1] = v[i].y * gk[i]; d[2] = v[i].z * gk[i]; d[3] = v[i].w * gk[i]; }
    LDS_WAIT(); asm volatile("" ::: "memory");
    const int c = lane & 7;
    if (J.sc != 1.0f) {
#pragma unroll
        for (int j = 0; j < 4; ++j) { const int n = (lane >> 3) + 8 * j; const LAS float* s = scr + (8 * c) * 33 + n;
            u32x2 o; o.x = pk4_f8(s[0 * 33], s[1 * 33], s[2 * 33], s[3 * 33]); o.y = pk4_f8(s[4 * 33], s[5 * 33], s[6 * 33], s[7 * 33]);
            *(u32x2*)((unsigned char*)J.dst + (size_t)n * J.ldt + 8 * c) = o; }
    } else {
#pragma unroll
    for (int j = 0; j < 4; ++j) { const int n = (lane >> 3) + 8 * j; const LAS float* s = scr + (8 * c) * 33 + n;
        v4u o; o.x = pk2(s[0 * 33], s[1 * 33]); o.y = pk2(s[2 * 33], s[3 * 33]); o.z = pk2(s[4 * 33], s[5 * 33]); o.w = pk2(s[6 * 33], s[7 * 33]);
        *(v4u*)(J.dst + (size_t)n * J.ldt + 8 * c) = o; }
    }
    LDS_WAIT(); asm volatile("" ::: "memory");
}
constexpr int TR_N_LATE = 2 * TR_I_SQ + 3 * TR_I_EXP, TR_N_EARLY = TR_I_IN + TR_I_PP;
__device__ __forceinline__ TrJob tr_decode_m(const __attribute__((address_space(4))) Args* ka, int mode, int l, int it) {
    if (mode == 1) {
        if (it < 2 * TR_I_SQ) return tr_decode(ka, l, TR_I_IN + it);
        it -= 2 * TR_I_SQ; if (it < 3 * TR_I_EXP) return tr_decode(ka, l, TR_I_IN + 2 * TR_I_SQ + TR_I_PP + it);
        it -= 3 * TR_I_EXP; ++l;
    }
    return tr_decode(ka, l, it < TR_I_IN ? it : 2 * TR_I_SQ + it);
}
__device__ __forceinline__ void convert_layer(const __attribute__((address_space(4))) Args* ka, int mode, int l, LAS unsigned char* lds, int gw, int NGW, int wave, int lane, int gtid, int NGT) {
    LAS float* scr = (LAS float*)(lds + RING_OFF + wave * 16384);
    const bool early = (mode == 0) || (l + 1 < DEPTH);
    const int NIT = (mode == 0) ? TR_N_EARLY : TR_N_LATE + (early ? TR_N_EARLY : 0);
    f32x4 va[8], vb[8]; float ga[8], gb[8]; TrJob Ja, Jb;
    int it = gw;
    if (it < NIT) { Ja = tr_decode_m(ka, mode, l, it); tr_load(Ja, va, ga, lane); }
    while (it < NIT) {
        const int it1 = it + NGW; if (it1 < NIT) { Jb = tr_decode_m(ka, mode, l, it1); tr_load(Jb, vb, gb, lane); }
        tr_store(Ja, va, ga, scr, lane);
        const int it2 = it1 + NGW; if (it2 < NIT) { Ja = tr_decode_m(ka, mode, l, it2); tr_load(Ja, va, ga, lane); }
        if (it1 < NIT) tr_store(Jb, vb, gb, scr, lane);
        it = it2;
    }
    if (!early) return;
    const int le = (mode == 0) ? 0 : l + 1;
    const f32x4* ps = (const f32x4*)(ka->in[1] + (size_t)le * MTOK * DPLE);
    v4u* pd = (v4u*)(ka->ws + WS_PBF);
    constexpr int NP = MTOK * DPLE / 8;
    for (int i = gtid; i < NP / 2; i += NGT) { const f32x4 a = __builtin_nontemporal_load(ps + 2 * i), b = __builtin_nontemporal_load(ps + 2 * i + 1), c = __builtin_nontemporal_load(ps + 2 * (i + NP / 2)), d = __builtin_nontemporal_load(ps + 2 * (i + NP / 2) + 1);
        v4u o; o.x = pk2(a.x, a.y); o.y = pk2(a.z, a.w); o.z = pk2(b.x, b.y); o.w = pk2(b.z, b.w); pd[i] = o;
        v4u q; q.x = pk2(c.x, c.y); q.y = pk2(c.z, c.w); q.z = pk2(d.x, d.y); q.w = pk2(d.z, d.w); pd[i + NP / 2] = q; }
}

struct GroupedOrder {
    pg8::StaticOrder so; int nN;
    __device__ __forceinline__ void init(int N, int G, int c) { so.init(MR, N, G, c); nN = N / 256; }
    __device__ __forceinline__ bool next(int i, pg8::Unit& u) const { if (!so.next(i, u)) return false; u.pn = (u.pm >> 4) * nN + u.pn; return true; }
    __device__ __forceinline__ void a_ready(const pg8::Unit&) const {}
    __device__ __forceinline__ void done(const pg8::Unit&) const {}
};

#ifndef ALIGN_RMW
#define ALIGN_RMW true
#endif
#ifndef PROBE_GDUP
#define PROBE_GDUP 0
#endif
template <int BIT> struct DupStatic {
    pg8::StaticOrder so;
    __device__ __forceinline__ void init(int M, int N, int G, int c) { so.init(M, N, G, c); }
    __device__ __forceinline__ bool next(int i, pg8::Unit& u) const { return so.next(((PROBE_GDUP >> BIT) & 1) ? (i >> 1) : i, u); }
    __device__ __forceinline__ void a_ready(const pg8::Unit&) const {}
    __device__ __forceinline__ void done(const pg8::Unit&) const {}
};
struct EpiQKV {
    static constexpr bool PERM = true, AFTER_DRAIN = false;
    bf16* qkv; const float* qg; const float2_t* cs_ax; const float2_t* cs_1d; const float* rs;
    __device__ __forceinline__ void operator()(const f32x4 (&acc)[2][2][4][2], const pg8::Unit& u, int wr, int wc, int fr, int fq) const {
        { const int l_ = lane_id(); fr = l_ & 15; fq = l_ >> 4; } asm volatile("" : "+s"(wr), "+s"(wc));
        const int hs = u.pn * 4 + wc;
        int kind, gi;
        if (hs < 4) { kind = 2; gi = 0; } else if (hs < 6) { kind = 2; gi = 1; } else if (hs < 8) { kind = 0; gi = 0; }
        else if (hs < 14) { kind = 1; gi = 2; } else if (hs < 20) { kind = 1; gi = 3; } else if (hs < 26) { kind = 0; gi = 0; }
        else if (hs < 32) { kind = 3; gi = 4; } else if (hs < 38) { kind = 3; gi = 5; } else { kind = 0; gi = 0; }
        const bool isq = (hs < 4) || (hs >= 8 && hs < 14) || (hs >= 26 && hs < 32);
        f32x4 gv[2][2];
#pragma unroll
        for (int bj = 0; bj < 2; ++bj)
#pragma unroll
            for (int n = 0; n < 2; ++n) gv[bj][n] = *(const f32x4*)(qg + gi * 64 + 32 * bj + 8 * fq + 4 * n);
        const int colbase = u.pn * 256 + wc * 64 + 8 * fq;
#pragma unroll
        for (int ai = 0; ai < 2; ++ai) {
            f32x4 rowcs[4]; float rsr[4];
#pragma unroll
            for (int m = 0; m < 4; ++m) rsr[m] = __hip_atomic_load(rs + (u.pm * 256 + ai * 128 + wr * 64 + m * 16 + fr), __ATOMIC_RELAXED, __HIP_MEMORY_SCOPE_AGENT);
            if (kind == 2) { const f32x4* p = (const f32x4*)(cs_ax + ((4 * u.pm + 2 * ai + wr) & 63) * 16 + 8 * (fq & 1));
#pragma unroll
                for (int k = 0; k < 4; ++k) rowcs[k] = p[k]; }
#pragma unroll
            for (int mp = 0; mp < 2; ++mp) {
                f32x4 tab[2][4];
                if (kind == 2) {
#pragma unroll
                    for (int mm = 0; mm < 2; ++mm) { const f32x4* p = (const f32x4*)(cs_ax + (16 * (2 * mp + mm) + fr) * 16 + 8 * (fq & 1));
#pragma unroll
                        for (int k = 0; k < 4; ++k) tab[mm][k] = p[k]; }
                }
                if (kind == 3) {
#pragma unroll
                    for (int mm = 0; mm < 2; ++mm) { const int s = (u.pm * 256 + ai * 128 + wr * 64 + (2 * mp + mm) * 16 + fr) & (SEQ - 1); const f32x4* p = (const f32x4*)(cs_1d + s * 8);
#pragma unroll
                        for (int k = 0; k < 4; ++k) tab[mm][k] = p[k]; }
                }
#pragma unroll
                for (int mm = 0; mm < 2; ++mm) { const int m = 2 * mp + mm;
                    const int row = u.pm * 256 + ai * 128 + wr * 64 + m * 16 + fr;
                    f32x4 v[2][2];
#pragma unroll
                    for (int bj = 0; bj < 2; ++bj)
#pragma unroll
                        for (int n = 0; n < 2; ++n) v[bj][n] = acc[ai][bj][m][n] * rsr[m];
                    if (kind != 0) {
                        float ss = 0.f;
#pragma unroll
                        for (int bj = 0; bj < 2; ++bj)
#pragma unroll
                            for (int n = 0; n < 2; ++n) ss += (v[bj][n].x * v[bj][n].x + v[bj][n].y * v[bj][n].y) + (v[bj][n].z * v[bj][n].z + v[bj][n].w * v[bj][n].w);
                        ss = xor16_add(ss); ss = xor32_add(ss);
                        const float rstd = __builtin_amdgcn_rsqf(ss * (1.0f / 64.0f) + RMS_EPS);
#pragma unroll
                        for (int bj = 0; bj < 2; ++bj)
#pragma unroll
                            for (int n = 0; n < 2; ++n) v[bj][n] = v[bj][n] * rstd * gv[bj][n];
                        if (kind == 2) {
#pragma unroll
                            for (int bj = 0; bj < 2; ++bj)
#pragma unroll
                                for (int n = 0; n < 2; ++n)
#pragma unroll
                                    for (int e = 0; e < 4; ++e) { const int k = 4 * n + e; const f32x4 cs4 = bj ? tab[mm][k >> 1] : rowcs[k >> 1]; const float c = cs4[2 * (k & 1)], sn = cs4[2 * (k & 1) + 1];
                                        const float own = v[bj][n][e]; auto sw = __builtin_amdgcn_permlane32_swap(__float_as_uint(own), __float_as_uint(own), false, false); const float oth = __uint_as_float(fq < 2 ? sw[1] : sw[0]);
                                        v[bj][n][e] = (fq < 2) ? (own * c - oth * sn) : (oth * sn + own * c); }
                        } else if (kind == 3) {
#pragma unroll
                            for (int n = 0; n < 2; ++n)
#pragma unroll
                                for (int e = 0; e < 4; ++e) { const int k = 4 * n + e; const f32x4 cs4 = tab[mm][k >> 1]; const float c = cs4[2 * (k & 1)], sn = cs4[2 * (k & 1) + 1];
                                    const float own = v[0][n][e]; auto sw = __builtin_amdgcn_permlane16_swap(__float_as_uint(own), __float_as_uint(own), false, false); const float oth = __uint_as_float((fq & 1) ? sw[0] : sw[1]);
                                    const float rot = (fq == 0) ? (own * c - oth * sn) : (oth * sn + own * c);
                                    v[0][n][e] = (fq < 2) ? rot : own; }
                        }
                    }
                    if (isq) {
#pragma unroll
                        for (int bj = 0; bj < 2; ++bj)
#pragma unroll
                            for (int n = 0; n < 2; ++n) v[bj][n] = v[bj][n] * QSCALE;
                    }
                    bf16* rp = qkv + (size_t)row * NQKV + colbase;
#pragma unroll
                    for (int bj = 0; bj < 2; ++bj) { v4u w; w.x = pk2(v[bj][0].x, v[bj][0].y); w.y = pk2(v[bj][0].z, v[bj][0].w); w.z = pk2(v[bj][1].x, v[bj][1].y); w.w = pk2(v[bj][1].z, v[bj][1].w); st16(rp + 32 * bj, w); }
                }
                asm volatile("" ::: "memory");
            }
        }
    }
};

struct EpiResid {
    static constexpr bool PERM = true, AFTER_DRAIN = false;
    const bf16* baseh; bf16* out; unsigned char* out8;
    __device__ __forceinline__ void operator()(const f32x4 (&acc)[2][2][4][2], const pg8::Unit& u, int wr, int wc, int fr, int fq) const {
        { const int l_ = lane_id(); fr = l_ & 15; fq = l_ >> 4; } asm volatile("" : "+s"(wr), "+s"(wc));
        const int col0 = u.pn * 256 + wc * 32 + 8 * fq;
#pragma unroll
        for (int ai = 0; ai < 2; ++ai) {
            {
                v4u b[4][2];
#pragma unroll
                for (int m = 0; m < 4; ++m) { const size_t off = (size_t)(u.pm * 256 + ai * 128 + wr * 64 + m * 16 + fr) * DM + col0;
#pragma unroll
                    for (int bj = 0; bj < 2; ++bj) b[m][bj] = *(const v4u*)(baseh + off + bj * 128); }
#pragma unroll
                for (int m = 0; m < 4; ++m) { const size_t off = (size_t)(u.pm * 256 + ai * 128 + wr * 64 + m * 16 + fr) * DM + col0;
#pragma unroll
                    for (int bj = 0; bj < 2; ++bj) { const f32x4 a0 = acc[ai][bj][m][0], a1 = acc[ai][bj][m][1]; const v4u p = b[m][bj];
                        const f32x4 o0 = (f32x4){bflo(p.x) + a0.x, bfhi(p.x) + a0.y, bflo(p.y) + a0.z, bfhi(p.y) + a0.w}, o1 = (f32x4){bflo(p.z) + a1.x, bfhi(p.z) + a1.y, bflo(p.w) + a1.z, bfhi(p.w) + a1.w};
                        v4u w; w.x = pk2(o0.x, o0.y); w.y = pk2(o0.z, o0.w); w.z = pk2(o1.x, o1.y); w.w = pk2(o1.z, o1.w);
                        st16(out + off + bj * 128, w);
                        u32x2 w8; w8.x = pk4_f8(o0.x, o0.y, o0.z, o0.w); w8.y = pk4_f8(o1.x, o1.y, o1.z, o1.w); *(u32x2*)(out8 + off + bj * 128) = w8; } }
            }
            asm volatile("" ::: "memory");
        }
    }
};

struct EpiStoreBf16NP {
    static constexpr bool PERM = false, AFTER_DRAIN = false;
    bf16* O;
    __device__ __forceinline__ void operator()(const f32x4 (&acc)[2][2][4][2], const pg8::Unit& u, int wr, int wc, int fr, int fq) const {
        { const int l_ = lane_id(); fr = l_ & 15; fq = l_ >> 4; } asm volatile("" : "+s"(wr), "+s"(wc));
        const int col0 = (u.pn & 3) * 256 + wc * 32 + 4 * fq;
#pragma unroll
        for (int ai = 0; ai < 2; ++ai)
#pragma unroll
            for (int m = 0; m < 4; ++m) { bf16* rp = O + (size_t)(u.pm * 256 + ai * 128 + wr * 64 + m * 16 + fr) * DM + col0;
#pragma unroll
                for (int bj = 0; bj < 2; ++bj)
#pragma unroll
                    for (int n = 0; n < 2; ++n) { const f32x4 a = acc[ai][bj][m][n]; u32x2 w; w.x = pk2(a.x, a.y); w.y = pk2(a.z, a.w); *(u32x2*)(rp + bj * 128 + n * 16) = w; } }
    }
};
struct EpiStoreBf16 {
    static constexpr bool PERM = true, AFTER_DRAIN = false;
    bf16* O;
    __device__ __forceinline__ void operator()(const f32x4 (&acc)[2][2][4][2], const pg8::Unit& u, int wr, int wc, int fr, int fq) const {
        { const int l_ = lane_id(); fr = l_ & 15; fq = l_ >> 4; } asm volatile("" : "+s"(wr), "+s"(wc));
        const int col0 = (u.pn & 3) * 256 + wc * 32 + 8 * fq;
#pragma unroll
        for (int ai = 0; ai < 2; ++ai)
#pragma unroll
            for (int m = 0; m < 4; ++m) { bf16* rp = O + (size_t)(u.pm * 256 + ai * 128 + wr * 64 + m * 16 + fr) * DM + col0;
#pragma unroll
                for (int bj = 0; bj < 2; ++bj) { const f32x4 a = acc[ai][bj][m][0], b = acc[ai][bj][m][1]; v4u w; w.x = pk2(a.x, a.y); w.y = pk2(a.z, a.w); w.z = pk2(b.x, b.y); w.w = pk2(b.z, b.w); st16(rp + bj * 128, w); } }
    }
};

struct EpiStoreF8 {
    static constexpr bool PERM = true, AFTER_DRAIN = false;
    unsigned char* O;
    __device__ __forceinline__ void operator()(const f32x4 (&acc)[2][2][4][2], const pg8::Unit& u, int wr, int wc, int fr, int fq) const {
        { const int l_ = lane_id(); fr = l_ & 15; fq = l_ >> 4; } asm volatile("" : "+s"(wr), "+s"(wc));
        const int col0 = (u.pn & 3) * 256 + wc * 32 + 8 * fq;
#pragma unroll
        for (int ai = 0; ai < 2; ++ai)
#pragma unroll
            for (int m = 0; m < 4; ++m) { unsigned char* rp = O + (size_t)(u.pm * 256 + ai * 128 + wr * 64 + m * 16 + fr) * DM + col0;
#pragma unroll
                for (int bj = 0; bj < 2; ++bj) { const f32x4 a = acc[ai][bj][m][0], b = acc[ai][bj][m][1]; u32x2 w; w.x = pk4_f8(a.x, a.y, a.z, a.w); w.y = pk4_f8(b.x, b.y, b.z, b.w); *(u32x2*)(rp + bj * 128) = w; } }
    }
};
struct EpiSwiGLU {
    static constexpr bool PERM = true, AFTER_DRAIN = false;
    unsigned char* H; const float* rs;
    __device__ __forceinline__ void operator()(const f32x4 (&acc)[2][2][4][2], const pg8::Unit& u, int wr, int wc, int fr, int fq) const {
        { const int l_ = lane_id(); fr = l_ & 15; fq = l_ >> 4; } asm volatile("" : "+s"(wr), "+s"(wc));
        const int col0 = (u.pn & 7) * 128 + wc * 32 + 8 * fq;
        float rsr[2][4];
#pragma unroll
        for (int ai = 0; ai < 2; ++ai)
#pragma unroll
            for (int m = 0; m < 4; ++m) rsr[ai][m] = rs[u.pm * 256 + ai * 128 + wr * 64 + m * 16 + fr] * (1.0f / F8_SC_W);
#pragma unroll
        for (int ai = 0; ai < 2; ++ai)
#pragma unroll
            for (int m = 0; m < 4; ++m) { unsigned char* rp = H + (size_t)(u.pm * 256 + ai * 128 + wr * 64 + m * 16 + fr) * DFF + col0; const float r1 = rsr[ai][m], r1u = r1 * F8_SC_HID;
                f32x4 h[2];
#pragma unroll
                for (int n = 0; n < 2; ++n) { const f32x4 g = acc[ai][0][m][n] * r1, up = acc[ai][1][m][n] * r1u;
#pragma unroll
                    for (int e = 0; e < 4; ++e) h[n][e] = g[e] * __builtin_amdgcn_rcpf(1.0f + __builtin_amdgcn_exp2f(-LOG2E * g[e])) * up[e]; }
                u32x2 w; w.x = pk4_f8(h[0].x, h[0].y, h[0].z, h[0].w); w.y = pk4_f8(h[1].x, h[1].y, h[1].z, h[1].w); *(u32x2*)rp = w; }
    }
};

struct EpiPLE {
    static constexpr bool PERM = true, AFTER_DRAIN = false;
    const bf16* hz; float* outf; bf16* outh; const bf16* pp; const float* rs; float* ssq;
    __device__ __forceinline__ void operator()(const f32x4 (&acc)[2][2][4][2], const pg8::Unit& u, int wr, int wc, int fr, int fq) const {
        { const int l_ = lane_id(); fr = l_ & 15; fq = l_ >> 4; } asm volatile("" : "+s"(wr), "+s"(wc));
        const int col0 = u.pn * 256 + wc * 32 + 8 * fq;
#pragma unroll
        for (int ai = 0; ai < 2; ++ai) {
            v4u hv[4][2], pw[4][2]; float rsr[4];
#pragma unroll
            for (int m = 0; m < 4; ++m) { const size_t off = (size_t)(u.pm * 256 + ai * 128 + wr * 64 + m * 16 + fr) * DM + col0; rsr[m] = rs[u.pm * 256 + ai * 128 + wr * 64 + m * 16 + fr];
#pragma unroll
                for (int bj = 0; bj < 2; ++bj) { hv[m][bj] = *(const v4u*)(hz + off + bj * 128); pw[m][bj] = *(const v4u*)(pp + off + bj * 128); } }
#pragma unroll
            for (int m = 0; m < 4; ++m) { const size_t off = (size_t)(u.pm * 256 + ai * 128 + wr * 64 + m * 16 + fr) * DM + col0; float sq = 0.f;
#pragma unroll
                for (int bj = 0; bj < 2; ++bj) { const v4u p4 = pw[m][bj], h4 = hv[m][bj]; f32x4 o[2];
#pragma unroll
                    for (int n = 0; n < 2; ++n) { const f32x4 a = acc[ai][bj][m][n] * (-LOG2E * rsr[m]); const unsigned p0 = n ? p4.z : p4.x, p1 = n ? p4.w : p4.y, h0 = n ? h4.z : h4.x, h1 = n ? h4.w : h4.y;
                        o[n].x = bflo(h0) + bflo(p0) * __builtin_amdgcn_rcpf(1.0f + __builtin_amdgcn_exp2f(a.x)); o[n].y = bfhi(h0) + bfhi(p0) * __builtin_amdgcn_rcpf(1.0f + __builtin_amdgcn_exp2f(a.y));
                        o[n].z = bflo(h1) + bflo(p1) * __builtin_amdgcn_rcpf(1.0f + __builtin_amdgcn_exp2f(a.z)); o[n].w = bfhi(h1) + bfhi(p1) * __builtin_amdgcn_rcpf(1.0f + __builtin_amdgcn_exp2f(a.w));
                        sq += (o[n].x * o[n].x + o[n].y * o[n].y) + (o[n].z * o[n].z + o[n].w * o[n].w); }
                    if (outf) { *(f32x4*)(outf + off + bj * 128) = o[0]; *(f32x4*)(outf + off + bj * 128 + 4) = o[1]; }
                    else { v4u w; w.x = pk2(o[0].x, o[0].y); w.y = pk2(o[0].z, o[0].w); w.z = pk2(o[1].x, o[1].y); w.w = pk2(o[1].z, o[1].w); st16(outh + off + bj * 128, w); } }
                if (!outf) { sq = xor16_add(sq); sq = xor32_add(sq); if (fq == 0) ssq[(size_t)(u.pm * 256 + ai * 128 + wr * 64 + m * 16 + fr) * 16 + u.pn * 4 + wc] = sq; } }
            asm volatile("" ::: "memory");
        }
    }
};

__device__ __forceinline__ void load_row64(const bf16* p, float (&q)[64], float sc) {
    const v4u* p4 = (const v4u*)p;
#pragma unroll
    for (int c = 0; c < 8; ++c) { const v4u u = p4[c];
        q[8 * c + 0] = bflo(u.x) * sc; q[8 * c + 1] = bfhi(u.x) * sc; q[8 * c + 2] = bflo(u.y) * sc; q[8 * c + 3] = bfhi(u.y) * sc;
        q[8 * c + 4] = bflo(u.z) * sc; q[8 * c + 5] = bfhi(u.z) * sc; q[8 * c + 6] = bflo(u.w) * sc; q[8 * c + 7] = bfhi(u.w) * sc; }
}
__device__ __forceinline__ float dot64(const float (&q)[64], const bf16* kp) {
    const v4u* p4 = (const v4u*)kp; float s0 = 0.f, s1 = 0.f;
#pragma unroll
    for (int c = 0; c < 8; ++c) { const v4u u = p4[c];
        s0 = fmaf(q[8 * c + 0], bflo(u.x), s0); s1 = fmaf(q[8 * c + 1], bfhi(u.x), s1); s0 = fmaf(q[8 * c + 2], bflo(u.y), s0); s1 = fmaf(q[8 * c + 3], bfhi(u.y), s1);
        s0 = fmaf(q[8 * c + 4], bflo(u.z), s0); s1 = fmaf(q[8 * c + 5], bfhi(u.z), s1); s0 = fmaf(q[8 * c + 6], bflo(u.w), s0); s1 = fmaf(q[8 * c + 7], bfhi(u.w), s1); }
    return s0 + s1;
}
__device__ __forceinline__ void online_update(float s, bool valid, const bf16* vp, float (&o)[64], float& m, float& l) {
    const float sm = valid ? s : -1e30f;
    if (__any(sm > m)) { const float mn = fmaxf(m, sm); const float corr = __builtin_amdgcn_exp2f(m - mn); l *= corr;
#pragma unroll
        for (int d = 0; d < 64; ++d) o[d] *= corr;
        m = mn; }
    const float p = valid ? __builtin_amdgcn_exp2f(s - m) : 0.f;
    l += p;
    const v4u* p4 = (const v4u*)vp;
#pragma unroll
    for (int c = 0; c < 8; ++c) { const v4u u = p4[c];
        o[8 * c + 0] = fmaf(p, bflo(u.x), o[8 * c + 0]); o[8 * c + 1] = fmaf(p, bfhi(u.x), o[8 * c + 1]); o[8 * c + 2] = fmaf(p, bflo(u.y), o[8 * c + 2]); o[8 * c + 3] = fmaf(p, bfhi(u.y), o[8 * c + 3]);
        o[8 * c + 4] = fmaf(p, bflo(u.z), o[8 * c + 4]); o[8 * c + 5] = fmaf(p, bfhi(u.z), o[8 * c + 5]); o[8 * c + 6] = fmaf(p, bflo(u.w), o[8 * c + 6]); o[8 * c + 7] = fmaf(p, bfhi(u.w), o[8 * c + 7]); }
}
__device__ __forceinline__ void store_row64(bf16* p, const float (&o)[64], float sc) {
    v4u* p4 = (v4u*)p;
#pragma unroll
    for (int c = 0; c < 8; ++c) { v4u w; w.x = pk2(o[8 * c + 0] * sc, o[8 * c + 1] * sc); w.y = pk2(o[8 * c + 2] * sc, o[8 * c + 3] * sc);
        w.z = pk2(o[8 * c + 4] * sc, o[8 * c + 5] * sc); w.w = pk2(o[8 * c + 6] * sc, o[8 * c + 7] * sc); p4[c] = w; }
}
__device__ __forceinline__ void attnA_naive(const bf16* qkv, bf16* ao, int item, int lane) {
    const int chunk = item & 63, hq = (item >> 6) & 3, b = item >> 8, kvh = hq >> 1, t = chunk * 64 + lane;
    float q[64], o[64];
    load_row64(qkv + (size_t)(b * SEQ + t) * NQKV + C_QA + hq * 64, q, 1.0f);
#pragma unroll
    for (int d = 0; d < 64; ++d) o[d] = 0.f;
    float m = -1e30f, l = 0.f;
    const bf16* kb = qkv + (size_t)b * SEQ * NQKV + C_KA + kvh * 64;
    const bf16* vb = qkv + (size_t)b * SEQ * NQKV + C_VA + kvh * 64;
    for (int j = 0; j < SEQ; ++j) { const float s = dot64(q, kb + (size_t)j * NQKV); online_update(s, true, vb + (size_t)j * NQKV, o, m, l); }
    store_row64(ao + (size_t)(b * SEQ + t) * DM + hq * 64, o, 1.0f / l);
}
__device__ __forceinline__ void attnB_naive(const bf16* qkv, const float* nab, bf16* ao, int item, int lane) {
    const int r = item & 63, bh = item >> 6, h = bh % 6, b = bh / 6, c = lane;
    const int rs = min(max(r - 4, 0), 56), cs = min(max(c - 8, 0), 48);
    float q[64], o[64];
    load_row64(qkv + (size_t)(b * SEQ + r * 64 + c) * NQKV + C_QB + h * 64, q, 1.0f);
#pragma unroll
    for (int d = 0; d < 64; ++d) o[d] = 0.f;
    float m = -1e30f, l = 0.f;
    for (int i = 0; i < 8; ++i)
        for (int jj = 0; jj < 16; ++jj) {
            const size_t krow = (size_t)(b * SEQ + (rs + i) * 64 + cs + jj) * NQKV;
            const float bias = nab[(h * 15 + (rs + i - r + 7)) * 31 + (cs + jj - c + 15)];
            const float s = dot64(q, qkv + krow + C_KB + h * 64) + bias * LOG2E;
            online_update(s, true, qkv + krow + C_VB + h * 64, o, m, l);
        }
    store_row64(ao + (size_t)(b * SEQ + r * 64 + c) * DM + 256 + h * 64, o, 1.0f / l);
}
__device__ __forceinline__ void attnC_naive(const bf16* qkv, bf16* ao, int item, int lane) {
    const int chunk = item & 63, bh = item >> 6, h = bh % 6, b = bh / 6, t = chunk * 64 + lane;
    float q[64], o[64];
    load_row64(qkv + (size_t)(b * SEQ + t) * NQKV + C_QC + h * 64, q, 1.0f);
#pragma unroll
    for (int d = 0; d < 64; ++d) o[d] = 0.f;
    float m = -1e30f, l = 0.f;
    for (int br = 0; br < 3; ++br) { const int dil = 1 << (2 * br);
        for (int j = -64; j <= 64; ++j) { const int pos = t + dil * j; const bool valid = (unsigned)pos < (unsigned)SEQ; const int pc = valid ? pos : t;
            const size_t krow = (size_t)(b * SEQ + pc) * NQKV;
            const float s = dot64(q, qkv + krow + C_KC + h * 64);
            online_update(s, valid, qkv + krow + C_VC + h * 64, o, m, l); } }
    store_row64(ao + (size_t)(b * SEQ + t) * DM + 640 + h * 64, o, 1.0f / l);
}

__device__ __forceinline__ void unpack16(const v4u u0, const v4u u1, float (&v)[16]) {
    v[0] = bflo(u0.x); v[1] = bfhi(u0.x); v[2] = bflo(u0.y); v[3] = bfhi(u0.y); v[4] = bflo(u0.z); v[5] = bfhi(u0.z); v[6] = bflo(u0.w); v[7] = bfhi(u0.w);
    v[8] = bflo(u1.x); v[9] = bfhi(u1.x); v[10] = bflo(u1.y); v[11] = bfhi(u1.y); v[12] = bflo(u1.z); v[13] = bfhi(u1.z); v[14] = bflo(u1.w); v[15] = bfhi(u1.w);
}
__device__ __forceinline__ void groupnorm_row2(const bf16* ao_, const bf16* part, const float* lse, int m0, int m1, const float* gout, bf16* mix_, int lane) {
    const int ms[2] = {m0, m1};
    v4u ld[2][6]; float ls[2][3];
    const int cc = 16 * lane - 640, hh = cc >> 6;
#pragma unroll
    for (int q = 0; q < 2; ++q) {
        if (lane < 40) { const v4u* a4 = (const v4u*)(ao_ + (size_t)ms[q] * DM) + 2 * lane; ld[q][0] = a4[0]; ld[q][1] = a4[1]; }
        else {
#pragma unroll
            for (int br = 0; br < 3; ++br) { const v4u* p4 = (const v4u*)(part + (size_t)br * MTOK * 384 + (size_t)ms[q] * 384 + cc); ld[q][2 * br] = p4[0]; ld[q][2 * br + 1] = p4[1];
                ls[q][br] = lse[(size_t)br * MTOK * 6 + (size_t)ms[q] * 6 + hh]; }
        }
    }
    const f32x4* g4 = (const f32x4*)gout + 4 * lane;
    const f32x4 g0 = g4[0], g1 = g4[1], g2 = g4[2], g3 = g4[3];
    if (lane < 40) { asm volatile("" : "+v"(ld[0][0]), "+v"(ld[0][1]), "+v"(ld[1][0]), "+v"(ld[1][1])); }
    else { asm volatile("" : "+v"(ld[0][0]), "+v"(ld[0][1]), "+v"(ld[0][2]), "+v"(ld[0][3]), "+v"(ld[0][4]), "+v"(ld[0][5]), "+v"(ld[1][0]), "+v"(ld[1][1]), "+v"(ld[1][2]), "+v"(ld[1][3]), "+v"(ld[1][4]), "+v"(ld[1][5])); }
    const int grp = lane < 16 ? 0 : (lane < 40 ? 1 : 2);
#pragma unroll
    for (int q = 0; q < 2; ++q) {
        float v[16];
        if (lane < 40) unpack16(ld[q][0], ld[q][1], v);
        else {
            const float l0 = ls[q][0], l1 = ls[q][1], l2 = ls[q][2];
            const float mx = fmaxf(l0, fmaxf(l1, l2));
            float w0 = __builtin_amdgcn_exp2f(l0 - mx), w1 = __builtin_amdgcn_exp2f(l1 - mx), w2 = __builtin_amdgcn_exp2f(l2 - mx);
            const float inv = 1.0f / (w0 + w1 + w2); w0 *= inv; w1 *= inv; w2 *= inv;
            float a[16], b[16], c[16];
            unpack16(ld[q][0], ld[q][1], a); unpack16(ld[q][2], ld[q][3], b); unpack16(ld[q][4], ld[q][5], c);
#pragma unroll
            for (int i = 0; i < 16; ++i) v[i] = w0 * a[i] + w1 * b[i] + w2 * c[i];
        }
        float ss = 0.f;
#pragma unroll
        for (int i = 0; i < 16; ++i) ss += v[i] * v[i];
        const float sa = wave_sum(grp == 0 ? ss : 0.f), sb = wave_sum(grp == 1 ? ss : 0.f), sc = wave_sum(grp == 2 ? ss : 0.f);
        const float rstd = (grp == 0) ? 1.0f / sqrtf(sa * (1.0f / 256.0f) + RMS_EPS) : (grp == 1) ? 1.0f / sqrtf(sb * (1.0f / 384.0f) + RMS_EPS) : 1.0f / sqrtf(sc * (1.0f / 384.0f) + RMS_EPS);
        v4u o0, o1;
        o0.x = pk2(v[0] * rstd * g0.x, v[1] * rstd * g0.y); o0.y = pk2(v[2] * rstd * g0.z, v[3] * rstd * g0.w); o0.z = pk2(v[4] * rstd * g1.x, v[5] * rstd * g1.y); o0.w = pk2(v[6] * rstd * g1.z, v[7] * rstd * g1.w);
        o1.x = pk2(v[8] * rstd * g2.x, v[9] * rstd * g2.y); o1.y = pk2(v[10] * rstd * g2.z, v[11] * rstd * g2.w); o1.z = pk2(v[12] * rstd * g3.x, v[13] * rstd * g3.y); o1.w = pk2(v[14] * rstd * g3.z, v[15] * rstd * g3.w);
        v4u* o4 = (v4u*)(mix_ + (size_t)ms[q] * DM) + 2 * lane; o4[0] = o0; o4[1] = o1;
    }
}

#define DPP_MOV_F(v, ctrl) __int_as_float(__builtin_amdgcn_update_dpp(0, __float_as_int(v), (ctrl), 0xf, 0xf, true))
__device__ __forceinline__ float swap32_add(float a, float b) { auto r = __builtin_amdgcn_permlane32_swap(__float_as_uint(a), __float_as_uint(b), false, false); return __uint_as_float(r[0]) + __uint_as_float(r[1]); }
__device__ __forceinline__ float swap16_add(float a, float b) { auto r = __builtin_amdgcn_permlane16_swap(__float_as_uint(a), __float_as_uint(b), false, false); return __uint_as_float(r[0]) + __uint_as_float(r[1]); }
__device__ __forceinline__ void router_phase(const bf16* h, const float* gffn, const float* wr, float* rs_, float* aff_, LAS unsigned char* lds, int tid, int lane, int q0, int qstep, int qend) {
    LAS float* wrT = (LAS float*)(lds + RING_OFF);
    for (int i = tid; i < DM * NE; i += NTHR) { const int col = i >> 4, e = i & 15; wrT[e * DM + col] = wr[i]; }
    __syncthreads();
    const bool b3 = (lane & 8) != 0, b2 = (lane & 4) != 0, b1 = (lane & 2) != 0, b0 = (lane & 1) != 0;
    for (int q4 = q0; q4 < qend; q4 += qstep) {
        const int m0 = q4 * 4;
        f32x4 v[4][4]; f32x4 g[4]; unsigned long long hx[4][4];
#pragma unroll
        for (int r = 0; r < 4; ++r) { const unsigned long long* xr = (const unsigned long long*)(h + (size_t)(m0 + r) * DM) + lane;
#pragma unroll
            for (int j = 0; j < 4; ++j) hx[r][j] = xr[64 * j]; }
#pragma unroll
        for (int r = 0; r < 4; ++r) PIN4V(hx[r]);
#pragma unroll
        for (int r = 0; r < 4; ++r)
#pragma unroll
            for (int j = 0; j < 4; ++j) { const unsigned long long x8 = hx[r][j]; const unsigned x0 = (unsigned)x8, x1 = (unsigned)(x8 >> 32); v[r][j] = (f32x4){bflo(x0), bfhi(x0), bflo(x1), bfhi(x1)}; }
#pragma unroll
        for (int j = 0; j < 4; ++j) g[j] = ((const f32x4*)gffn + lane)[64 * j];
#pragma unroll
        for (int r = 0; r < 4; ++r) { float s = 0.f;
#pragma unroll
            for (int j = 0; j < 4; ++j) s += (v[r][j].x * v[r][j].x + v[r][j].y * v[r][j].y) + (v[r][j].z * v[r][j].z + v[r][j].w * v[r][j].w);
            const float rstd = 1.0f / sqrtf(wave_sum(s) * (1.0f / DM) + RMS_EPS);
            if (lane == 0) { if (FUSE_RT) __hip_atomic_store(rs_ + m0 + r, rstd, __ATOMIC_RELAXED, __HIP_MEMORY_SCOPE_AGENT); else rs_[m0 + r] = rstd; }
#pragma unroll
            for (int j = 0; j < 4; ++j) { v[r][j].x = v[r][j].x * rstd * g[j].x; v[r][j].y = v[r][j].y * rstd * g[j].y; v[r][j].z = v[r][j].z * rstd * g[j].z; v[r][j].w = v[r][j].w * rstd * g[j].w; } }
        float pa[64];
#pragma unroll
        for (int e = 0; e < 16; ++e) { f32x4 w[4];
#pragma unroll
            for (int j = 0; j < 4; ++j) w[j] = *(const LAS f32x4*)(wrT + e * DM + 4 * lane + 256 * j);
#pragma unroll
            for (int r = 0; r < 4; ++r) { typedef float f2 __attribute__((ext_vector_type(2))); f2 a2 = {0.f, 0.f};
#pragma unroll
                for (int j = 0; j < 4; ++j) { a2 += (f2){v[r][j].x, v[r][j].y} * (f2){w[j].x, w[j].y}; a2 += (f2){v[r][j].z, v[r][j].w} * (f2){w[j].z, w[j].w}; }
                pa[16 * r + e] = a2.x + a2.y; }
            if ((e & 3) == 3) asm volatile("" ::: "memory"); }
        float p32[32], p16[16], p8[8], p4[4], p2[2];
#pragma unroll
        for (int i = 0; i < 32; ++i) p32[i] = swap32_add(pa[i], pa[i + 32]);
#pragma unroll
        for (int i = 0; i < 16; ++i) p16[i] = swap16_add(p32[i], p32[i + 16]);
#pragma unroll
        for (int i = 0; i < 8; ++i) { const float keep = b3 ? p16[i + 8] : p16[i], send = b3 ? p16[i] : p16[i + 8]; p8[i] = keep + DPP_MOV_F(send, 0x128); }
#pragma unroll
        for (int i = 0; i < 4; ++i) { const float keep = b2 ? p8[i + 4] : p8[i], send = b2 ? p8[i] : p8[i + 4]; const float hm = DPP_MOV_F(send, 0x141); p4[i] = keep + DPP_MOV_F(hm, 0x1B); }
#pragma unroll
        for (int i = 0; i < 2; ++i) { const float keep = b1 ? p4[i + 2] : p4[i], send = b1 ? p4[i] : p4[i + 2]; p2[i] = keep + DPP_MOV_F(send, 0x4E); }
        float lg; { const float keep = b0 ? p2[1] : p2[0], send = b0 ? p2[0] : p2[1]; lg = keep + DPP_MOV_F(send, 0xB1); }
        float mx = lg;
        mx = fmaxf(mx, DPP_MOV_F(mx, 0xB1)); mx = fmaxf(mx, DPP_MOV_F(mx, 0x4E)); mx = fmaxf(mx, DPP_MOV_F(mx, 0x141)); mx = fmaxf(mx, DPP_MOV_F(mx, 0x140));
        const float pe = expf(lg - mx);
        float sm = pe; sm = DPP_ADD_F(sm, 0xB1); sm = DPP_ADD_F(sm, 0x4E); sm = DPP_ADD_F(sm, 0x141); sm = DPP_ADD_F(sm, 0x140);
        { const int r = lane >> 4, e = lane & 15, b = m0 >> 12, sidx = (m0 & (SEQ - 1)) + r; if (FUSE_RT) __hip_atomic_store(aff_ + (size_t)(b * NE + e) * SEQ + sidx, pe / sm, __ATOMIC_RELAXED, __HIP_MEMORY_SCOPE_AGENT); else aff_[(size_t)(b * NE + e) * SEQ + sidx] = pe / sm; }
    }
    __syncthreads();
}

__device__ __forceinline__ unsigned short bf16_rne(float f) { return (unsigned short)(pk2(f, 0.f) & 0xffffu); }
__device__ __forceinline__ void router_mfma_phase(const bf16* h, const float* gffn, const float* wr, float* rs_, float* aff_, LAS unsigned char* lds, int tid, int lane, int gw, int NGW) {
    constexpr int WP = 1032;
    LAS unsigned short* wt = (LAS unsigned short*)(lds + RING_OFF);
#pragma unroll
    for (int bt = 0; bt < 4; ++bt) { float wv[8], gv[8];
#pragma unroll
        for (int j = 0; j < 8; ++j) { const int i = tid + NTHR * (8 * bt + j); wv[j] = wr[i]; gv[j] = gffn[i >> 4]; }
        asm volatile("" : "+v"(wv[0]), "+v"(wv[1]), "+v"(wv[2]), "+v"(wv[3]), "+v"(wv[4]), "+v"(wv[5]), "+v"(wv[6]), "+v"(wv[7]));
#pragma unroll
        for (int j = 0; j < 8; ++j) { const int i = tid + NTHR * (8 * bt + j); const int k = i >> 4, e = i & 15; const float w = wv[j] * gv[j];
            const unsigned short hi = bf16_rne(w); const float r1 = w - __uint_as_float((unsigned)hi << 16);
            const unsigned short lo = bf16_rne(r1); const float r2 = r1 - __uint_as_float((unsigned)lo << 16);
            const unsigned short l2 = bf16_rne(r2);
            wt[(0 * 16 + e) * WP + k] = hi; wt[(1 * 16 + e) * WP + k] = lo; wt[(2 * 16 + e) * WP + k] = l2; } }
    __syncthreads();
    const int r = lane & 15, kq = lane >> 4;
    for (int g = gw; g < MTOK / 16; g += NGW) {
        const v4u* ap = (const v4u*)(h + (size_t)(16 * g + r) * DM + 8 * kq);
        f32x4 acc = {0.f, 0.f, 0.f, 0.f}; float ss = 0.f;
#pragma unroll
        for (int hf = 0; hf < 2; ++hf) {
            v4u a[16];
#pragma unroll
            for (int s = 0; s < 16; ++s) a[s] = ap[(16 * hf + s) * 4];
            PIN4V(a); PIN4V(a + 4); PIN4V(a + 8); PIN4V(a + 12);
#pragma unroll
            for (int s = 0; s < 16; ++s) { const int ks = 16 * hf + s; const v4u u = a[s];
                ss += (bflo(u.x) * bflo(u.x) + bfhi(u.x) * bfhi(u.x)) + (bflo(u.y) * bflo(u.y) + bfhi(u.y) * bfhi(u.y)) + (bflo(u.z) * bflo(u.z) + bfhi(u.z) * bfhi(u.z)) + (bflo(u.w) * bflo(u.w) + bfhi(u.w) * bfhi(u.w));
                const bf16x8 af = __builtin_bit_cast(bf16x8, u);
#pragma unroll
                for (int tm = 0; tm < 3; ++tm) { const bf16x8 bfr = *(const LAS bf16x8*)(wt + (tm * 16 + r) * WP + 32 * ks + 8 * kq);
                    acc = __builtin_amdgcn_mfma_f32_16x16x32_bf16(af, bfr, acc, 0, 0, 0); } }
        }
        ss = xor16_add(ss); ss = xor32_add(ss);
        const float rstd = 1.0f / sqrtf(ss * (1.0f / DM) + RMS_EPS);
        if (kq == 0) rs_[16 * g + r] = rstd;
        f32x4 o;
#pragma unroll
        for (int j = 0; j < 4; ++j) { const float rr = __int_as_float(__builtin_amdgcn_ds_bpermute((4 * kq + j) << 2, __float_as_int(rstd))); const float lg = acc[j] * rr;
            float mx = lg; mx = fmaxf(mx, DPP_MOV_F(mx, 0xB1)); mx = fmaxf(mx, DPP_MOV_F(mx, 0x4E)); mx = fmaxf(mx, DPP_MOV_F(mx, 0x141)); mx = fmaxf(mx, DPP_MOV_F(mx, 0x140));
            const float pe = expf(lg - mx);
            float sm = pe; sm = DPP_ADD_F(sm, 0xB1); sm = DPP_ADD_F(sm, 0x4E); sm = DPP_ADD_F(sm, 0x141); sm = DPP_ADD_F(sm, 0x140);
            o[j] = pe / sm; }
        { const int m0 = 16 * g, b = m0 >> 12, s0 = m0 & (SEQ - 1); *(f32x4*)(aff_ + (size_t)(b * NE + r) * SEQ + s0 + 4 * kq) = o; }
    }
    __syncthreads();
}

__device__ __forceinline__ void topk_item(const float* aff_, int* idx_, float* gval_, int* sel_, const bf16* an_, const float* rs_, float* rsg_, bf16* xg_, int b, int e, int half, int nhalf, LAS unsigned char* lds, int tid, int lane, int wave) {
    LAS int* lidx = (LAS int*)(lds + RING_OFF + 1024);
    LAS int* sc = (LAS int*)(lds + RING_OFF);
    const f32x4* a4 = (const f32x4*)(aff_ + (size_t)(b * NE + e) * SEQ) + 2 * tid;
    const f32x4 x0 = a4[0], x1 = a4[1];
    unsigned v[8] = {__float_as_uint(x0.x), __float_as_uint(x0.y), __float_as_uint(x0.z), __float_as_uint(x0.w), __float_as_uint(x1.x), __float_as_uint(x1.y), __float_as_uint(x1.z), __float_as_uint(x1.w)};
    unsigned T = 0u;
    for (int bit = 30; bit >= 0; --bit) {
        const unsigned cand = T | (1u << bit);
        int c = 0;
#pragma unroll
        for (int i = 0; i < 8; ++i) c += (v[i] >= cand) ? 1 : 0;
        c = wave_sum_i(c);
        const int par = (bit & 1) * 8;
        if (lane == 0) sc[par + wave] = c;
        __syncthreads();
        int tot = 0;
#pragma unroll
        for (int w = 0; w < 8; ++w) tot += sc[par + w];
        if (tot >= CAP) T = cand;
    }
    int cg = 0, ce = 0;
#pragma unroll
    for (int i = 0; i < 8; ++i) { cg += (v[i] > T) ? 1 : 0; ce += (v[i] == T) ? 1 : 0; }
    int sg = cg, se = ce;
#pragma unroll
    for (int o = 1; o < 64; o <<= 1) { const int src = ((lane - o) & 63) << 2; const int tg = __builtin_amdgcn_ds_bpermute(src, sg), te = __builtin_amdgcn_ds_bpermute(src, se); if (lane >= o) { sg += tg; se += te; } }
    if (lane == 63) { sc[32 + wave] = sg; sc[48 + wave] = se; }
    __syncthreads();
    int baseg = 0, basee = 0, totg = 0;
#pragma unroll
    for (int w = 0; w < 8; ++w) { const int g = sc[32 + w], q = sc[48 + w]; if (w < wave) { baseg += g; basee += q; } totg += g; }
    int pg = baseg + sg - cg, pe = basee + se - ce;
    const int need = CAP - totg;
    const int R0 = (e * NB + b) * CAP;
#pragma unroll
    for (int i = 0; i < 8; ++i) { const int s = tid * 8 + i; int slot = -1;
        if (v[i] > T) { slot = pg; ++pg; }
        else if (v[i] == T) { if (pe < need) slot = totg + pe; ++pe; }
        if (half == 0) sel_[(size_t)(b * SEQ + s) * NE + e] = slot;
        if (slot >= 0) { lidx[slot] = s; if (half == 0) { idx_[R0 + slot] = s; gval_[R0 + slot] = __uint_as_float(v[i]) * (1.0f / (F8_SC_HID * F8_SC_WD)); } } }
    __syncthreads();
    const int per = CAP / nhalf;
    for (int c = half * per + wave * 64 + lane; c < (half + 1) * per; c += NWAVES * 64) rsg_[R0 + c] = rs_[b * SEQ + lidx[c]];
    __syncthreads();
}

#ifndef ONLY_PHASE
#define ONLY_PHASE -1
#endif
#define PHEN(k) (ONLY_PHASE < 0 || ONLY_PHASE == (k))
#ifndef PROBE_DUP
#define PROBE_DUP 0
#endif
#define PROBE_REPS 2
#define REP(k) _Pragma("unroll") for (int rep_ = 0; rep_ < ((PROBE_DUP >> (k)) & 1) + 1; ++rep_)
#define KAS __attribute__((address_space(4)))
#define PHV int ll = lane_id(); int gwl = gw, wvl = wave; asm volatile("" : "+s"(gwl), "+s"(wvl)); int tl = wvl * 64 + ll; (void)tl; (void)ll; (void)gwl; (void)wvl; \
    const KAS Args* ka = (const KAS Args*)__builtin_amdgcn_kernarg_segment_ptr(); asm volatile("" : "+s"(ka)); unsigned char* const ws = ka->ws; float* const hout = ka->out; (void)ws; (void)hout


#define cs_ax ((float2_t*)(ws + WS_TAB))
#define cs_1d ((float2_t*)(ws + WS_TAB + 65536))
#define aff ((float*)(ws + WS_AFF))
#define idx ((int*)(ws + WS_IDX))
#define gval ((float*)(ws + WS_GATE))
#define sel ((int*)(ws + WS_SEL))
#define Win_t ((bf16*)(ws + WS_WIN))
#define Wout_t ((bf16*)(ws + ((l & 1) ? WS_WOUT_ALT : WS_WOUT)))
#define Wpg_t ((bf16*)(ws + ((l & 1) ? WS_WPG_ALT : WS_WPG)))
#define Wpp_t ((bf16*)(ws + WS_WPP))
#define Wgu_t ((bf16*)(ws + WS_WGU + (size_t)(l & 1) * (32 * MiB)))
#define Wd_t ((bf16*)(ws + WS_WD + (size_t)(l & 1) * (16 * MiB)))
#define hY8 ((unsigned char*)(ws + WS_HY8))
#define pbf ((bf16*)(ws + WS_PBF))
#define an ((bf16*)(ws + WS_AN))
#define qkv ((bf16*)(ws + WS_QKV))
#define ao ((bf16*)(ws + WS_AO))
#define xg ((bf16*)(ws + WS_XG))
#define hid ((unsigned char*)(ws + WS_HID))
#define pp ((bf16*)(ws + WS_PP))
#define mix ((bf16*)(ws + WS_MIX))
#define yb ((bf16*)(ws + WS_Y))
#define y8 ((unsigned char*)(ws + WS_Y))
#define rsZ ((float*)(ws + WS_RSZ))
#define rsY ((float*)(ws + WS_RSY))
#define rsA ((float*)(ws + WS_RSA))
#define rsG ((float*)(ws + WS_RSG))
#define ssqP ((float*)(ws + WS_SSQ))
#define hY ((bf16*)(ws + WS_QKV))
#define hZ8 ((unsigned char*)(ws + WS_XG + 96 * MiB))
#define hZ ((bf16*)(ws + WS_XG))
#define cpart ((bf16*)(ws + WS_XG))
#define clse ((float*)(ws + WS_XG + 80 * MiB))
#define IN_X (ka->in[0])
#define IN_P (ka->in[1])
#define IN_GMIX (ka->in[2])
#define IN_WIN (ka->in[3])
#define IN_QKG (ka->in[4])
#define IN_NAB (ka->in[5])
#define IN_GOUT (ka->in[6])
#define IN_WOUT (ka->in[7])
#define IN_GFFN (ka->in[8])
#define IN_WR (ka->in[9])
#define IN_WG (ka->in[10])
#define IN_WU (ka->in[11])
#define IN_WD (ka->in[12])
#define IN_GPLE (ka->in[13])
#define IN_WPG (ka->in[14])
#define IN_WPP (ka->in[15])
__global__ void __launch_bounds__(NTHR, 2) mk_fwd(Args args) {
    extern __shared__ __attribute__((aligned(16))) unsigned char lds_raw[];
    LAS unsigned char* lds = (LAS unsigned char*)lds_raw;
    volatile LAS unsigned* MISC = (volatile LAS unsigned*)(lds + MISC_OFF);
    __builtin_amdgcn_s_setreg((0 << 11) | (23 << 6) | 1, 1);
    const int wave = __builtin_amdgcn_readfirstlane((int)threadIdx.x >> 6);
    const int G = gridDim.x;
    gu32* ctl = (gu32*)(args.ws + WS_CTL);
    int bid = blockIdx.x;
#if XCD_TRUE
    if (G == 256 && (args.ph_hi - args.ph_lo) > 1) {
        if (wave == 0 && lane_id() == 0) { const unsigned x = (unsigned)__builtin_amdgcn_s_getreg((3 << 11) | 20) & 0xFu; const unsigned r = __hip_atomic_fetch_add(ctl + CW_XRANK + 64 * x, 1u, __ATOMIC_RELAXED, __HIP_MEMORY_SCOPE_AGENT);
            unsigned sp = 0; bool ok = true;
            for (;;) { unsigned tot = 0, bad = 0;
#pragma unroll
                for (int j = 0; j < 16; ++j) { const unsigned c = __hip_atomic_load(ctl + CW_XRANK + 64 * j, __ATOMIC_RELAXED, __HIP_MEMORY_SCOPE_AGENT); tot += c; bad |= (j < 8) ? (c > 32u) : (c != 0u); }
                if (bad) { ok = false; break; } if (tot == 256u) break;
                __builtin_amdgcn_s_sleep(1); if (++sp > (1u << 20)) { ok = false; break; } }
            ((LAS int*)(lds + MISC_OFF))[16] = ok ? (int)(x + 8u * r) : -1; }
        __syncthreads();
        const int vb = ((LAS int*)(lds + MISC_OFF))[16]; if (vb >= 0) bid = vb;
        __syncthreads();
    }
#endif
    const int gw = bid * NWAVES + wave, NGW = G * NWAVES, NGT = G * NTHR;

    for (int u = wave * 64 + lane_id(); u < (LDS_BYTES - LDSCTL_OFF) / 4; u += NTHR) ((LAS unsigned*)(lds + LDSCTL_OFF))[u] = 0u;
    __syncthreads();
    const int lo = args.ph_lo, hi = args.ph_hi;
    const bool use_bar = (hi - lo) > 1;
    XcdBarrier bar; bar.bar = (unsigned*)(ctl + CW_BAR); bar.x = 0; bar.st = nullptr;
    if (use_bar) bar = xcd_barrier_post((unsigned*)(ctl + CW_BAR), MISC + 8);
#define IN(k) (lo <= (k) && (k) < hi)
#define SEAM(k) do { if (IN(k) && IN((k) + 1)) xcd_barrier(bar); } while (0)

    if (PHEN(100) && IN(0)) { PHV;
        const int gtid0 = bid * NTHR + tl;
        for (int i = gtid0; i < 64 * 16 + SEQ * 8; i += NGT) {
            float c, s;
            if (i < 1024) { const int pos = i >> 4, j = i & 15; sincos_acc((float)pos * ka->inv_ax[j], c, s); cs_ax[i].x = c; cs_ax[i].y = s; }
            else { const int k = i - 1024, pos = k >> 3, j = k & 7; sincos_acc((float)pos * ka->inv_1d[j], c, s); cs_1d[k].x = c; cs_1d[k].y = s; }
        }
        for (int m = gwl; m < MTOK / 2; m += NGW) cast_row2(IN_X + (size_t)m * DM, IN_X + (size_t)(m + MTOK / 2) * DM, an + (size_t)m * DM, an + (size_t)(m + MTOK / 2) * DM, rsA + m, rsA + m + MTOK / 2, ll);
        convert_layer(ka, 0, 0, lds, gwl, NGW, wvl, ll, gtid0, NGT);
    }
    SEAM(0);

    for (int l = 0; l < DEPTH; ++l) {
        const int pb = 1 + l * NPH_LAYER;
        if (PHEN(0) && IN(pb + 0)) REP(0) { PHV;
            pg8::Gemm g{(l == 0) ? an : (bf16*)hout, Win_t, MTOK, NQKV, DM}; DupStatic<0> S; S.init(MTOK, NQKV, G, bid);
            if (l > 0) {
                for (int i0 = 0; ; i0 += 3) {
                    pg8::Unit uu; int rw[3]; f32x4 pa[3][4]; bool any = false;
#pragma unroll
                    for (int i = 0; i < 3; ++i) { const bool v = S.next(i0 + i, uu); any |= v; rw[i] = v ? uu.pm * 256 + (tl & 255) : -1; const f32x4* p4 = (const f32x4*)(ssqP + (size_t)(v ? rw[i] : 0) * 16);
#pragma unroll
                        for (int q = 0; q < 4; ++q) pa[i][q] = p4[q]; }
                    if (!any) break;
#pragma unroll
                    for (int i = 0; i < 3; ++i) if (tl < 256 && rw[i] >= 0) { const f32x4 a = pa[i][0], b = pa[i][1], c = pa[i][2], d = pa[i][3];
                        const float s = ((a.x + a.y) + (a.z + a.w)) + ((b.x + b.y) + (b.z + b.w)) + ((c.x + c.y) + (c.z + c.w)) + ((d.x + d.y) + (d.z + d.w));
                        rsA[rw[i]] = 1.0f / sqrtf(s * (1.0f / DM) + RMS_EPS); }
                }
                asm volatile("s_waitcnt vmcnt(0)" ::: "memory"); __syncthreads();
            }
            EpiQKV E{qkv, IN_QKG + (size_t)l * 3 * 2 * 64, cs_ax, cs_1d, rsA};
            pg8::gemm_phase<EpiQKV, DupStatic<0>, true, true>(lds + RING_OFF, g, S, E, tl);
            { const bool split = (G == 256); const int g2 = split ? 128 : G, c2 = split ? bid - 128 : bid;
              if (c2 >= 0) { pg8::Gemm gp{pbf, Wpp_t, MTOK, DM, DPLE}; pg8::StaticOrder S2; S2.init(MTOK, DM, g2, c2);
                EpiStoreBf16NP E2{pp};
                pg8::gemm_phase<EpiStoreBf16NP, pg8::StaticOrder, true, true>(lds + RING_OFF, gp, S2, E2, wvl * 64 + lane_id()); } }
        }
        SEAM(pb + 0);
        if (PHEN(1) && IN(pb + 1)) REP(1) { PHV;
#pragma unroll 1
          for (int pass_ = 0; pass_ < 2; ++pass_) {
            if (pass_ == (bid & 1)) {
                asm volatile("s_waitcnt vmcnt(0) lgkmcnt(0)" ::: "memory"); __syncthreads();
                { const int l2_ = lane_id(); int w2_ = wvl; asm volatile("" : "+s"(w2_));
                  convert_layer(ka, 1, l, lds, bid * NWAVES + w2_, NGW, w2_, l2_, bid * NTHR + w2_ * 64 + l2_, NGT); }
                asm volatile("s_waitcnt vmcnt(0) lgkmcnt(0)" ::: "memory"); __syncthreads();
            }
            if (pass_ == 0) {
#ifdef NAIVE_ATTA
            for (int it = gwl; it < NB * 4 * 64; it += NGW) attnA_naive(qkv, ao, it, ll);
#else
            { const attn_body::AttnTensors AT{(const attn_body::bf16*)(qkv + C_QA), (const attn_body::bf16*)(qkv + C_KA), (const attn_body::bf16*)(qkv + C_VA), (attn_body::bf16*)ao};
              const attn_body::StaticOrder S(G, bid);
              attn_body::attn_phase<attn_body::StaticOrder>((char*)lds_raw + RING_OFF, AT, S, lane_id(), wvl); }
#endif
#ifdef NAIVE_ATTBC
            for (int it = gwl; it < NB * 6 * 64; it += NGW) attnB_naive(qkv, IN_NAB + (size_t)l * 6 * 15 * 31, ao, it, ll);
            for (int it = gwl; it < NB * 6 * 64; it += NGW) attnC_naive(qkv, ao, it, ll);
#else
#ifndef PROBE_DUPB
#define PROBE_DUPB 0
#endif
#ifndef PROBE_DUPC
#define PROBE_DUPC 0
#endif
#ifndef WAVE_B
#define WAVE_B 0
#endif
#ifndef WAVE_C
#define WAVE_C 0
#endif
#if WAVE_B
            attn_body::attnB_wave_phase((char*)lds_raw, (const attn_body::bf16*)qkv, C_QB, C_KB, C_VB, IN_NAB + (size_t)l * 6 * 15 * 31, (attn_body::bf16*)ao, G, bid, lane_id(), wvl);
            asm volatile("s_waitcnt vmcnt(0) lgkmcnt(0)\n\ts_barrier" ::: "memory");
#else
            for (int rb_ = 0; rb_ < 1 + PROBE_DUPB; ++rb_) attn_body::attnB_phase((char*)lds_raw + RING_OFF, (const attn_body::bf16*)qkv, C_QB, C_KB, C_VB, IN_NAB + (size_t)l * 6 * 15 * 31, (attn_body::bf16*)ao, G, bid, lane_id(), wvl);
#endif
#if WAVE_C
            attn_body::attnC_wave_phase((char*)lds_raw, (const attn_body::bf16*)qkv, C_QC, C_KC, C_VC, (attn_body::bf16*)cpart, clse, G, bid, lane_id(), wvl);
            asm volatile("s_waitcnt vmcnt(0) lgkmcnt(0)\n\ts_barrier" ::: "memory");
#else
            for (int rc_ = 0; rc_ < 1 + PROBE_DUPC; ++rc_) attn_body::attnC_phase((char*)lds_raw + RING_OFF, (const attn_body::bf16*)qkv, C_QC, C_KC, C_VC, (attn_body::bf16*)cpart, clse, G, bid, lane_id(), wvl);
#endif
#endif
            }
          }
        }
        SEAM(pb + 1);
        if (PHEN(2) && IN(pb + 2)) REP(2) { PHV;
            for (int m = gwl; m < MTOK / 2; m += NGW) groupnorm_row2(ao, cpart, clse, m, m + MTOK / 2, IN_GOUT + (size_t)l * DM, mix, ll);
        }
        SEAM(pb + 2);
        if (PHEN(3) && IN(pb + 3)) REP(3) { PHV;
            pg8::Gemm g{mix, Wout_t, MTOK, DM, DM}; DupStatic<3> S; S.init(MTOK, DM, G, bid);
            EpiResid E{(l == 0) ? (const bf16*)an : (const bf16*)hout, hY, hY8};
            pg8::gemm_phase<EpiResid, DupStatic<3>, ALIGN_RMW, true>(lds + RING_OFF, g, S, E, tl);
        }
        SEAM(pb + 3);
        if (PHEN(4) && IN(pb + 4)) REP(4) { PHV;
            if (FUSE_RT && G == 256 && IN(pb + 5)) {
                const int bat = bid >> 5, j = bid & 31;
                router_phase(hY, IN_GFFN + (size_t)l * DM, IN_WR + (size_t)l * DM * NE, rsY, aff, lds, tl, ll, bat * 1024 + j * 32 + wvl, NWAVES, bat * 1024 + j * 32 + 32);
                asm volatile("s_waitcnt vmcnt(0)" ::: "memory"); __syncthreads();
                if (tl == 0) { gu32* cnt = ctl + CW_GRP + ((l * PROBE_REPS + rep_) * NB + bat) * 64;
                    __hip_atomic_fetch_add(cnt, 1u, __ATOMIC_RELAXED, __HIP_MEMORY_SCOPE_AGENT);
                    unsigned sp = 0; while (__hip_atomic_load(cnt, __ATOMIC_RELAXED, __HIP_MEMORY_SCOPE_AGENT) < 32u) { __builtin_amdgcn_s_sleep(1); if (++sp > (1u << 22)) { __hip_atomic_store(ctl + 0, 0xDEAD0004u, __ATOMIC_RELAXED, __HIP_MEMORY_SCOPE_AGENT); break; } }
                    __builtin_amdgcn_fence(__ATOMIC_ACQUIRE, "agent"); asm volatile("s_waitcnt vmcnt(0)" ::: "memory"); }
                __syncthreads();
                __builtin_amdgcn_fence(__ATOMIC_ACQUIRE, "agent"); asm volatile("s_waitcnt vmcnt(0)" ::: "memory");
                topk_item(aff, idx, gval, sel, hY, rsY, rsG, xg, bat, j >> 1, j & 1, 2, lds, tl, ll, wvl);
            } else if (ROUTER_MFMA) router_mfma_phase(hY, IN_GFFN + (size_t)l * DM, IN_WR + (size_t)l * DM * NE, rsY, aff, lds, tl, ll, gwl, NGW);
            else router_phase(hY, IN_GFFN + (size_t)l * DM, IN_WR + (size_t)l * DM * NE, rsY, aff, lds, tl, ll, gwl, NGW, MTOK / 4);
        }
        if (!(FUSE_RT && G == 256 && IN(pb + 4) && IN(pb + 5))) SEAM(pb + 4);
        if (PHEN(5) && IN(pb + 5) && !(FUSE_RT && G == 256 && IN(pb + 4))) REP(5) { PHV;
            const int nh = (G >= 2 * NB * NE) ? 2 : 1, ng = G / nh;
            if (bid < ng * nh) for (int it = bid / nh; it < NB * NE; it += ng) topk_item(aff, idx, gval, sel, hY, rsY, rsG, xg, it >> 4, it & 15, bid % nh, nh, lds, tl, ll, wvl);
        }
        SEAM(pb + 5);
        if (PHEN(7) && IN(pb + 7)) REP(7) { PHV;
            GroupedOrder S; S.init(2048, G, bid);
            LAS int* gtok = (LAS int*)(lds + GTOK_OFF);
            { pg8::Unit uu; int Rv[GTOK_UNITS], iv[GTOK_UNITS];
#pragma unroll
              for (int i = 0; i < GTOK_UNITS; ++i) { Rv[i] = S.next(i, uu) ? uu.pm * 256 + (tl & 255) : -1; iv[i] = (Rv[i] >= 0) ? idx[Rv[i]] : 0; }
#pragma unroll
              for (int i = 0; i < GTOK_UNITS; ++i) if (tl < 256 && Rv[i] >= 0) gtok[i * 256 + tl] = ((Rv[i] >> 9) & 7) * SEQ + iv[i]; }
            __syncthreads();
            pg8::Gemm g{(const bf16*)hY8, Wgu_t, MR, 2048, DM / 2};
            EpiSwiGLU E{hid, rsG};
            pg8::gemm_phase<EpiSwiGLU, GroupedOrder, true, true, true, true>(lds + RING_OFF, g, S, E, tl, gtok);
        }
        SEAM(pb + 7);
        if (PHEN(8) && IN(pb + 8)) REP(8) { PHV;
            pg8::Gemm g{(const bf16*)hid, Wd_t, MR, DM, DFF / 2}; GroupedOrder S; S.init(DM, G, bid);
            LAS int* gtok = (LAS int*)(lds + GTOK_OFF);
            { pg8::Unit uu;
#pragma unroll
              for (int i = 0; i < GTOK_UNITS; ++i) if (S.next(i, uu) && tl < 256) gtok[i * 256 + tl] = uu.pm * 256 + tl; }
            __syncthreads();
            EpiStoreF8 E{y8};
            pg8::gemm_phase<EpiStoreF8, GroupedOrder, true, true, true, true>(lds + RING_OFF, g, S, E, tl, gtok);
        }
        SEAM(pb + 8);
        if (PHEN(9) && IN(pb + 9)) REP(9) { PHV;
            for (int q4 = gwl; q4 < MTOK / 4; q4 += NGW) {
                const int m0 = q4 * 4, b = m0 >> 12;
                f32x4 v[4][4]; unsigned long long hx[4][4];
#pragma unroll
                for (int r = 0; r < 4; ++r) { const unsigned long long* hr = (const unsigned long long*)(hY + (size_t)(m0 + r) * DM) + ll;
#pragma unroll
                    for (int j = 0; j < 4; ++j) hx[r][j] = hr[64 * j]; }
                const int slot = sel[(size_t)m0 * NE + ll];
                const int Rv = ((ll & 15) * NB + b) * CAP + (slot < 0 ? 0 : slot);
                const float gv = gval[Rv];
                const unsigned long long msk = __ballot(slot >= 0);
                unsigned mj[4] = {(unsigned)(msk & 0xffffu), (unsigned)((msk >> 16) & 0xffffu), (unsigned)((msk >> 32) & 0xffffu), (unsigned)((msk >> 48) & 0xffffu)};
#pragma unroll
                for (int r = 0; r < 4; ++r)
#pragma unroll
                    for (int j = 0; j < 4; ++j) v[r][j] = (f32x4){0.f, 0.f, 0.f, 0.f};
                while ((mj[0] | mj[1] | mj[2] | mj[3]) != 0u) {
                    unsigned yv[4][4]; float gt[4];
#pragma unroll
                    for (int r = 0; r < 4; ++r) { const bool has = mj[r] != 0u; const int i = has ? __builtin_ctz(mj[r]) : 0; mj[r] &= mj[r] - 1u;
                        const int R = __builtin_amdgcn_readlane(Rv, 16 * r + i); const float g = __uint_as_float(__builtin_amdgcn_readlane(__float_as_uint(gv), 16 * r + i)); gt[r] = has ? g : 0.f;
                        const unsigned* yr = (const unsigned*)(y8 + (size_t)R * DM) + ll;
#pragma unroll
                        for (int j = 0; j < 4; ++j) yv[r][j] = yr[64 * j]; }
#pragma unroll
                    for (int r = 0; r < 4; ++r) PIN4V(yv[r]);
#pragma unroll
                    for (int r = 0; r < 4; ++r)
#pragma unroll
                        for (int j = 0; j < 4; ++j) { const auto lo = __builtin_amdgcn_cvt_pk_f32_fp8((int)yv[r][j], false), hi2 = __builtin_amdgcn_cvt_pk_f32_fp8((int)yv[r][j], true);
                            v[r][j].x += gt[r] * lo[0]; v[r][j].y += gt[r] * lo[1]; v[r][j].z += gt[r] * hi2[0]; v[r][j].w += gt[r] * hi2[1]; }
                }
#pragma unroll
                for (int r = 0; r < 4; ++r) PIN4V(hx[r]);
#pragma unroll
                for (int r = 0; r < 4; ++r)
#pragma unroll
                    for (int j = 0; j < 4; ++j) { const unsigned long long x8 = hx[r][j]; const unsigned x0 = (unsigned)x8, x1 = (unsigned)(x8 >> 32); v[r][j].x += bflo(x0); v[r][j].y += bfhi(x0); v[r][j].z += bflo(x1); v[r][j].w += bfhi(x1); }
#pragma unroll
                for (int r = 0; r < 4; ++r) { unsigned long long* hw = (unsigned long long*)(hZ + (size_t)(m0 + r) * DM) + ll; unsigned* hw8 = (unsigned*)(hZ8 + (size_t)(m0 + r) * DM) + ll; float s = 0.f;
#pragma unroll
                    for (int j = 0; j < 4; ++j) { hw[64 * j] = (unsigned long long)pk2(v[r][j].x, v[r][j].y) | ((unsigned long long)pk2(v[r][j].z, v[r][j].w) << 32); hw8[64 * j] = pk4_f8(v[r][j].x, v[r][j].y, v[r][j].z, v[r][j].w); s += (v[r][j].x * v[r][j].x + v[r][j].y * v[r][j].y) + (v[r][j].z * v[r][j].z + v[r][j].w * v[r][j].w); }
                    const float rstd = 1.0f / sqrtf(wave_sum(s) * (1.0f / DM) + RMS_EPS);
                    if (ll == 0) rsZ[m0 + r] = rstd * (1.0f / F8_SC_W); }
            }
        }
        SEAM(pb + 9);
        if (PHEN(10) && IN(pb + 10)) REP(10) { PHV;
            pg8::Gemm g{(const bf16*)hZ8, Wpg_t, MTOK, DM, DM / 2}; DupStatic<10> S; S.init(MTOK, DM, G, bid);
            LAS int* gtok = (LAS int*)(lds + GTOK_OFF);
            { pg8::Unit uu;
#pragma unroll
              for (int i = 0; i < GTOK_UNITS; ++i) if (S.next(i, uu) && tl < 256) gtok[i * 256 + tl] = uu.pm * 256 + tl; }
            __syncthreads();
            EpiPLE E{hZ, (l == DEPTH - 1) ? hout : (float*)nullptr, (bf16*)hout, pp, rsZ, ssqP};
            pg8::gemm_phase<EpiPLE, DupStatic<10>, ALIGN_RMW, true, true, true>(lds + RING_OFF, g, S, E, tl, gtok);
        }
        SEAM(pb + 10);
    }
#undef IN
#undef SEAM
}

#ifndef MK_ONE_LAUNCH
#define MK_ONE_LAUNCH 1
#endif
extern "C" void kernel_launch(void* const* d_in, const int* in_sizes, int n_in, void* d_out, int out_size, void* d_ws, size_t ws_size, hipStream_t stream) {
    static int grid = 0;
    if (grid == 0) {
        if (n_in != 16 || out_size != MTOK * DM || ws_size < WS_END) { fprintf(stderr, "kernel_launch: unexpected shapes (n_in %d out %d ws %zu)\n", n_in, out_size, ws_size); grid = -1; return; }
        int dev = 0, cus = 0, per_cu = 0;
        if (hipGetDevice(&dev) != hipSuccess || hipDeviceGetAttribute(&cus, hipDeviceAttributeMultiprocessorCount, dev) != hipSuccess) { grid = -1; return; }
        if (hipFuncSetAttribute((const void*)mk_fwd, hipFuncAttributeMaxDynamicSharedMemorySize, LDS_BYTES) != hipSuccess) { fprintf(stderr, "kernel_launch: hipFuncSetAttribute failed\n"); grid = -1; return; }
        if (hipOccupancyMaxActiveBlocksPerMultiprocessor(&per_cu, (const void*)mk_fwd, NTHR, LDS_BYTES) != hipSuccess || per_cu < 1) fprintf(stderr, "kernel_launch: occupancy query says %d\n", per_cu);
        (void)hipGetLastError();
        grid = cus;
        if (grid * GTOK_UNITS * 256 < MR * 8) { fprintf(stderr, "kernel_launch: built for >= 256 CUs (the expert GEMM's row table holds %d units per workgroup); got %d\n", GTOK_UNITS, grid); grid = -1; return; }
    }
    if (grid < 0) return;
    (void)hipMemsetAsync((char*)d_ws + WS_CTL, 0, CTL_ZERO_BYTES, stream);
    Args a{};
    for (int i = 0; i < 16; ++i) a.in[i] = (const float*)d_in[i];
    a.out = (float*)d_out; a.ws = (unsigned char*)d_ws;
    for (int j = 0; j < 16; ++j) a.inv_ax[j] = (float)pow(10000.0, -(double)j / 16.0);
    for (int j = 0; j < 8; ++j) a.inv_1d[j] = (float)pow(500000.0, -(double)j / 8.0);
#if MK_ONE_LAUNCH
    a.ph_lo = 0; a.ph_hi = NPHASES;
    hipLaunchKernelGGL(mk_fwd, dim3(grid), dim3(NTHR), LDS_BYTES, stream, a);
#else
    for (int ph = 0; ph < NPHASES - 1; ++ph) { a.ph_lo = ph; a.ph_hi = ph + 1; hipLaunchKernelGGL(mk_fwd, dim3(grid), dim3(NTHR), LDS_BYTES, stream, a); }
#endif
}
```

```cpp
#include <hip/hip_runtime.h>
#include <hip/hip_bf16.h>
#include <cstdio>
#include <cstdint>
#include <cmath>
namespace pg8 {
#define PG8_LAS __attribute__((address_space(3)))
typedef unsigned short bf16_t;
typedef short bf16x8 __attribute__((ext_vector_type(8)));
typedef float f32x4 __attribute__((ext_vector_type(4)));
typedef unsigned u32x4 __attribute__((ext_vector_type(4)));
constexpr int BM = 256, BK = 64, HALF = 128, HTB = HALF * BK * 2  , STAGE_BYTES = 8 * HTB, NXCD = 8, WGM = 8;

__host__ __device__ __forceinline__ int lds_byte(int r, int c) { const int st = (r >> 4) * 2 + (c >> 5), rr = r & 15, cc = c & 31, ob = rr * 64 + cc * 2; return st * 1024 + (ob ^ (((ob >> 9) & 1) << 5)); }
__host__ __device__ __forceinline__ void stage_rc(int b, int& R, int& C) { const int st = b / 1024, sb = b % 1024, swz = sb ^ (((sb >> 9) & 1) << 5); R = (st >> 1) * 16 + swz / 64; C = (st & 1) * 32 + (swz % 64) / 2; }
__host__ __device__ __forceinline__ int perm32(int rho) { const int n = rho >> 4, i = rho & 15; return 8 * (i >> 2) + 4 * n + (i & 3); }

struct Unit { int pm, pn; };
struct Gemm { const bf16_t* A; const bf16_t* Bt; int M, N, K; };

struct StaticOrder {
    int nM, nN, nwg, G, c;
    __host__ __device__ void init(int M, int N, int G_, int c_) { nM = M / BM; nN = N / BM; nwg = nM * nN; G = G_; c = c_; }
    __host__ __device__ bool next(int i, Unit& u) const {
        const long L = (long)i * G + c; if (L >= nwg) return false;
        int wgid = (int)L; { const int q = nwg / NXCD, r = nwg % NXCD, xcd = wgid % NXCD, off = wgid / NXCD; wgid = (xcd < r ? xcd * (q + 1) : r * (q + 1) + (xcd - r) * q) + off; }
        const int nig = WGM * nN, gid = wgid / nig, fm = gid * WGM, gsz = (nM - fm) < WGM ? (nM - fm) : WGM;
        u.pm = fm + ((wgid % nig) % gsz); u.pn = (wgid % nig) / gsz; return true;
    }
    __device__ __forceinline__ void a_ready(const Unit&) const {}
    __device__ __forceinline__ void done(const Unit&) const {}
};

__device__ __forceinline__ unsigned cvt_pk_bf16(float lo, float hi) { unsigned r; asm volatile("v_cvt_pk_bf16_f32 %0, %1, %2" : "=v"(r) : "v"(lo), "v"(hi)); return r; }
typedef float f32x2 __attribute__((ext_vector_type(2)));
__device__ __forceinline__ f32x2 gelu_pk(f32x2 v) {
    const f32x2 av = __builtin_elementwise_abs(v), d = av * 0.2316418882f + 1.0f;
    f32x2 t; t.x = __builtin_amdgcn_rcpf(d.x); t.y = __builtin_amdgcn_rcpf(d.y);
    f32x2 q = t * 0.5307027145f + (-0.7265760135f); q = q * t + 0.7107068705f; q = q * t + (-0.142248368f); q = q * t + 0.127414796f; q = q * t;
    const f32x2 s = (v * v) * (-0.72134752044f);
    f32x2 e; e.x = __builtin_amdgcn_exp2f(s.x); e.y = __builtin_amdgcn_exp2f(s.y);
    const f32x2 m = v * (q * e), r = v - m;
    f32x2 o; o.x = v.x < 0.f ? m.x : r.x; o.y = v.y < 0.f ? m.y : r.y; return o;
}

template <int ACT  > struct EpiBf16 {
    static constexpr bool PERM = true, AFTER_DRAIN = false; static_assert(ACT == 0 || ACT == 1, "EpiBf16: ACT is 0 (none) or 1 (gelu_pk)");
    bf16_t* O; int ldc; const float* bias; int split_cols; size_t split_stride; float scale0;
    __device__ __forceinline__ void operator()(const f32x4 (&acc)[2][2][4][2], const Unit& u, int wr, int wc, int fr, int fq) const {
        const int row0 = u.pm * BM + wr * 64 + fr; int colt = u.pn * BM; bf16_t* base = O;
        float sc = 1.f; if (split_cols) { const int t = colt / split_cols; base += (size_t)t * split_stride; colt -= t * split_cols; if (t == 0) sc = scale0; }
        const int col0 = colt + wc * 32 + 8 * fq, bcol0 = u.pn * BM + wc * 32 + 8 * fq;
        f32x4 bv[2][2];
#pragma unroll
        for (int bj = 0; bj < 2; ++bj)
#pragma unroll
            for (int n = 0; n < 2; ++n) bv[bj][n] = bias ? *(const f32x4*)(bias + bcol0 + bj * HALF + 4 * n) : (f32x4){0.f, 0.f, 0.f, 0.f};
#pragma unroll
        for (int ai = 0; ai < 2; ++ai)
#pragma unroll
            for (int m = 0; m < 4; ++m) { bf16_t* rowp = base + (size_t)(row0 + ai * HALF + m * 16) * ldc + col0;
#pragma unroll
                for (int bj = 0; bj < 2; ++bj) { f32x4 v0 = acc[ai][bj][m][0] + bv[bj][0], v1 = acc[ai][bj][m][1] + bv[bj][1];
                    if (ACT == 1) { f32x2 a = gelu_pk((f32x2){v0[0], v0[1]}), b = gelu_pk((f32x2){v0[2], v0[3]}), c = gelu_pk((f32x2){v1[0], v1[1]}), d = gelu_pk((f32x2){v1[2], v1[3]});
                        v0 = (f32x4){a.x, a.y, b.x, b.y}; v1 = (f32x4){c.x, c.y, d.x, d.y}; }
                    v0 = v0 * sc; v1 = v1 * sc; u32x4 w; w.x = cvt_pk_bf16(v0[0], v0[1]); w.y = cvt_pk_bf16(v0[2], v0[3]); w.z = cvt_pk_bf16(v1[0], v1[1]); w.w = cvt_pk_bf16(v1[2], v1[3]);
                    *(u32x4*)(rowp + bj * HALF) = w; } }
    }
};

struct PanelStats {
    unsigned* xbuf;
    unsigned* cnt;
    unsigned* tmo;
    int ntn; float eps;
    unsigned code;
    __device__ __forceinline__ bool run(const f32x4 (&v)[2][2][4][2], const Unit& u, int wr, int wc, int fr, int fq, PG8_LAS unsigned char* lds, int wid, int lane) const {
        typedef float f32x2v __attribute__((ext_vector_type(2)));
        PG8_LAS f32x2v* P = (PG8_LAS f32x2v*)lds;
        PG8_LAS f32x2v* S = (PG8_LAS f32x2v*)(lds + 8192);
        PG8_LAS unsigned* flag = (PG8_LAS unsigned*)(lds + 8192 + 2048);
#pragma unroll
        for (int ai = 0; ai < 2; ++ai)
#pragma unroll
            for (int m = 0; m < 4; ++m) {
                float s = 0.f;
#pragma unroll
                for (int bj = 0; bj < 2; ++bj)
#pragma unroll
                    for (int n = 0; n < 2; ++n) { const f32x4 x = v[ai][bj][m][n]; s += (x[0] + x[1]) + (x[2] + x[3]); }
                s += __shfl_xor(s, 16); s += __shfl_xor(s, 32);
                const float mw = s * (1.0f / 64.0f); float q = 0.f;
#pragma unroll
                for (int bj = 0; bj < 2; ++bj)
#pragma unroll
                    for (int n = 0; n < 2; ++n) { const f32x4 d = v[ai][bj][m][n] - mw; q += (d[0] * d[0] + d[1] * d[1]) + (d[2] * d[2] + d[3] * d[3]); }
                q += __shfl_xor(q, 16); q += __shfl_xor(q, 32);
                if (fq == 0) P[(ai * HALF + wr * 64 + m * 16 + fr) * 4 + wc] = (f32x2v){mw, q};
            }
        asm volatile("s_waitcnt lgkmcnt(0)" ::: "memory"); __builtin_amdgcn_s_barrier(); asm volatile("" ::: "memory");
#if defined(BROKEN_EXCHANGE_NO_WAIT)
#warning BROKEN CONTROL BUILD: the row-statistics exchange does not wait; results are wrong by design
        if (blockIdx.x >= 64) { const long long t0_ = clock64(); while (clock64() - t0_ < 60000) __builtin_amdgcn_s_sleep(8); }
#endif
        const int row = wid * 32 + (lane & 31);
        if (lane < 32) {
            const f32x2v a = P[row * 4 + 0], b = P[row * 4 + 1], c = P[row * 4 + 2], d = P[row * 4 + 3];
            const float mt = (a.x + b.x + c.x + d.x) * 0.25f;
            const float da = a.x - mt, db = b.x - mt, dc = c.x - mt, dd = d.x - mt;
            const float m2 = (a.y + b.y) + (c.y + d.y) + 64.0f * ((da * da + db * db) + (dc * dc + dd * dd));
            unsigned long long* slot = (unsigned long long*)xbuf + ((size_t)(u.pm * BM + row) * 4 + u.pn);
            __hip_atomic_store(slot, ((unsigned long long)__float_as_uint(m2) << 32) | __float_as_uint(mt), __ATOMIC_RELAXED, __HIP_MEMORY_SCOPE_AGENT);
        }
        asm volatile("s_waitcnt vmcnt(0)" ::: "memory");
        if (lane == 0) __hip_atomic_fetch_add(cnt + 64 * u.pm, 1u, __ATOMIC_RELAXED, __HIP_MEMORY_SCOPE_AGENT);
        if (wid == 0) {
            bool dead = false; const unsigned long long t0 = __builtin_amdgcn_s_memrealtime(); const unsigned want = 8u * (unsigned)ntn;
            for (;;) {
#if defined(BROKEN_EXCHANGE_NO_WAIT)
                break;
#endif
                if ((unsigned)__builtin_amdgcn_readfirstlane(__hip_atomic_load(cnt + 64 * u.pm, __ATOMIC_RELAXED, __HIP_MEMORY_SCOPE_AGENT)) >= want) break;
                if (__builtin_amdgcn_s_memrealtime() - t0 > 2000000ull) {
                    if (lane == 0) { unsigned expect = 0u; __hip_atomic_compare_exchange_strong(tmo + 1, &expect, code | (unsigned)(u.pm & 0xff), __ATOMIC_RELAXED, __ATOMIC_RELAXED, __HIP_MEMORY_SCOPE_AGENT);
                                     __hip_atomic_store(tmo, 1u, __ATOMIC_RELAXED, __HIP_MEMORY_SCOPE_AGENT); }
                    dead = true; break; }
                __builtin_amdgcn_s_sleep(2);
            }
            __builtin_amdgcn_fence(__ATOMIC_ACQUIRE, "agent");
            if (lane == 0) flag[0] = dead ? 1u : 0u;
        }
        asm volatile("s_waitcnt vmcnt(0) lgkmcnt(0)" ::: "memory"); __builtin_amdgcn_s_barrier(); asm volatile("" ::: "memory");
        const bool bad = flag[0] != 0u;
        if (lane < 32) {
            const unsigned long long* slot = (const unsigned long long*)xbuf + (size_t)(u.pm * BM + row) * 4; float mt[4], m2[4]; float ms = 0.f;
#pragma unroll
            for (int t = 0; t < 4; ++t) { if (t < ntn) { const unsigned long long w = __hip_atomic_load(slot + t, __ATOMIC_RELAXED, __HIP_MEMORY_SCOPE_AGENT); mt[t] = __uint_as_float((unsigned)w); m2[t] = __uint_as_float((unsigned)(w >> 32)); } else { mt[t] = 0.f; m2[t] = 0.f; } ms += mt[t]; }
            const float mean = ms / (float)ntn; float q = 0.f;
#pragma unroll
            for (int t = 0; t < 4; ++t) if (t < ntn) { const float dm = mt[t] - mean; q += m2[t] + 256.0f * dm * dm; }
            S[row] = (f32x2v){mean, 1.0f / sqrtf(q / (256.0f * (float)ntn) + eps)};
        }
        asm volatile("s_waitcnt lgkmcnt(0)" ::: "memory"); __builtin_amdgcn_s_barrier(); asm volatile("" ::: "memory");
        return bad;
    }
};
struct EpiLnRes {
    static constexpr bool PERM = false, AFTER_DRAIN = true;
    const float* base; float* out; int ldc; const float* bias; PanelStats st; unsigned poison;
    __device__ __forceinline__ void fused(f32x4 (&acc)[2][2][4][2], const Unit& u, int wr, int wc, int fr, int fq, PG8_LAS unsigned char* lds, int wid, int lane) const {
        typedef float f32x2v __attribute__((ext_vector_type(2)));
        const PG8_LAS f32x2v* S = (const PG8_LAS f32x2v*)(lds + 8192);
        const int col0 = u.pn * BM + wc * 32 + 4 * fq;
#pragma unroll
        for (int bj = 0; bj < 2; ++bj)
#pragma unroll
            for (int n = 0; n < 2; ++n) { const f32x4 bv = bias ? *(const f32x4*)(bias + col0 + bj * HALF + n * 16) : (f32x4){0.f, 0.f, 0.f, 0.f};
#pragma unroll
                for (int ai = 0; ai < 2; ++ai)
#pragma unroll
                    for (int m = 0; m < 4; ++m) acc[ai][bj][m][n] += bv; }
        f32x4 pre[4][2][2];
#pragma unroll
        for (int m = 0; m < 4; ++m) { const size_t off = (size_t)(u.pm * BM + wr * 64 + m * 16 + fr) * ldc + col0;
#pragma unroll
            for (int bj = 0; bj < 2; ++bj)
#pragma unroll
                for (int n = 0; n < 2; ++n) pre[m][bj][n] = *(const f32x4*)(base + off + bj * HALF + n * 16); }
        const bool bad = st.run(acc, u, wr, wc, fr, fq, lds, wid, lane) || poison != 0u;
        const float qnan = __builtin_nanf("");
#pragma unroll
        for (int ai = 0; ai < 2; ++ai)
#pragma unroll
            for (int m = 0; m < 4; ++m) { const int r = ai * HALF + wr * 64 + m * 16 + fr; const f32x2v sr = S[r]; const size_t off = (size_t)(u.pm * BM + r) * ldc + col0;
#pragma unroll
                for (int bj = 0; bj < 2; ++bj)
#pragma unroll
                    for (int n = 0; n < 2; ++n) { const f32x4 bs = ai == 0 ? pre[m][bj][n] : *(const f32x4*)(base + off + bj * HALF + n * 16); f32x4 o = bs + (acc[ai][bj][m][n] - sr.x) * sr.y;
                        if (bad) o = (f32x4){qnan, qnan, qnan, qnan}; *(f32x4*)(out + off + bj * HALF + n * 16) = o; }
                if (m & 1) asm volatile("" ::: "memory"); }
    }
};
struct EpiLnResLn {
    static constexpr bool PERM = false, AFTER_DRAIN = true;
    const float* base; float* out; bf16_t* xn; int ldc; const float* bias; PanelStats st1, st2; unsigned poison;
    __device__ __forceinline__ void fused(f32x4 (&acc)[2][2][4][2], const Unit& u, int wr, int wc, int fr, int fq, PG8_LAS unsigned char* lds, int wid, int lane) const {
        typedef float f32x2v __attribute__((ext_vector_type(2))); typedef unsigned u32x2v __attribute__((ext_vector_type(2)));
        const PG8_LAS f32x2v* S = (const PG8_LAS f32x2v*)(lds + 8192);
        const int col0 = u.pn * BM + wc * 32 + 4 * fq;
#pragma unroll
        for (int bj = 0; bj < 2; ++bj)
#pragma unroll
            for (int n = 0; n < 2; ++n) { const f32x4 bv = bias ? *(const f32x4*)(bias + col0 + bj * HALF + n * 16) : (f32x4){0.f, 0.f, 0.f, 0.f};
#pragma unroll
                for (int ai = 0; ai < 2; ++ai)
#pragma unroll
                    for (int m = 0; m < 4; ++m) acc[ai][bj][m][n] += bv; }
        bool bad = st1.run(acc, u, wr, wc, fr, fq, lds, wid, lane) || poison != 0u;
        const float qnan = __builtin_nanf("");
#pragma unroll
        for (int ai = 0; ai < 2; ++ai)
#pragma unroll
            for (int m = 0; m < 4; ++m) { const int r = ai * HALF + wr * 64 + m * 16 + fr; const f32x2v sr = S[r]; const size_t off = (size_t)(u.pm * BM + r) * ldc + col0;
#pragma unroll
                for (int bj = 0; bj < 2; ++bj)
#pragma unroll
                    for (int n = 0; n < 2; ++n) { const f32x4 bs = *(const f32x4*)(base + off + bj * HALF + n * 16); acc[ai][bj][m][n] = bs + (acc[ai][bj][m][n] - sr.x) * sr.y; }
                asm volatile("" : "+v"(acc[ai][0][m][0]), "+v"(acc[ai][0][m][1]), "+v"(acc[ai][1][m][0]), "+v"(acc[ai][1][m][1]));
                if (m & 1) asm volatile("" ::: "memory"); }
        const bool bad1 = bad;
        bad = st2.run(acc, u, wr, wc, fr, fq, lds, wid, lane) || bad;
#pragma unroll
        for (int ai = 0; ai < 2; ++ai)
#pragma unroll
            for (int m = 0; m < 4; ++m) { const int r = ai * HALF + wr * 64 + m * 16 + fr; const f32x2v sr = S[r]; const size_t off = (size_t)(u.pm * BM + r) * ldc + col0;
#pragma unroll
                for (int bj = 0; bj < 2; ++bj)
#pragma unroll
                    for (int n = 0; n < 2; ++n) { const f32x4 x1 = acc[ai][bj][m][n]; *(f32x4*)(out + off + bj * HALF + n * 16) = bad1 ? (f32x4){qnan, qnan, qnan, qnan} : x1;
                        const f32x4 o = (x1 - sr.x) * sr.y; u32x2v w; w.x = cvt_pk_bf16(o[0], o[1]); w.y = cvt_pk_bf16(o[2], o[3]);
                        if (bad) { w.x = 0x7fc07fc0u; w.y = 0x7fc07fc0u; } *(u32x2v*)(xn + off + bj * HALF + n * 16) = w; }
                asm volatile("" ::: "memory"); }
    }
};

typedef int pg8_v8i __attribute__((ext_vector_type(8)));
typedef short pg8_s16 __attribute__((ext_vector_type(16)));
__device__ __forceinline__ pg8_v8i cat8(const bf16x8 (&x)[2]) { return __builtin_bit_cast(pg8_v8i, __builtin_shufflevector(x[0], x[1], 0, 1, 2, 3, 4, 5, 6, 7, 8, 9, 10, 11, 12, 13, 14, 15)); }
template <bool F8> __device__ __forceinline__ void mma_pair(f32x4& c, const bf16x8 (&b)[2], const bf16x8 (&a)[2]) {
    if constexpr (F8) { c = __builtin_amdgcn_mfma_scale_f32_16x16x128_f8f6f4(cat8(b), cat8(a), c, 0, 0, 0, 0x7F7F7F7F, 0, 0x7F7F7F7F); }
    else { c = __builtin_amdgcn_mfma_f32_16x16x32_bf16(b[0], a[0], c, 0, 0, 0); c = __builtin_amdgcn_mfma_f32_16x16x32_bf16(b[1], a[1], c, 0, 0, 0); }
}
template <class Epi, class Sched, bool ALIGN_EPI = false, bool SP2 = false, bool GATHER = false, bool F8 = false>
__device__ __forceinline__ void gemm_phase(PG8_LAS unsigned char* lds, const Gemm g, const Sched& S, const Epi& E, const int tid_in, const PG8_LAS int* gtok = nullptr) {
    int tid_l = tid_in; asm volatile("" : "+v"(tid_l));
    const int tid = tid_l, wid = __builtin_amdgcn_readfirstlane(tid >> 6), lane = tid & 63, wr = wid >> 2, wc = wid & 3, fr = lane & 15, fq = lane >> 4;
    const bf16_t* gA_l = g.A; const bf16_t* gB_l = g.Bt; asm volatile("" : "+s"(gA_l), "+s"(gB_l));
    const int K = g.K, nt = K / BK;
    unsigned voffA[2], voffB[2], voffA1[2];
#pragma unroll
    for (int i = 0; i < 2; ++i) { int R, C; stage_rc(tid * 16 + i * 8192, R, C); const int Rb = Epi::PERM ? ((R & ~31) + perm32(R & 31)) : R;
        voffA[i] = (unsigned)(R * K + C) * 2u; voffB[i] = (unsigned)(Rb * K + C) * 2u; voffA1[i] = voffA[i]; }
    if constexpr (GATHER) {
#pragma unroll
        for (int i = 0; i < 2; ++i) { int R, C; stage_rc(tid * 16 + i * 8192, R, C); voffA[i] = (unsigned)(gtok[R] * K + C) * 2u; voffA1[i] = (unsigned)(gtok[HALF + R] * K + C) * 2u; } }
    const size_t kstep = (size_t)(BK * 2);
    const size_t hstep = (size_t)HALF * K * 2;
    const size_t hsA = GATHER ? (size_t)0 : hstep;
    const size_t tstep = 2 * hstep;
    const unsigned ldsw = (unsigned)wid * 1024u;
    const int aoff = lds_byte(wr * 64 + fr, fq * 8), boff = lds_byte(wc * 32 + fr, fq * 8);
#define PG8_SA(b, h) (((b) * 2 + (h)) * HTB)
#define PG8_SB(b, h) ((4 + (b) * 2 + (h)) * HTB)
#define PG8_STAGE(bufoff, gbase, voff) do { _Pragma("unroll") for (int _i = 0; _i < 2; ++_i) \
        __builtin_amdgcn_global_load_lds((const unsigned*)((const char*)(gbase) + (voff)[_i]), (PG8_LAS unsigned*)(lds + (bufoff) + ldsw + _i * 8192), 16, 0, 0); } while (0)
#define PG8_LDA(dst, b, h) do { _Pragma("unroll") for (int m = 0; m < 4; ++m) _Pragma("unroll") for (int k = 0; k < 2; ++k) dst[m][k] = *(const PG8_LAS bf16x8*)(lds + PG8_SA(b, h) + aoff + m * 2048 + k * 1024); } while (0)
#define PG8_LDB(dst, b, h) do { _Pragma("unroll") for (int n = 0; n < 2; ++n) _Pragma("unroll") for (int k = 0; k < 2; ++k) dst[n][k] = *(const PG8_LAS bf16x8*)(lds + PG8_SB(b, h) + boff + n * 2048 + k * 1024); } while (0)
#define PG8_MMA(ai, bj, At, Bt) do { __builtin_amdgcn_s_setprio(1); _Pragma("unroll") for (int m = 0; m < 4; ++m) _Pragma("unroll") for (int n = 0; n < 2; ++n) \
        mma_pair<F8>(acc[ai][bj][m][n], Bt[n], At[m]); __builtin_amdgcn_s_setprio(0); } while (0)
#define PG8_WAIT_V(n) asm volatile("s_waitcnt vmcnt(" #n ")" ::: "memory")
#define PG8_WAIT_L(n) asm volatile("s_waitcnt lgkmcnt(" #n ")" ::: "memory")
#define PG8_BAR __builtin_amdgcn_s_barrier()
#define PG8_SCHED __builtin_amdgcn_sched_barrier(0)
    Unit cur, nxt; int ui = 0;
    if (!S.next(0, cur)) return;
    f32x4 acc[2][2][4][2];
#pragma unroll
    for (int a = 0; a < 2; ++a)
#pragma unroll
        for (int b = 0; b < 2; ++b)
#pragma unroll
            for (int m = 0; m < 4; ++m)
#pragma unroll
                for (int n = 0; n < 2; ++n) acc[a][b][m][n] = (f32x4){0.f, 0.f, 0.f, 0.f};
    bf16x8 At[4][2], B0[2][2], B1[2][2];
    const char* cA = (const char*)gA_l + (GATHER ? (size_t)0 : (size_t)cur.pm * tstep); const char* cB = (const char*)gB_l + (size_t)cur.pn * tstep;
    S.a_ready(cur);
    if constexpr (SP2) {
        PG8_STAGE(PG8_SB(0, 0), cB, voffB); PG8_STAGE(PG8_SB(0, 1), cB + hstep, voffB); PG8_STAGE(PG8_SA(0, 0), cA, voffA); PG8_STAGE(PG8_SA(0, 1), cA + hsA, voffA1);
        if (wr == 1) PG8_BAR;
        PG8_WAIT_V(2); PG8_BAR;
        PG8_STAGE(PG8_SB(1, 0), cB + kstep, voffB); PG8_STAGE(PG8_SA(1, 0), cA + kstep, voffA); PG8_STAGE(PG8_SB(1, 1), cB + hstep + kstep, voffB);
        PG8_WAIT_V(6); PG8_BAR;
    } else {
        PG8_STAGE(PG8_SB(0, 0), cB, voffB); PG8_STAGE(PG8_SA(0, 0), cA, voffA); PG8_STAGE(PG8_SB(0, 1), cB + hstep, voffB); PG8_STAGE(PG8_SA(0, 1), cA + hsA, voffA1);
        if (wr == 1) PG8_BAR;
        PG8_WAIT_V(4); PG8_BAR;
        PG8_STAGE(PG8_SB(1, 0), cB + kstep, voffB); PG8_STAGE(PG8_SA(1, 0), cA + kstep, voffA); PG8_STAGE(PG8_SB(1, 1), cB + hstep + kstep, voffB);
        PG8_WAIT_V(6); PG8_BAR;
    }
    for (;;) {
        const bool has_next = S.next(ui + 1, nxt);
        const char* nA = (has_next && !GATHER) ? (const char*)gA_l + (size_t)nxt.pm * tstep : cA; const char* nB = has_next ? (const char*)gB_l + (size_t)nxt.pn * tstep : cB;
#pragma nounroll
        for (int t = 0; t < nt; t += 2) {
            const bool last = (t == nt - 2);
            const char* a1 = cA + (size_t)(t + 1) * kstep;
            const char* a2 = last ? nA : cA + (size_t)(t + 2) * kstep; const char* b2 = last ? nB : cB + (size_t)(t + 2) * kstep;
            const char* a3 = a2 + kstep; const char* b3 = b2 + kstep;
            if (last && has_next) S.a_ready(nxt);
            if constexpr (SP2) {
            PG8_LDB(B0, 0, 0); PG8_LDB(B1, 0, 1); PG8_SCHED; PG8_LDA(At, 0, 0); PG8_STAGE(PG8_SA(1, 1), a1 + hsA, voffA1);
            if constexpr (GATHER) { if (last && has_next) {
                const PG8_LAS int* nt_ = gtok + (ui + 1) * BM;
#pragma unroll
                for (int i = 0; i < 2; ++i) { int R, C; stage_rc(tid * 16 + i * 8192, R, C); voffA[i] = (unsigned)(nt_[R] * K + C) * 2u; voffA1[i] = (unsigned)(nt_[HALF + R] * K + C) * 2u; } } }
            PG8_WAIT_V(8); PG8_WAIT_L(0); PG8_BAR; PG8_MMA(0, 0, At, B0); PG8_MMA(0, 1, At, B1); PG8_BAR; PG8_SCHED;
            PG8_LDA(At, 0, 1); PG8_STAGE(PG8_SB(0, 0), b2, voffB); PG8_STAGE(PG8_SB(0, 1), b2 + hstep, voffB); PG8_STAGE(PG8_SA(0, 0), a2, voffA);
            PG8_WAIT_V(8); PG8_WAIT_L(0); PG8_BAR; PG8_MMA(1, 0, At, B0); PG8_MMA(1, 1, At, B1); PG8_BAR; PG8_SCHED;
            PG8_LDB(B0, 1, 0); PG8_LDB(B1, 1, 1); PG8_SCHED; PG8_LDA(At, 1, 0); PG8_STAGE(PG8_SA(0, 1), a2 + hsA, voffA1);
            PG8_WAIT_V(8); PG8_WAIT_L(0); PG8_BAR; PG8_MMA(0, 0, At, B0); PG8_MMA(0, 1, At, B1); PG8_BAR; PG8_SCHED;
            PG8_LDA(At, 1, 1); PG8_STAGE(PG8_SB(1, 0), b3, voffB); PG8_STAGE(PG8_SB(1, 1), b3 + hstep, voffB); PG8_STAGE(PG8_SA(1, 0), a3, voffA);
            PG8_WAIT_V(8); PG8_WAIT_L(0); PG8_BAR; PG8_MMA(1, 0, At, B0); PG8_MMA(1, 1, At, B1); PG8_BAR; PG8_SCHED;
            } else {
            PG8_LDB(B0, 0, 0); PG8_SCHED; PG8_LDA(At, 0, 0); PG8_STAGE(PG8_SA(1, 1), a1 + hsA, voffA1);
            PG8_WAIT_L(8); PG8_BAR; PG8_WAIT_L(0); PG8_MMA(0, 0, At, B0); PG8_BAR; PG8_SCHED;
            PG8_LDB(B1, 0, 1); PG8_STAGE(PG8_SB(0, 0), b2, voffB);
            PG8_BAR; PG8_WAIT_L(0); PG8_MMA(0, 1, At, B1); PG8_BAR;
            PG8_LDA(At, 0, 1); PG8_STAGE(PG8_SA(0, 0), a2, voffA);
            PG8_BAR; PG8_WAIT_L(0); PG8_MMA(1, 0, At, B0); PG8_BAR; PG8_SCHED;
            PG8_STAGE(PG8_SB(0, 1), b2 + hstep, voffB);
            PG8_WAIT_V(6); PG8_BAR; PG8_MMA(1, 1, At, B1); PG8_BAR;
            PG8_LDB(B0, 1, 0); PG8_SCHED; PG8_LDA(At, 1, 0); PG8_STAGE(PG8_SA(0, 1), a2 + hsA, voffA1);
            PG8_WAIT_L(8); PG8_BAR; PG8_WAIT_L(0); PG8_MMA(0, 0, At, B0); PG8_BAR; PG8_SCHED;
            PG8_LDB(B1, 1, 1); PG8_STAGE(PG8_SB(1, 0), b3, voffB);
            PG8_BAR; PG8_WAIT_L(0); PG8_MMA(0, 1, At, B1); PG8_BAR;
            PG8_LDA(At, 1, 1); PG8_STAGE(PG8_SA(1, 0), a3, voffA);
            PG8_BAR; PG8_WAIT_L(0); PG8_MMA(1, 0, At, B0); PG8_BAR; PG8_SCHED;
            PG8_STAGE(PG8_SB(1, 1), b3 + hstep, voffB);
            PG8_WAIT_V(6); PG8_BAR; PG8_MMA(1, 1, At, B1); PG8_BAR;
            }
        }
        if constexpr (ALIGN_EPI) { if (wr == 0) PG8_BAR; }
        if constexpr (!Epi::AFTER_DRAIN) { E(acc, cur, wr, wc, fr, fq); S.done(cur); }
        if (!has_next) break;
#pragma unroll
        for (int a = 0; a < 2; ++a)
#pragma unroll
            for (int b = 0; b < 2; ++b)
#pragma unroll
                for (int m = 0; m < 4; ++m)
#pragma unroll
                    for (int n = 0; n < 2; ++n) acc[a][b][m][n] = (f32x4){0.f, 0.f, 0.f, 0.f};
        cur = nxt; cA = nA; cB = nB; ++ui;
        if constexpr (ALIGN_EPI) { if (wr == 1) PG8_BAR; }
    }
    PG8_WAIT_V(0);
    if constexpr (!ALIGN_EPI) { if (wr == 0) PG8_BAR; }
    PG8_BAR;
    if constexpr (Epi::AFTER_DRAIN) { E.fused(acc, cur, wr, wc, fr, fq, lds, wid, lane); S.done(cur); }
#undef PG8_SA
#undef PG8_SB
#undef PG8_STAGE
#undef PG8_LDA
#undef PG8_LDB
#undef PG8_MMA
#undef PG8_WAIT_V
#undef PG8_WAIT_L
#undef PG8_BAR
#undef PG8_SCHED
}
}
namespace attn_body {
using bf16=__hip_bfloat16;
using bf16x8=__attribute__((ext_vector_type(8)))short;
using s16x4=__attribute__((ext_vector_type(4)))short;
using f32x16=__attribute__((ext_vector_type(16)))float;
using u32x4=__attribute__((ext_vector_type(4)))unsigned;
constexpr int SEQ=4096,D=64,DM=2816,OPITCH=1024;
constexpr int NW=8,QBLK=32,QB=QBLK*NW,KVBLK=64,NQB=SEQ/QB;
constexpr int ATTN_PITCH=DM, ATTN_UNIT_ROWS=QB;
__device__ __forceinline__ int crow(int r,int hi){return (r&3)+8*(r>>2)+4*hi;}
#define SBAR() __builtin_amdgcn_sched_barrier(0)
__device__ __forceinline__ void cmask(f32x16&p0,f32x16&p1,int jb,int qrel,int hi){
  const float NEG=-INFINITY; int kb=64*jb+4*hi;
  #pragma unroll
  for(int r=0;r<16;++r){int kv=kb+(r&3)+8*(r>>2); if(kv>qrel)p0[r]=NEG; if(kv+32>qrel)p1[r]=NEG;}
}

constexpr int NSLOT=3, SLOTB=8192;
constexpr int LDS_K=0, LDS_V=NSLOT*SLOTB, LDS_WS=2*NSLOT*SLOTB, LDS_OST=LDS_WS+NW*64*4, LDS_BYTES=LDS_OST+NW*4096;
constexpr float C2=0.125f*1.4426950408889634f;
__device__ __forceinline__ void glds16(const void*gsrc,unsigned lds_dst){unsigned keep;
  asm volatile("s_mov_b32 %0, m0\n\ts_mov_b32 m0, %2\n\ts_nop 0\n\tglobal_load_lds_dwordx4 %1, off\n\ts_mov_b32 m0, %0":"=&s"(keep):"v"(gsrc),"s"(lds_dst):"memory");}
__device__ __forceinline__ float max3f(float a,float b,float c){float r;asm("v_max3_f32 %0, %1, %2, %3":"=v"(r):"v"(a),"v"(b),"v"(c));return r;}
__device__ __forceinline__ float max2f(float a,float b){float r;asm("v_max_f32_e32 %0, %1, %2":"=v"(r):"v"(a),"v"(b));return r;}
__device__ __forceinline__ float fadd_s(float a,float b){float r;asm("v_add_f32_e32 %0, %1, %2":"=v"(r):"v"(a),"v"(b));return r;}
__device__ __forceinline__ float fsub_s(float a,float b){float r;asm("v_sub_f32_e32 %0, %1, %2":"=v"(r):"v"(a),"v"(b));return r;}
typedef float f32x2_t __attribute__((ext_vector_type(2))); typedef __bf16 bf16x2_t __attribute__((ext_vector_type(2)));
__device__ __forceinline__ unsigned cvtpk_s(float lo,float hi){f32x2_t v={lo,hi};bf16x2_t b=__builtin_convertvector(v,bf16x2_t);return __builtin_bit_cast(unsigned,b);}
#define WAIT_BAR(N) asm volatile("s_waitcnt vmcnt(" #N ") lgkmcnt(0)\n\ts_barrier":::"memory")

__device__ __forceinline__ void qkt(f32x16&p0,f32x16&p1,const char*Kslot,const bf16x8*qr,const f32x16&negm,int r32,int hi){
  const char*kb=Kslot+hi*1024+r32*16;
  #pragma unroll
  for(int d0=0;d0<4;++d0){
    const bf16x8 b0=*reinterpret_cast<const bf16x8*>(kb+d0*2048);
    const bf16x8 b1=*reinterpret_cast<const bf16x8*>(kb+d0*2048+512);
    if(d0==0){p0=__builtin_amdgcn_mfma_f32_32x32x16_bf16(b0,qr[0],negm,0,0,0);p1=__builtin_amdgcn_mfma_f32_32x32x16_bf16(b1,qr[0],negm,0,0,0);}
    else{p0=__builtin_amdgcn_mfma_f32_32x32x16_bf16(b0,qr[d0],p0,0,0,0);p1=__builtin_amdgcn_mfma_f32_32x32x16_bf16(b1,qr[d0],p1,0,0,0);}}
}
typedef __attribute__((address_space(3))) const char* lds_cptr;
typedef short v4i16_t __attribute__((ext_vector_type(4)));
__device__ __forceinline__ void kload8(bf16x8*kf,lds_cptr kp){
  kf[0]=*(const __attribute__((address_space(3))) bf16x8*)(kp);      kf[1]=*(const __attribute__((address_space(3))) bf16x8*)(kp+512);
  kf[2]=*(const __attribute__((address_space(3))) bf16x8*)(kp+2048); kf[3]=*(const __attribute__((address_space(3))) bf16x8*)(kp+2560);
  kf[4]=*(const __attribute__((address_space(3))) bf16x8*)(kp+4096); kf[5]=*(const __attribute__((address_space(3))) bf16x8*)(kp+4608);
  kf[6]=*(const __attribute__((address_space(3))) bf16x8*)(kp+6144); kf[7]=*(const __attribute__((address_space(3))) bf16x8*)(kp+6656);
}
__device__ __forceinline__ void kload2(bf16x8*kf,lds_cptr kp,int j){ kf[2*j]=*(const __attribute__((address_space(3))) bf16x8*)(kp+j*2048); kf[2*j+1]=*(const __attribute__((address_space(3))) bf16x8*)(kp+j*2048+512); }
__device__ __forceinline__ int ksoff(int r32,int hi,int d0,int half){ return (r32>>3)*1024+((hi^((r32>>3)&1))*128)+(r32&7)*16+d0*256+half*4096; }
__device__ __forceinline__ void qkt_s(f32x16&p0,f32x16&p1,const char*Kslot,const bf16x8*qr,const f32x16&negm,int r32,int hi){
  #pragma unroll
  for(int d0=0;d0<4;++d0){
    const bf16x8 b0=*reinterpret_cast<const bf16x8*>(Kslot+ksoff(r32,hi,d0,0));
    const bf16x8 b1=*reinterpret_cast<const bf16x8*>(Kslot+ksoff(r32,hi,d0,1));
    if(d0==0){p0=__builtin_amdgcn_mfma_f32_32x32x16_bf16(b0,qr[0],negm,0,0,0);p1=__builtin_amdgcn_mfma_f32_32x32x16_bf16(b1,qr[0],negm,0,0,0);}
    else{p0=__builtin_amdgcn_mfma_f32_32x32x16_bf16(b0,qr[d0],p0,0,0,0);p1=__builtin_amdgcn_mfma_f32_32x32x16_bf16(b1,qr[d0],p1,0,0,0);}}
}
__device__ __forceinline__ void kload2_s(bf16x8*kf,lds_cptr ks,int j,int r32,int hi){ kf[2*j]=*(const __attribute__((address_space(3))) bf16x8*)(ks+ksoff(r32,hi,j,0)); kf[2*j+1]=*(const __attribute__((address_space(3))) bf16x8*)(ks+ksoff(r32,hi,j,1)); }
__device__ __forceinline__ void kload8_s(bf16x8*kf,lds_cptr ks,int r32,int hi){ kload2_s(kf,ks,0,r32,hi); kload2_s(kf,ks,1,r32,hi); kload2_s(kf,ks,2,r32,hi); kload2_s(kf,ks,3,r32,hi); }
__device__ __forceinline__ s16x4 vtr(lds_cptr p){ return __builtin_bit_cast(s16x4,__builtin_amdgcn_ds_read_tr16_b64_v4i16((__attribute__((address_space(3))) v4i16_t*)p)); }
__device__ __forceinline__ float rowmax(const f32x16&p0,const f32x16&p1){
  float a=max3f(p0[0],p0[1],p1[0]),b=max3f(p0[2],p0[3],p1[1]);a=max3f(a,p1[2],p1[3]);
  #pragma unroll
  for(int r=4;r<16;r+=4){a=max3f(a,p0[r],p0[r+1]);b=max3f(b,p0[r+2],p0[r+3]);a=max3f(a,p1[r],p1[r+1]);b=max3f(b,p1[r+2],p1[r+3]);}
  const float m=max2f(a,b);
  auto rr=__builtin_amdgcn_permlane32_swap(__float_as_uint(m),__float_as_uint(m),false,false);
  return max2f(__uint_as_float(rr[0]),__uint_as_float(rr[1]));
}
__device__ __forceinline__ void pv(f32x16*o,int vb,bf16x8 pa0,bf16x8 pa1,bf16x8 pa2,bf16x8 pa3){
  #pragma unroll
  for(int d0=0;d0<2;++d0){s16x4 lo[4],hi[4];
    #pragma unroll
    for(int ks=0;ks<4;++ks){
      asm volatile("ds_read_b64_tr_b16 %0,%1 offset:%c2":"=&v"(lo[ks]):"v"(vb),"i"(d0*4096+ks*1024):"memory");
      asm volatile("ds_read_b64_tr_b16 %0,%1 offset:%c2":"=&v"(hi[ks]):"v"(vb),"i"(d0*4096+ks*1024+512):"memory");}
    asm volatile("s_waitcnt lgkmcnt(0)":::"memory");SBAR();
    #define PK(k) (bf16x8){lo[k][0],lo[k][1],lo[k][2],lo[k][3],hi[k][0],hi[k][1],hi[k][2],hi[k][3]}
    o[d0]=__builtin_amdgcn_mfma_f32_32x32x16_bf16(pa0,PK(0),o[d0],0,0,0);
    o[d0]=__builtin_amdgcn_mfma_f32_32x32x16_bf16(pa1,PK(1),o[d0],0,0,0);
    o[d0]=__builtin_amdgcn_mfma_f32_32x32x16_bf16(pa2,PK(2),o[d0],0,0,0);
    o[d0]=__builtin_amdgcn_mfma_f32_32x32x16_bf16(pa3,PK(3),o[d0],0,0,0);
    #undef PK
  }
}

#ifndef ATTN_STORE16
#define ATTN_STORE16(p,v) (*(u32x4*)(p)=(v))
#endif
template<int THRL> __device__ __forceinline__ void attn_unit(int b,int h,int kvh,int qb,const bf16*Q,const bf16*__restrict__ K,const bf16*__restrict__ V,bf16*O,char*shm,int lane,int wid){
  const int r32=lane&31,hi=lane>>5;
  const long rowbase=(long)b*SEQ; const int q0=qb*QB;
  const bf16*Qw=Q+(rowbase+q0+wid*QBLK)*DM+h*D;
  const bf16*Kh=K+rowbase*DM+kvh*D,*Vh=V+rowbase*DM+kvh*D;
  const unsigned lds0=(unsigned)(uintptr_t)shm;
  float*wsf=(float*)(shm+LDS_WS)+wid*64;
  const bf16*ksrc=Kh+(long)(8*wid+(lane&7))*DM+((lane>>3)^(wid&1))*8;
  const bf16*vsrc=Vh+(long)(16*(wid&3)+(lane>>2))*DM+(wid>>2)*32+(lane&3)*8;
  const unsigned kdst=lds0+LDS_K+wid*1024, vdst=lds0+LDS_V+wid*1024;
  #define DMA_K(t,slot) glds16(ksrc+(long)(t)*KVBLK*DM,(unsigned)__builtin_amdgcn_readfirstlane(kdst+(slot)))
  #define DMA_V(t,slot) glds16(vsrc+(long)(t)*KVBLK*DM,(unsigned)__builtin_amdgcn_readfirstlane(vdst+(slot)))
  const int vb0=(int)(lds0+LDS_V)+((lane>>4)&1)*32+(lane&3)*8+(4*hi+((lane&15)>>2))*64;
  const char*Kbase=shm+LDS_K; bf16x8 kf[8];
  const lds_cptr shm3=(lds_cptr)shm; const lds_cptr kp0=shm3+LDS_K+hi*1024+r32*16; const lds_cptr vp0=shm3+LDS_V+((lane>>4)&1)*32+(lane&3)*8+(4*hi+((lane&15)>>2))*64;
  constexpr int NT=SEQ/KVBLK;
  DMA_K(0,0);DMA_V(0,0);DMA_K(1,SLOTB);
  bf16x8 qr[4];
  #pragma unroll
  for(int d0=0;d0<4;++d0)qr[d0]=*reinterpret_cast<const bf16x8*>(&Qw[(long)r32*DM+d0*16+hi*8]);
  float zz_;asm volatile("v_mov_b32 %0, 0":"=v"(zz_));
  float mhat=zz_,l_reg=zz_;f32x16 o[2];f32x16 negm;
  _Pragma("unroll") for(int r=0;r<16;++r){o[0][r]=zz_;o[1][r]=zz_;negm[r]=zz_;} asm volatile("":"+v"(negm));
  #define CMASK(P0,P1,t) do{}while(0)
  bool resc=false;
  #define START(P0,P1) do{ const float rm=rowmax(P0,P1); resc=false; \
    { const float dl=rm; mhat=fadd_s(mhat,dl); \
      _Pragma("unroll") for(int r=0;r<16;++r){P0[r]=fsub_s(P0[r],dl);P1[r]=fsub_s(P1[r],dl);} \
      _Pragma("unroll") for(int r=0;r<16;++r)negm[r]=-mhat; asm volatile("":"+v"(negm)); } \
    _Pragma("unroll") for(int r=0;r<16;++r)P0[r]=__builtin_amdgcn_exp2f(P0[r]); }while(0)
  #define RESC() do{ if(resc){ asm volatile("s_waitcnt lgkmcnt(0)":::"memory"); \
      _Pragma("unroll") for(int d_=0;d_<2;++d_) _Pragma("unroll") for(int r=0;r<16;++r)o[d_][r]*=wsf[crow(r,hi)]; } }while(0)
  f32x16 pA0,pA1,pB0,pB1;
  int sl_prev=0,sl_cur=0,sl_next=SLOTB;
  #define ROT() do{sl_prev=sl_cur;sl_cur=sl_next;sl_next=(sl_next==(NSLOT-1)*SLOTB)?0:sl_next+SLOTB;}while(0)
  DMA_K(2,2*SLOTB);
  WAIT_BAR(3);
  qkt_s(pA0,pA1,Kbase,qr,negm,r32,hi);asm volatile("s_nop 15\n\ts_nop 7":"+v"(pA0),"+v"(pA1));CMASK(pA0,pA1,0);
  START(pA0,pA1);
  _Pragma("unroll") for(int r=0;r<16;++r)pA1[r]=__builtin_amdgcn_exp2f(pA1[r]);
  WAIT_BAR(0);
  DMA_K(3,0);DMA_V(1,SLOTB);
  ROT();
  kload8_s(kf,shm3+LDS_K+sl_cur,r32,hi);
  WAIT_BAR(2);
  s16x4 vlo[8],vhi[8]; u32x4 pw0,pw1,pw2,pw3;
  #define PKW(P,B) cvtpk_s(P[B],P[B+1])
  #define PAF(k) __builtin_bit_cast(bf16x8,pw##k)
  #define VFR(i) (bf16x8){vlo[i][0],vlo[i][1],vlo[i][2],vlo[i][3],vhi[i][0],vhi[i][1],vhi[i][2],vhi[i][3]}
  #define PIN(x) asm volatile("":"+v"(x))
  #define MX3(a,b,c) __builtin_fmaxf(__builtin_fmaxf((a),(b)),(c))
  #define GAPA(MF,A0,A1,A2,A3,W0,W1,PW) do{ MF; sacc+=A0; sacc+=A1; sacc+=A2; sacc+=A3; PIN(sacc); W0; W1; PIN(PW); SBAR(); }while(0)
  #define EX(v) __builtin_amdgcn_exp2f(v)
  #define GAPB(MF,X,B) do{ MF; X[B]=EX(X[B]); X[B+1]=EX(X[B+1]); X[B+2]=EX(X[B+2]); X[B+3]=EX(X[B+3]); PIN(X); SBAR(); }while(0)
  #define VRD(i) do{ vlo[i]=vtr(vp_+(((i)>>2)*4096+((i)&3)*1024)); vhi[i]=vtr(vp_+(((i)>>2)*4096+((i)&3)*1024+512)); }while(0)
  #define KRD(G,j) do{ if(G){ kload2_s(kf,shm3+LDS_K+sl_next,j,r32,hi); SBAR(); } }while(0)
  #define STEP(C0,C1,P0,P1,t,GK,GV,GL) do{ SBAR(); \
    const lds_cptr vp_=vp0+sl_prev; \
    VRD(0); SBAR(); float sacc=(P0[0]+P0[1]); \
    GAPA(C0=__builtin_amdgcn_mfma_f32_32x32x16_bf16(kf[0],qr[0],negm,0,0,0), P0[2],P0[3],P0[4],P0[5],     pw0[0]=PKW(P0,0), pw0[1]=PKW(P0,2), pw0); \
    VRD(4); SBAR(); GAPA(C1=__builtin_amdgcn_mfma_f32_32x32x16_bf16(kf[1],qr[0],negm,0,0,0), P0[6],P0[7],P0[8],P0[9],     pw0[2]=PKW(P0,4), pw0[3]=PKW(P0,6), pw0); \
    VRD(1); SBAR(); GAPA(C0=__builtin_amdgcn_mfma_f32_32x32x16_bf16(kf[2],qr[1],C0,0,0,0),   P0[10],P0[11],P0[12],P0[13], pw1[0]=PKW(P0,8), pw1[1]=PKW(P0,10), pw1); \
    VRD(5); SBAR(); GAPA(C1=__builtin_amdgcn_mfma_f32_32x32x16_bf16(kf[3],qr[1],C1,0,0,0),   P0[14],P0[15],P1[0],P1[1],   pw1[2]=PKW(P0,12),pw1[3]=PKW(P0,14), pw1); \
    VRD(2); SBAR(); GAPA(C0=__builtin_amdgcn_mfma_f32_32x32x16_bf16(kf[4],qr[2],C0,0,0,0),   P1[2],P1[3],P1[4],P1[5],     pw2[0]=PKW(P1,0), pw2[1]=PKW(P1,2), pw2); \
    VRD(6); SBAR(); GAPA(C1=__builtin_amdgcn_mfma_f32_32x32x16_bf16(kf[5],qr[2],C1,0,0,0),   P1[6],P1[7],P1[8],P1[9],     pw2[2]=PKW(P1,4), pw2[3]=PKW(P1,6), pw2); \
    VRD(3); SBAR(); GAPA(C0=__builtin_amdgcn_mfma_f32_32x32x16_bf16(kf[6],qr[3],C0,0,0,0),   P1[10],P1[11],P1[12],P1[13], pw3[0]=PKW(P1,8), pw3[1]=PKW(P1,10), pw3); \
    VRD(7); SBAR(); GAPA(C1=__builtin_amdgcn_mfma_f32_32x32x16_bf16(kf[7],qr[3],C1,0,0,0),   P1[14],P1[15],0.f,0.f,       pw3[2]=PKW(P1,12),pw3[3]=PKW(P1,14), pw3); \
    l_reg+=sacc; \
    if(GK){DMA_K((t)+3,sl_cur);} if(GV){DMA_V((t)+1,sl_next);} \
    CMASK(C0,C1,t); \
    { float a=MX3(C0[0],C0[1],C1[0]),b=MX3(C0[2],C0[3],C1[1]); a=MX3(a,C1[2],C1[3]); \
      _Pragma("unroll") for(int r=4;r<16;r+=4){a=MX3(a,C0[r],C0[r+1]);b=MX3(b,C0[r+2],C0[r+3]);a=MX3(a,C1[r],C1[r+1]);b=MX3(b,C1[r+2],C1[r+3]);} \
      float rm=__builtin_fmaxf(a,b); { auto rr=__builtin_amdgcn_permlane32_swap(__float_as_uint(rm),__float_as_uint(rm),false,false); rm=__builtin_fmaxf(__uint_as_float(rr[0]),__uint_as_float(rr[1])); } \
      resc=false; \
      if(__builtin_expect(__any(rm>(float)THRL),0)){ const float dl=__builtin_fmaxf(rm,0.f); mhat+=dl; \
        _Pragma("unroll") for(int r=0;r<16;++r){C0[r]-=dl;C1[r]-=dl;} \
        _Pragma("unroll") for(int r=0;r<16;++r)negm[r]=-mhat; asm volatile("":"+v"(negm)); \
        const float f=__builtin_amdgcn_exp2f(-dl); l_reg*=f; if(hi==0)wsf[r32]=f; resc=true; } } \
    SBAR(); \
    GAPB(o[0]=__builtin_amdgcn_mfma_f32_32x32x16_bf16(PAF(0),VFR(0),o[0],0,0,0), C0,0); \
    GAPB(o[1]=__builtin_amdgcn_mfma_f32_32x32x16_bf16(PAF(0),VFR(4),o[1],0,0,0), C0,4); \
    KRD(GL,0); GAPB(o[0]=__builtin_amdgcn_mfma_f32_32x32x16_bf16(PAF(1),VFR(1),o[0],0,0,0), C0,8); \
    KRD(GL,1); GAPB(o[1]=__builtin_amdgcn_mfma_f32_32x32x16_bf16(PAF(1),VFR(5),o[1],0,0,0), C0,12); \
    KRD(GL,2); GAPB(o[0]=__builtin_amdgcn_mfma_f32_32x32x16_bf16(PAF(2),VFR(2),o[0],0,0,0), C1,0); \
    KRD(GL,3); GAPB(o[1]=__builtin_amdgcn_mfma_f32_32x32x16_bf16(PAF(2),VFR(6),o[1],0,0,0), C1,4); \
    GAPB(o[0]=__builtin_amdgcn_mfma_f32_32x32x16_bf16(PAF(3),VFR(3),o[0],0,0,0), C1,8); \
    GAPB(o[1]=__builtin_amdgcn_mfma_f32_32x32x16_bf16(PAF(3),VFR(7),o[1],0,0,0), C1,12); \
    }while(0)
  int t=1;
  #undef CMASK
  #define CMASK(P0,P1,t) do{}while(0)
  for(;t+5<NT;t+=2){
    STEP(pB0,pB1,pA0,pA1,t,true,true,true);     WAIT_BAR(2); RESC(); ROT();
    STEP(pA0,pA1,pB0,pB1,t+1,true,true,true);   WAIT_BAR(2); RESC(); ROT();
  }
  #undef CMASK
  #define CMASK(P0,P1,t) do{}while(0)
  #define ENDW(tt) do{ if((tt)+3<NT){WAIT_BAR(2);} else if((tt)+2<NT){WAIT_BAR(1);} else {WAIT_BAR(0);} }while(0)
  for(;t+1<NT;t+=2){
    STEP(pB0,pB1,pA0,pA1,t,(t+3<NT),(t+1<NT),(t+1<NT));       ENDW(t);   RESC(); ROT();
    STEP(pA0,pA1,pB0,pB1,t+1,(t+4<NT),(t+2<NT),(t+2<NT));     ENDW(t+1); RESC(); ROT();
  }
  STEP(pB0,pB1,pA0,pA1,NT-1,false,false,false); RESC();
  { float sacc=pB0[0]+pB0[1]; _Pragma("unroll") for(int r=2;r<16;++r)sacc+=pB0[r]; _Pragma("unroll") for(int r=0;r<16;++r)sacc+=pB1[r]; l_reg+=sacc;
    pw0=(u32x4){PKW(pB0,0),PKW(pB0,2),PKW(pB0,4),PKW(pB0,6)};pw1=(u32x4){PKW(pB0,8),PKW(pB0,10),PKW(pB0,12),PKW(pB0,14)};pw2=(u32x4){PKW(pB1,0),PKW(pB1,2),PKW(pB1,4),PKW(pB1,6)};pw3=(u32x4){PKW(pB1,8),PKW(pB1,10),PKW(pB1,12),PKW(pB1,14)};
    SBAR(); pv(o,vb0+sl_cur,PAF(0),PAF(1),PAF(2),PAF(3)); }
  #undef PKW
  #undef PAF
  #undef VFR
  #undef PIN
  #undef MX3
  #undef GAPA
  #undef GAPB
  #undef EX
  #undef VRD
  #undef KRD
  #undef STEP
  #undef ENDW
  {auto rr=__builtin_amdgcn_permlane32_swap(__float_as_uint(l_reg),__float_as_uint(l_reg),false,false);l_reg=__uint_as_float(rr[0])+__uint_as_float(rr[1]);}
  if(hi==0)wsf[32+r32]=l_reg;asm volatile("s_waitcnt lgkmcnt(0)":::"memory");
  float rli[16];
  #pragma unroll
  for(int r=0;r<16;++r)rli[r]=__builtin_amdgcn_rcpf(wsf[32+crow(r,hi)]);
  bf16*Ow=O+(rowbase+q0+wid*QBLK)*OPITCH+h*D;
  { bf16*stg=(bf16*)(shm+LDS_OST)+wid*2048;
    #pragma unroll
    for(int r=0;r<16;++r){const int orow=crow(r,hi);
      #pragma unroll
      for(int d0=0;d0<2;++d0)stg[orow*64+d0*32+r32]=__float2bfloat16(o[d0][r]*rli[r]);}
    asm volatile("s_waitcnt lgkmcnt(0)":::"memory");
    #pragma unroll
    for(int i=0;i<4;++i){const int row=i*8+(lane>>3),ch=lane&7; const u32x4 v=*(const u32x4*)(stg+row*64+ch*8); ATTN_STORE16(Ow+(long)row*OPITCH+ch*8,v);} }
  asm volatile("s_waitcnt lgkmcnt(0)\n\ts_barrier":::"memory");
  #undef DMA_K
  #undef DMA_V
  #undef CMASK
  #undef START
  #undef RESC
  #undef ROT
}
template<class Var,int THRL> __device__ __forceinline__ void attn_unit_g(const Var&W,const bf16*Q,const bf16*__restrict__ K,const bf16*__restrict__ V,bf16*O,char*shm,int lane,int wid){
  const int r32=lane&31,hi=lane>>5;
  const unsigned lds0=(unsigned)(uintptr_t)shm;
  float*wsf=(float*)(shm+LDS_WS)+wid*64;
  const bf16*ksrc=K+wid*8;
  const bf16*vsrc=V+(wid>>2)*32+(lane&3)*8; const int vidx=16*(wid&3)+(lane>>2);
  const unsigned kdst=lds0+LDS_K+wid*1024, vdst=lds0+LDS_V+wid*1024;
  #define DMA_K(t,slot) glds16(ksrc+W.krow((t),lane)*DM,(unsigned)__builtin_amdgcn_readfirstlane(kdst+(slot)))
  #define DMA_V(t,slot) glds16(vsrc+W.krow((t),vidx)*DM,(unsigned)__builtin_amdgcn_readfirstlane(vdst+(slot)))
  const int vb0=(int)(lds0+LDS_V)+((lane>>4)&1)*32+(lane&3)*8+(4*hi+((lane&15)>>2))*64;
  const char*Kbase=shm+LDS_K; bf16x8 kf[8];
  const lds_cptr shm3=(lds_cptr)shm; const lds_cptr kp0=shm3+LDS_K+hi*1024+r32*16; const lds_cptr vp0=shm3+LDS_V+((lane>>4)&1)*32+(lane&3)*8+(4*hi+((lane&15)>>2))*64;
  constexpr int NT=Var::NT;
  DMA_K(0,0);DMA_V(0,0);DMA_K(1,SLOTB);
  bf16x8 qr[4];
  #pragma unroll
  for(int d0=0;d0<4;++d0)qr[d0]=*reinterpret_cast<const bf16x8*>(&Q[W.qrow(wid,r32)*DM+d0*16+hi*8]);
  float zz_;asm volatile("v_mov_b32 %0, 0":"=v"(zz_));
  float mhat=zz_,l_reg=zz_;f32x16 o[2];f32x16 negm;
  _Pragma("unroll") for(int r=0;r<16;++r){o[0][r]=zz_;o[1][r]=zz_;negm[r]=zz_;} asm volatile("":"+v"(negm));
  #define CMASK(P0,P1,t) W.mask(P0,P1,(t),wid,r32,hi)
  bool resc=false;
  #define START(P0,P1) do{ const float rm=rowmax(P0,P1); resc=false; \
    { const float dl=__builtin_fmaxf(rm,-30.f); mhat=fadd_s(mhat,dl);   \
      _Pragma("unroll") for(int r=0;r<16;++r){P0[r]=fsub_s(P0[r],dl);P1[r]=fsub_s(P1[r],dl);} \
      _Pragma("unroll") for(int r=0;r<16;++r)negm[r]=-mhat; asm volatile("":"+v"(negm)); } \
    _Pragma("unroll") for(int r=0;r<16;++r)P0[r]=__builtin_amdgcn_exp2f(P0[r]); }while(0)
  #define RESC() do{ if(resc){ asm volatile("s_waitcnt lgkmcnt(0)":::"memory"); \
      _Pragma("unroll") for(int d_=0;d_<2;++d_) _Pragma("unroll") for(int r=0;r<16;++r)o[d_][r]*=wsf[crow(r,hi)]; } }while(0)
  f32x16 pA0,pA1,pB0,pB1;
  int sl_prev=0,sl_cur=0,sl_next=SLOTB;
  #define ROT() do{sl_prev=sl_cur;sl_cur=sl_next;sl_next=(sl_next==(NSLOT-1)*SLOTB)?0:sl_next+SLOTB;}while(0)
  DMA_K(2,2*SLOTB);
  WAIT_BAR(3);
  qkt(pA0,pA1,Kbase,qr,negm,r32,hi);asm volatile("s_nop 15\n\ts_nop 7":"+v"(pA0),"+v"(pA1));CMASK(pA0,pA1,0);
  START(pA0,pA1);
  _Pragma("unroll") for(int r=0;r<16;++r)pA1[r]=__builtin_amdgcn_exp2f(pA1[r]);
  WAIT_BAR(0);
  DMA_K(3,0);DMA_V(1,SLOTB);
  ROT();
  kload8(kf,kp0+sl_cur);
  WAIT_BAR(2);
  s16x4 vlo[8],vhi[8]; u32x4 pw0,pw1,pw2,pw3;
  #define PKW(P,B) cvtpk_s(P[B],P[B+1])
  #define PAF(k) __builtin_bit_cast(bf16x8,pw##k)
  #define VFR(i) (bf16x8){vlo[i][0],vlo[i][1],vlo[i][2],vlo[i][3],vhi[i][0],vhi[i][1],vhi[i][2],vhi[i][3]}
  #define PIN(x) asm volatile("":"+v"(x))
  #define MX3(a,b,c) __builtin_fmaxf(__builtin_fmaxf((a),(b)),(c))
  #define GAPA(MF,A0,A1,A2,A3,W0,W1,PW) do{ if(va_){MF;} sacc+=A0; sacc+=A1; sacc+=A2; sacc+=A3; PIN(sacc); W0; W1; PIN(PW); SBAR(); }while(0)
  #define EX(v) __builtin_amdgcn_exp2f(v)
  #define GAPB(MF,X,B) do{ if(vb_){MF;} X[B]=EX(X[B]); X[B+1]=EX(X[B+1]); X[B+2]=EX(X[B+2]); X[B+3]=EX(X[B+3]); PIN(X); SBAR(); }while(0)
  #define VRD(i) do{ vlo[i]=vtr(vp_+(((i)>>2)*4096+((i)&3)*1024)); vhi[i]=vtr(vp_+(((i)>>2)*4096+((i)&3)*1024+512)); }while(0)
  #define KRD(G,j) do{ if(G){ kload2(kf,kp0+sl_next,j); SBAR(); } }while(0)
  #define STEP(C0,C1,P0,P1,t,GK,GV,GL) do{ SBAR(); \
    const bool va_=W.tile_valid((t),wid), vb_=W.tile_valid((t)-1,wid); \
    if(!va_){ _Pragma("unroll") for(int r=0;r<16;++r){C0[r]=-INFINITY;C1[r]=-INFINITY;} } \
    const lds_cptr vp_=vp0+sl_prev; \
    VRD(0); SBAR(); float sacc=(P0[0]+P0[1]); \
    GAPA(C0=__builtin_amdgcn_mfma_f32_32x32x16_bf16(kf[0],qr[0],negm,0,0,0), P0[2],P0[3],P0[4],P0[5],     pw0[0]=PKW(P0,0), pw0[1]=PKW(P0,2), pw0); \
    VRD(4); SBAR(); GAPA(C1=__builtin_amdgcn_mfma_f32_32x32x16_bf16(kf[1],qr[0],negm,0,0,0), P0[6],P0[7],P0[8],P0[9],     pw0[2]=PKW(P0,4), pw0[3]=PKW(P0,6), pw0); \
    VRD(1); SBAR(); GAPA(C0=__builtin_amdgcn_mfma_f32_32x32x16_bf16(kf[2],qr[1],C0,0,0,0),   P0[10],P0[11],P0[12],P0[13], pw1[0]=PKW(P0,8), pw1[1]=PKW(P0,10), pw1); \
    VRD(5); SBAR(); GAPA(C1=__builtin_amdgcn_mfma_f32_32x32x16_bf16(kf[3],qr[1],C1,0,0,0),   P0[14],P0[15],P1[0],P1[1],   pw1[2]=PKW(P0,12),pw1[3]=PKW(P0,14), pw1); \
    VRD(2); SBAR(); GAPA(C0=__builtin_amdgcn_mfma_f32_32x32x16_bf16(kf[4],qr[2],C0,0,0,0),   P1[2],P1[3],P1[4],P1[5],     pw2[0]=PKW(P1,0), pw2[1]=PKW(P1,2), pw2); \
    VRD(6); SBAR(); GAPA(C1=__builtin_amdgcn_mfma_f32_32x32x16_bf16(kf[5],qr[2],C1,0,0,0),   P1[6],P1[7],P1[8],P1[9],     pw2[2]=PKW(P1,4), pw2[3]=PKW(P1,6), pw2); \
    VRD(3); SBAR(); GAPA(C0=__builtin_amdgcn_mfma_f32_32x32x16_bf16(kf[6],qr[3],C0,0,0,0),   P1[10],P1[11],P1[12],P1[13], pw3[0]=PKW(P1,8), pw3[1]=PKW(P1,10), pw3); \
    VRD(7); SBAR(); GAPA(C1=__builtin_amdgcn_mfma_f32_32x32x16_bf16(kf[7],qr[3],C1,0,0,0),   P1[14],P1[15],0.f,0.f,       pw3[2]=PKW(P1,12),pw3[3]=PKW(P1,14), pw3); \
    l_reg+=sacc; \
    if(GK){DMA_K((t)+3,sl_cur);} if(GV){DMA_V((t)+1,sl_next);} \
    if(va_){CMASK(C0,C1,t);} \
    { float a=MX3(C0[0],C0[1],C1[0]),b=MX3(C0[2],C0[3],C1[1]); a=MX3(a,C1[2],C1[3]); \
      _Pragma("unroll") for(int r=4;r<16;r+=4){a=MX3(a,C0[r],C0[r+1]);b=MX3(b,C0[r+2],C0[r+3]);a=MX3(a,C1[r],C1[r+1]);b=MX3(b,C1[r+2],C1[r+3]);} \
      float rm=__builtin_fmaxf(a,b); { auto rr=__builtin_amdgcn_permlane32_swap(__float_as_uint(rm),__float_as_uint(rm),false,false); rm=__builtin_fmaxf(__uint_as_float(rr[0]),__uint_as_float(rr[1])); } \
      resc=false; \
      if(__builtin_expect(__any(rm>(float)THRL),0)){ const float dl=__builtin_fmaxf(rm,0.f); mhat+=dl; \
        _Pragma("unroll") for(int r=0;r<16;++r){C0[r]-=dl;C1[r]-=dl;} \
        _Pragma("unroll") for(int r=0;r<16;++r)negm[r]=-mhat; asm volatile("":"+v"(negm)); \
        const float f=__builtin_amdgcn_exp2f(-dl); l_reg*=f; { int r_=r32; asm volatile("":"+v"(r_)); if(hi==0)wsf[r_]=f; } resc=true; } } \
    SBAR(); \
    GAPB(o[0]=__builtin_amdgcn_mfma_f32_32x32x16_bf16(PAF(0),VFR(0),o[0],0,0,0), C0,0); \
    GAPB(o[1]=__builtin_amdgcn_mfma_f32_32x32x16_bf16(PAF(0),VFR(4),o[1],0,0,0), C0,4); \
    KRD(GL,0); GAPB(o[0]=__builtin_amdgcn_mfma_f32_32x32x16_bf16(PAF(1),VFR(1),o[0],0,0,0), C0,8); \
    KRD(GL,1); GAPB(o[1]=__builtin_amdgcn_mfma_f32_32x32x16_bf16(PAF(1),VFR(5),o[1],0,0,0), C0,12); \
    KRD(GL,2); GAPB(o[0]=__builtin_amdgcn_mfma_f32_32x32x16_bf16(PAF(2),VFR(2),o[0],0,0,0), C1,0); \
    KRD(GL,3); GAPB(o[1]=__builtin_amdgcn_mfma_f32_32x32x16_bf16(PAF(2),VFR(6),o[1],0,0,0), C1,4); \
    GAPB(o[0]=__builtin_amdgcn_mfma_f32_32x32x16_bf16(PAF(3),VFR(3),o[0],0,0,0), C1,8); \
    GAPB(o[1]=__builtin_amdgcn_mfma_f32_32x32x16_bf16(PAF(3),VFR(7),o[1],0,0,0), C1,12); \
    }while(0)
  int t=1;
  #undef CMASK
  #define CMASK(P0,P1,t) W.mask(P0,P1,(t),wid,r32,hi)
  for(;t+5<NT;t+=2){
    STEP(pB0,pB1,pA0,pA1,t,true,true,true);     WAIT_BAR(2); RESC(); ROT();
    STEP(pA0,pA1,pB0,pB1,t+1,true,true,true);   WAIT_BAR(2); RESC(); ROT();
  }
  #undef CMASK
  #define CMASK(P0,P1,t) W.mask(P0,P1,(t),wid,r32,hi)
  #define ENDW(tt) do{ if((tt)+3<NT){WAIT_BAR(2);} else if((tt)+2<NT){WAIT_BAR(1);} else {WAIT_BAR(0);} }while(0)
  for(;t+1<NT;t+=2){
    STEP(pB0,pB1,pA0,pA1,t,(t+3<NT),(t+1<NT),(t+1<NT));       ENDW(t);   RESC(); ROT();
    STEP(pA0,pA1,pB0,pB1,t+1,(t+4<NT),(t+2<NT),(t+2<NT));     ENDW(t+1); RESC(); ROT();
  }
  STEP(pB0,pB1,pA0,pA1,NT-1,false,false,false); RESC();
  { float sacc=pB0[0]+pB0[1]; _Pragma("unroll") for(int r=2;r<16;++r)sacc+=pB0[r]; _Pragma("unroll") for(int r=0;r<16;++r)sacc+=pB1[r]; l_reg+=sacc;
    pw0=(u32x4){PKW(pB0,0),PKW(pB0,2),PKW(pB0,4),PKW(pB0,6)};pw1=(u32x4){PKW(pB0,8),PKW(pB0,10),PKW(pB0,12),PKW(pB0,14)};pw2=(u32x4){PKW(pB1,0),PKW(pB1,2),PKW(pB1,4),PKW(pB1,6)};pw3=(u32x4){PKW(pB1,8),PKW(pB1,10),PKW(pB1,12),PKW(pB1,14)};
    SBAR(); if(W.tile_valid(NT-1,wid)) pv(o,vb0+sl_cur,PAF(0),PAF(1),PAF(2),PAF(3)); }
  #undef PKW
  #undef PAF
  #undef VFR
  #undef PIN
  #undef MX3
  #undef GAPA
  #undef GAPB
  #undef EX
  #undef VRD
  #undef KRD
  #undef STEP
  #undef ENDW
  {auto rr=__builtin_amdgcn_permlane32_swap(__float_as_uint(l_reg),__float_as_uint(l_reg),false,false);l_reg=__uint_as_float(rr[0])+__uint_as_float(rr[1]);}
  if(hi==0)wsf[32+r32]=l_reg;asm volatile("s_waitcnt lgkmcnt(0)":::"memory");
  float rli[16];
  #pragma unroll
  for(int r=0;r<16;++r)rli[r]=__builtin_amdgcn_rcpf(wsf[32+crow(r,hi)]);
  W.store_lse(wid,r32,hi,mhat,l_reg);
  { bf16*stg=(bf16*)(shm+LDS_OST)+wid*2048;
    #pragma unroll
    for(int r=0;r<16;++r){const int orow=crow(r,hi);
      #pragma unroll
      for(int d0=0;d0<2;++d0)stg[orow*64+d0*32+r32]=__float2bfloat16(o[d0][r]*rli[r]);}
    asm volatile("s_waitcnt lgkmcnt(0)":::"memory");
    #pragma unroll
    for(int i=0;i<4;++i){const int row=i*8+(lane>>3),ch=lane&7; const u32x4 v=*(const u32x4*)(stg+row*64+ch*8); ATTN_STORE16(O+W.qrow(wid,row)*Var::OP+ch*8,v);} }
  asm volatile("s_waitcnt lgkmcnt(0)\n\ts_barrier":::"memory");
  #undef DMA_K
  #undef DMA_V
  #undef CMASK
  #undef START
  #undef RESC
  #undef ROT
}
template<class Var,int THRL> __device__ __forceinline__ void attn_unit_r(const Var&W,const bf16*Q,const bf16*__restrict__ K,const bf16*__restrict__ V,bf16*O,char*shm,int lane,int wid){
  const int r32=lane&31,hi=lane>>5;
  constexpr int NT=Var::NT, RK=0, RV=NT*SLOTB, RWS=2*NT*SLOTB;
  const unsigned lds0=(unsigned)(uintptr_t)shm;
  float*wsf=(float*)(shm+RWS)+wid*64;
  const bf16*vsrc=V+(wid>>2)*32+(lane&3)*8; const int vidx=16*(wid&3)+(lane>>2);
  const unsigned kdst=lds0+RK+wid*1024, vdst=lds0+RV+wid*1024;
  #define DMA_K(t,slot) glds16(K+W.krow((t),8*wid+(lane&7))*DM+((lane>>3)^(wid&1))*8,(unsigned)__builtin_amdgcn_readfirstlane(kdst+(slot)))
  #define DMA_V(t,slot) glds16(vsrc+W.krow((t),vidx)*DM,(unsigned)__builtin_amdgcn_readfirstlane(vdst+(slot)))
  const int vb0=(int)(lds0+RV)+((lane>>4)&1)*32+(lane&3)*8+(4*hi+((lane&15)>>2))*64;
  const char*Kbase=shm+RK; bf16x8 kf[8];
  const lds_cptr shm3=(lds_cptr)shm; const lds_cptr kp0=shm3+RK+hi*1024+r32*16; const lds_cptr vp0=shm3+RV+((lane>>4)&1)*32+(lane&3)*8+(4*hi+((lane&15)>>2))*64;
  _Pragma("unroll") for(int t_=0;t_<NT;++t_){DMA_K(t_,t_*SLOTB);}
  _Pragma("unroll") for(int t_=0;t_<NT;++t_){DMA_V(t_,t_*SLOTB);}
  bf16x8 qr[4];
  #pragma unroll
  for(int d0=0;d0<4;++d0)qr[d0]=*reinterpret_cast<const bf16x8*>(&Q[W.qrow(wid,r32)*DM+d0*16+hi*8]);
  float zz_;asm volatile("v_mov_b32 %0, 0":"=v"(zz_));
  float mhat=zz_,l_reg=zz_;f32x16 o[2];f32x16 negm;
  _Pragma("unroll") for(int r=0;r<16;++r){o[0][r]=zz_;o[1][r]=zz_;negm[r]=zz_;} asm volatile("":"+v"(negm));
  #define CMASK(P0,P1,t) W.mask(P0,P1,(t),wid,r32,hi)
  bool resc=false;
  #define START(P0,P1) do{ const float rm=rowmax(P0,P1); resc=false; \
    { const float dl=__builtin_fmaxf(rm,-30.f); mhat=fadd_s(mhat,dl);   \
      _Pragma("unroll") for(int r=0;r<16;++r){P0[r]=fsub_s(P0[r],dl);P1[r]=fsub_s(P1[r],dl);} \
      _Pragma("unroll") for(int r=0;r<16;++r)negm[r]=-mhat; asm volatile("":"+v"(negm)); } \
    _Pragma("unroll") for(int r=0;r<16;++r)P0[r]=__builtin_amdgcn_exp2f(P0[r]); }while(0)
  #define RESC() do{ if(resc){ asm volatile("s_waitcnt lgkmcnt(0)":::"memory"); \
      _Pragma("unroll") for(int d_=0;d_<2;++d_) _Pragma("unroll") for(int r=0;r<16;++r)o[d_][r]*=wsf[crow(r,hi)]; } }while(0)
  f32x16 pA0,pA1,pB0,pB1;
  const int tb=W.first_tile(wid);
  int sl_prev=0,sl_cur=tb*SLOTB,sl_next=sl_cur+SLOTB;
  #define ROT() do{sl_prev=sl_cur;sl_cur=sl_next;sl_next+=SLOTB;}while(0)
  asm volatile("s_waitcnt vmcnt(0)\n\ts_barrier":::"memory");
  qkt_s(pA0,pA1,Kbase+sl_cur,qr,negm,r32,hi);asm volatile("s_nop 15\n\ts_nop 7":"+v"(pA0),"+v"(pA1));CMASK(pA0,pA1,tb);
  START(pA0,pA1);
  _Pragma("unroll") for(int r=0;r<16;++r)pA1[r]=__builtin_amdgcn_exp2f(pA1[r]);
  ROT();
  kload8_s(kf,shm3+RK+sl_cur,r32,hi);
  s16x4 vlo[8],vhi[8]; u32x4 pw0,pw1,pw2,pw3;
  #define PKW(P,B) cvtpk_s(P[B],P[B+1])
  #define PAF(k) __builtin_bit_cast(bf16x8,pw##k)
  #define VFR(i) (bf16x8){vlo[i][0],vlo[i][1],vlo[i][2],vlo[i][3],vhi[i][0],vhi[i][1],vhi[i][2],vhi[i][3]}
  #define PIN(x) asm volatile("":"+v"(x))
  #define MX3(a,b,c) __builtin_fmaxf(__builtin_fmaxf((a),(b)),(c))
  #define GAPA(MF,A0,A1,A2,A3,W0,W1,PW) do{ if(va_){MF;} sacc+=A0; sacc+=A1; sacc+=A2; sacc+=A3; PIN(sacc); W0; W1; PIN(PW); SBAR(); }while(0)
  #define EX(v) __builtin_amdgcn_exp2f(v)
  #define GAPB(MF,X,B) do{ if(vb_){MF;} X[B]=EX(X[B]); X[B+1]=EX(X[B+1]); X[B+2]=EX(X[B+2]); X[B+3]=EX(X[B+3]); PIN(X); SBAR(); }while(0)
  #define VRD(i) do{ vlo[i]=vtr(vp_+(((i)>>2)*4096+((i)&3)*1024)); vhi[i]=vtr(vp_+(((i)>>2)*4096+((i)&3)*1024+512)); }while(0)
  #define KRD(G,j) do{ if(G){ kload2_s(kf,shm3+RK+sl_next,j,r32,hi); SBAR(); } }while(0)
  #define STEP(C0,C1,P0,P1,t,GK,GV,GL) do{ SBAR(); \
    const bool va_=((t)<NT)&&W.tile_valid((t),wid), vb_=W.tile_valid((t)-1,wid); \
    if(!va_){ _Pragma("unroll") for(int r=0;r<16;++r){C0[r]=-INFINITY;C1[r]=-INFINITY;} } \
    const lds_cptr vp_=vp0+sl_prev; \
    VRD(0); SBAR(); float sacc=(P0[0]+P0[1]); \
    GAPA(C0=__builtin_amdgcn_mfma_f32_32x32x16_bf16(kf[0],qr[0],negm,0,0,0), P0[2],P0[3],P0[4],P0[5],     pw0[0]=PKW(P0,0), pw0[1]=PKW(P0,2), pw0); \
    VRD(4); SBAR(); GAPA(C1=__builtin_amdgcn_mfma_f32_32x32x16_bf16(kf[1],qr[0],negm,0,0,0), P0[6],P0[7],P0[8],P0[9],     pw0[2]=PKW(P0,4), pw0[3]=PKW(P0,6), pw0); \
    VRD(1); SBAR(); GAPA(C0=__builtin_amdgcn_mfma_f32_32x32x16_bf16(kf[2],qr[1],C0,0,0,0),   P0[10],P0[11],P0[12],P0[13], pw1[0]=PKW(P0,8), pw1[1]=PKW(P0,10), pw1); \
    VRD(5); SBAR(); GAPA(C1=__builtin_amdgcn_mfma_f32_32x32x16_bf16(kf[3],qr[1],C1,0,0,0),   P0[14],P0[15],P1[0],P1[1],   pw1[2]=PKW(P0,12),pw1[3]=PKW(P0,14), pw1); \
    VRD(2); SBAR(); GAPA(C0=__builtin_amdgcn_mfma_f32_32x32x16_bf16(kf[4],qr[2],C0,0,0,0),   P1[2],P1[3],P1[4],P1[5],     pw2[0]=PKW(P1,0), pw2[1]=PKW(P1,2), pw2); \
    VRD(6); SBAR(); GAPA(C1=__builtin_amdgcn_mfma_f32_32x32x16_bf16(kf[5],qr[2],C1,0,0,0),   P1[6],P1[7],P1[8],P1[9],     pw2[2]=PKW(P1,4), pw2[3]=PKW(P1,6), pw2); \
    VRD(3); SBAR(); GAPA(C0=__builtin_amdgcn_mfma_f32_32x32x16_bf16(kf[6],qr[3],C0,0,0,0),   P1[10],P1[11],P1[12],P1[13], pw3[0]=PKW(P1,8), pw3[1]=PKW(P1,10), pw3); \
    VRD(7); SBAR(); GAPA(C1=__builtin_amdgcn_mfma_f32_32x32x16_bf16(kf[7],qr[3],C1,0,0,0),   P1[14],P1[15],0.f,0.f,       pw3[2]=PKW(P1,12),pw3[3]=PKW(P1,14), pw3); \
    l_reg+=sacc; \
    if(GK){DMA_K((t)+3,sl_cur);} if(GV){DMA_V((t)+1,sl_next);} \
    if(va_){CMASK(C0,C1,t);} \
    { float a=MX3(C0[0],C0[1],C1[0]),b=MX3(C0[2],C0[3],C1[1]); a=MX3(a,C1[2],C1[3]); \
      _Pragma("unroll") for(int r=4;r<16;r+=4){a=MX3(a,C0[r],C0[r+1]);b=MX3(b,C0[r+2],C0[r+3]);a=MX3(a,C1[r],C1[r+1]);b=MX3(b,C1[r+2],C1[r+3]);} \
      float rm=__builtin_fmaxf(a,b); { auto rr=__builtin_amdgcn_permlane32_swap(__float_as_uint(rm),__float_as_uint(rm),false,false); rm=__builtin_fmaxf(__uint_as_float(rr[0]),__uint_as_float(rr[1])); } \
      resc=false; \
      if(__builtin_expect(__any(rm>(float)THRL),0)){ const float dl=__builtin_fmaxf(rm,0.f); mhat+=dl; \
        _Pragma("unroll") for(int r=0;r<16;++r){C0[r]-=dl;C1[r]-=dl;} \
        _Pragma("unroll") for(int r=0;r<16;++r)negm[r]=-mhat; asm volatile("":"+v"(negm)); \
        const float f=__builtin_amdgcn_exp2f(-dl); l_reg*=f; { int r_=r32; asm volatile("":"+v"(r_)); if(hi==0)wsf[r_]=f; } resc=true; } } \
    SBAR(); \
    GAPB(o[0]=__builtin_amdgcn_mfma_f32_32x32x16_bf16(PAF(0),VFR(0),o[0],0,0,0), C0,0); \
    GAPB(o[1]=__builtin_amdgcn_mfma_f32_32x32x16_bf16(PAF(0),VFR(4),o[1],0,0,0), C0,4); \
    KRD(GL,0); GAPB(o[0]=__builtin_amdgcn_mfma_f32_32x32x16_bf16(PAF(1),VFR(1),o[0],0,0,0), C0,8); \
    KRD(GL,1); GAPB(o[1]=__builtin_amdgcn_mfma_f32_32x32x16_bf16(PAF(1),VFR(5),o[1],0,0,0), C0,12); \
    KRD(GL,2); GAPB(o[0]=__builtin_amdgcn_mfma_f32_32x32x16_bf16(PAF(2),VFR(2),o[0],0,0,0), C1,0); \
    KRD(GL,3); GAPB(o[1]=__builtin_amdgcn_mfma_f32_32x32x16_bf16(PAF(2),VFR(6),o[1],0,0,0), C1,4); \
    GAPB(o[0]=__builtin_amdgcn_mfma_f32_32x32x16_bf16(PAF(3),VFR(3),o[0],0,0,0), C1,8); \
    GAPB(o[1]=__builtin_amdgcn_mfma_f32_32x32x16_bf16(PAF(3),VFR(7),o[1],0,0,0), C1,12); \
    }while(0)
  STEP(pB0,pB1,pA0,pA1,tb+1,false,false,true);  RESC(); ROT();
  STEP(pA0,pA1,pB0,pB1,tb+2,false,false,false); RESC();
  { float sacc=pA0[0]+pA0[1]; _Pragma("unroll") for(int r=2;r<16;++r)sacc+=pA0[r]; _Pragma("unroll") for(int r=0;r<16;++r)sacc+=pA1[r]; l_reg+=sacc;
    pw0=(u32x4){PKW(pA0,0),PKW(pA0,2),PKW(pA0,4),PKW(pA0,6)};pw1=(u32x4){PKW(pA0,8),PKW(pA0,10),PKW(pA0,12),PKW(pA0,14)};pw2=(u32x4){PKW(pA1,0),PKW(pA1,2),PKW(pA1,4),PKW(pA1,6)};pw3=(u32x4){PKW(pA1,8),PKW(pA1,10),PKW(pA1,12),PKW(pA1,14)};
    SBAR(); if((tb+2<NT)&&W.tile_valid(tb+2,wid)) pv(o,vb0+sl_cur,PAF(0),PAF(1),PAF(2),PAF(3)); }
  #undef PKW
  #undef PAF
  #undef VFR
  #undef PIN
  #undef MX3
  #undef GAPA
  #undef GAPB
  #undef EX
  #undef VRD
  #undef KRD
  #undef STEP
  {auto rr=__builtin_amdgcn_permlane32_swap(__float_as_uint(l_reg),__float_as_uint(l_reg),false,false);l_reg=__uint_as_float(rr[0])+__uint_as_float(rr[1]);}
  if(hi==0)wsf[32+r32]=l_reg;asm volatile("s_waitcnt lgkmcnt(0)":::"memory");
  float rli[16];
  #pragma unroll
  for(int r=0;r<16;++r)rli[r]=__builtin_amdgcn_rcpf(wsf[32+crow(r,hi)]);
  W.store_lse(wid,r32,hi,mhat,l_reg);
  asm volatile("s_waitcnt lgkmcnt(0)\n\ts_barrier":::"memory");
  { bf16*stg=(bf16*)(shm+RK)+wid*2048;
    #pragma unroll
    for(int r=0;r<16;++r){const int orow=crow(r,hi);
      #pragma unroll
      for(int d0=0;d0<2;++d0)stg[orow*64+d0*32+r32]=__float2bfloat16(o[d0][r]*rli[r]);}
    asm volatile("s_waitcnt lgkmcnt(0)":::"memory");
    #pragma unroll
    for(int i=0;i<4;++i){const int row=i*8+(lane>>3),ch=lane&7; const u32x4 v=*(const u32x4*)(stg+row*64+ch*8); ATTN_STORE16(O+W.qrow(wid,row)*Var::OP+ch*8,v);} }
  asm volatile("s_waitcnt lgkmcnt(0)\n\ts_barrier":::"memory");
  #undef DMA_K
  #undef DMA_V
  #undef CMASK
  #undef START
  #undef RESC
  #undef ROT
}
template<class Var,int THRL> __device__ __forceinline__ void attn_unit_b(const Var&W,const bf16*Q,const bf16*__restrict__ K,const bf16*__restrict__ V,bf16*O,char*shm,int lane,int wid){
  const int r32=lane&31,hi=lane>>5;
  constexpr int NT=Var::NT, NRS=8, RK=0, RV=NRS*SLOTB, RWS=131584;
  const unsigned lds0=(unsigned)(uintptr_t)shm;
  float*wsf=(float*)(shm+RWS)+wid*64;
  const bf16*vsrc=V+(wid>>2)*32+(lane&3)*8; const int vidx=16*(wid&3)+(lane>>2);
  const unsigned kdst=lds0+RK+wid*1024, vdst=lds0+RV+wid*1024;
  #define DMA_K(t,slot) glds16(K+W.krow((t),8*wid+(lane&7))*DM+((lane>>3)^(wid&1))*8,(unsigned)__builtin_amdgcn_readfirstlane(kdst+(slot)))
  #define DMA_V(t,slot) glds16(vsrc+W.krow((t),vidx)*DM,(unsigned)__builtin_amdgcn_readfirstlane(vdst+(slot)))
  const int vb0=(int)(lds0+RV)+((lane>>4)&1)*32+(lane&3)*8+(4*hi+((lane&15)>>2))*64;
  const char*Kbase=shm+RK; bf16x8 kf[8];
  const lds_cptr shm3=(lds_cptr)shm; const lds_cptr kp0=shm3+RK+hi*1024+r32*16; const lds_cptr vp0=shm3+RV+((lane>>4)&1)*32+(lane&3)*8+(4*hi+((lane&15)>>2))*64;
  _Pragma("unroll") for(int t_=0;t_<NRS;++t_){DMA_K(t_,t_*SLOTB);}
  _Pragma("unroll") for(int t_=0;t_<NRS;++t_){DMA_V(t_,t_*SLOTB);}
  bf16x8 qr[4];
  #pragma unroll
  for(int d0=0;d0<4;++d0)qr[d0]=*reinterpret_cast<const bf16x8*>(&Q[W.qrow(wid,r32)*DM+d0*16+hi*8]);
  float zz_;asm volatile("v_mov_b32 %0, 0":"=v"(zz_));
  float mhat=zz_,l_reg=zz_;f32x16 o[2];f32x16 negm;
  _Pragma("unroll") for(int r=0;r<16;++r){o[0][r]=zz_;o[1][r]=zz_;negm[r]=zz_;} asm volatile("":"+v"(negm));
  #define CMASK(P0,P1,t) W.mask(P0,P1,(t),wid,r32,hi)
  bool resc=false;
  #define START(P0,P1) do{ const float rm=rowmax(P0,P1); resc=false; \
    { const float dl=__builtin_fmaxf(rm,-30.f); mhat=fadd_s(mhat,dl);   \
      _Pragma("unroll") for(int r=0;r<16;++r){P0[r]=fsub_s(P0[r],dl);P1[r]=fsub_s(P1[r],dl);} \
      _Pragma("unroll") for(int r=0;r<16;++r)negm[r]=-mhat; asm volatile("":"+v"(negm)); } \
    _Pragma("unroll") for(int r=0;r<16;++r)P0[r]=__builtin_amdgcn_exp2f(P0[r]); }while(0)
  #define RESC() do{ if(resc){ asm volatile("s_waitcnt lgkmcnt(0)":::"memory"); \
      _Pragma("unroll") for(int d_=0;d_<2;++d_) _Pragma("unroll") for(int r=0;r<16;++r)o[d_][r]*=wsf[crow(r,hi)]; } }while(0)
  f32x16 pA0,pA1,pB0,pB1;
  const int tb=W.first_tile(wid);
  int sl_prev=0,sl_cur=tb*SLOTB,sl_next=sl_cur+SLOTB;
  #define ROT() do{sl_prev=sl_cur;sl_cur=sl_next;sl_next=(sl_next+SLOTB)&(NRS*SLOTB-1);}while(0)
  asm volatile("s_waitcnt vmcnt(0)\n\ts_barrier":::"memory");
  qkt_s(pA0,pA1,Kbase+sl_cur,qr,negm,r32,hi);asm volatile("s_nop 15\n\ts_nop 7":"+v"(pA0),"+v"(pA1));CMASK(pA0,pA1,tb);
  START(pA0,pA1);
  _Pragma("unroll") for(int r=0;r<16;++r)pA1[r]=__builtin_amdgcn_exp2f(pA1[r]);
  ROT();
  kload8_s(kf,shm3+RK+sl_cur,r32,hi);
  s16x4 vlo[8],vhi[8]; u32x4 pw0,pw1,pw2,pw3;
  #define PKW(P,B) cvtpk_s(P[B],P[B+1])
  #define PAF(k) __builtin_bit_cast(bf16x8,pw##k)
  #define VFR(i) (bf16x8){vlo[i][0],vlo[i][1],vlo[i][2],vlo[i][3],vhi[i][0],vhi[i][1],vhi[i][2],vhi[i][3]}
  #define PIN(x) asm volatile("":"+v"(x))
  #define MX3(a,b,c) __builtin_fmaxf(__builtin_fmaxf((a),(b)),(c))
  #define GAPA(MF,A0,A1,A2,A3,W0,W1,PW) do{ if(va_){MF;} sacc+=A0; sacc+=A1; sacc+=A2; sacc+=A3; PIN(sacc); W0; W1; PIN(PW); SBAR(); }while(0)
  #define EX(v) __builtin_amdgcn_exp2f(v)
  #define GAPB(MF,X,B) do{ if(vb_){MF;} X[B]=EX(X[B]); X[B+1]=EX(X[B+1]); X[B+2]=EX(X[B+2]); X[B+3]=EX(X[B+3]); PIN(X); SBAR(); }while(0)
  #define VRD(i) do{ vlo[i]=vtr(vp_+(((i)>>2)*4096+((i)&3)*1024)); vhi[i]=vtr(vp_+(((i)>>2)*4096+((i)&3)*1024+512)); }while(0)
  #define KRD(G,j) do{ if(G){ kload2_s(kf,shm3+RK+sl_next,j,r32,hi); SBAR(); } }while(0)
  #define STEP(C0,C1,P0,P1,t,GK,GV,GL) do{ SBAR(); \
    const bool va_=((t)<NT)&&W.tile_valid((t),wid), vb_=W.tile_valid((t)-1,wid); \
    if(!va_){ _Pragma("unroll") for(int r=0;r<16;++r){C0[r]=-INFINITY;C1[r]=-INFINITY;} } \
    const lds_cptr vp_=vp0+sl_prev; \
    VRD(0); SBAR(); float sacc=(P0[0]+P0[1]); \
    GAPA(C0=__builtin_amdgcn_mfma_f32_32x32x16_bf16(kf[0],qr[0],negm,0,0,0), P0[2],P0[3],P0[4],P0[5],     pw0[0]=PKW(P0,0), pw0[1]=PKW(P0,2), pw0); \
    VRD(4); SBAR(); GAPA(C1=__builtin_amdgcn_mfma_f32_32x32x16_bf16(kf[1],qr[0],negm,0,0,0), P0[6],P0[7],P0[8],P0[9],     pw0[2]=PKW(P0,4), pw0[3]=PKW(P0,6), pw0); \
    VRD(1); SBAR(); GAPA(C0=__builtin_amdgcn_mfma_f32_32x32x16_bf16(kf[2],qr[1],C0,0,0,0),   P0[10],P0[11],P0[12],P0[13], pw1[0]=PKW(P0,8), pw1[1]=PKW(P0,10), pw1); \
    VRD(5); SBAR(); GAPA(C1=__builtin_amdgcn_mfma_f32_32x32x16_bf16(kf[3],qr[1],C1,0,0,0),   P0[14],P0[15],P1[0],P1[1],   pw1[2]=PKW(P0,12),pw1[3]=PKW(P0,14), pw1); \
    VRD(2); SBAR(); GAPA(C0=__builtin_amdgcn_mfma_f32_32x32x16_bf16(kf[4],qr[2],C0,0,0,0),   P1[2],P1[3],P1[4],P1[5],     pw2[0]=PKW(P1,0), pw2[1]=PKW(P1,2), pw2); \
    VRD(6); SBAR(); GAPA(C1=__builtin_amdgcn_mfma_f32_32x32x16_bf16(kf[5],qr[2],C1,0,0,0),   P1[6],P1[7],P1[8],P1[9],     pw2[2]=PKW(P1,4), pw2[3]=PKW(P1,6), pw2); \
    VRD(3); SBAR(); GAPA(C0=__builtin_amdgcn_mfma_f32_32x32x16_bf16(kf[6],qr[3],C0,0,0,0),   P1[10],P1[11],P1[12],P1[13], pw3[0]=PKW(P1,8), pw3[1]=PKW(P1,10), pw3); \
    VRD(7); SBAR(); GAPA(C1=__builtin_amdgcn_mfma_f32_32x32x16_bf16(kf[7],qr[3],C1,0,0,0),   P1[14],P1[15],0.f,0.f,       pw3[2]=PKW(P1,12),pw3[3]=PKW(P1,14), pw3); \
    l_reg+=sacc; \
    if(GK){DMA_K((t)+3,sl_cur);} if(GV){DMA_V((t)+1,sl_next);} \
    if(va_){CMASK(C0,C1,t);} \
    { float a=MX3(C0[0],C0[1],C1[0]),b=MX3(C0[2],C0[3],C1[1]); a=MX3(a,C1[2],C1[3]); \
      _Pragma("unroll") for(int r=4;r<16;r+=4){a=MX3(a,C0[r],C0[r+1]);b=MX3(b,C0[r+2],C0[r+3]);a=MX3(a,C1[r],C1[r+1]);b=MX3(b,C1[r+2],C1[r+3]);} \
      float rm=__builtin_fmaxf(a,b); { auto rr=__builtin_amdgcn_permlane32_swap(__float_as_uint(rm),__float_as_uint(rm),false,false); rm=__builtin_fmaxf(__uint_as_float(rr[0]),__uint_as_float(rr[1])); } \
      resc=false; \
      if(__builtin_expect(__any(rm>(float)THRL),0)){ const float dl=__builtin_fmaxf(rm,0.f); mhat+=dl; \
        _Pragma("unroll") for(int r=0;r<16;++r){C0[r]-=dl;C1[r]-=dl;} \
        _Pragma("unroll") for(int r=0;r<16;++r)negm[r]=-mhat; asm volatile("":"+v"(negm)); \
        const float f=__builtin_amdgcn_exp2f(-dl); l_reg*=f; { int r_=r32; asm volatile("":"+v"(r_)); if(hi==0)wsf[r_]=f; } resc=true; } } \
    SBAR(); \
    GAPB(o[0]=__builtin_amdgcn_mfma_f32_32x32x16_bf16(PAF(0),VFR(0),o[0],0,0,0), C0,0); \
    GAPB(o[1]=__builtin_amdgcn_mfma_f32_32x32x16_bf16(PAF(0),VFR(4),o[1],0,0,0), C0,4); \
    KRD(GL,0); GAPB(o[0]=__builtin_amdgcn_mfma_f32_32x32x16_bf16(PAF(1),VFR(1),o[0],0,0,0), C0,8); \
    KRD(GL,1); GAPB(o[1]=__builtin_amdgcn_mfma_f32_32x32x16_bf16(PAF(1),VFR(5),o[1],0,0,0), C0,12); \
    KRD(GL,2); GAPB(o[0]=__builtin_amdgcn_mfma_f32_32x32x16_bf16(PAF(2),VFR(2),o[0],0,0,0), C1,0); \
    KRD(GL,3); GAPB(o[1]=__builtin_amdgcn_mfma_f32_32x32x16_bf16(PAF(2),VFR(6),o[1],0,0,0), C1,4); \
    GAPB(o[0]=__builtin_amdgcn_mfma_f32_32x32x16_bf16(PAF(3),VFR(3),o[0],0,0,0), C1,8); \
    GAPB(o[1]=__builtin_amdgcn_mfma_f32_32x32x16_bf16(PAF(3),VFR(7),o[1],0,0,0), C1,12); \
    }while(0)
  #define BARV(N) asm volatile("s_waitcnt vmcnt(" #N ") lgkmcnt(0)\n\ts_barrier":::"memory")
  STEP(pB0,pB1,pA0,pA1,tb+1,false,false,true); RESC(); ROT(); BARV(0); DMA_K(8,0);       DMA_V(8,0);
  STEP(pA0,pA1,pB0,pB1,tb+2,false,false,true); RESC(); ROT(); BARV(2); DMA_K(9,SLOTB);   DMA_V(9,SLOTB);
  STEP(pB0,pB1,pA0,pA1,tb+3,false,false,true); RESC(); ROT(); BARV(2); DMA_K(10,2*SLOTB);DMA_V(10,2*SLOTB);
  STEP(pA0,pA1,pB0,pB1,tb+4,false,false,true); RESC(); ROT(); BARV(2);
  STEP(pB0,pB1,pA0,pA1,tb+5,false,false,true); RESC(); ROT(); BARV(0);
  STEP(pA0,pA1,pB0,pB1,tb+6,false,false,true); RESC(); ROT();
  STEP(pB0,pB1,pA0,pA1,tb+7,false,false,false); RESC();
  #undef BARV
  { float sacc=pB0[0]+pB0[1]; _Pragma("unroll") for(int r=2;r<16;++r)sacc+=pB0[r]; _Pragma("unroll") for(int r=0;r<16;++r)sacc+=pB1[r]; l_reg+=sacc;
    pw0=(u32x4){PKW(pB0,0),PKW(pB0,2),PKW(pB0,4),PKW(pB0,6)};pw1=(u32x4){PKW(pB0,8),PKW(pB0,10),PKW(pB0,12),PKW(pB0,14)};pw2=(u32x4){PKW(pB1,0),PKW(pB1,2),PKW(pB1,4),PKW(pB1,6)};pw3=(u32x4){PKW(pB1,8),PKW(pB1,10),PKW(pB1,12),PKW(pB1,14)};
    SBAR(); pv(o,vb0+sl_cur,PAF(0),PAF(1),PAF(2),PAF(3)); }
  #undef PKW
  #undef PAF
  #undef VFR
  #undef PIN
  #undef MX3
  #undef GAPA
  #undef GAPB
  #undef EX
  #undef VRD
  #undef KRD
  #undef STEP
  {auto rr=__builtin_amdgcn_permlane32_swap(__float_as_uint(l_reg),__float_as_uint(l_reg),false,false);l_reg=__uint_as_float(rr[0])+__uint_as_float(rr[1]);}
  if(hi==0)wsf[32+r32]=l_reg;asm volatile("s_waitcnt lgkmcnt(0)":::"memory");
  float rli[16];
  #pragma unroll
  for(int r=0;r<16;++r)rli[r]=__builtin_amdgcn_rcpf(wsf[32+crow(r,hi)]);
  W.store_lse(wid,r32,hi,mhat,l_reg);
  asm volatile("s_waitcnt lgkmcnt(0)\n\ts_barrier":::"memory");
  { bf16*stg=(bf16*)(shm+RK)+wid*2048;
    #pragma unroll
    for(int r=0;r<16;++r){const int orow=crow(r,hi);
      #pragma unroll
      for(int d0=0;d0<2;++d0)stg[orow*64+d0*32+r32]=__float2bfloat16(o[d0][r]*rli[r]);}
    asm volatile("s_waitcnt lgkmcnt(0)":::"memory");
    #pragma unroll
    for(int i=0;i<4;++i){const int row=i*8+(lane>>3),ch=lane&7; const u32x4 v=*(const u32x4*)(stg+row*64+ch*8); ATTN_STORE16(O+W.qrow(wid,row)*Var::OP+ch*8,v);} }
  asm volatile("s_waitcnt lgkmcnt(0)\n\ts_barrier":::"memory");
  #undef DMA_K
  #undef DMA_V
  #undef CMASK
  #undef START
  #undef RESC
  #undef ROT
}
constexpr int ATTN_LDS_BYTES=LDS_BYTES;
struct AttnTensors { const bf16* Q; const bf16* K; const bf16* V; bf16* O; };
struct AttnUnit { int b, h, kvh, qb; };
struct StaticOrder {
  int xcd, j, G;
  __device__ __forceinline__ explicit StaticOrder(int grid,int block):xcd(block&7),j(block>>3),G(grid){}
  __device__ __forceinline__ bool next(int i,AttnUnit&u)const{
    if(G==256){ if(i>=2)return false; const int pair=2*xcd+i; u.b=pair>>1; u.kvh=pair&1; u.h=u.kvh*2+(j>>4); u.qb=j&15; return true; }
    const int L=i*G+(xcd+8*j); if(L>=512)return false; u.qb=L&15; u.h=(L>>4)&3; u.kvh=u.h>>1; u.b=L>>6; return true; }
};
template<class Sched,int THRL=8> __device__ __forceinline__ void attn_phase(char*lds,const AttnTensors&T,const Sched&S,int lane,int wid){
  AttnUnit u;
  for(int i=0;S.next(i,u);++i){ attn_unit<THRL>(u.b,u.h,u.kvh,u.qb,T.Q,T.K,T.V,T.O,lds,lane,wid); }
}

template<int NTT> struct VarC_ {
  static constexpr int NT=NTT, OP=384;
  int rowb, dil, cls, u0, L, toff; float* lse; int h;
  __device__ __forceinline__ long qrow(int wid,int r)const{ return (long)rowb+(long)(u0+32*wid+r)*dil+cls; }
  __device__ __forceinline__ long krow(int t,int idx)const{ int u=u0-64+64*(t+toff)+idx; u=u<0?0:(u>L-1?L-1:u); return (long)rowb+(long)u*dil+cls; }
  __device__ __forceinline__ void mask(f32x16&P0,f32x16&P1,int t,int wid,int r32,int hi)const{
    const int tt=t+toff, ulo=u0-64+64*tt, A=32*wid+r32-64*tt;
    int lo=A>-ulo?A:-ulo; const int hb=A+128<L-1-ulo?A+128:L-1-ulo; const bool none=hb<lo;
    const unsigned span=(unsigned)(hb-lo); lo-=4*hi;
    #pragma unroll
    for(int r=0;r<16;++r){ const int kk=(r&3)+8*(r>>2);
      const bool ok0=!none&&((unsigned)(kk-lo)<=span), ok1=!none&&((unsigned)(kk+32-lo)<=span);
      P0[r]=ok0?P0[r]:-INFINITY; P1[r]=ok1?P1[r]:-INFINITY; }
  }
  __device__ __forceinline__ bool tile_valid(int t,int wid)const{ const int lo=wid>>1, tt=t+toff; return tt>=lo&&tt<=lo+2; }
  __device__ __forceinline__ int first_tile(int wid)const{ const int t=(wid>>1)-toff; return t<0?0:t; }
  __device__ __forceinline__ void store_lse(int wid,int r32,int hi,float mhat,float l)const{ if(hi==0) lse[qrow(wid,r32)*6+h]=mhat+__builtin_amdgcn_logf(l); }
};
typedef VarC_<6> VarC;
struct VarB {
  static constexpr int NT=12, OP=1024;
  int rowb, r0, rs0; const float* tab;
  __device__ __forceinline__ long qrow(int wid,int r)const{ return (long)rowb+(r0+(wid>>1))*64+32*(wid&1)+r; }
  __device__ __forceinline__ long krow(int t,int idx)const{ int kr=rs0+t; kr=kr>63?63:kr; return (long)rowb+kr*64+idx; }
  __device__ __forceinline__ void mask(f32x16&P0,f32x16&P1,int t,int wid,int r32,int hi)const{
    const int r=r0+(wid>>1), c=32*(wid&1)+r32, kr=rs0+t;
    int rs=r-4; rs=rs<0?0:(rs>56?56:rs); int cs=c-8; cs=cs<0?0:(cs>48?48:cs);
    const bool rowok=(kr>=rs)&&(kr<rs+8);
    if(!rowok){
      #pragma unroll
      for(int q=0;q<16;++q){P0[q]=-INFINITY;P1[q]=-INFINITY;}
    } else {
      const int cb=4*hi-cs; const float*tb=tab+((kr-r+7)*31+4*hi-c+15);
      #pragma unroll
      for(int g=0;g<4;++g){ float b0[4],b1[4];
        #pragma unroll
        for(int e=0;e<4;++e){ b0[e]=tb[8*g+e]; b1[e]=tb[8*g+e+32]; }
        asm volatile("":"+v"(b0[0]),"+v"(b0[1]),"+v"(b0[2]),"+v"(b0[3]),"+v"(b1[0]),"+v"(b1[1]),"+v"(b1[2]),"+v"(b1[3]));
        #pragma unroll
        for(int e=0;e<4;++e){ const int q=4*g+e, kk=8*g+e;
          const bool ok0=((unsigned)(cb+kk)<16u), ok1=((unsigned)(cb+kk+32)<16u);
          P0[q]=ok0?P0[q]+b0[e]:-INFINITY; P1[q]=ok1?P1[q]+b1[e]:-INFINITY; }
        asm volatile("":::"memory"); }
    }
  }
  __device__ __forceinline__ bool tile_valid(int t,int wid)const{ const int r=r0+(wid>>1); int rs=r-4; rs=rs<0?0:(rs>56?56:rs); const int kr=rs0+t; return kr>=rs&&kr<rs+8; }
  __device__ __forceinline__ int first_tile(int wid)const{ const int r=r0+(wid>>1); int rs=r-4; rs=rs<0?0:(rs>56?56:rs); return rs-rs0; }
  __device__ __forceinline__ void store_lse(int,int,int,float,float)const{}
};
constexpr int LDS_TAB_B=133632;
constexpr int LDS_TAB=86016;
constexpr int ATTN_G_LDS_BYTES=LDS_TAB+6*465*4;
__device__ __forceinline__ void attnB_phase(char*lds,const bf16*qkv,int cq,int ck,int cv,const float*nab,bf16*ao,int G,int bid,int lane,int wid){
  float*tab=(float*)(lds+LDS_TAB_B);
  { float tv[6];
    #pragma unroll
    for(int q=0;q<6;++q){ const int i=wid*64+lane+512*q; tv[q]=(i<6*465)?nab[i]:0.f; }
    #pragma unroll
    for(int q=0;q<6;++q){ const int i=wid*64+lane+512*q; if(i<6*465)tab[i]=tv[q]*1.4426950408889634f; } }
  asm volatile("s_waitcnt lgkmcnt(0)\n\ts_barrier":::"memory");
  for(int it0=bid;it0<8*6*16;it0+=G){ const int it=(G==256)?((((bid&7)+8*(2*(it0>>8)+(bid>>7)))<<4)|((bid>>3)&15)):it0; const int rb=it&15,bh=it>>4,h=bh%6,b=bh/6; asm volatile("":"+v"(lane));
    VarB W; W.rowb=b*SEQ; W.r0=4*rb; int rs0=4*rb-4; W.rs0=rs0<0?0:(rs0>56?56:rs0); W.tab=tab+h*465;
    attn_unit_b<VarB,8>(W,qkv+cq+h*64,qkv+ck+h*64,qkv+cv+h*64,ao+256+h*64,lds,lane,wid); }
}
__device__ __forceinline__ void attnC_phase(char*lds,const bf16*qkv,int cq,int ck,int cv,bf16*part,float*lse,int G,int bid,int lane,int wid){
  auto c1=[&](int it){ const int k=it&15,br=(it>>4)&1,bh=it>>5,h=bh%6,b=bh/6; asm volatile("":"+v"(lane));
    VarC W; W.rowb=b*SEQ; W.dil=1<<(2*br); W.L=SEQ>>(2*br); W.h=h; W.toff=0;
    if(br==0){W.cls=0;W.u0=256*k;} else {W.cls=k&3;W.u0=256*(k>>2);}
    W.lse=lse+(size_t)br*(8*SEQ*6);
    attn_unit_r<VarC,8>(W,qkv+cq+h*64,qkv+ck+h*64,qkv+cv+h*64,part+(size_t)br*(8*SEQ*384)+h*64,lds,lane,wid); };
  auto c2=[&](int it){ const int k=it&15,bh=it>>4,h=bh%6,b=bh/6; asm volatile("":"+v"(lane));
    VarC_<4> W; W.rowb=b*SEQ; W.dil=16; W.L=256; W.h=h; W.toff=1; W.cls=k; W.u0=0;
    W.lse=lse+(size_t)2*(8*SEQ*6);
    attn_unit_r<VarC_<4>,8>(W,qkv+cq+h*64,qkv+ck+h*64,qkv+cv+h*64,part+(size_t)2*(8*SEQ*384)+h*64,lds,lane,wid); };
  const int n1=(8*6*2*16-bid+G-1)/G, n2=(8*6*16-bid+G-1)/G, ns=(G==256)?9:n1+n2;
  for(int s_=0;s_<ns;++s_){ bool kind; int it;
    if(G==256){ const int i=s_/3,r=s_-3*i; kind=(r==2); it=kind?((((bid&7)+8*(2*i+(bid>>7)))<<4)|((bid>>3)&15)):((((bid&7)+8*(2*i+r))<<5)|(bid>>3)); }
    else { kind=(s_>=n1); it=kind?bid+(s_-n1)*G:bid+s_*G; }
    if(kind) c2(it); else c1(it); }
}
template<class Var> __device__ __forceinline__ void attn_wave_item(const Var&W,const bf16*Q,const bf16*__restrict__ K,const bf16*__restrict__ V,bf16*O,char*shm,float*wsf,int lane){
  const int r32=lane&31,hi=lane>>5;
  const unsigned lds0=(unsigned)(uintptr_t)shm;
  const int vb0=(int)(lds0+8192)+((lane>>4)&1)*32+(lane&3)*8+(4*hi+((lane&15)>>2))*64;
  #define WDMA_K(t) do{ const bf16*s_=K+W.krow((t),lane)*DM; _Pragma("unroll") for(int c_=0;c_<8;++c_) glds16(s_+c_*8,(unsigned)__builtin_amdgcn_readfirstlane(lds0+c_*1024)); }while(0)
  #define WDMA_V(t) do{ _Pragma("unroll") for(int g_=0;g_<4;++g_){ const bf16*s_=V+W.krow((t),16*g_+(lane>>2))*DM+(lane&3)*8; \
      glds16(s_,(unsigned)__builtin_amdgcn_readfirstlane(lds0+8192+g_*1024)); glds16(s_+32,(unsigned)__builtin_amdgcn_readfirstlane(lds0+8192+(4+g_)*1024)); } }while(0)
  bf16x8 qr[4];
  { const bf16*qp=Q+W.qrow(r32)*DM+hi*8;
    #pragma unroll
    for(int d0=0;d0<4;++d0)qr[d0]=*reinterpret_cast<const bf16x8*>(qp+d0*16); }
  WDMA_K(0); WDMA_V(0);
  float zz_;asm volatile("v_mov_b32 %0, 0":"=v"(zz_));
  float mhat=zz_,l_reg=zz_;f32x16 o[2];f32x16 negm;
  _Pragma("unroll") for(int r=0;r<16;++r){o[0][r]=zz_;o[1][r]=zz_;negm[r]=zz_;} asm volatile("":"+v"(negm));
  for(int t=0;t<Var::NT;++t){
    asm volatile("s_waitcnt vmcnt(8)":::"memory");
    f32x16 p0,p1; qkt(p0,p1,shm,qr,negm,r32,hi); asm volatile("s_nop 15\n\ts_nop 7":"+v"(p0),"+v"(p1));
    asm volatile("s_waitcnt lgkmcnt(0)":::"memory");
    if(t+1<Var::NT){ WDMA_K(t+1); }
    W.mask(p0,p1,t,r32,hi);
    const float rm=rowmax(p0,p1);
    if(t==0){ const float dl=__builtin_fmaxf(rm,-30.f); mhat+=dl;
      _Pragma("unroll") for(int r=0;r<16;++r){p0[r]-=dl;p1[r]-=dl;}
      _Pragma("unroll") for(int r=0;r<16;++r)negm[r]=-mhat; asm volatile("":"+v"(negm)); }
    else if(__any(rm>8.f)){ const float dl=__builtin_fmaxf(rm,0.f); mhat+=dl;
      _Pragma("unroll") for(int r=0;r<16;++r){p0[r]-=dl;p1[r]-=dl;}
      _Pragma("unroll") for(int r=0;r<16;++r)negm[r]=-mhat; asm volatile("":"+v"(negm));
      const float f=__builtin_amdgcn_exp2f(-dl); l_reg*=f; if(hi==0)wsf[r32]=f;
      asm volatile("s_waitcnt lgkmcnt(0)":::"memory");
      _Pragma("unroll") for(int d_=0;d_<2;++d_) _Pragma("unroll") for(int r=0;r<16;++r)o[d_][r]*=wsf[crow(r,hi)];
      asm volatile("s_waitcnt lgkmcnt(0)":::"memory"); }
    float sacc=0.f;
    _Pragma("unroll") for(int r=0;r<16;++r){p0[r]=__builtin_amdgcn_exp2f(p0[r]);p1[r]=__builtin_amdgcn_exp2f(p1[r]);sacc+=p0[r]+p1[r];}
    l_reg+=sacc;
    u32x4 pw0,pw1,pw2,pw3;
    pw0=(u32x4){cvtpk_s(p0[0],p0[1]),cvtpk_s(p0[2],p0[3]),cvtpk_s(p0[4],p0[5]),cvtpk_s(p0[6],p0[7])};
    pw1=(u32x4){cvtpk_s(p0[8],p0[9]),cvtpk_s(p0[10],p0[11]),cvtpk_s(p0[12],p0[13]),cvtpk_s(p0[14],p0[15])};
    pw2=(u32x4){cvtpk_s(p1[0],p1[1]),cvtpk_s(p1[2],p1[3]),cvtpk_s(p1[4],p1[5]),cvtpk_s(p1[6],p1[7])};
    pw3=(u32x4){cvtpk_s(p1[8],p1[9]),cvtpk_s(p1[10],p1[11]),cvtpk_s(p1[12],p1[13]),cvtpk_s(p1[14],p1[15])};
    if(t+1<Var::NT){ asm volatile("s_waitcnt vmcnt(8)":::"memory"); } else { asm volatile("s_waitcnt vmcnt(0)":::"memory"); }
    __builtin_amdgcn_sched_barrier(0);
    pv(o,vb0,__builtin_bit_cast(bf16x8,pw0),__builtin_bit_cast(bf16x8,pw1),__builtin_bit_cast(bf16x8,pw2),__builtin_bit_cast(bf16x8,pw3));
    if(t+1<Var::NT){ WDMA_V(t+1); }
  }
  {auto rr=__builtin_amdgcn_permlane32_swap(__float_as_uint(l_reg),__float_as_uint(l_reg),false,false);l_reg=__uint_as_float(rr[0])+__uint_as_float(rr[1]);}
  if(hi==0)wsf[32+r32]=l_reg;asm volatile("s_waitcnt lgkmcnt(0)":::"memory");
  float rli[16];
  #pragma unroll
  for(int r=0;r<16;++r)rli[r]=__builtin_amdgcn_rcpf(wsf[32+crow(r,hi)]);
  W.store_lse(r32,hi,mhat,l_reg);
  { bf16*stg=(bf16*)shm;
    #pragma unroll
    for(int r=0;r<16;++r){const int orow=crow(r,hi);
      #pragma unroll
      for(int d0=0;d0<2;++d0)stg[orow*64+d0*32+r32]=__float2bfloat16(o[d0][r]*rli[r]);}
    asm volatile("s_waitcnt lgkmcnt(0)":::"memory");
    #pragma unroll
    for(int i=0;i<4;++i){const int row=i*8+(lane>>3),ch=lane&7; const u32x4 v=*(const u32x4*)(stg+row*64+ch*8); ATTN_STORE16(O+W.qrow(row)*Var::OP+ch*8,v);}
    asm volatile("s_waitcnt lgkmcnt(0)":::"memory"); }
  #undef WDMA_K
  #undef WDMA_V
}
struct VarCw {
  static constexpr int NT=3, OP=384;
  int rowb, dil, cls, u0, L; float* lse; int h;
  __device__ __forceinline__ long qrow(int r)const{ return (long)rowb+(long)(u0+r)*dil+cls; }
  __device__ __forceinline__ long krow(int t,int idx)const{ int u=u0-64+64*t+idx; u=u<0?0:(u>L-1?L-1:u); return (long)rowb+(long)u*dil+cls; }
  __device__ __forceinline__ void mask(f32x16&P0,f32x16&P1,int t,int r32,int hi)const{
    const int dbase=64*t-64+4*hi-r32, ubase=u0-64+64*t+4*hi;
    #pragma unroll
    for(int r=0;r<16;++r){ const int kk=(r&3)+8*(r>>2);
      const bool ok0=((unsigned)(dbase+kk+64)<=128u)&&((unsigned)(ubase+kk)<(unsigned)L);
      const bool ok1=((unsigned)(dbase+kk+32+64)<=128u)&&((unsigned)(ubase+kk+32)<(unsigned)L);
      P0[r]=ok0?P0[r]:-INFINITY; P1[r]=ok1?P1[r]:-INFINITY; }
  }
  __device__ __forceinline__ void store_lse(int r32,int hi,float mhat,float l)const{ if(hi==0) lse[qrow(r32)*6+h]=mhat+__builtin_amdgcn_logf(l); }
};
struct VarBw {
  static constexpr int NT=8, OP=1024;
  int rowb, r, c0, rs; const float* tab;
  __device__ __forceinline__ long qrow(int rr)const{ return (long)rowb+r*64+c0+rr; }
  __device__ __forceinline__ long krow(int t,int idx)const{ return (long)rowb+(rs+t)*64+idx; }
  __device__ __forceinline__ void mask(f32x16&P0,f32x16&P1,int t,int r32,int hi)const{
    const int c=c0+r32, kr=rs+t; int cs=c-8; cs=cs<0?0:(cs>48?48:cs);
    const int cb=4*hi-cs; const float*tb=tab+((kr-r+7)*31+4*hi-c+15);
    #pragma unroll
    for(int q=0;q<16;++q){ const int kk=(q&3)+8*(q>>2);
      const bool ok0=((unsigned)(cb+kk)<16u), ok1=((unsigned)(cb+kk+32)<16u);
      const float b0=tb[kk], b1=tb[kk+32];
      P0[q]=ok0?P0[q]+b0:-INFINITY; P1[q]=ok1?P1[q]+b1:-INFINITY;
      if((q&3)==3)asm volatile("":::"memory"); }
  }
  __device__ __forceinline__ void store_lse(int,int,float,float)const{}
};
constexpr int WV_WSF=132096, WV_TAB=134144;
__device__ __forceinline__ void attnB_wave_phase(char*lds,const bf16*qkv,int cq,int ck,int cv,const float*nab,bf16*ao,int G,int bid,int lane,int wid){
  float*tab=(float*)(lds+WV_TAB); float*wsf=(float*)(lds+WV_WSF)+wid*64; char*shm=lds+wid*16384;
  const int h=bid%6, j=bid/6, nbh=(G-h+5)/6;
  { const int i=wid*64+lane; if(i<15*31)tab[i]=nab[h*465+i]*1.4426950408889634f; }
  asm volatile("s_waitcnt lgkmcnt(0)\n\ts_barrier":::"memory");
  for(int it=j*8+wid;it<8*128;it+=nbh*8){ const int b=it>>7,r=(it>>1)&63,half=it&1;
    VarBw W; W.rowb=b*SEQ; W.r=r; W.c0=32*half; int rs=r-4; W.rs=rs<0?0:(rs>56?56:rs); W.tab=tab;
    attn_wave_item<VarBw>(W,qkv+cq+h*64,qkv+ck+h*64,qkv+cv+h*64,ao+256+h*64,shm,wsf,lane); }
}
__device__ __forceinline__ void attnC_wave_phase(char*lds,const bf16*qkv,int cq,int ck,int cv,bf16*part,float*lse,int G,int bid,int lane,int wid){
  float*wsf=(float*)(lds+WV_WSF)+wid*64; char*shm=lds+wid*16384;
  for(int it=bid*8+wid;it<8*6*3*128;it+=G*8){ const int k=it&127,rest=it>>7,br=rest%3,bh=rest/3,h=bh%6,b=bh/6;
    VarCw W; W.rowb=b*SEQ; W.dil=1<<(2*br); W.L=SEQ>>(2*br); W.h=h;
    if(br==0){W.cls=0;W.u0=32*k;} else if(br==1){W.cls=k&3;W.u0=32*(k>>2);} else {W.cls=k&15;W.u0=32*(k>>4);}
    W.lse=lse+(size_t)br*(8*SEQ*6);
    attn_wave_item<VarCw>(W,qkv+cq+h*64,qkv+ck+h*64,qkv+cv+h*64,part+(size_t)br*(8*SEQ*384)+h*64,shm,wsf,lane); }
}
#undef SBAR
#undef WAIT_BAR
}
#define GAS __attribute__((address_space(1)))
#define LAS __attribute__((address_space(3)))
typedef unsigned short bf16;
typedef unsigned v4u __attribute__((ext_vector_type(4)));
typedef float f32x4 __attribute__((ext_vector_type(4)));
typedef short bf16x8 __attribute__((ext_vector_type(8)));
typedef GAS unsigned gu32;
typedef GAS unsigned long long gu64;
#define RLX_AGENT __ATOMIC_RELAXED, __HIP_MEMORY_SCOPE_AGENT
#define LDS_WAIT() asm volatile("s_waitcnt lgkmcnt(0)" ::: "memory")
#define VM_WAIT() asm volatile("s_waitcnt vmcnt(0)" ::: "memory")
__device__ __forceinline__ unsigned long long rt() { return __builtin_amdgcn_s_memrealtime(); }
__device__ __forceinline__ unsigned f2bf(float f) { unsigned u = __builtin_bit_cast(unsigned, f); return (u + 0x7fffu + ((u >> 16) & 1u)) >> 16; }
typedef float pk_f32x2 __attribute__((ext_vector_type(2))); typedef __bf16 pk_bf16x2 __attribute__((ext_vector_type(2)));
__device__ __forceinline__ unsigned pk2(float lo, float hi) { pk_f32x2 v = {lo, hi}; pk_bf16x2 b = __builtin_convertvector(v, pk_bf16x2); return __builtin_bit_cast(unsigned, b); }

#define XB_TMO      128
#define XB_XCNT(j)  (256  + 64 * (j))
#define XB_XSUB(j)  (1280 + 64 * (j))
#define XB_XGEN(j)  (2304 + 64 * (j))
#define XB_TOP      3328
#define XB_TOPGEN   3392
#define XCD_BAR_WORDS 3456
#define XB_SPIN_CAP (1u << 18)

__device__ __forceinline__ unsigned xb_ld(unsigned* p)              { return __hip_atomic_load(p, __ATOMIC_RELAXED, __HIP_MEMORY_SCOPE_AGENT); }
__device__ __forceinline__ unsigned xb_add(unsigned* p, unsigned v) { return __hip_atomic_fetch_add(p, v, __ATOMIC_RELAXED, __HIP_MEMORY_SCOPE_AGENT); }
__device__ __forceinline__ unsigned xb_xcc_id() { return (unsigned)__builtin_amdgcn_s_getreg((3 << 11) | 20) & 0xFu; }
#define XB_SPIN(cond, bar) do { unsigned _sp = 0; while (cond) { __builtin_amdgcn_s_sleep(1); \
    if ((++_sp & 255u) == 0u) { if (xb_ld(&(bar)[XB_TMO])) break; if (_sp > XB_SPIN_CAP) { atomicAdd(&(bar)[XB_TMO], 1u); break; } } } } while (0)

struct XcdBarrier {
    unsigned* bar; unsigned x;
    volatile LAS unsigned* st;
};

__device__ __forceinline__ XcdBarrier xcd_barrier_post(unsigned* bar, volatile LAS unsigned* st) {
    XcdBarrier b; b.bar = bar; b.x = xb_xcc_id(); b.st = st;
    if (threadIdx.x == 0) (void)xb_add(&bar[XB_XCNT(b.x)], 1u);
    return b;
}
__device__ __forceinline__ void xcd_barrier_complete(unsigned* bar, unsigned x, unsigned& nloc, unsigned& nx) {
    const unsigned G = gridDim.x * gridDim.y * gridDim.z;
    unsigned sum, cnt, mine, sp = 0u;
    for (;;) {
        sum = 0u; cnt = 0u; mine = 0u;
#pragma unroll
        for (unsigned j = 0; j < 16; ++j) { const unsigned c = xb_ld(&bar[XB_XCNT(j)]); sum += c; cnt += (c > 0u) ? 1u : 0u; mine = (j == x) ? c : mine; }
        if (sum == G) break;
        __builtin_amdgcn_s_sleep(1);
        if ((++sp & 255u) == 0u) { if (xb_ld(&bar[XB_TMO])) break; if (sp > XB_SPIN_CAP) { atomicAdd(&bar[XB_TMO], 1u); break; } }
    }
    nloc = mine > 0u ? mine : 1u; nx = cnt > 0u ? cnt : 1u;
}

__device__ __forceinline__ void xcd_barrier(const XcdBarrier& b) {
    asm volatile("s_waitcnt vmcnt(0)" ::: "memory");
    __syncthreads();
    if (threadIdx.x == 0) {
        unsigned* bar = b.bar;
        __builtin_amdgcn_s_waitcnt(0);
        unsigned nloc = b.st[0], nx = b.st[1];
        if (nloc == 0u) { xcd_barrier_complete(bar, b.x, nloc, nx); b.st[0] = nloc; b.st[1] = nx; }
        const unsigned old = xb_add(&bar[XB_XSUB(b.x)], 1u);
        const unsigned gen = old / nloc;
        if (old + 1u == (gen + 1u) * nloc) {
            __builtin_amdgcn_fence(__ATOMIC_RELEASE, "agent");
            asm volatile("s_waitcnt vmcnt(0)" ::: "memory");
            const unsigned og = xb_add(&bar[XB_TOP], 1u);
            const unsigned tg = og / nx;
            if (og + 1u == (tg + 1u) * nx) xb_add(&bar[XB_TOPGEN], 1u);
            else XB_SPIN(xb_ld(&bar[XB_TOPGEN]) == tg, bar);
            __builtin_amdgcn_fence(__ATOMIC_ACQUIRE, "agent");
            xb_add(&bar[XB_XGEN(b.x)], 1u);
            asm volatile("s_waitcnt vmcnt(0)" ::: "memory");
        } else {
            XB_SPIN(xb_ld(&bar[XB_XGEN(b.x)]) == gen, bar);
            __builtin_amdgcn_fence(__ATOMIC_ACQUIRE, "agent");
            asm volatile("s_waitcnt vmcnt(0)" ::: "memory");
        }
    }
    __syncthreads();
}

constexpr int NB = 8, SEQ = 4096, DM = 1024, DEPTH = 4, MTOK = NB * SEQ;
constexpr int NQKV = 2816, NE = 16, CAP = 512, DFF = 1024, DPLE = 256, MR = NE * NB * CAP;
constexpr int NWAVES = 8, NTHR = NWAVES * 64;
constexpr float RMS_EPS = 1e-6f;
constexpr float LOG2E = 1.4426950408889634f, QSCALE = 0.125f * LOG2E;
constexpr int C_QA = 0, C_KA = 256, C_VA = 384, C_QB = 512, C_KB = 896, C_VB = 1280, C_QC = 1664, C_KC = 2048, C_VC = 2432;
constexpr int NPH_LAYER = 12, NPHASES = 1 + DEPTH * NPH_LAYER;

constexpr size_t MiB = 1u << 20;
constexpr size_t WS_CTL = 0, CTL_ZERO_BYTES = 128 * 1024;
constexpr size_t WS_TAB = 1 * MiB;
constexpr size_t WS_AFF = 2 * MiB;
constexpr size_t WS_IDX = 4 * MiB;
constexpr size_t WS_GATE = 5 * MiB;
constexpr size_t WS_SEL = 6 * MiB;
constexpr size_t WS_RSZ = 8 * MiB;
constexpr size_t WS_RSY = 8 * MiB + 256 * 1024;
constexpr size_t WS_RSA = 8 * MiB + 512 * 1024;
constexpr size_t WS_RSG = 9 * MiB;
constexpr size_t WS_SSQ = 10 * MiB;
constexpr size_t WS_WPG_ALT = 12 * MiB;
constexpr size_t WS_WOUT_ALT = 14 * MiB;
constexpr size_t WS_WIN = 16 * MiB;
constexpr size_t WS_WOUT = 22 * MiB;
constexpr size_t WS_WPG = 24 * MiB;
constexpr size_t WS_WPP = 26 * MiB;
constexpr size_t WS_WGU = 28 * MiB;
constexpr size_t WS_WD = 92 * MiB;
constexpr size_t WS_PBF = 124 * MiB;
constexpr size_t WS_AN = 140 * MiB;
constexpr size_t WS_QKV = 204 * MiB;
constexpr size_t WS_AO = 380 * MiB;
constexpr size_t WS_XG = 444 * MiB;
constexpr size_t WS_HID = 572 * MiB;
constexpr size_t WS_HY8 = WS_HID + 64 * MiB;
constexpr size_t WS_PP = 700 * MiB;
constexpr size_t WS_MIX = 764 * MiB;
constexpr size_t WS_Y = 828 * MiB;
constexpr size_t WS_END = 956 * MiB;
constexpr int CW_BAR = 4096;
constexpr int CW_XRANK = 8192;
constexpr int CW_GRP = 16384;

constexpr int RING_OFF = 0, RING_BYTES = 131072;
constexpr int LDSCTL_OFF = RING_BYTES, MISC_OFF = LDSCTL_OFF + 320;
constexpr int LDS_BYTES = 147456;
constexpr int GTOK_OFF = 136192, GTOK_UNITS = 8;

struct float2_t { float x, y; };
typedef unsigned u32x2 __attribute__((ext_vector_type(2)));

#ifndef ROUTER_MFMA
#define ROUTER_MFMA 1
#endif
#ifndef XCD_TRUE
#define XCD_TRUE 0
#endif
#ifndef FUSE_RT
#define FUSE_RT 0
#endif
#ifndef NT_STORES
#define NT_STORES 0
#endif
__device__ __forceinline__ void st16(void* p, v4u v) { if (NT_STORES) __builtin_nontemporal_store(v, (v4u*)p); else *(v4u*)p = v; }
#define PIN4V(a) asm volatile("" : "+v"((a)[0]), "+v"((a)[1]), "+v"((a)[2]), "+v"((a)[3]))

__device__ __forceinline__ int dpp_i(int v, const int ctrl_unused) { return v; }
#define DPP_ADD_I(v, ctrl) ((v) + __builtin_amdgcn_update_dpp(0, (v), (ctrl), 0xf, 0xf, true))
__device__ __forceinline__ int xor16_add_i(int v) { auto r = __builtin_amdgcn_permlane16_swap((unsigned)v, (unsigned)v, false, false); return (int)(r[0] + r[1]); }
__device__ __forceinline__ int xor32_add_i(int v) { auto r = __builtin_amdgcn_permlane32_swap((unsigned)v, (unsigned)v, false, false); return (int)(r[0] + r[1]); }
__device__ __forceinline__ float xor16_add(float v) { auto r = __builtin_amdgcn_permlane16_swap(__float_as_uint(v), __float_as_uint(v), false, false); return __uint_as_float(r[0]) + __uint_as_float(r[1]); }
__device__ __forceinline__ float xor32_add(float v) { auto r = __builtin_amdgcn_permlane32_swap(__float_as_uint(v), __float_as_uint(v), false, false); return __uint_as_float(r[0]) + __uint_as_float(r[1]); }
__device__ __forceinline__ float dpp_f(float v, int) { return v; }
#define DPP_ADD_F(v, ctrl) ((v) + __int_as_float(__builtin_amdgcn_update_dpp(0, __float_as_int(v), (ctrl), 0xf, 0xf, true)))
__device__ __forceinline__ float wave_sum(float v) {
    v = DPP_ADD_F(v, 0xB1); v = DPP_ADD_F(v, 0x4E); v = DPP_ADD_F(v, 0x141); v = DPP_ADD_F(v, 0x140);
    v = xor16_add(v); v = xor32_add(v);
    return v;
}
__device__ __forceinline__ int wave_sum_i(int v) {
    v = DPP_ADD_I(v, 0xB1); v = DPP_ADD_I(v, 0x4E); v = DPP_ADD_I(v, 0x141); v = DPP_ADD_I(v, 0x140);
    v = xor16_add_i(v); v = xor32_add_i(v);
    return v;
}
__device__ __forceinline__ int lane_id() { int l; asm volatile("v_mbcnt_lo_u32_b32 %0, -1, 0\n\tv_mbcnt_hi_u32_b32 %0, -1, %0" : "=v"(l)); return l; }
constexpr float F8_SC_W = 64.0f, F8_SC_WD = 16.0f, F8_SC_HID = 1.0f;
__device__ __forceinline__ unsigned pk4_f8(float a, float b, float c, float d) {
    int r = __builtin_amdgcn_cvt_pk_fp8_f32(a, b, 0, false); r = __builtin_amdgcn_cvt_pk_fp8_f32(c, d, r, true); return (unsigned)r; }
__device__ __forceinline__ float bflo(unsigned u) { return __uint_as_float(u << 16); }
__device__ __forceinline__ float bfhi(unsigned u) { return __uint_as_float(u & 0xffff0000u); }

__device__ __forceinline__ void sincos_acc(float ang, float& c, float& s) {
    const double a = (double)ang;
    const double q = __builtin_rint(a * 0.63661977236758134308);
    const double t = a - q * 1.57079632679489661923;
    const int qi = (int)q;
    const double t2 = t * t;
    const double sn = t * (1.0 + t2 * (-1.0 / 6.0 + t2 * (1.0 / 120.0 + t2 * (-1.0 / 5040.0 + t2 * (1.0 / 362880.0 + t2 * (-1.0 / 39916800.0))))));
    const double cs = 1.0 + t2 * (-0.5 + t2 * (1.0 / 24.0 + t2 * (-1.0 / 720.0 + t2 * (1.0 / 40320.0 + t2 * (-1.0 / 3628800.0 + t2 * (1.0 / 479001600.0))))));
    const int k = qi & 3;
    const double cc = (k == 0) ? cs : (k == 1) ? -sn : (k == 2) ? -cs : sn;
    const double ss = (k == 0) ? sn : (k == 1) ? cs : (k == 2) ? -sn : -cs;
    c = (float)cc; s = (float)ss;
}

__device__ __forceinline__ void norm_row2_bf16(const float* x0, const float* x1, const float* gain, bf16* o0, bf16* o1, int lane) {
    const f32x4* xr0 = (const f32x4*)x0 + lane; const f32x4* xr1 = (const f32x4*)x1 + lane;
    const f32x4* gr = (const f32x4*)gain + lane;
    f32x4 v[4], w[4], g[4]; float s = 0.f, q = 0.f;
#pragma unroll
    for (int j = 0; j < 4; ++j) { v[j] = xr0[64 * j]; w[j] = xr1[64 * j]; g[j] = gr[64 * j]; }
    PIN4V(v); PIN4V(w);
#pragma unroll
    for (int j = 0; j < 4; ++j) { s += (v[j].x * v[j].x + v[j].y * v[j].y) + (v[j].z * v[j].z + v[j].w * v[j].w); q += (w[j].x * w[j].x + w[j].y * w[j].y) + (w[j].z * w[j].z + w[j].w * w[j].w); }
    const float rs = 1.0f / sqrtf(wave_sum(s) * (1.0f / DM) + RMS_EPS), rq = 1.0f / sqrtf(wave_sum(q) * (1.0f / DM) + RMS_EPS);
    unsigned long long* a8 = (unsigned long long*)o0 + lane; unsigned long long* b8 = (unsigned long long*)o1 + lane;
#pragma unroll
    for (int j = 0; j < 4; ++j) {
        a8[64 * j] = (unsigned long long)pk2(v[j].x * rs * g[j].x, v[j].y * rs * g[j].y) | ((unsigned long long)pk2(v[j].z * rs * g[j].z, v[j].w * rs * g[j].w) << 32);
        b8[64 * j] = (unsigned long long)pk2(w[j].x * rq * g[j].x, w[j].y * rq * g[j].y) | ((unsigned long long)pk2(w[j].z * rq * g[j].z, w[j].w * rq * g[j].w) << 32); }
}

__device__ __forceinline__ void cast_row2(const float* x0, const float* x1, bf16* o0, bf16* o1, float* rs0, float* rs1, int lane) {
    const f32x4* xr0 = (const f32x4*)x0 + lane; const f32x4* xr1 = (const f32x4*)x1 + lane;
    f32x4 v[4], w[4]; float s = 0.f, q = 0.f;
#pragma unroll
    for (int j = 0; j < 4; ++j) { v[j] = xr0[64 * j]; w[j] = xr1[64 * j]; }
    PIN4V(v); PIN4V(w);
    unsigned long long* a8 = (unsigned long long*)o0 + lane; unsigned long long* b8 = (unsigned long long*)o1 + lane;
#pragma unroll
    for (int j = 0; j < 4; ++j) { s += (v[j].x * v[j].x + v[j].y * v[j].y) + (v[j].z * v[j].z + v[j].w * v[j].w); q += (w[j].x * w[j].x + w[j].y * w[j].y) + (w[j].z * w[j].z + w[j].w * w[j].w);
        a8[64 * j] = (unsigned long long)pk2(v[j].x, v[j].y) | ((unsigned long long)pk2(v[j].z, v[j].w) << 32);
        b8[64 * j] = (unsigned long long)pk2(w[j].x, w[j].y) | ((unsigned long long)pk2(w[j].z, w[j].w) << 32); }
    const float rs = 1.0f / sqrtf(wave_sum(s) * (1.0f / DM) + RMS_EPS), rq = 1.0f / sqrtf(wave_sum(q) * (1.0f / DM) + RMS_EPS);
    if (lane == 0) { *rs0 = rs; *rs1 = rq; }
}
__device__ __forceinline__ void norm_row2_h16(const bf16* x0, const bf16* x1, const float* gain, bf16* o0, bf16* o1, int lane) {
    const unsigned long long* xr0 = (const unsigned long long*)x0 + lane; const unsigned long long* xr1 = (const unsigned long long*)x1 + lane;
    const f32x4* gr = (const f32x4*)gain + lane;
    unsigned long long a[4], b[4]; f32x4 v[4], w[4], g[4]; float s = 0.f, q = 0.f;
#pragma unroll
    for (int j = 0; j < 4; ++j) { a[j] = xr0[64 * j]; b[j] = xr1[64 * j]; g[j] = gr[64 * j]; }
    PIN4V(a); PIN4V(b);
#pragma unroll
    for (int j = 0; j < 4; ++j) { const unsigned a0 = (unsigned)a[j], a1 = (unsigned)(a[j] >> 32), b0 = (unsigned)b[j], b1 = (unsigned)(b[j] >> 32);
        v[j] = (f32x4){bflo(a0), bfhi(a0), bflo(a1), bfhi(a1)}; w[j] = (f32x4){bflo(b0), bfhi(b0), bflo(b1), bfhi(b1)};
        s += (v[j].x * v[j].x + v[j].y * v[j].y) + (v[j].z * v[j].z + v[j].w * v[j].w); q += (w[j].x * w[j].x + w[j].y * w[j].y) + (w[j].z * w[j].z + w[j].w * w[j].w); }
    const float rs = 1.0f / sqrtf(wave_sum(s) * (1.0f / DM) + RMS_EPS), rq = 1.0f / sqrtf(wave_sum(q) * (1.0f / DM) + RMS_EPS);
    unsigned long long* a8 = (unsigned long long*)o0 + lane; unsigned long long* b8 = (unsigned long long*)o1 + lane;
#pragma unroll
    for (int j = 0; j < 4; ++j) {
        a8[64 * j] = (unsigned long long)pk2(v[j].x * rs * g[j].x, v[j].y * rs * g[j].y) | ((unsigned long long)pk2(v[j].z * rs * g[j].z, v[j].w * rs * g[j].w) << 32);
        b8[64 * j] = (unsigned long long)pk2(w[j].x * rq * g[j].x, w[j].y * rq * g[j].y) | ((unsigned long long)pk2(w[j].z * rq * g[j].z, w[j].w * rq * g[j].w) << 32); }
}

struct TrJob { const float* src; bf16* dst; const float* gain; int ldw, ldt; float sc; };
struct Args { const float* in[16]; float* out; unsigned char* ws; float inv_ax[16]; float inv_1d[8]; int ph_lo, ph_hi; };
constexpr int TR_I_IN = 16 * 88, TR_I_SQ = 16 * 32, TR_I_PP = 4 * 32, TR_I_EXP = 16 * 512, TR_NITEMS = TR_I_IN + 2 * TR_I_SQ + TR_I_PP + 3 * TR_I_EXP;
__device__ __forceinline__ TrJob tr_decode(const __attribute__((address_space(4))) Args* ka, int l, int it) {
    TrJob J; J.gain = nullptr; J.sc = 1.0f; int r = it; unsigned char* ws = ka->ws;
    if (r < TR_I_IN) { const int kb = r / 88, nb = r % 88, n0 = 32 * nb, tile = n0 >> 8, lw = n0 & 255, wc = lw >> 6, bj = (lw >> 5) & 1;
        J.ldw = NQKV; J.ldt = DM; J.src = ka->in[3] + (size_t)l * DM * NQKV + (size_t)(64 * kb) * NQKV + n0; J.dst = (bf16*)(ws + WS_WIN) + (size_t)(tile * 256 + 128 * bj + 32 * wc) * DM + 64 * kb; J.gain = ka->in[2] + (size_t)l * DM + 64 * kb; return J; } r -= TR_I_IN;
    if (r < TR_I_SQ) { const int kb = r >> 5, nb = r & 31; J.ldw = DM; J.ldt = DM; J.src = ka->in[7] + (size_t)l * DM * DM + (size_t)(64 * kb) * DM + 32 * nb; J.dst = (bf16*)(ws + ((l & 1) ? WS_WOUT_ALT : WS_WOUT)) + (size_t)(32 * nb) * DM + 64 * kb; return J; } r -= TR_I_SQ;
    if (r < TR_I_SQ) { const int kb = r >> 5, nb = r & 31; J.ldw = DM; J.ldt = DM; J.src = ka->in[14] + (size_t)l * DM * DM + (size_t)(64 * kb) * DM + 32 * nb; J.dst = (bf16*)(ws + ((l & 1) ? WS_WPG_ALT : WS_WPG) + (size_t)(32 * nb) * DM + 64 * kb); J.gain = ka->in[13] + (size_t)l * DM + 64 * kb; J.sc = F8_SC_W; return J; } r -= TR_I_SQ;
    if (r < TR_I_PP) { const int kb = r >> 5, nb = r & 31; J.ldw = DM; J.ldt = DPLE; J.src = ka->in[15] + (size_t)l * DPLE * DM + (size_t)(64 * kb) * DM + 32 * nb; J.dst = (bf16*)(ws + WS_WPP) + (size_t)(32 * nb) * DPLE + 64 * kb; return J; } r -= TR_I_PP;
    const int which = r / TR_I_EXP; r -= which * TR_I_EXP;
    const int e = r >> 9, rr = r & 511, kb = rr >> 5, nb = rr & 31, n0 = 32 * nb;
    J.ldw = DM; J.ldt = DM; J.sc = F8_SC_W;
    if (which < 2) J.gain = ka->in[8] + (size_t)l * DM + 64 * kb;
    if (which == 0) { J.src = ka->in[10] + (size_t)(l * NE + e) * DM * DFF + (size_t)(64 * kb) * DFF + n0; J.dst = (bf16*)(ws + WS_WGU + (size_t)(l & 1) * (32 * MiB) + (size_t)(e * 2048 + (n0 >> 7) * 256 + (n0 & 127)) * DM + 64 * kb); }
    else if (which == 1) { J.src = ka->in[11] + (size_t)(l * NE + e) * DM * DFF + (size_t)(64 * kb) * DFF + n0; J.dst = (bf16*)(ws + WS_WGU + (size_t)(l & 1) * (32 * MiB) + (size_t)(e * 2048 + (n0 >> 7) * 256 + 128 + (n0 & 127)) * DM + 64 * kb); }
    else { J.src = ka->in[12] + (size_t)(l * NE + e) * DFF * DM + (size_t)(64 * kb) * DM + n0; J.dst = (bf16*)(ws + WS_WD + (size_t)(l & 1) * (16 * MiB) + (size_t)(e * 1024 + n0) * DFF + 64 * kb); J.sc = F8_SC_WD; }
    return J;
}
__device__ __forceinline__ void tr_load(const TrJob& J, f32x4 (&v)[8], float (&gk)[8], int lane) {
    const int kq = lane >> 3, nq = (lane & 7) * 4;
#pragma unroll
    for (int i = 0; i < 8; ++i) v[i] = __builtin_nontemporal_load((const f32x4*)(J.src + (size_t)(8 * i + kq) * J.ldw + nq));
    if (J.gain) {
#pragma unroll
        for (int i = 0; i < 8; ++i) gk[i] = J.gain[8 * i + kq] * J.sc;
    } else {
#pragma unroll
        for (int i = 0; i < 8; ++i) gk[i] = J.sc;
    }
}
__device__ __forceinline__ void tr_store(const TrJob& J, const f32x4 (&v)[8], const float (&gk)[8], LAS float* scr, int lane) {
    const int kq = lane >> 3, nq = (lane & 7) * 4;
#pragma unroll
    for (int i = 0; i < 8; ++i) { LAS float* d = scr + (8 * i + kq) * 33 + nq; d[0] = v[i].x * gk[i]; d[1] = v[i].y * gk[i]; d[2] = v[i].z * gk[i]; d[3] = v[i].w * gk[i]; }
    LDS_WAIT(); asm volatile("" ::: "memory");
    const int c = lane & 7;
    if (J.sc != 1.0f) {
#pragma unroll
        for (int j = 0; j < 4; ++j) { const int n = (lane >> 3) + 8 * j; const LAS float* s = scr + (8 * c) * 33 + n;
            u32x2 o; o.x = pk4_f8(s[0 * 33], s[1 * 33], s[2 * 33], s[3 * 33]); o.y = pk4_f8(s[4 * 33], s[5 * 33], s[6 * 33], s[7 * 33]);
            *(u32x2*)((unsigned char*)J.dst + (size_t)n * J.ldt + 8 * c) = o; }
    } else {
#pragma unroll
    for (int j = 0; j < 4; ++j) { const int n = (lane >> 3) + 8 * j; const LAS float* s = scr + (8 * c) * 33 + n;
        v4u o; o.x = pk2(s[0 * 33], s[1 * 33]); o.y = pk2(s[2 * 33], s[3 * 33]); o.z = pk2(s[4 * 33], s[5 * 33]); o.w = pk2(s[6 * 33], s[7 * 33]);
        *(v4u*)(J.dst + (size_t)n * J.ldt + 8 * c) = o; }
    }
    LDS_WAIT(); asm volatile("" ::: "memory");
}
constexpr int TR_N_LATE = 2 * TR_I_SQ + 3 * TR_I_EXP, TR_N_EARLY = TR_I_IN + TR_I_PP;
__device__ __forceinline__ TrJob tr_decode_m(const __attribute__((address_space(4))) Args* ka, int mode, int l, int it) {
    if (mode == 1) {
        if (it < 2 * TR_I_SQ) return tr_decode(ka, l, TR_I_IN + it);
        it -= 2 * TR_I_SQ; if (it < 3 * TR_I_EXP) return tr_decode(ka, l, TR_I_IN + 2 * TR_I_SQ + TR_I_PP + it);
        it -= 3 * TR_I_EXP; ++l;
    }
    return tr_decode(ka, l, it < TR_I_IN ? it : 2 * TR_I_SQ + it);
}
__device__ __forceinline__ void convert_layer(const __attribute__((address_space(4))) Args* ka, int mode, int l, LAS unsigned char* lds, int gw, int NGW, int wave, int lane, int gtid, int NGT) {
    LAS float* scr = (LAS float*)(lds + RING_OFF + wave * 16384);
    const bool early = (mode == 0) || (l + 1 < DEPTH);
    const int NIT = (mode == 0) ? TR_N_EARLY : TR_N_LATE + (early ? TR_N_EARLY : 0);
    f32x4 va[8], vb[8]; float ga[8], gb[8]; TrJob Ja, Jb;
    int it = gw;
    if (it < NIT) { Ja = tr_decode_m(ka, mode, l, it); tr_load(Ja, va, ga, lane); }
    while (it < NIT) {
        const int it1 = it + NGW; if (it1 < NIT) { Jb = tr_decode_m(ka, mode, l, it1); tr_load(Jb, vb, gb, lane); }
        tr_store(Ja, va, ga, scr, lane);
        const int it2 = it1 + NGW; if (it2 < NIT) { Ja = tr_decode_m(ka, mode, l, it2); tr_load(Ja, va, ga, lane); }
        if (it1 < NIT) tr_store(Jb, vb, gb, scr, lane);
        it = it2;
    }
    if (!early) return;
    const int le = (mode == 0) ? 0 : l + 1;
    const f32x4* ps = (const f32x4*)(ka->in[1] + (size_t)le * MTOK * DPLE);
    v4u* pd = (v4u*)(ka->ws + WS_PBF);
    constexpr int NP = MTOK * DPLE / 8;
    for (int i = gtid; i < NP / 2; i += NGT) { const f32x4 a = __builtin_nontemporal_load(ps + 2 * i), b = __builtin_nontemporal_load(ps + 2 * i + 1), c = __builtin_nontemporal_load(ps + 2 * (i + NP / 2)), d = __builtin_nontemporal_load(ps + 2 * (i + NP / 2) + 1);
        v4u o; o.x = pk2(a.x, a.y); o.y = pk2(a.z, a.w); o.z = pk2(b.x, b.y); o.w = pk2(b.z, b.w); pd[i] = o;
        v4u q; q.x = pk2(c.x, c.y); q.y = pk2(c.z, c.w); q.z = pk2(d.x, d.y); q.w = pk2(d.z, d.w); pd[i + NP / 2] = q; }
}

struct GroupedOrder {
    pg8::StaticOrder so; int nN;
    __device__ __forceinline__ void init(int N, int G, int c) { so.init(MR, N, G, c); nN = N / 256; }
    __device__ __forceinline__ bool next(int i, pg8::Unit& u) const { if (!so.next(i, u)) return false; u.pn = (u.pm >> 4) * nN + u.pn; return true; }
    __device__ __forceinline__ void a_ready(const pg8::Unit&) const {}
    __device__ __forceinline__ void done(const pg8::Unit&) const {}
};

#ifndef ALIGN_RMW
#define ALIGN_RMW true
#endif
#ifndef PROBE_GDUP
#define PROBE_GDUP 0
#endif
template <int BIT> struct DupStatic {
    pg8::StaticOrder so;
    __device__ __forceinline__ void init(int M, int N, int G, int c) { so.init(M, N, G, c); }
    __device__ __forceinline__ bool next(int i, pg8::Unit& u) const { return so.next(((PROBE_GDUP >> BIT) & 1) ? (i >> 1) : i, u); }
    __device__ __forceinline__ void a_ready(const pg8::Unit&) const {}
    __device__ __forceinline__ void done(const pg8::Unit&) const {}
};
struct EpiQKV {
    static constexpr bool PERM = true, AFTER_DRAIN = false;
    bf16* qkv; const float* qg; const float2_t* cs_ax; const float2_t* cs_1d; const float* rs;
    __device__ __forceinline__ void operator()(const f32x4 (&acc)[2][2][4][2], const pg8::Unit& u, int wr, int wc, int fr, int fq) const {
        { const int l_ = lane_id(); fr = l_ & 15; fq = l_ >> 4; } asm volatile("" : "+s"(wr), "+s"(wc));
        const int hs = u.pn * 4 + wc;
        int kind, gi;
        if (hs < 4) { kind = 2; gi = 0; } else if (hs < 6) { kind = 2; gi = 1; } else if (hs < 8) { kind = 0; gi = 0; }
        else if (hs < 14) { kind = 1; gi = 2; } else if (hs < 20) { kind = 1; gi = 3; } else if (hs < 26) { kind = 0; gi = 0; }
        else if (hs < 32) { kind = 3; gi = 4; } else if (hs < 38) { kind = 3; gi = 5; } else { kind = 0; gi = 0; }
        const bool isq = (hs < 4) || (hs >= 8 && hs < 14) || (hs >= 26 && hs < 32);
        f32x4 gv[2][2];
#pragma unroll
        for (int bj = 0; bj < 2; ++bj)
#pragma unroll
            for (int n = 0; n < 2; ++n) gv[bj][n] = *(const f32x4*)(qg + gi * 64 + 32 * bj + 8 * fq + 4 * n);
        const int colbase = u.pn * 256 + wc * 64 + 8 * fq;
#pragma unroll
        for (int ai = 0; ai < 2; ++ai) {
            f32x4 rowcs[4]; float rsr[4];
#pragma unroll
            for (int m = 0; m < 4; ++m) rsr[m] = __hip_atomic_load(rs + (u.pm * 256 + ai * 128 + wr * 64 + m * 16 + fr), __ATOMIC_RELAXED, __HIP_MEMORY_SCOPE_AGENT);
            if (kind == 2) { const f32x4* p = (const f32x4*)(cs_ax + ((4 * u.pm + 2 * ai + wr) & 63) * 16 + 8 * (fq & 1));
#pragma unroll
                for (int k = 0; k < 4; ++k) rowcs[k] = p[k]; }
#pragma unroll
            for (int mp = 0; mp < 2; ++mp) {
                f32x4 tab[2][4];
                if (kind == 2) {
#pragma unroll
                    for (int mm = 0; mm < 2; ++mm) { const f32x4* p = (const f32x4*)(cs_ax + (16 * (2 * mp + mm) + fr) * 16 + 8 * (fq & 1));
#pragma unroll
                        for (int k = 0; k < 4; ++k) tab[mm][k] = p[k]; }
                }
                if (kind == 3) {
#pragma unroll
                    for (int mm = 0; mm < 2; ++mm) { const int s = (u.pm * 256 + ai * 128 + wr * 64 + (2 * mp + mm) * 16 + fr) & (SEQ - 1); const f32x4* p = (const f32x4*)(cs_1d + s * 8);
#pragma unroll
                        for (int k = 0; k < 4; ++k) tab[mm][k] = p[k]; }
                }
#pragma unroll
                for (int mm = 0; mm < 2; ++mm) { const int m = 2 * mp + mm;
                    const int row = u.pm * 256 + ai * 128 + wr * 64 + m * 16 + fr;
                    f32x4 v[2][2];
#pragma unroll
                    for (int bj = 0; bj < 2; ++bj)
#pragma unroll
                        for (int n = 0; n < 2; ++n) v[bj][n] = acc[ai][bj][m][n] * rsr[m];
                    if (kind != 0) {
                        float ss = 0.f;
#pragma unroll
                        for (int bj = 0; bj < 2; ++bj)
#pragma unroll
                            for (int n = 0; n < 2; ++n) ss += (v[bj][n].x * v[bj][n].x + v[bj][n].y * v[bj][n].y) + (v[bj][n].z * v[bj][n].z + v[bj][n].w * v[bj][n].w);
                        ss = xor16_add(ss); ss = xor32_add(ss);
                        const float rstd = __builtin_amdgcn_rsqf(ss * (1.0f / 64.0f) + RMS_EPS);
#pragma unroll
                        for (int bj = 0; bj < 2; ++bj)
#pragma unroll
                            for (int n = 0; n < 2; ++n) v[bj][n] = v[bj][n] * rstd * gv[bj][n];
                        if (kind == 2) {
#pragma unroll
                            for (int bj = 0; bj < 2; ++bj)
#pragma unroll
                                for (int n = 0; n < 2; ++n)
#pragma unroll
                                    for (int e = 0; e < 4; ++e) { const int k = 4 * n + e; const f32x4 cs4 = bj ? tab[mm][k >> 1] : rowcs[k >> 1]; const float c = cs4[2 * (k & 1)], sn = cs4[2 * (k & 1) + 1];
                                        const float own = v[bj][n][e]; auto sw = __builtin_amdgcn_permlane32_swap(__float_as_uint(own), __float_as_uint(own), false, false); const float oth = __uint_as_float(fq < 2 ? sw[1] : sw[0]);
                                        v[bj][n][e] = (fq < 2) ? (own * c - oth * sn) : (oth * sn + own * c); }
                        } else if (kind == 3) {
#pragma unroll
                            for (int n = 0; n < 2; ++n)
#pragma unroll
                                for (int e = 0; e < 4; ++e) { const int k = 4 * n + e; const f32x4 cs4 = tab[mm][k >> 1]; const float c = cs4[2 * (k & 1)], sn = cs4[2 * (k & 1) + 1];
                                    const float own = v[0][n][e]; auto sw = __builtin_amdgcn_permlane16_swap(__float_as_uint(own), __float_as_uint(own), false, false); const float oth = __uint_as_float((fq & 1) ? sw[0] : sw[1]);
                                    const float rot = (fq == 0) ? (own * c - oth * sn) : (oth * sn + own * c);
                                    v[0][n][e] = (fq < 2) ? rot : own; }
                        }
                    }
                    if (isq) {
#pragma unroll
                        for (int bj = 0; bj < 2; ++bj)
#pragma unroll
                            for (int n = 0; n < 2; ++n) v[bj][n] = v[bj][n] * QSCALE;
                    }
                    bf16* rp = qkv + (size_t)row * NQKV + colbase;
#pragma unroll
                    for (int bj = 0; bj < 2; ++bj) { v4u w; w.x = pk2(v[bj][0].x, v[bj][0].y); w.y = pk2(v[bj][0].z, v[bj][0].w); w.z = pk2(v[bj][1].x, v[bj][1].y); w.w = pk2(v[bj][1].z, v[bj][1].w); st16(rp + 32 * bj, w); }
                }
                asm volatile("" ::: "memory");
            }
        }
    }
};

struct EpiResid {
    static constexpr bool PERM = true, AFTER_DRAIN = false;
    const bf16* baseh; bf16* out; unsigned char* out8;
    __device__ __forceinline__ void operator()(const f32x4 (&acc)[2][2][4][2], const pg8::Unit& u, int wr, int wc, int fr, int fq) const {
        { const int l_ = lane_id(); fr = l_ & 15; fq = l_ >> 4; } asm volatile("" : "+s"(wr), "+s"(wc));
        const int col0 = u.pn * 256 + wc * 32 + 8 * fq;
#pragma unroll
        for (int ai = 0; ai < 2; ++ai) {
            {
                v4u b[4][2];
#pragma unroll
                for (int m = 0; m < 4; ++m) { const size_t off = (size_t)(u.pm * 256 + ai * 128 + wr * 64 + m * 16 + fr) * DM + col0;
#pragma unroll
                    for (int bj = 0; bj < 2; ++bj) b[m][bj] = *(const v4u*)(baseh + off + bj * 128); }
#pragma unroll
                for (int m = 0; m < 4; ++m) { const size_t off = (size_t)(u.pm * 256 + ai * 128 + wr * 64 + m * 16 + fr) * DM + col0;
#pragma unroll
                    for (int bj = 0; bj < 2; ++bj) { const f32x4 a0 = acc[ai][bj][m][0], a1 = acc[ai][bj][m][1]; const v4u p = b[m][bj];
                        const f32x4 o0 = (f32x4){bflo(p.x) + a0.x, bfhi(p.x) + a0.y, bflo(p.y) + a0.z, bfhi(p.y) + a0.w}, o1 = (f32x4){bflo(p.z) + a1.x, bfhi(p.z) + a1.y, bflo(p.w) + a1.z, bfhi(p.w) + a1.w};
                        v4u w; w.x = pk2(o0.x, o0.y); w.y = pk2(o0.z, o0.w); w.z = pk2(o1.x, o1.y); w.w = pk2(o1.z, o1.w);
                        st16(out + off + bj * 128, w);
                        u32x2 w8; w8.x = pk4_f8(o0.x, o0.y, o0.z, o0.w); w8.y = pk4_f8(o1.x, o1.y, o1.z, o1.w); *(u32x2*)(out8 + off + bj * 128) = w8; } }
            }
            asm volatile("" ::: "memory");
        }
    }
};

struct EpiStoreBf16NP {
    static constexpr bool PERM = false, AFTER_DRAIN = false;
    bf16* O;
    __device__ __forceinline__ void operator()(const f32x4 (&acc)[2][2][4][2], const pg8::Unit& u, int wr, int wc, int fr, int fq) const {
        { const int l_ = lane_id(); fr = l_ & 15; fq = l_ >> 4; } asm volatile("" : "+s"(wr), "+s"(wc));
        const int col0 = (u.pn & 3) * 256 + wc * 32 + 4 * fq;
#pragma unroll
        for (int ai = 0; ai < 2; ++ai)
#pragma unroll
            for (int m = 0; m < 4; ++m) { bf16* rp = O + (size_t)(u.pm * 256 + ai * 128 + wr * 64 + m * 16 + fr) * DM + col0;
#pragma unroll
                for (int bj = 0; bj < 2; ++bj)
#pragma unroll
                    for (int n = 0; n < 2; ++n) { const f32x4 a = acc[ai][bj][m][n]; u32x2 w; w.x = pk2(a.x, a.y); w.y = pk2(a.z, a.w); *(u32x2*)(rp + bj * 128 + n * 16) = w; } }
    }
};
struct EpiStoreBf16 {
    static constexpr bool PERM = true, AFTER_DRAIN = false;
    bf16* O;
    __device__ __forceinline__ void operator()(const f32x4 (&acc)[2][2][4][2], const pg8::Unit& u, int wr, int wc, int fr, int fq) const {
        { const int l_ = lane_id(); fr = l_ & 15; fq = l_ >> 4; } asm volatile("" : "+s"(wr), "+s"(wc));
        const int col0 = (u.pn & 3) * 256 + wc * 32 + 8 * fq;
#pragma unroll
        for (int ai = 0; ai < 2; ++ai)
#pragma unroll
            for (int m = 0; m < 4; ++m) { bf16* rp = O + (size_t)(u.pm * 256 + ai * 128 + wr * 64 + m * 16 + fr) * DM + col0;
#pragma unroll
                for (int bj = 0; bj < 2; ++bj) { const f32x4 a = acc[ai][bj][m][0], b = acc[ai][bj][m][1]; v4u w; w.x = pk2(a.x, a.y); w.y = pk2(a.z, a.w); w.z = pk2(b.x, b.y); w.w = pk2(b.z, b.w); st16(rp + bj * 128, w); } }
    }
};

struct EpiStoreF8 {
    static constexpr bool PERM = true, AFTER_DRAIN = false;
    unsigned char* O;
    __device__ __forceinline__ void operator()(const f32x4 (&acc)[2][2][4][2], const pg8::Unit& u, int wr, int wc, int fr, int fq) const {
        { const int l_ = lane_id(); fr = l_ & 15; fq = l_ >> 4; } asm volatile("" : "+s"(wr), "+s"(wc));
        const int col0 = (u.pn & 3) * 256 + wc * 32 + 8 * fq;
#pragma unroll
        for (int ai = 0; ai < 2; ++ai)
#pragma unroll
            for (int m = 0; m < 4; ++m) { unsigned char* rp = O + (size_t)(u.pm * 256 + ai * 128 + wr * 64 + m * 16 + fr) * DM + col0;
#pragma unroll
                for (int bj = 0; bj < 2; ++bj) { const f32x4 a = acc[ai][bj][m][0], b = acc[ai][bj][m][1]; u32x2 w; w.x = pk4_f8(a.x, a.y, a.z, a.w); w.y = pk4_f8(b.x, b.y, b.z, b.w); *(u32x2*)(rp + bj * 128) = w; } }
    }
};
struct EpiSwiGLU {
    static constexpr bool PERM = true, AFTER_DRAIN = false;
    unsigned char* H; const float* rs;
    __device__ __forceinline__ void operator()(const f32x4 (&acc)[2][2][4][2], const pg8::Unit& u, int wr, int wc, int fr, int fq) const {
        { const int l_ = lane_id(); fr = l_ & 15; fq = l_ >> 4; } asm volatile("" : "+s"(wr), "+s"(wc));
        const int col0 = (u.pn & 7) * 128 + wc * 32 + 8 * fq;
        float rsr[2][4];
#pragma unroll
        for (int ai = 0; ai < 2; ++ai)
#pragma unroll
            for (int m = 0; m < 4; ++m) rsr[ai][m] = rs[u.pm * 256 + ai * 128 + wr * 64 + m * 16 + fr] * (1.0f / F8_SC_W);
#pragma unroll
        for (int ai = 0; ai < 2; ++ai)
#pragma unroll
            for (int m = 0; m < 4; ++m) { unsigned char* rp = H + (size_t)(u.pm * 256 + ai * 128 + wr * 64 + m * 16 + fr) * DFF + col0; const float r1 = rsr[ai][m], r1u = r1 * F8_SC_HID;
                f32x4 h[2];
#pragma unroll
                for (int n = 0; n < 2; ++n) { const f32x4 g = acc[ai][0][m][n] * r1, up = acc[ai][1][m][n] * r1u;
#pragma unroll
                    for (int e = 0; e < 4; ++e) h[n][e] = g[e] * __builtin_amdgcn_rcpf(1.0f + __builtin_amdgcn_exp2f(-LOG2E * g[e])) * up[e]; }
                u32x2 w; w.x = pk4_f8(h[0].x, h[0].y, h[0].z, h[0].w); w.y = pk4_f8(h[1].x, h[1].y, h[1].z, h[1].w); *(u32x2*)rp = w; }
    }
};

struct EpiPLE {
    static constexpr bool PERM = true, AFTER_DRAIN = false;
    const bf16* hz; float* outf; bf16* outh; const bf16* pp; const float* rs; float* ssq;
    __device__ __forceinline__ void operator()(const f32x4 (&acc)[2][2][4][2], const pg8::Unit& u, int wr, int wc, int fr, int fq) const {
        { const int l_ = lane_id(); fr = l_ & 15; fq = l_ >> 4; } asm volatile("" : "+s"(wr), "+s"(wc));
        const int col0 = u.pn * 256 + wc * 32 + 8 * fq;
#pragma unroll
        for (int ai = 0; ai < 2; ++ai) {
            v4u hv[4][2], pw[4][2]; float rsr[4];
#pragma unroll
            for (int m = 0; m < 4; ++m) { const size_t off = (size_t)(u.pm * 256 + ai * 128 + wr * 64 + m * 16 + fr) * DM + col0; rsr[m] = rs[u.pm * 256 + ai * 128 + wr * 64 + m * 16 + fr];
#pragma unroll
                for (int bj = 0; bj < 2; ++bj) { hv[m][bj] = *(const v4u*)(hz + off + bj * 128); pw[m][bj] = *(const v4u*)(pp + off + bj * 128); } }
#pragma unroll
            for (int m = 0; m < 4; ++m) { const size_t off = (size_t)(u.pm * 256 + ai * 128 + wr * 64 + m * 16 + fr) * DM + col0; float sq = 0.f;
#pragma unroll
                for (int bj = 0; bj < 2; ++bj) { const v4u p4 = pw[m][bj], h4 = hv[m][bj]; f32x4 o[2];
#pragma unroll
                    for (int n = 0; n < 2; ++n) { const f32x4 a = acc[ai][bj][m][n] * (-LOG2E * rsr[m]); const unsigned p0 = n ? p4.z : p4.x, p1 = n ? p4.w : p4.y, h0 = n ? h4.z : h4.x, h1 = n ? h4.w : h4.y;
                        o[n].x = bflo(h0) + bflo(p0) * __builtin_amdgcn_rcpf(1.0f + __builtin_amdgcn_exp2f(a.x)); o[n].y = bfhi(h0) + bfhi(p0) * __builtin_amdgcn_rcpf(1.0f + __builtin_amdgcn_exp2f(a.y));
                        o[n].z = bflo(h1) + bflo(p1) * __builtin_amdgcn_rcpf(1.0f + __builtin_amdgcn_exp2f(a.z)); o[n].w = bfhi(h1) + bfhi(p1) * __builtin_amdgcn_rcpf(1.0f + __builtin_amdgcn_exp2f(a.w));
                        sq += (o[n].x * o[n].x + o[n].y * o[n].y) + (o[n].z * o[n].z + o[n].w * o[n].w); }
                    if (outf) { *(f32x4*)(outf + off + bj * 128) = o[0]; *(f32x4*)(outf + off + bj * 128 + 4) = o[1]; }
                    else { v4u w; w.x = pk2(o[0].x, o[0].y); w.y = pk2(o[0].z, o[0].w); w.z = pk2(o[1].x, o[1].y); w.w = pk2(o[1].z, o[1].w); st16(outh + off + bj * 128, w); } }
                if (!outf) { sq = xor16_add(sq); sq = xor32_add(sq); if (fq == 0) ssq[(size_t)(u.pm * 256 + ai * 128 + wr * 64 + m * 16 + fr) * 16 + u.pn * 4 + wc] = sq; } }
            asm volatile("" ::: "memory");
        }
    }
};

__device__ __forceinline__ void load_row64(const bf16* p, float (&q)[64], float sc) {
    const v4u* p4 = (const v4u*)p;
#pragma unroll
    for (int c = 0; c < 8; ++c) { const v4u u = p4[c];
        q[8 * c + 0] = bflo(u.x) * sc; q[8 * c + 1] = bfhi(u.x) * sc; q[8 * c + 2] = bflo(u.y) * sc; q[8 * c + 3] = bfhi(u.y) * sc;
        q[8 * c + 4] = bflo(u.z) * sc; q[8 * c + 5] = bfhi(u.z) * sc; q[8 * c + 6] = bflo(u.w) * sc; q[8 * c + 7] = bfhi(u.w) * sc; }
}
__device__ __forceinline__ float dot64(const float (&q)[64], const bf16* kp) {
    const v4u* p4 = (const v4u*)kp; float s0 = 0.f, s1 = 0.f;
#pragma unroll
    for (int c = 0; c < 8; ++c) { const v4u u = p4[c];
        s0 = fmaf(q[8 * c + 0], bflo(u.x), s0); s1 = fmaf(q[8 * c + 1], bfhi(u.x), s1); s0 = fmaf(q[8 * c + 2], bflo(u.y), s0); s1 = fmaf(q[8 * c + 3], bfhi(u.y), s1);
        s0 = fmaf(q[8 * c + 4], bflo(u.z), s0); s1 = fmaf(q[8 * c + 5], bfhi(u.z), s1); s0 = fmaf(q[8 * c + 6], bflo(u.w), s0); s1 = fmaf(q[8 * c + 7], bfhi(u.w), s1); }
    return s0 + s1;
}
__device__ __forceinline__ void online_update(float s, bool valid, const bf16* vp, float (&o)[64], float& m, float& l) {
    const float sm = valid ? s : -1e30f;
    if (__any(sm > m)) { const float mn = fmaxf(m, sm); const float corr = __builtin_amdgcn_exp2f(m - mn); l *= corr;
#pragma unroll
        for (int d = 0; d < 64; ++d) o[d] *= corr;
        m = mn; }
    const float p = valid ? __builtin_amdgcn_exp2f(s - m) : 0.f;
    l += p;
    const v4u* p4 = (const v4u*)vp;
#pragma unroll
    for (int c = 0; c < 8; ++c) { const v4u u = p4[c];
        o[8 * c + 0] = fmaf(p, bflo(u.x), o[8 * c + 0]); o[8 * c + 1] = fmaf(p, bfhi(u.x), o[8 * c + 1]); o[8 * c + 2] = fmaf(p, bflo(u.y), o[8 * c + 2]); o[8 * c + 3] = fmaf(p, bfhi(u.y), o[8 * c + 3]);
        o[8 * c + 4] = fmaf(p, bflo(u.z), o[8 * c + 4]); o[8 * c + 5] = fmaf(p, bfhi(u.z), o[8 * c + 5]); o[8 * c + 6] = fmaf(p, bflo(u.w), o[8 * c + 6]); o[8 * c + 7] = fmaf(p, bfhi(u.w), o[8 * c + 7]); }
}
__device__ __forceinline__ void store_row64(bf16* p, const float (&o)[64], float sc) {
    v4u* p4 = (v4u*)p;
#pragma unroll
    for (int c = 0; c < 8; ++c) { v4u w; w.x = pk2(o[8 * c + 0] * sc, o[8 * c + 1] * sc); w.y = pk2(o[8 * c + 2] * sc, o[8 * c + 3] * sc);
        w.z = pk2(o[8 * c + 4] * sc, o[8 * c + 5] * sc); w.w = pk2(o[8 * c + 6] * sc, o[8 * c + 7] * sc); p4[c] = w; }
}
__device__ __forceinline__ void attnA_naive(const bf16* qkv, bf16* ao, int item, int lane) {
    const int chunk = item & 63, hq = (item >> 6) & 3, b = item >> 8, kvh = hq >> 1, t = chunk * 64 + lane;
    float q[64], o[64];
    load_row64(qkv + (size_t)(b * SEQ + t) * NQKV + C_QA + hq * 64, q, 1.0f);
#pragma unroll
    for (int d = 0; d < 64; ++d) o[d] = 0.f;
    float m = -1e30f, l = 0.f;
    const bf16* kb = qkv + (size_t)b * SEQ * NQKV + C_KA + kvh * 64;
    const bf16* vb = qkv + (size_t)b * SEQ * NQKV + C_VA + kvh * 64;
    for (int j = 0; j < SEQ; ++j) { const float s = dot64(q, kb + (size_t)j * NQKV); online_update(s, true, vb + (size_t)j * NQKV, o, m, l); }
    store_row64(ao + (size_t)(b * SEQ + t) * DM + hq * 64, o, 1.0f / l);
}
__device__ __forceinline__ void attnB_naive(const bf16* qkv, const float* nab, bf16* ao, int item, int lane) {
    const int r = item & 63, bh = item >> 6, h = bh % 6, b = bh / 6, c = lane;
    const int rs = min(max(r - 4, 0), 56), cs = min(max(c - 8, 0), 48);
    float q[64], o[64];
    load_row64(qkv + (size_t)(b * SEQ + r * 64 + c) * NQKV + C_QB + h * 64, q, 1.0f);
#pragma unroll
    for (int d = 0; d < 64; ++d) o[d] = 0.f;
    float m = -1e30f, l = 0.f;
    for (int i = 0; i < 8; ++i)
        for (int jj = 0; jj < 16; ++jj) {
            const size_t krow = (size_t)(b * SEQ + (rs + i) * 64 + cs + jj) * NQKV;
            const float bias = nab[(h * 15 + (rs + i - r + 7)) * 31 + (cs + jj - c + 15)];
            const float s = dot64(q, qkv + krow + C_KB + h * 64) + bias * LOG2E;
            online_update(s, true, qkv + krow + C_VB + h * 64, o, m, l);
        }
    store_row64(ao + (size_t)(b * SEQ + r * 64 + c) * DM + 256 + h * 64, o, 1.0f / l);
}
__device__ __forceinline__ void attnC_naive(const bf16* qkv, bf16* ao, int item, int lane) {
    const int chunk = item & 63, bh = item >> 6, h = bh % 6, b = bh / 6, t = chunk * 64 + lane;
    float q[64], o[64];
    load_row64(qkv + (size_t)(b * SEQ + t) * NQKV + C_QC + h * 64, q, 1.0f);
#pragma unroll
    for (int d = 0; d < 64; ++d) o[d] = 0.f;
    float m = -1e30f, l = 0.f;
    for (int br = 0; br < 3; ++br) { const int dil = 1 << (2 * br);
        for (int j = -64; j <= 64; ++j) { const int pos = t + dil * j; const bool valid = (unsigned)pos < (unsigned)SEQ; const int pc = valid ? pos : t;
            const size_t krow = (size_t)(b * SEQ + pc) * NQKV;
            const float s = dot64(q, qkv + krow + C_KC + h * 64);
            online_update(s, valid, qkv + krow + C_VC + h * 64, o, m, l); } }
    store_row64(ao + (size_t)(b * SEQ + t) * DM + 640 + h * 64, o, 1.0f / l);
}

__device__ __forceinline__ void unpack16(const v4u u0, const v4u u1, float (&v)[16]) {
    v[0] = bflo(u0.x); v[1] = bfhi(u0.x); v[2] = bflo(u0.y); v[3] = bfhi(u0.y); v[4] = bflo(u0.z); v[5] = bfhi(u0.z); v[6] = bflo(u0.w); v[7] = bfhi(u0.w);
    v[8] = bflo(u1.x); v[9] = bfhi(u1.x); v[10] = bflo(u1.y); v[11] = bfhi(u1.y); v[12] = bflo(u1.z); v[13] = bfhi(u1.z); v[14] = bflo(u1.w); v[15] = bfhi(u1.w);
}
__device__ __forceinline__ void groupnorm_row2(const bf16* ao_, const bf16* part, const float* lse, int m0, int m1, const float* gout, bf16* mix_, int lane) {
    const int ms[2] = {m0, m1};
    v4u ld[2][6]; float ls[2][3];
    const int cc = 16 * lane - 640, hh = cc >> 6;
#pragma unroll
    for (int q = 0; q < 2; ++q) {
        if (lane < 40) { const v4u* a4 = (const v4u*)(ao_ + (size_t)ms[q] * DM) + 2 * lane; ld[q][0] = a4[0]; ld[q][1] = a4[1]; }
        else {
#pragma unroll
            for (int br = 0; br < 3; ++br) { const v4u* p4 = (const v4u*)(part + (size_t)br * MTOK * 384 + (size_t)ms[q] * 384 + cc); ld[q][2 * br] = p4[0]; ld[q][2 * br + 1] = p4[1];
                ls[q][br] = lse[(size_t)br * MTOK * 6 + (size_t)ms[q] * 6 + hh]; }
        }
    }
    const f32x4* g4 = (const f32x4*)gout + 4 * lane;
    const f32x4 g0 = g4[0], g1 = g4[1], g2 = g4[2], g3 = g4[3];
    if (lane < 40) { asm volatile("" : "+v"(ld[0][0]), "+v"(ld[0][1]), "+v"(ld[1][0]), "+v"(ld[1][1])); }
    else { asm volatile("" : "+v"(ld[0][0]), "+v"(ld[0][1]), "+v"(ld[0][2]), "+v"(ld[0][3]), "+v"(ld[0][4]), "+v"(ld[0][5]), "+v"(ld[1][0]), "+v"(ld[1][1]), "+v"(ld[1][2]), "+v"(ld[1][3]), "+v"(ld[1][4]), "+v"(ld[1][5])); }
    const int grp = lane < 16 ? 0 : (lane < 40 ? 1 : 2);
#pragma unroll
    for (int q = 0; q < 2; ++q) {
        float v[16];
        if (lane < 40) unpack16(ld[q][0], ld[q][1], v);
        else {
            const float l0 = ls[q][0], l1 = ls[q][1], l2 = ls[q][2];
            const float mx = fmaxf(l0, fmaxf(l1, l2));
            float w0 = __builtin_amdgcn_exp2f(l0 - mx), w1 = __builtin_amdgcn_exp2f(l1 - mx), w2 = __builtin_amdgcn_exp2f(l2 - mx);
            const float inv = 1.0f / (w0 + w1 + w2); w0 *= inv; w1 *= inv; w2 *= inv;
            float a[16], b[16], c[16];
            unpack16(ld[q][0], ld[q][1], a); unpack16(ld[q][2], ld[q][3], b); unpack16(ld[q][4], ld[q][5], c);
#pragma unroll
            for (int i = 0; i < 16; ++i) v[i] = w0 * a[i] + w1 * b[i] + w2 * c[i];
        }
        float ss = 0.f;
#pragma unroll
        for (int i = 0; i < 16; ++i) ss += v[i] * v[i];
        const float sa = wave_sum(grp == 0 ? ss : 0.f), sb = wave_sum(grp == 1 ? ss : 0.f), sc = wave_sum(grp == 2 ? ss : 0.f);
        const float rstd = (grp == 0) ? 1.0f / sqrtf(sa * (1.0f / 256.0f) + RMS_EPS) : (grp == 1) ? 1.0f / sqrtf(sb * (1.0f / 384.0f) + RMS_EPS) : 1.0f / sqrtf(sc * (1.0f / 384.0f) + RMS_EPS);
        v4u o0, o1;
        o0.x = pk2(v[0] * rstd * g0.x, v[1] * rstd * g0.y); o0.y = pk2(v[2] * rstd * g0.z, v[3] * rstd * g0.w); o0.z = pk2(v[4] * rstd * g1.x, v[5] * rstd * g1.y); o0.w = pk2(v[6] * rstd * g1.z, v[7] * rstd * g1.w);
        o1.x = pk2(v[8] * rstd * g2.x, v[9] * rstd * g2.y); o1.y = pk2(v[10] * rstd * g2.z, v[11] * rstd * g2.w); o1.z = pk2(v[12] * rstd * g3.x, v[13] * rstd * g3.y); o1.w = pk2(v[14] * rstd * g3.z, v[15] * rstd * g3.w);
        v4u* o4 = (v4u*)(mix_ + (size_t)ms[q] * DM) + 2 * lane; o4[0] = o0; o4[1] = o1;
    }
}

#define DPP_MOV_F(v, ctrl) __int_as_float(__builtin_amdgcn_update_dpp(0, __float_as_int(v), (ctrl), 0xf, 0xf, true))
__device__ __forceinline__ float swap32_add(float a, float b) { auto r = __builtin_amdgcn_permlane32_swap(__float_as_uint(a), __float_as_uint(b), false, false); return __uint_as_float(r[0]) + __uint_as_float(r[1]); }
__device__ __forceinline__ float swap16_add(float a, float b) { auto r = __builtin_amdgcn_permlane16_swap(__float_as_uint(a), __float_as_uint(b), false, false); return __uint_as_float(r[0]) + __uint_as_float(r[1]); }
__device__ __forceinline__ void router_phase(const bf16* h, const float* gffn, const float* wr, float* rs_, float* aff_, LAS unsigned char* lds, int tid, int lane, int q0, int qstep, int qend) {
    LAS float* wrT = (LAS float*)(lds + RING_OFF);
    for (int i = tid; i < DM * NE; i += NTHR) { const int col = i >> 4, e = i & 15; wrT[e * DM + col] = wr[i]; }
    __syncthreads();
    const bool b3 = (lane & 8) != 0, b2 = (lane & 4) != 0, b1 = (lane & 2) != 0, b0 = (lane & 1) != 0;
    for (int q4 = q0; q4 < qend; q4 += qstep) {
        const int m0 = q4 * 4;
        f32x4 v[4][4]; f32x4 g[4]; unsigned long long hx[4][4];
#pragma unroll
        for (int r = 0; r < 4; ++r) { const unsigned long long* xr = (const unsigned long long*)(h + (size_t)(m0 + r) * DM) + lane;
#pragma unroll
            for (int j = 0; j < 4; ++j) hx[r][j] = xr[64 * j]; }
#pragma unroll
        for (int r = 0; r < 4; ++r) PIN4V(hx[r]);
#pragma unroll
        for (int r = 0; r < 4; ++r)
#pragma unroll
            for (int j = 0; j < 4; ++j) { const unsigned long long x8 = hx[r][j]; const unsigned x0 = (unsigned)x8, x1 = (unsigned)(x8 >> 32); v[r][j] = (f32x4){bflo(x0), bfhi(x0), bflo(x1), bfhi(x1)}; }
#pragma unroll
        for (int j = 0; j < 4; ++j) g[j] = ((const f32x4*)gffn + lane)[64 * j];
#pragma unroll
        for (int r = 0; r < 4; ++r) { float s = 0.f;
#pragma unroll
            for (int j = 0; j < 4; ++j) s += (v[r][j].x * v[r][j].x + v[r][j].y * v[r][j].y) + (v[r][j].z * v[r][j].z + v[r][j].w * v[r][j].w);
            const float rstd = 1.0f / sqrtf(wave_sum(s) * (1.0f / DM) + RMS_EPS);
            if (lane == 0) { if (FUSE_RT) __hip_atomic_store(rs_ + m0 + r, rstd, __ATOMIC_RELAXED, __HIP_MEMORY_SCOPE_AGENT); else rs_[m0 + r] = rstd; }
#pragma unroll
            for (int j = 0; j < 4; ++j) { v[r][j].x = v[r][j].x * rstd * g[j].x; v[r][j].y = v[r][j].y * rstd * g[j].y; v[r][j].z = v[r][j].z * rstd * g[j].z; v[r][j].w = v[r][j].w * rstd * g[j].w; } }
        float pa[64];
#pragma unroll
        for (int e = 0; e < 16; ++e) { f32x4 w[4];
#pragma unroll
            for (int j = 0; j < 4; ++j) w[j] = *(const LAS f32x4*)(wrT + e * DM + 4 * lane + 256 * j);
#pragma unroll
            for (int r = 0; r < 4; ++r) { typedef float f2 __attribute__((ext_vector_type(2))); f2 a2 = {0.f, 0.f};
#pragma unroll
                for (int j = 0; j < 4; ++j) { a2 += (f2){v[r][j].x, v[r][j].y} * (f2){w[j].x, w[j].y}; a2 += (f2){v[r][j].z, v[r][j].w} * (f2){w[j].z, w[j].w}; }
                pa[16 * r + e] = a2.x + a2.y; }
            if ((e & 3) == 3) asm volatile("" ::: "memory"); }
        float p32[32], p16[16], p8[8], p4[4], p2[2];
#pragma unroll
        for (int i = 0; i < 32; ++i) p32[i] = swap32_add(pa[i], pa[i + 32]);
#pragma unroll
        for (int i = 0; i < 16; ++i) p16[i] = swap16_add(p32[i], p32[i + 16]);
#pragma unroll
        for (int i = 0; i < 8; ++i) { const float keep = b3 ? p16[i + 8] : p16[i], send = b3 ? p16[i] : p16[i + 8]; p8[i] = keep + DPP_MOV_F(send, 0x128); }
#pragma unroll
        for (int i = 0; i < 4; ++i) { const float keep = b2 ? p8[i + 4] : p8[i], send = b2 ? p8[i] : p8[i + 4]; const float hm = DPP_MOV_F(send, 0x141); p4[i] = keep + DPP_MOV_F(hm, 0x1B); }
#pragma unroll
        for (int i = 0; i < 2; ++i) { const float keep = b1 ? p4[i + 2] : p4[i], send = b1 ? p4[i] : p4[i + 2]; p2[i] = keep + DPP_MOV_F(send, 0x4E); }
        float lg; { const float keep = b0 ? p2[1] : p2[0], send = b0 ? p2[0] : p2[1]; lg = keep + DPP_MOV_F(send, 0xB1); }
        float mx = lg;
        mx = fmaxf(mx, DPP_MOV_F(mx, 0xB1)); mx = fmaxf(mx, DPP_MOV_F(mx, 0x4E)); mx = fmaxf(mx, DPP_MOV_F(mx, 0x141)); mx = fmaxf(mx, DPP_MOV_F(mx, 0x140));
        const float pe = expf(lg - mx);
        float sm = pe; sm = DPP_ADD_F(sm, 0xB1); sm = DPP_ADD_F(sm, 0x4E); sm = DPP_ADD_F(sm, 0x141); sm = DPP_ADD_F(sm, 0x140);
        { const int r = lane >> 4, e = lane & 15, b = m0 >> 12, sidx = (m0 & (SEQ - 1)) + r; if (FUSE_RT) __hip_atomic_store(aff_ + (size_t)(b * NE + e) * SEQ + sidx, pe / sm, __ATOMIC_RELAXED, __HIP_MEMORY_SCOPE_AGENT); else aff_[(size_t)(b * NE + e) * SEQ + sidx] = pe / sm; }
    }
    __syncthreads();
}

__device__ __forceinline__ unsigned short bf16_rne(float f) { return (unsigned short)(pk2(f, 0.f) & 0xffffu); }
__device__ __forceinline__ void router_mfma_phase(const bf16* h, const float* gffn, const float* wr, float* rs_, float* aff_, LAS unsigned char* lds, int tid, int lane, int gw, int NGW) {
    constexpr int WP = 1032;
    LAS unsigned short* wt = (LAS unsigned short*)(lds + RING_OFF);
#pragma unroll
    for (int bt = 0; bt < 4; ++bt) { float wv[8], gv[8];
#pragma unroll
        for (int j = 0; j < 8; ++j) { const int i = tid + NTHR * (8 * bt + j); wv[j] = wr[i]; gv[j] = gffn[i >> 4]; }
        asm volatile("" : "+v"(wv[0]), "+v"(wv[1]), "+v"(wv[2]), "+v"(wv[3]), "+v"(wv[4]), "+v"(wv[5]), "+v"(wv[6]), "+v"(wv[7]));
#pragma unroll
        for (int j = 0; j < 8; ++j) { const int i = tid + NTHR * (8 * bt + j); const int k = i >> 4, e = i & 15; const float w = wv[j] * gv[j];
            const unsigned short hi = bf16_rne(w); const float r1 = w - __uint_as_float((unsigned)hi << 16);
            const unsigned short lo = bf16_rne(r1); const float r2 = r1 - __uint_as_float((unsigned)lo << 16);
            const unsigned short l2 = bf16_rne(r2);
            wt[(0 * 16 + e) * WP + k] = hi; wt[(1 * 16 + e) * WP + k] = lo; wt[(2 * 16 + e) * WP + k] = l2; } }
    __syncthreads();
    const int r = lane & 15, kq = lane >> 4;
    for (int g = gw; g < MTOK / 16; g += NGW) {
        const v4u* ap = (const v4u*)(h + (size_t)(16 * g + r) * DM + 8 * kq);
        f32x4 acc = {0.f, 0.f, 0.f, 0.f}; float ss = 0.f;
        v4u aa[2][16];
#pragma unroll
        for (int hf = 0; hf < 2; ++hf)
#pragma unroll
            for (int s = 0; s < 16; ++s) aa[hf][s] = ap[(16 * hf + s) * 4];
#pragma unroll
        for (int hf = 0; hf < 2; ++hf) {
            v4u (&a)[16] = aa[hf];
            PIN4V(a); PIN4V(a + 4); PIN4V(a + 8); PIN4V(a + 12);
#pragma unroll
            for (int s = 0; s < 16; ++s) { const int ks = 16 * hf + s; const v4u u = a[s];
                ss += (bflo(u.x) * bflo(u.x) + bfhi(u.x) * bfhi(u.x)) + (bflo(u.y) * bflo(u.y) + bfhi(u.y) * bfhi(u.y)) + (bflo(u.z) * bflo(u.z) + bfhi(u.z) * bfhi(u.z)) + (bflo(u.w) * bflo(u.w) + bfhi(u.w) * bfhi(u.w));
                const bf16x8 af = __builtin_bit_cast(bf16x8, u);
#pragma unroll
                for (int tm = 0; tm < 3; ++tm) { const bf16x8 bfr = *(const LAS bf16x8*)(wt + (tm * 16 + r) * WP + 32 * ks + 8 * kq);
                    acc = __builtin_amdgcn_mfma_f32_16x16x32_bf16(af, bfr, acc, 0, 0, 0); } }
        }
        ss = xor16_add(ss); ss = xor32_add(ss);
        const float rstd = 1.0f / sqrtf(ss * (1.0f / DM) + RMS_EPS);
        if (kq == 0) rs_[16 * g + r] = rstd;
        f32x4 o;
#pragma unroll
        for (int j = 0; j < 4; ++j) { const float rr = __int_as_float(__builtin_amdgcn_ds_bpermute((4 * kq + j) << 2, __float_as_int(rstd))); const float lg = acc[j] * rr;
            float mx = lg; mx = fmaxf(mx, DPP_MOV_F(mx, 0xB1)); mx = fmaxf(mx, DPP_MOV_F(mx, 0x4E)); mx = fmaxf(mx, DPP_MOV_F(mx, 0x141)); mx = fmaxf(mx, DPP_MOV_F(mx, 0x140));
            const float pe = expf(lg - mx);
            float sm = pe; sm = DPP_ADD_F(sm, 0xB1); sm = DPP_ADD_F(sm, 0x4E); sm = DPP_ADD_F(sm, 0x141); sm = DPP_ADD_F(sm, 0x140);
            o[j] = pe / sm; }
        { const int m0 = 16 * g, b = m0 >> 12, s0 = m0 & (SEQ - 1); *(f32x4*)(aff_ + (size_t)(b * NE + r) * SEQ + s0 + 4 * kq) = o; }
    }
    __syncthreads();
}

__device__ __forceinline__ void topk_item(const float* aff_, int* idx_, float* gval_, int* sel_, const bf16* an_, const float* rs_, float* rsg_, bf16* xg_, int b, int e, int half, int nhalf, LAS unsigned char* lds, int tid, int lane, int wave) {
    LAS int* lidx = (LAS int*)(lds + RING_OFF + 1024);
    LAS int* sc = (LAS int*)(lds + RING_OFF);
    const f32x4* a4 = (const f32x4*)(aff_ + (size_t)(b * NE + e) * SEQ) + 2 * tid;
    const f32x4 x0 = a4[0], x1 = a4[1];
    unsigned v[8] = {__float_as_uint(x0.x), __float_as_uint(x0.y), __float_as_uint(x0.z), __float_as_uint(x0.w), __float_as_uint(x1.x), __float_as_uint(x1.y), __float_as_uint(x1.z), __float_as_uint(x1.w)};
    unsigned T = 0u;
    for (int bit = 30; bit >= 0; --bit) {
        const unsigned cand = T | (1u << bit);
        int c = 0;
#pragma unroll
        for (int i = 0; i < 8; ++i) c += (v[i] >= cand) ? 1 : 0;
        c = wave_sum_i(c);
        const int par = (bit & 1) * 8;
        if (lane == 0) sc[par + wave] = c;
        __syncthreads();
        int tot = 0;
#pragma unroll
        for (int w = 0; w < 8; ++w) tot += sc[par + w];
        if (tot >= CAP) T = cand;
    }
    int cg = 0, ce = 0;
#pragma unroll
    for (int i = 0; i < 8; ++i) { cg += (v[i] > T) ? 1 : 0; ce += (v[i] == T) ? 1 : 0; }
    int sg = cg, se = ce;
#pragma unroll
    for (int o = 1; o < 64; o <<= 1) { const int src = ((lane - o) & 63) << 2; const int tg = __builtin_amdgcn_ds_bpermute(src, sg), te = __builtin_amdgcn_ds_bpermute(src, se); if (lane >= o) { sg += tg; se += te; } }
    if (lane == 63) { sc[32 + wave] = sg; sc[48 + wave] = se; }
    __syncthreads();
    int baseg = 0, basee = 0, totg = 0;
#pragma unroll
    for (int w = 0; w < 8; ++w) { const int g = sc[32 + w], q = sc[48 + w]; if (w < wave) { baseg += g; basee += q; } totg += g; }
    int pg = baseg + sg - cg, pe = basee + se - ce;
    const int need = CAP - totg;
    const int R0 = (e * NB + b) * CAP;
#pragma unroll
    for (int i = 0; i < 8; ++i) { const int s = tid * 8 + i; int slot = -1;
        if (v[i] > T) { slot = pg; ++pg; }
        else if (v[i] == T) { if (pe < need) slot = totg + pe; ++pe; }
        if (half == 0) sel_[(size_t)(b * SEQ + s) * NE + e] = slot;
        if (slot >= 0) { lidx[slot] = s; if (half == 0) { idx_[R0 + slot] = s; gval_[R0 + slot] = __uint_as_float(v[i]) * (1.0f / (F8_SC_HID * F8_SC_WD)); } } }
    __syncthreads();
    const int per = CAP / nhalf;
    for (int c = half * per + wave * 64 + lane; c < (half + 1) * per; c += NWAVES * 64) rsg_[R0 + c] = rs_[b * SEQ + lidx[c]];
    __syncthreads();
}

#ifndef ONLY_PHASE
#define ONLY_PHASE -1
#endif
#define PHEN(k) (ONLY_PHASE < 0 || ONLY_PHASE == (k))
#ifndef PROBE_DUP
#define PROBE_DUP 0
#endif
#define PROBE_REPS 2
#define REP(k) _Pragma("unroll") for (int rep_ = 0; rep_ < ((PROBE_DUP >> (k)) & 1) + 1; ++rep_)
#define KAS __attribute__((address_space(4)))
#define PHV int ll = lane_id(); int gwl = gw, wvl = wave; asm volatile("" : "+s"(gwl), "+s"(wvl)); int tl = wvl * 64 + ll; (void)tl; (void)ll; (void)gwl; (void)wvl; \
    const KAS Args* ka = (const KAS Args*)__builtin_amdgcn_kernarg_segment_ptr(); asm volatile("" : "+s"(ka)); unsigned char* const ws = ka->ws; float* const hout = ka->out; (void)ws; (void)hout


#define cs_ax ((float2_t*)(ws + WS_TAB))
#define cs_1d ((float2_t*)(ws + WS_TAB + 65536))
#define aff ((float*)(ws + WS_AFF))
#define idx ((int*)(ws + WS_IDX))
#define gval ((float*)(ws + WS_GATE))
#define sel ((int*)(ws + WS_SEL))
#define Win_t ((bf16*)(ws + WS_WIN))
#define Wout_t ((bf16*)(ws + ((l & 1) ? WS_WOUT_ALT : WS_WOUT)))
#define Wpg_t ((bf16*)(ws + ((l & 1) ? WS_WPG_ALT : WS_WPG)))
#define Wpp_t ((bf16*)(ws + WS_WPP))
#define Wgu_t ((bf16*)(ws + WS_WGU + (size_t)(l & 1) * (32 * MiB)))
#define Wd_t ((bf16*)(ws + WS_WD + (size_t)(l & 1) * (16 * MiB)))
#define hY8 ((unsigned char*)(ws + WS_HY8))
#define pbf ((bf16*)(ws + WS_PBF))
#define an ((bf16*)(ws + WS_AN))
#define qkv ((bf16*)(ws + WS_QKV))
#define ao ((bf16*)(ws + WS_AO))
#define xg ((bf16*)(ws + WS_XG))
#define hid ((unsigned char*)(ws + WS_HID))
#define pp ((bf16*)(ws + WS_PP))
#define mix ((bf16*)(ws + WS_MIX))
#define yb ((bf16*)(ws + WS_Y))
#define y8 ((unsigned char*)(ws + WS_Y))
#define rsZ ((float*)(ws + WS_RSZ))
#define rsY ((float*)(ws + WS_RSY))
#define rsA ((float*)(ws + WS_RSA))
#define rsG ((float*)(ws + WS_RSG))
#define ssqP ((float*)(ws + WS_SSQ))
#define hY ((bf16*)(ws + WS_QKV))
#define hZ8 ((unsigned char*)(ws + WS_XG + 96 * MiB))
#define hZ ((bf16*)(ws + WS_XG))
#define cpart ((bf16*)(ws + WS_XG))
#define clse ((float*)(ws + WS_XG + 80 * MiB))
#define IN_X (ka->in[0])
#define IN_P (ka->in[1])
#define IN_GMIX (ka->in[2])
#define IN_WIN (ka->in[3])
#define IN_QKG (ka->in[4])
#define IN_NAB (ka->in[5])
#define IN_GOUT (ka->in[6])
#define IN_WOUT (ka->in[7])
#define IN_GFFN (ka->in[8])
#define IN_WR (ka->in[9])
#define IN_WG (ka->in[10])
#define IN_WU (ka->in[11])
#define IN_WD (ka->in[12])
#define IN_GPLE (ka->in[13])
#define IN_WPG (ka->in[14])
#define IN_WPP (ka->in[15])
__global__ void __launch_bounds__(NTHR, 2) mk_fwd(Args args) {
    extern __shared__ __attribute__((aligned(16))) unsigned char lds_raw[];
    LAS unsigned char* lds = (LAS unsigned char*)lds_raw;
    volatile LAS unsigned* MISC = (volatile LAS unsigned*)(lds + MISC_OFF);
    __builtin_amdgcn_s_setreg((0 << 11) | (23 << 6) | 1, 1);
    const int wave = __builtin_amdgcn_readfirstlane((int)threadIdx.x >> 6);
    const int G = gridDim.x;
    gu32* ctl = (gu32*)(args.ws + WS_CTL);
    int bid = blockIdx.x;
#if XCD_TRUE
    if (G == 256 && (args.ph_hi - args.ph_lo) > 1) {
        if (wave == 0 && lane_id() == 0) { const unsigned x = (unsigned)__builtin_amdgcn_s_getreg((3 << 11) | 20) & 0xFu; const unsigned r = __hip_atomic_fetch_add(ctl + CW_XRANK + 64 * x, 1u, __ATOMIC_RELAXED, __HIP_MEMORY_SCOPE_AGENT);
            unsigned sp = 0; bool ok = true;
            for (;;) { unsigned tot = 0, bad = 0;
#pragma unroll
                for (int j = 0; j < 16; ++j) { const unsigned c = __hip_atomic_load(ctl + CW_XRANK + 64 * j, __ATOMIC_RELAXED, __HIP_MEMORY_SCOPE_AGENT); tot += c; bad |= (j < 8) ? (c > 32u) : (c != 0u); }
                if (bad) { ok = false; break; } if (tot == 256u) break;
                __builtin_amdgcn_s_sleep(1); if (++sp > (1u << 20)) { ok = false; break; } }
            ((LAS int*)(lds + MISC_OFF))[16] = ok ? (int)(x + 8u * r) : -1; }
        __syncthreads();
        const int vb = ((LAS int*)(lds + MISC_OFF))[16]; if (vb >= 0) bid = vb;
        __syncthreads();
    }
#endif
    const int gw = bid * NWAVES + wave, NGW = G * NWAVES, NGT = G * NTHR;

    for (int u = wave * 64 + lane_id(); u < (LDS_BYTES - LDSCTL_OFF) / 4; u += NTHR) ((LAS unsigned*)(lds + LDSCTL_OFF))[u] = 0u;
    __syncthreads();
    const int lo = args.ph_lo, hi = args.ph_hi;
    const bool use_bar = (hi - lo) > 1;
    XcdBarrier bar; bar.bar = (unsigned*)(ctl + CW_BAR); bar.x = 0; bar.st = nullptr;
    if (use_bar) bar = xcd_barrier_post((unsigned*)(ctl + CW_BAR), MISC + 8);
#define IN(k) (lo <= (k) && (k) < hi)
#define SEAM(k) do { if (IN(k) && IN((k) + 1)) xcd_barrier(bar); } while (0)

    if (PHEN(100) && IN(0)) { PHV;
        const int gtid0 = bid * NTHR + tl;
        for (int i = gtid0; i < 64 * 16 + SEQ * 8; i += NGT) {
            float c, s;
            if (i < 1024) { const int pos = i >> 4, j = i & 15; sincos_acc((float)pos * ka->inv_ax[j], c, s); cs_ax[i].x = c; cs_ax[i].y = s; }
            else { const int k = i - 1024, pos = k >> 3, j = k & 7; sincos_acc((float)pos * ka->inv_1d[j], c, s); cs_1d[k].x = c; cs_1d[k].y = s; }
        }
        for (int m = gwl; m < MTOK / 2; m += NGW) cast_row2(IN_X + (size_t)m * DM, IN_X + (size_t)(m + MTOK / 2) * DM, an + (size_t)m * DM, an + (size_t)(m + MTOK / 2) * DM, rsA + m, rsA + m + MTOK / 2, ll);
        convert_layer(ka, 0, 0, lds, gwl, NGW, wvl, ll, gtid0, NGT);
    }
    SEAM(0);

    for (int l = 0; l < DEPTH; ++l) {
        const int pb = 1 + l * NPH_LAYER;
        if (PHEN(0) && IN(pb + 0)) REP(0) { PHV;
            pg8::Gemm g{(l == 0) ? an : (bf16*)hout, Win_t, MTOK, NQKV, DM}; DupStatic<0> S; S.init(MTOK, NQKV, G, bid);
            if (l > 0) {
                for (int i0 = 0; ; i0 += 3) {
                    pg8::Unit uu; int rw[3]; f32x4 pa[3][4]; bool any = false;
#pragma unroll
                    for (int i = 0; i < 3; ++i) { const bool v = S.next(i0 + i, uu); any |= v; rw[i] = v ? uu.pm * 256 + (tl & 255) : -1; const f32x4* p4 = (const f32x4*)(ssqP + (size_t)(v ? rw[i] : 0) * 16);
#pragma unroll
                        for (int q = 0; q < 4; ++q) pa[i][q] = p4[q]; }
                    if (!any) break;
#pragma unroll
                    for (int i = 0; i < 3; ++i) if (tl < 256 && rw[i] >= 0) { const f32x4 a = pa[i][0], b = pa[i][1], c = pa[i][2], d = pa[i][3];
                        const float s = ((a.x + a.y) + (a.z + a.w)) + ((b.x + b.y) + (b.z + b.w)) + ((c.x + c.y) + (c.z + c.w)) + ((d.x + d.y) + (d.z + d.w));
                        rsA[rw[i]] = 1.0f / sqrtf(s * (1.0f / DM) + RMS_EPS); }
                }
                asm volatile("s_waitcnt vmcnt(0)" ::: "memory"); __syncthreads();
            }
            EpiQKV E{qkv, IN_QKG + (size_t)l * 3 * 2 * 64, cs_ax, cs_1d, rsA};
            pg8::gemm_phase<EpiQKV, DupStatic<0>, true, true>(lds + RING_OFF, g, S, E, tl);
            { const bool split = (G == 256); const int g2 = split ? 128 : G, c2 = split ? bid - 128 : bid;
              if (c2 >= 0) { pg8::Gemm gp{pbf, Wpp_t, MTOK, DM, DPLE}; pg8::StaticOrder S2; S2.init(MTOK, DM, g2, c2);
                EpiStoreBf16NP E2{pp};
                pg8::gemm_phase<EpiStoreBf16NP, pg8::StaticOrder, true, true>(lds + RING_OFF, gp, S2, E2, wvl * 64 + lane_id()); } }
        }
        SEAM(pb + 0);
        if (PHEN(1) && IN(pb + 1)) REP(1) { PHV;
#pragma unroll 1
          for (int pass_ = 0; pass_ < 2; ++pass_) {
            if (pass_ == (bid & 1)) {
                asm volatile("s_waitcnt vmcnt(0) lgkmcnt(0)" ::: "memory"); __syncthreads();
                { const int l2_ = lane_id(); int w2_ = wvl; asm volatile("" : "+s"(w2_));
                  convert_layer(ka, 1, l, lds, bid * NWAVES + w2_, NGW, w2_, l2_, bid * NTHR + w2_ * 64 + l2_, NGT); }
                asm volatile("s_waitcnt vmcnt(0) lgkmcnt(0)" ::: "memory"); __syncthreads();
            }
            if (pass_ == 0) {
#ifdef NAIVE_ATTA
            for (int it = gwl; it < NB * 4 * 64; it += NGW) attnA_naive(qkv, ao, it, ll);
#else
            { const attn_body::AttnTensors AT{(const attn_body::bf16*)(qkv + C_QA), (const attn_body::bf16*)(qkv + C_KA), (const attn_body::bf16*)(qkv + C_VA), (attn_body::bf16*)ao};
              const attn_body::StaticOrder S(G, bid);
              attn_body::attn_phase<attn_body::StaticOrder>((char*)lds_raw + RING_OFF, AT, S, lane_id(), wvl); }
#endif
#ifdef NAIVE_ATTBC
            for (int it = gwl; it < NB * 6 * 64; it += NGW) attnB_naive(qkv, IN_NAB + (size_t)l * 6 * 15 * 31, ao, it, ll);
            for (int it = gwl; it < NB * 6 * 64; it += NGW) attnC_naive(qkv, ao, it, ll);
#else
#ifndef PROBE_DUPB
#define PROBE_DUPB 0
#endif
#ifndef PROBE_DUPC
#define PROBE_DUPC 0
#endif
#ifndef WAVE_B
#define WAVE_B 0
#endif
#ifndef WAVE_C
#define WAVE_C 0
#endif
#if WAVE_B
            attn_body::attnB_wave_phase((char*)lds_raw, (const attn_body::bf16*)qkv, C_QB, C_KB, C_VB, IN_NAB + (size_t)l * 6 * 15 * 31, (attn_body::bf16*)ao, G, bid, lane_id(), wvl);
            asm volatile("s_waitcnt vmcnt(0) lgkmcnt(0)\n\ts_barrier" ::: "memory");
#else
            for (int rb_ = 0; rb_ < 1 + PROBE_DUPB; ++rb_) attn_body::attnB_phase((char*)lds_raw + RING_OFF, (const attn_body::bf16*)qkv, C_QB, C_KB, C_VB, IN_NAB + (size_t)l * 6 * 15 * 31, (attn_body::bf16*)ao, G, bid, lane_id(), wvl);
#endif
#if WAVE_C
            attn_body::attnC_wave_phase((char*)lds_raw, (const attn_body::bf16*)qkv, C_QC, C_KC, C_VC, (attn_body::bf16*)cpart, clse, G, bid, lane_id(), wvl);
            asm volatile("s_waitcnt vmcnt(0) lgkmcnt(0)\n\ts_barrier" ::: "memory");
#else
            for (int rc_ = 0; rc_ < 1 + PROBE_DUPC; ++rc_) attn_body::attnC_phase((char*)lds_raw + RING_OFF, (const attn_body::bf16*)qkv, C_QC, C_KC, C_VC, (attn_body::bf16*)cpart, clse, G, bid, lane_id(), wvl);
#endif
#endif
            }
          }
        }
        SEAM(pb + 1);
        if (PHEN(2) && IN(pb + 2)) REP(2) { PHV;
            for (int m = gwl; m < MTOK / 2; m += NGW) groupnorm_row2(ao, cpart, clse, m, m + MTOK / 2, IN_GOUT + (size_t)l * DM, mix, ll);
        }
        SEAM(pb + 2);
        if (PHEN(3) && IN(pb + 3)) REP(3) { PHV;
            pg8::Gemm g{mix, Wout_t, MTOK, DM, DM}; DupStatic<3> S; S.init(MTOK, DM, G, bid);
            EpiResid E{(l == 0) ? (const bf16*)an : (const bf16*)hout, hY, hY8};
            pg8::gemm_phase<EpiResid, DupStatic<3>, ALIGN_RMW, true>(lds + RING_OFF, g, S, E, tl);
        }
        SEAM(pb + 3);
        if (PHEN(4) && IN(pb + 4)) REP(4) { PHV;
            if (FUSE_RT && G == 256 && IN(pb + 5)) {
                const int bat = bid >> 5, j = bid & 31;
                router_phase(hY, IN_GFFN + (size_t)l * DM, IN_WR + (size_t)l * DM * NE, rsY, aff, lds, tl, ll, bat * 1024 + j * 32 + wvl, NWAVES, bat * 1024 + j * 32 + 32);
                asm volatile("s_waitcnt vmcnt(0)" ::: "memory"); __syncthreads();
                if (tl == 0) { gu32* cnt = ctl + CW_GRP + ((l * PROBE_REPS + rep_) * NB + bat) * 64;
                    __hip_atomic_fetch_add(cnt, 1u, __ATOMIC_RELAXED, __HIP_MEMORY_SCOPE_AGENT);
                    unsigned sp = 0; while (__hip_atomic_load(cnt, __ATOMIC_RELAXED, __HIP_MEMORY_SCOPE_AGENT) < 32u) { __builtin_amdgcn_s_sleep(1); if (++sp > (1u << 22)) { __hip_atomic_store(ctl + 0, 0xDEAD0004u, __ATOMIC_RELAXED, __HIP_MEMORY_SCOPE_AGENT); break; } }
                    __builtin_amdgcn_fence(__ATOMIC_ACQUIRE, "agent"); asm volatile("s_waitcnt vmcnt(0)" ::: "memory"); }
                __syncthreads();
                __builtin_amdgcn_fence(__ATOMIC_ACQUIRE, "agent"); asm volatile("s_waitcnt vmcnt(0)" ::: "memory");
                topk_item(aff, idx, gval, sel, hY, rsY, rsG, xg, bat, j >> 1, j & 1, 2, lds, tl, ll, wvl);
            } else if (ROUTER_MFMA) router_mfma_phase(hY, IN_GFFN + (size_t)l * DM, IN_WR + (size_t)l * DM * NE, rsY, aff, lds, tl, ll, gwl, NGW);
            else router_phase(hY, IN_GFFN + (size_t)l * DM, IN_WR + (size_t)l * DM * NE, rsY, aff, lds, tl, ll, gwl, NGW, MTOK / 4);
        }
        if (!(FUSE_RT && G == 256 && IN(pb + 4) && IN(pb + 5))) SEAM(pb + 4);
        if (PHEN(5) && IN(pb + 5) && !(FUSE_RT && G == 256 && IN(pb + 4))) REP(5) { PHV;
            const int nh = (G >= 2 * NB * NE) ? 2 : 1, ng = G / nh;
            if (bid < ng * nh) for (int it = bid / nh; it < NB * NE; it += ng) topk_item(aff, idx, gval, sel, hY, rsY, rsG, xg, it >> 4, it & 15, bid % nh, nh, lds, tl, ll, wvl);
        }
        SEAM(pb + 5);
        if (PHEN(7) && IN(pb + 7)) REP(7) { PHV;
            GroupedOrder S; S.init(2048, G, bid);
            LAS int* gtok = (LAS int*)(lds + GTOK_OFF);
            { pg8::Unit uu; int Rv[GTOK_UNITS], iv[GTOK_UNITS];
#pragma unroll
              for (int i = 0; i < GTOK_UNITS; ++i) { Rv[i] = S.next(i, uu) ? uu.pm * 256 + (tl & 255) : -1; iv[i] = (Rv[i] >= 0) ? idx[Rv[i]] : 0; }
#pragma unroll
              for (int i = 0; i < GTOK_UNITS; ++i) if (tl < 256 && Rv[i] >= 0) gtok[i * 256 + tl] = ((Rv[i] >> 9) & 7) * SEQ + iv[i]; }
            __syncthreads();
            pg8::Gemm g{(const bf16*)hY8, Wgu_t, MR, 2048, DM / 2};
            EpiSwiGLU E{hid, rsG};
            pg8::gemm_phase<EpiSwiGLU, GroupedOrder, true, true, true, true>(lds + RING_OFF, g, S, E, tl, gtok);
        }
        SEAM(pb + 7);
        if (PHEN(8) && IN(pb + 8)) REP(8) { PHV;
            pg8::Gemm g{(const bf16*)hid, Wd_t, MR, DM, DFF / 2}; GroupedOrder S; S.init(DM, G, bid);
            LAS int* gtok = (LAS int*)(lds + GTOK_OFF);
            { pg8::Unit uu;
#pragma unroll
              for (int i = 0; i < GTOK_UNITS; ++i) if (S.next(i, uu) && tl < 256) gtok[i * 256 + tl] = uu.pm * 256 + tl; }
            __syncthreads();
            EpiStoreF8 E{y8};
            pg8::gemm_phase<EpiStoreF8, GroupedOrder, true, true, true, true>(lds + RING_OFF, g, S, E, tl, gtok);
        }
        SEAM(pb + 8);
        if (PHEN(9) && IN(pb + 9)) REP(9) { PHV;
            for (int q4 = gwl; q4 < MTOK / 4; q4 += NGW) {
                const int m0 = q4 * 4, b = m0 >> 12;
                f32x4 v[4][4]; unsigned long long hx[4][4];
#pragma unroll
                for (int r = 0; r < 4; ++r) { const unsigned long long* hr = (const unsigned long long*)(hY + (size_t)(m0 + r) * DM) + ll;
#pragma unroll
                    for (int j = 0; j < 4; ++j) hx[r][j] = hr[64 * j]; }
                const int slot = sel[(size_t)m0 * NE + ll];
                const int Rv = ((ll & 15) * NB + b) * CAP + (slot < 0 ? 0 : slot);
                const float gv = gval[Rv];
                const unsigned long long msk = __ballot(slot >= 0);
                unsigned mj[4] = {(unsigned)(msk & 0xffffu), (unsigned)((msk >> 16) & 0xffffu), (unsigned)((msk >> 32) & 0xffffu), (unsigned)((msk >> 48) & 0xffffu)};
#pragma unroll
                for (int r = 0; r < 4; ++r)
#pragma unroll
                    for (int j = 0; j < 4; ++j) v[r][j] = (f32x4){0.f, 0.f, 0.f, 0.f};
                while ((mj[0] | mj[1] | mj[2] | mj[3]) != 0u) {
                    unsigned yv[4][4]; float gt[4];
#pragma unroll
                    for (int r = 0; r < 4; ++r) { const bool has = mj[r] != 0u; const int i = has ? __builtin_ctz(mj[r]) : 0; mj[r] &= mj[r] - 1u;
                        const int R = __builtin_amdgcn_readlane(Rv, 16 * r + i); const float g = __uint_as_float(__builtin_amdgcn_readlane(__float_as_uint(gv), 16 * r + i)); gt[r] = has ? g : 0.f;
                        const unsigned* yr = (const unsigned*)(y8 + (size_t)R * DM) + ll;
#pragma unroll
                        for (int j = 0; j < 4; ++j) yv[r][j] = yr[64 * j]; }
#pragma unroll
                    for (int r = 0; r < 4; ++r) PIN4V(yv[r]);
#pragma unroll
                    for (int r = 0; r < 4; ++r)
#pragma unroll
                        for (int j = 0; j < 4; ++j) { const auto lo = __builtin_amdgcn_cvt_pk_f32_fp8((int)yv[r][j], false), hi2 = __builtin_amdgcn_cvt_pk_f32_fp8((int)yv[r][j], true);
                            v[r][j].x += gt[r] * lo[0]; v[r][j].y += gt[r] * lo[1]; v[r][j].z += gt[r] * hi2[0]; v[r][j].w += gt[r] * hi2[1]; }
                }
#pragma unroll
                for (int r = 0; r < 4; ++r) PIN4V(hx[r]);
#pragma unroll
                for (int r = 0; r < 4; ++r)
#pragma unroll
                    for (int j = 0; j < 4; ++j) { const unsigned long long x8 = hx[r][j]; const unsigned x0 = (unsigned)x8, x1 = (unsigned)(x8 >> 32); v[r][j].x += bflo(x0); v[r][j].y += bfhi(x0); v[r][j].z += bflo(x1); v[r][j].w += bfhi(x1); }
#pragma unroll
                for (int r = 0; r < 4; ++r) { unsigned long long* hw = (unsigned long long*)(hZ + (size_t)(m0 + r) * DM) + ll; unsigned* hw8 = (unsigned*)(hZ8 + (size_t)(m0 + r) * DM) + ll; float s = 0.f;
#pragma unroll
                    for (int j = 0; j < 4; ++j) { hw[64 * j] = (unsigned long long)pk2(v[r][j].x, v[r][j].y) | ((unsigned long long)pk2(v[r][j].z, v[r][j].w) << 32); hw8[64 * j] = pk4_f8(v[r][j].x, v[r][j].y, v[r][j].z, v[r][j].w); s += (v[r][j].x * v[r][j].x + v[r][j].y * v[r][j].y) + (v[r][j].z * v[r][j].z + v[r][j].w * v[r][j].w); }
                    const float rstd = 1.0f / sqrtf(wave_sum(s) * (1.0f / DM) + RMS_EPS);
                    if (ll == 0) rsZ[m0 + r] = rstd * (1.0f / F8_SC_W); }
            }
        }
        SEAM(pb + 9);
        if (PHEN(10) && IN(pb + 10)) REP(10) { PHV;
            pg8::Gemm g{(const bf16*)hZ8, Wpg_t, MTOK, DM, DM / 2}; DupStatic<10> S; S.init(MTOK, DM, G, bid);
            LAS int* gtok = (LAS int*)(lds + GTOK_OFF);
            { pg8::Unit uu;
#pragma unroll
              for (int i = 0; i < GTOK_UNITS; ++i) if (S.next(i, uu) && tl < 256) gtok[i * 256 + tl] = uu.pm * 256 + tl; }
            __syncthreads();
            EpiPLE E{hZ, (l == DEPTH - 1) ? hout : (float*)nullptr, (bf16*)hout, pp, rsZ, ssqP};
            pg8::gemm_phase<EpiPLE, DupStatic<10>, ALIGN_RMW, true, true, true>(lds + RING_OFF, g, S, E, tl, gtok);
        }
        SEAM(pb + 10);
    }
#undef IN
#undef SEAM
}

#ifndef MK_ONE_LAUNCH
#define MK_ONE_LAUNCH 1
#endif
extern "C" void kernel_launch(void* const* d_in, const int* in_sizes, int n_in, void* d_out, int out_size, void* d_ws, size_t ws_size, hipStream_t stream) {
    static int grid = 0;
    if (grid == 0) {
        if (n_in != 16 || out_size != MTOK * DM || ws_size < WS_END) { fprintf(stderr, "kernel_launch: unexpected shapes (n_in %d out %d ws %zu)\n", n_in, out_size, ws_size); grid = -1; return; }
        int dev = 0, cus = 0, per_cu = 0;
        if (hipGetDevice(&dev) != hipSuccess || hipDeviceGetAttribute(&cus, hipDeviceAttributeMultiprocessorCount, dev) != hipSuccess) { grid = -1; return; }
        if (hipFuncSetAttribute((const void*)mk_fwd, hipFuncAttributeMaxDynamicSharedMemorySize, LDS_BYTES) != hipSuccess) { fprintf(stderr, "kernel_launch: hipFuncSetAttribute failed\n"); grid = -1; return; }
        if (hipOccupancyMaxActiveBlocksPerMultiprocessor(&per_cu, (const void*)mk_fwd, NTHR, LDS_BYTES) != hipSuccess || per_cu < 1) fprintf(stderr, "kernel_launch: occupancy query says %d\n", per_cu);
        (void)hipGetLastError();
        grid = cus;
        if (grid * GTOK_UNITS * 256 < MR * 8) { fprintf(stderr, "kernel_launch: built for >= 256 CUs (the expert GEMM's row table holds %d units per workgroup); got %d\n", GTOK_UNITS, grid); grid = -1; return; }
    }
    if (grid < 0) return;
    (void)hipMemsetAsync((char*)d_ws + WS_CTL, 0, CTL_ZERO_BYTES, stream);
    Args a{};
    for (int i = 0; i < 16; ++i) a.in[i] = (const float*)d_in[i];
    a.out = (float*)d_out; a.ws = (unsigned char*)d_ws;
    for (int j = 0; j < 16; ++j) a.inv_ax[j] = (float)pow(10000.0, -(double)j / 16.0);
    for (int j = 0; j < 8; ++j) a.inv_1d[j] = (float)pow(500000.0, -(double)j / 8.0);
#if MK_ONE_LAUNCH
    a.ph_lo = 0; a.ph_hi = NPHASES;
    hipLaunchKernelGGL(mk_fwd, dim3(grid), dim3(NTHR), LDS_BYTES, stream, a);
#else
    for (int ph = 0; ph < NPHASES - 1; ++ph) { a.ph_lo = ph; a.ph_hi = ph + 1; hipLaunchKernelGGL(mk_fwd, dim3(grid), dim3(NTHR), LDS_BYTES, stream, a); }
#endif
}
```
